# Optimizing an MI355X kernel written in HIP

```python
import math
import jax, jax.numpy as jnp
from jax import lax
import numpy as np

D_MODEL = 1024
BATCH = 8
SEQ = 2048
DEPTH = 1

N_MEM = 256
A_HEADS = 4
A_HEAD_DIM = 64
A_V_DIM = 2 * A_HEAD_DIM
B_GROUPS = ((128, 1), (512, 4), (2048, 16))
B_HEADS_PER_GROUP = 4
B_HEAD_DIM = 128
C_HEADS = 4
C_HEAD_DIM = 128
N_BRANCHES = 3
BRANCH_WIDTH = 512
D_FF = -(-8 * D_MODEL // (3 * 256)) * 256
Q_BLOCK = 128
EPS = 1e-6
ALIBI_MAX_BIAS = 8.0

A_QK_COLS = A_HEADS * 2 * A_HEAD_DIM
A_V_COLS = A_HEADS * A_V_DIM
B_COLS = len(B_GROUPS) * B_HEADS_PER_GROUP * B_HEAD_DIM
C_Q_COLS = C_HEADS * C_HEAD_DIM
IN_SIZES = (A_QK_COLS, A_QK_COLS, A_V_COLS, B_COLS, B_COLS, B_COLS, C_Q_COLS)
D_IN = sum(IN_SIZES)

kernel_name = 'gated_hybrid_diff_dilated_memory_block'


def rms_norm(x, g):
    xf = x.astype(jnp.float32)
    y = xf * lax.rsqrt(jnp.mean(xf * xf, axis=-1, keepdims=True) + EPS)
    return (y * g.astype(jnp.float32)).astype(x.dtype)


def alibi_slopes(n):
    return jnp.exp2(-ALIBI_MAX_BIAS * jnp.arange(1, n + 1, dtype=jnp.float32) / n)


def diff_attention(q, k, v, slopes, lam):
    b, t, h, _, dh = q.shape
    nq = t // Q_BLOCK
    scale = dh ** -0.5
    pos_k = jnp.arange(t, dtype=jnp.int32)
    q_blocks = q.reshape(b, nq, Q_BLOCK, h, 2, dh).transpose(1, 0, 2, 3, 4, 5)
    starts = jnp.arange(nq, dtype=jnp.int32) * Q_BLOCK

    def one_block(args):
        qb, start = args
        s = jnp.einsum('bqhcd,bkhcd->bhcqk', qb, k).astype(jnp.float32) * scale
        pos_q = start + jnp.arange(Q_BLOCK, dtype=jnp.int32)
        dist = jnp.abs(pos_q[:, None] - pos_k[None, :]).astype(jnp.float32)
        s = s - slopes[None, :, None, None, None] * dist[None, None, None]
        p = jax.nn.softmax(s, axis=-1)
        p_diff = p[:, :, 0] - lam * p[:, :, 1]
        return jnp.einsum('bhqk,bkhe->bqhe', p_diff.astype(v.dtype), v)

    o = lax.map(one_block, (q_blocks, starts))
    return o.transpose(1, 0, 2, 3, 4).reshape(b, t, h, v.shape[-1])


def dilated_window_attention(q, k, v, slopes, window, dilation):
    b, t, h, hd = q.shape
    n_side = window // (2 * dilation)
    sub_len = t // dilation
    blk = n_side
    nb = -(-sub_len // blk)
    pad = nb * blk - sub_len

    def to_sub(a):
        return a.reshape(b, sub_len, dilation, h, hd).transpose(0, 2, 3, 1, 4)

    qs = jnp.pad(to_sub(q), ((0, 0), (0, 0), (0, 0), (0, pad), (0, 0)))
    qs = qs.reshape(b, dilation, h, nb, blk, hd)

    def windows(a):
        ap = jnp.pad(to_sub(a), ((0, 0), (0, 0), (0, 0), (blk, blk + pad), (0, 0)))
        ap = ap.reshape(b, dilation, h, nb + 2, blk, hd)
        return jnp.concatenate([ap[:, :, :, :-2], ap[:, :, :, 1:-1], ap[:, :, :, 2:]], axis=4)

    kw, vw = windows(k), windows(v)
    s = jnp.einsum('brhnqd,brhnkd->brhnqk', qs, kw).astype(jnp.float32) * hd ** -0.5
    q_idx = jnp.arange(nb)[:, None, None] * blk + jnp.arange(blk)[None, :, None]
    k_idx = (jnp.arange(nb)[:, None, None] - 1) * blk + jnp.arange(3 * blk)[None, None, :]
    rel = k_idx - q_idx
    valid = (jnp.abs(rel) <= n_side) & (k_idx >= 0) & (k_idx < sub_len)
    dist = (dilation * jnp.abs(rel)).astype(jnp.float32)
    s = s - slopes[None, None, :, None, None, None] * dist
    s = jnp.where(valid, s, -jnp.inf)
    lse = jax.nn.logsumexp(s, axis=-1)
    p = jnp.exp(s - lse[..., None])
    o = jnp.einsum('brhnqk,brhnkd->brhnqd', p.astype(v.dtype), vw)
    o = o.reshape(b, dilation, h, nb * blk, hd)[:, :, :, :sub_len]
    lse = lse.reshape(b, dilation, h, nb * blk)[:, :, :, :sub_len]
    o = o.transpose(0, 3, 1, 2, 4).reshape(b, t, h, hd)
    lse = lse.transpose(0, 3, 1, 2).reshape(b, t, h)
    return o, lse


def memory_attention(q, k, v):
    s = jnp.einsum('bthd,bnhd->bhtn', q, k).astype(jnp.float32) * q.shape[-1] ** -0.5
    p = jax.nn.softmax(s, axis=-1)
    return jnp.einsum('bhtn,bnhd->bthd', p.astype(v.dtype), v)


def setup_inputs(seed: int = 0) -> dict:
    key = jax.random.key(seed)
    ks = jax.random.split(key, 32)
    L = DEPTH

    def nrm(k, shape, fan_in):
        return jax.random.normal(k, shape, jnp.float32) * fan_in ** -0.5

    def gain(k, shape):
        return 1.0 + 0.02 * jax.random.normal(k, shape, jnp.float32)

    def small(k, shape, scale):
        return scale * jax.random.normal(k, shape, jnp.float32)

    return {
        'x': jax.random.normal(ks[0], (BATCH, SEQ, D_MODEL), jnp.float32),
        'mem': jax.random.normal(ks[1], (BATCH, N_MEM, D_MODEL), jnp.float32),
        'norm_mix': gain(ks[2], (L, D_MODEL)),
        'w_in': nrm(ks[3], (L, D_MODEL, D_IN), D_MODEL),
        'w_gate': nrm(ks[4], (L, D_MODEL, N_BRANCHES * D_MODEL), D_MODEL),
        'b_gate': small(ks[5], (L, N_BRANCHES * D_MODEL), 0.02),
        'a_q_norm': gain(ks[6], (L, A_HEAD_DIM)),
        'a_k_norm': gain(ks[7], (L, A_HEAD_DIM)),
        'a_lambda_q1': small(ks[8], (L, A_HEAD_DIM), 0.1),
        'a_lambda_k1': small(ks[9], (L, A_HEAD_DIM), 0.1),
        'a_lambda_q2': small(ks[10], (L, A_HEAD_DIM), 0.1),
        'a_lambda_k2': small(ks[11], (L, A_HEAD_DIM), 0.1),
        'a_subln': gain(ks[12], (L, A_V_DIM)),
        'b_q_norm': gain(ks[13], (L, B_HEAD_DIM)),
        'b_k_norm': gain(ks[14], (L, B_HEAD_DIM)),
        'mem_norm': gain(ks[15], (L, D_MODEL)),
        'w_mem_kv': nrm(ks[16], (L, D_MODEL, 2 * C_HEADS * C_HEAD_DIM), D_MODEL),
        'c_q_norm': gain(ks[17], (L, C_HEAD_DIM)),
        'c_k_norm': gain(ks[18], (L, C_HEAD_DIM)),
        'w_branch': nrm(ks[19], (L, N_BRANCHES, BRANCH_WIDTH, D_MODEL), BRANCH_WIDTH),
        'w_out': nrm(ks[20], (L, D_MODEL, D_MODEL), D_MODEL),
        'norm_ffn': gain(ks[21], (L, D_MODEL)),
        'w_ffn_gate': nrm(ks[22], (L, D_MODEL, D_FF), D_MODEL),
        'w_ffn_up': nrm(ks[23], (L, D_MODEL, D_FF), D_MODEL),
        'w_ffn_down': nrm(ks[24], (L, D_FF, D_MODEL), D_FF),
    }


def reference(x, mem, norm_mix, w_in, w_gate, b_gate, a_q_norm, a_k_norm, a_lambda_q1, a_lambda_k1,
              a_lambda_q2, a_lambda_k2, a_subln, b_q_norm, b_k_norm, mem_norm, w_mem_kv, c_q_norm,
              c_k_norm, w_branch, w_out, norm_ffn, w_ffn_gate, w_ffn_up, w_ffn_down):
    b, t, d = x.shape
    n_mem = mem.shape[1]
    n_groups = len(B_GROUPS)
    offsets = [int(o) for o in np.cumsum(IN_SIZES)[:-1]]
    slopes_a = alibi_slopes(A_HEADS)
    slopes_b = alibi_slopes(n_groups * B_HEADS_PER_GROUP).reshape(n_groups, B_HEADS_PER_GROUP)
    for l in range(DEPTH):
        lambda_init = 0.8 - 0.6 * math.exp(-0.3 * l)
        h = rms_norm(x, norm_mix[l])
        aq, ak, av, bq, bk, bv, cq = jnp.split(h @ w_in[l], offsets, axis=-1)

        aq = rms_norm(aq.reshape(b, t, A_HEADS, 2, A_HEAD_DIM), a_q_norm[l])
        ak = rms_norm(ak.reshape(b, t, A_HEADS, 2, A_HEAD_DIM), a_k_norm[l])
        av = av.reshape(b, t, A_HEADS, A_V_DIM)
        lam = (jnp.exp(jnp.sum(a_lambda_q1[l] * a_lambda_k1[l]).astype(jnp.float32))
               - jnp.exp(jnp.sum(a_lambda_q2[l] * a_lambda_k2[l]).astype(jnp.float32)) + lambda_init)
        out_a = diff_attention(aq, ak, av, slopes_a, lam)
        out_a = (rms_norm(out_a, a_subln[l]) * (1.0 - lambda_init)).reshape(b, t, BRANCH_WIDTH)

        bq = rms_norm(bq.reshape(b, t, n_groups, B_HEADS_PER_GROUP, B_HEAD_DIM), b_q_norm[l])
        bk = rms_norm(bk.reshape(b, t, n_groups, B_HEADS_PER_GROUP, B_HEAD_DIM), b_k_norm[l])
        bv = bv.reshape(b, t, n_groups, B_HEADS_PER_GROUP, B_HEAD_DIM)
        outs, lses = [], []
        for g, (window, dilation) in enumerate(B_GROUPS):
            o, lse = dilated_window_attention(bq[:, :, g], bk[:, :, g], bv[:, :, g], slopes_b[g], window, dilation)
            outs.append(o)
            lses.append(lse)
        wts = jax.nn.softmax(jnp.stack(lses, axis=2), axis=2)
        out_b = jnp.sum(wts[..., None].astype(bv.dtype) * jnp.stack(outs, axis=2), axis=2)
        out_b = out_b.reshape(b, t, BRANCH_WIDTH)

        m = rms_norm(mem, mem_norm[l])
        kv = (m @ w_mem_kv[l]).reshape(b, n_mem, 2, C_HEADS, C_HEAD_DIM)
        ck = rms_norm(kv[:, :, 0], c_k_norm[l])
        cv = kv[:, :, 1]
        cq = rms_norm(cq.reshape(b, t, C_HEADS, C_HEAD_DIM), c_q_norm[l])
        out_c = memory_attention(cq, ck, cv).reshape(b, t, BRANCH_WIDTH)

        branches = jnp.einsum('btgc,gcd->btgd', jnp.stack([out_a, out_b, out_c], axis=2), w_branch[l])
        gates = jax.nn.sigmoid(h @ w_gate[l] + b_gate[l]).reshape(b, t, N_BRANCHES, d)
        x = x + jnp.sum(gates * branches, axis=2) @ w_out[l]

        h2 = rms_norm(x, norm_ffn[l])
        x = x + (jax.nn.silu(h2 @ w_ffn_gate[l]) * (h2 @ w_ffn_up[l])) @ w_ffn_down[l]
    return x
```

```cpp
#include <hip/hip_runtime.h>
#include <hip/hip_cooperative_groups.h>
#include <cstdio>
#include <cstdint>
namespace cg = cooperative_groups;
namespace pg8 {
#define PG8_LAS __attribute__((address_space(3)))
typedef unsigned short bf16_t;
typedef short bf16x8 __attribute__((ext_vector_type(8)));
typedef float f32x4 __attribute__((ext_vector_type(4)));
typedef unsigned u32x4 __attribute__((ext_vector_type(4)));
constexpr int BM = 256, BK = 64, HALF = 128, HTB = HALF * BK * 2  , STAGE_BYTES = 8 * HTB, NXCD = 8, WGM = 8;

__host__ __device__ __forceinline__ int lds_byte(int r, int c) { const int st = (r >> 4) * 2 + (c >> 5), rr = r & 15, cc = c & 31, ob = rr * 64 + cc * 2; return st * 1024 + (ob ^ (((ob >> 9) & 1) << 5)); }
__host__ __device__ __forceinline__ void stage_rc(int b, int& R, int& C) { const int st = b / 1024, sb = b % 1024, swz = sb ^ (((sb >> 9) & 1) << 5); R = (st >> 1) * 16 + swz / 64; C = (st & 1) * 32 + (swz % 64) / 2; }
__host__ __device__ __forceinline__ int perm32(int rho) { const int n = rho >> 4, i = rho & 15; return 8 * (i >> 2) + 4 * n + (i & 3); }

struct Unit { int pm, pn; };
struct Gemm { const bf16_t* A; const bf16_t* Bt; int M, N, K, lda; };

struct StaticOrder {
    int nM, nN, nwg, G, c;
    __host__ __device__ void init(int M, int N, int G_, int c_) { nM = M / BM; nN = N / BM; nwg = nM * nN; G = G_; c = c_; }
    __host__ __device__ bool next(int i, Unit& u) const {
        const long L = (long)i * G + c; if (L >= nwg) return false;
        int wgid = (int)L; { const int q = nwg / NXCD, r = nwg % NXCD, xcd = wgid % NXCD, off = wgid / NXCD; wgid = (xcd < r ? xcd * (q + 1) : r * (q + 1) + (xcd - r) * q) + off; }
        const int nig = WGM * nN, gid = wgid / nig, fm = gid * WGM, gsz = (nM - fm) < WGM ? (nM - fm) : WGM;
        u.pm = fm + ((wgid % nig) % gsz); u.pn = (wgid % nig) / gsz; return true;
    }
    __device__ __forceinline__ void a_ready(const Unit&) const {}
    __device__ __forceinline__ void done(const Unit&) const {}
};

typedef float f32x2v_t __attribute__((ext_vector_type(2))); typedef __bf16 bf16x2v_t __attribute__((ext_vector_type(2)));
__device__ __forceinline__ unsigned cvt_pk_bf16(float lo, float hi) { f32x2v_t v = {lo, hi}; bf16x2v_t b = __builtin_convertvector(v, bf16x2v_t); return __builtin_bit_cast(unsigned, b); }
__device__ __forceinline__ float bf_lo(unsigned w) { return __builtin_bit_cast(float, w << 16); }
__device__ __forceinline__ float bf_hi(unsigned w) { return __builtin_bit_cast(float, w & 0xffff0000u); }
#define PG8_ACC const f32x4 (&acc)[2][2][4][2]

struct EpiQKV {
    static constexpr bool PERM = true, AFTER_DRAIN = false;
    bf16_t* O; int ldc; int mode;
    PG8_LAS const float* GT;
    PG8_LAS float* X;
    __device__ __forceinline__ void operator()(PG8_ACC, const Unit& u, int wr, int wc, int fr, int fq) const {
        const int pn = u.pn;
        int kind, gp; float sc = 1.f;
        constexpr float L2E = 1.4426950408889634f;
        if (mode == 0) {
            if (pn < 2) { kind = 1; gp = 0; sc = 0.125f * L2E; }
            else if (pn < 4) { kind = 1; gp = 64; }
            else if (pn < 6) { kind = 0; gp = 64; }
            else if (pn < 12) { kind = 2; gp = 128; sc = 0.08838834764831845f * L2E; }
            else if (pn < 18) { kind = 2; gp = 256; }
            else if (pn < 24) { kind = 0; gp = 256; }
            else { kind = 2; gp = 384; sc = 0.08838834764831845f * L2E; }
        } else {
            if (pn < 2) { kind = 2; gp = 512; } else { kind = 0; gp = 512; }
        }
        const int row0 = u.pm * BM + wr * 64 + fr, col0 = pn * BM + wc * 32 + 8 * fq;
        float rs[2][4][2];
        f32x4 gv[2];
        if (kind != 0) {
#pragma unroll
            for (int ai = 0; ai < 2; ++ai)
#pragma unroll
                for (int m = 0; m < 4; ++m)
#pragma unroll
                    for (int bj = 0; bj < 2; ++bj) {
                        const f32x4 a = acc[ai][bj][m][0], b = acc[ai][bj][m][1];
                        float s = (a[0] * a[0] + a[1] * a[1]) + (a[2] * a[2] + a[3] * a[3]) + (b[0] * b[0] + b[1] * b[1]) + (b[2] * b[2] + b[3] * b[3]);
                        s += __shfl_xor(s, 16); s += __shfl_xor(s, 32);
                        if (fq == 0) X[((ai * 128 + wr * 64 + m * 16 + fr) * 2 + bj) * 4 + wc] = s;
                    }
            asm volatile("s_waitcnt lgkmcnt(0)" ::: "memory"); __builtin_amdgcn_s_barrier(); asm volatile("" ::: "memory");
            const int hd = (kind == 1) ? 64 : 128;
            const float inv_hd = (kind == 1) ? (1.f / 64.f) : (1.f / 128.f);
#pragma unroll
            for (int ai = 0; ai < 2; ++ai)
#pragma unroll
                for (int m = 0; m < 4; ++m)
#pragma unroll
                    for (int bj = 0; bj < 2; ++bj) {
                        const f32x4 xs = *(const PG8_LAS f32x4*)(X + ((ai * 128 + wr * 64 + m * 16 + fr) * 2 + bj) * 4);
                        float tot;
                        if (kind == 1) tot = (wc < 2) ? (xs[0] + xs[1]) : (xs[2] + xs[3]);
                        else tot = (xs[0] + xs[1]) + (xs[2] + xs[3]);
                        rs[ai][m][bj] = __builtin_amdgcn_rsqf(tot * inv_hd + 1e-6f) * sc;
                    }
            const int gc = ((wc * 32 + 8 * fq) & (hd - 1));
            gv[0] = *(const PG8_LAS f32x4*)(GT + gp + gc); gv[1] = *(const PG8_LAS f32x4*)(GT + gp + gc + 4);
        } else {
#pragma unroll
            for (int ai = 0; ai < 2; ++ai)
#pragma unroll
                for (int m = 0; m < 4; ++m)
#pragma unroll
                    for (int bj = 0; bj < 2; ++bj) rs[ai][m][bj] = 1.f;
            gv[0] = (f32x4){1.f, 1.f, 1.f, 1.f}; gv[1] = gv[0];
        }
#pragma unroll
        for (int ai = 0; ai < 2; ++ai)
#pragma unroll
            for (int m = 0; m < 4; ++m) { bf16_t* rowp = O + (size_t)(row0 + ai * HALF + m * 16) * ldc + col0;
#pragma unroll
                for (int bj = 0; bj < 2; ++bj) { const float r = rs[ai][m][bj];
                    const f32x4 v0 = acc[ai][bj][m][0] * gv[0] * r, v1 = acc[ai][bj][m][1] * gv[1] * r;
                    u32x4 w; w.x = cvt_pk_bf16(v0[0], v0[1]); w.y = cvt_pk_bf16(v0[2], v0[3]); w.z = cvt_pk_bf16(v1[0], v1[1]); w.w = cvt_pk_bf16(v1[2], v1[3]);
                    *(u32x4*)(rowp + bj * HALF) = w; } }
    }
};

struct EpiGate {
    static constexpr bool PERM = true, AFTER_DRAIN = false;
    bf16_t* O; int ldc; const float* bias;
    __device__ __forceinline__ void operator()(PG8_ACC, const Unit& u, int wr, int wc, int fr, int fq) const {
        const int row0 = u.pm * BM + wr * 64 + fr, col0 = u.pn * BM + wc * 32 + 8 * fq;
        f32x4 bv[2][2];
#pragma unroll
        for (int bj = 0; bj < 2; ++bj)
#pragma unroll
            for (int n = 0; n < 2; ++n) bv[bj][n] = *(const f32x4*)(bias + col0 + bj * HALF + 4 * n);
#pragma unroll
        for (int ai = 0; ai < 2; ++ai)
#pragma unroll
            for (int m = 0; m < 4; ++m) { bf16_t* rowp = O + (size_t)(row0 + ai * HALF + m * 16) * ldc + col0;
#pragma unroll
                for (int bj = 0; bj < 2; ++bj) { f32x4 v0 = acc[ai][bj][m][0] + bv[bj][0], v1 = acc[ai][bj][m][1] + bv[bj][1];
#pragma unroll
                    for (int e = 0; e < 4; ++e) { v0[e] = __builtin_amdgcn_rcpf(1.f + __builtin_amdgcn_exp2f(-1.4426950408889634f * v0[e])); v1[e] = __builtin_amdgcn_rcpf(1.f + __builtin_amdgcn_exp2f(-1.4426950408889634f * v1[e])); }
                    u32x4 w; w.x = cvt_pk_bf16(v0[0], v0[1]); w.y = cvt_pk_bf16(v0[2], v0[3]); w.z = cvt_pk_bf16(v1[0], v1[1]); w.w = cvt_pk_bf16(v1[2], v1[3]);
                    *(u32x4*)(rowp + bj * HALF) = w; } }
    }
};

struct EpiBranch {
    static constexpr bool PERM = true, AFTER_DRAIN = false;
    bf16_t* G; int ldc;
    __device__ __forceinline__ void operator()(PG8_ACC, const Unit& u, int wr, int wc, int fr, int fq) const {
        const int row0 = u.pm * BM + wr * 64 + fr, col0 = u.pn * BM + wc * 32 + 8 * fq;
#pragma unroll
        for (int ai = 0; ai < 2; ++ai)
#pragma unroll
            for (int m = 0; m < 4; ++m) { bf16_t* rowp = G + (size_t)(row0 + ai * HALF + m * 16) * ldc + col0;
#pragma unroll
                for (int bj = 0; bj < 2; ++bj) { const u32x4 gt = *(const u32x4*)(rowp + bj * HALF);
                    const f32x4 a = acc[ai][bj][m][0], b = acc[ai][bj][m][1];
                    u32x4 w; w.x = cvt_pk_bf16(a[0] * bf_lo(gt.x), a[1] * bf_hi(gt.x)); w.y = cvt_pk_bf16(a[2] * bf_lo(gt.y), a[3] * bf_hi(gt.y));
                    w.z = cvt_pk_bf16(b[0] * bf_lo(gt.z), b[1] * bf_hi(gt.z)); w.w = cvt_pk_bf16(b[2] * bf_lo(gt.w), b[3] * bf_hi(gt.w));
                    *(u32x4*)(rowp + bj * HALF) = w; } }
    }
};

struct EpiResid {
    static constexpr bool PERM = true, AFTER_DRAIN = false;
    const float* res; float* out; int ld;
    __device__ __forceinline__ void operator()(PG8_ACC, const Unit& u, int wr, int wc, int fr, int fq) const {
        const int row0 = u.pm * BM + wr * 64 + fr, col0 = u.pn * BM + wc * 32 + 8 * fq;
#pragma unroll
        for (int ai = 0; ai < 2; ++ai)
#pragma unroll
            for (int m = 0; m < 4; ++m) { const size_t off = (size_t)(row0 + ai * HALF + m * 16) * ld + col0;
#pragma unroll
                for (int bj = 0; bj < 2; ++bj) {
                    const f32x4 r0 = *(const f32x4*)(res + off + bj * HALF), r1 = *(const f32x4*)(res + off + bj * HALF + 4);
                    const f32x4 v0 = acc[ai][bj][m][0] + r0, v1 = acc[ai][bj][m][1] + r1;
                    *(f32x4*)(out + off + bj * HALF) = v0; *(f32x4*)(out + off + bj * HALF + 4) = v1; } }
    }
};

struct EpiSwiGLU {
    static constexpr bool PERM = true, AFTER_DRAIN = false;
    bf16_t* O; int ldc;
    __device__ __forceinline__ void operator()(PG8_ACC, const Unit& u, int wr, int wc, int fr, int fq) const {
        const int row0 = u.pm * BM + wr * 64 + fr, col0 = u.pn * HALF + wc * 32 + 8 * fq;
#pragma unroll
        for (int ai = 0; ai < 2; ++ai)
#pragma unroll
            for (int m = 0; m < 4; ++m) { bf16_t* rowp = O + (size_t)(row0 + ai * HALF + m * 16) * ldc + col0;
                f32x4 v[2];
#pragma unroll
                for (int n = 0; n < 2; ++n) { const f32x4 gt = acc[ai][0][m][n], up = acc[ai][1][m][n];
#pragma unroll
                    for (int e = 0; e < 4; ++e) v[n][e] = gt[e] * __builtin_amdgcn_rcpf(1.f + __builtin_amdgcn_exp2f(-1.4426950408889634f * gt[e])) * up[e]; }
                u32x4 w; w.x = cvt_pk_bf16(v[0][0], v[0][1]); w.y = cvt_pk_bf16(v[0][2], v[0][3]); w.z = cvt_pk_bf16(v[1][0], v[1][1]); w.w = cvt_pk_bf16(v[1][2], v[1][3]);
                *(u32x4*)rowp = w; }
    }
};

template <class Epi, class Sched, bool ALIGN_EPI = false, bool SP2 = false>
__device__ __forceinline__ void gemm_phase(PG8_LAS unsigned char* lds, const Gemm g, const Sched& S, const Epi& E) {
    int tid = threadIdx.x; asm volatile("" : "+v"(tid));
    const int wid = __builtin_amdgcn_readfirstlane(tid >> 6), lane = tid & 63, wr = wid >> 2, wc = wid & 3, fr = lane & 15, fq = lane >> 4;
    const int K = g.K, nt = K / BK;
    unsigned voffA[2], voffB[2];
#pragma unroll
    for (int i = 0; i < 2; ++i) { int R, C; stage_rc(tid * 16 + i * 8192, R, C); const int Rb = Epi::PERM ? ((R & ~31) + perm32(R & 31)) : R;
        voffA[i] = (unsigned)(R * g.lda + C) * 2u; voffB[i] = (unsigned)(Rb * K + C) * 2u; }
    const size_t kstep = (size_t)(BK * 2);
    const size_t hstepA = (size_t)HALF * g.lda * 2, hstepB = (size_t)HALF * K * 2;
    const size_t tstepA = 2 * hstepA, tstepB = 2 * hstepB;
    const unsigned ldsw = (unsigned)wid * 1024u;
    const int aoff = lds_byte(wr * 64 + fr, fq * 8), boff = lds_byte(wc * 32 + fr, fq * 8);
#define PG8_SA(b, h) (((b) * 2 + (h)) * HTB)
#define PG8_SB(b, h) ((4 + (b) * 2 + (h)) * HTB)
#define PG8_STAGE(bufoff, gbase, voff) do { _Pragma("unroll") for (int _i = 0; _i < 2; ++_i) \
        __builtin_amdgcn_global_load_lds((const unsigned*)((const char*)(gbase) + (voff)[_i]), (PG8_LAS unsigned*)(lds + (bufoff) + ldsw + _i * 8192), 16, 0, 0); } while (0)
#define PG8_LDA(dst, b, h) do { _Pragma("unroll") for (int m = 0; m < 4; ++m) _Pragma("unroll") for (int k = 0; k < 2; ++k) dst[m][k] = *(const PG8_LAS bf16x8*)(lds + PG8_SA(b, h) + aoff + m * 2048 + k * 1024); } while (0)
#define PG8_LDB(dst, b, h) do { _Pragma("unroll") for (int n = 0; n < 2; ++n) _Pragma("unroll") for (int k = 0; k < 2; ++k) dst[n][k] = *(const PG8_LAS bf16x8*)(lds + PG8_SB(b, h) + boff + n * 2048 + k * 1024); } while (0)
#define PG8_MMA(ai, bj, At, Bt) do { __builtin_amdgcn_s_setprio(1); _Pragma("unroll") for (int m = 0; m < 4; ++m) _Pragma("unroll") for (int n = 0; n < 2; ++n) _Pragma("unroll") for (int k = 0; k < 2; ++k) \
        acc[ai][bj][m][n] = __builtin_amdgcn_mfma_f32_16x16x32_bf16(Bt[n][k], At[m][k], acc[ai][bj][m][n], 0, 0, 0); __builtin_amdgcn_s_setprio(0); } while (0)
#define PG8_WAIT_V(n) asm volatile("s_waitcnt vmcnt(" #n ")" ::: "memory")
#define PG8_WAIT_L(n) asm volatile("s_waitcnt lgkmcnt(" #n ")" ::: "memory")
#define PG8_BAR __builtin_amdgcn_s_barrier()
#define PG8_SCHED __builtin_amdgcn_sched_barrier(0)
    Unit cur, nxt; int ui = 0;
    if (!S.next(0, cur)) return;
    f32x4 acc[2][2][4][2];
#pragma unroll
    for (int a = 0; a < 2; ++a)
#pragma unroll
        for (int b = 0; b < 2; ++b)
#pragma unroll
            for (int m = 0; m < 4; ++m)
#pragma unroll
                for (int n = 0; n < 2; ++n) acc[a][b][m][n] = (f32x4){0.f, 0.f, 0.f, 0.f};
    bf16x8 At[4][2], B0[2][2], B1[2][2];
    const char* cA = (const char*)g.A + (size_t)cur.pm * tstepA; const char* cB = (const char*)g.Bt + (size_t)cur.pn * tstepB;
    S.a_ready(cur);
    if constexpr (SP2) {
        PG8_STAGE(PG8_SB(0, 0), cB, voffB); PG8_STAGE(PG8_SB(0, 1), cB + hstepB, voffB); PG8_STAGE(PG8_SA(0, 0), cA, voffA); PG8_STAGE(PG8_SA(0, 1), cA + hstepA, voffA);
        if (wr == 1) PG8_BAR;
        PG8_WAIT_V(2); PG8_BAR;
        PG8_STAGE(PG8_SB(1, 0), cB + kstep, voffB); PG8_STAGE(PG8_SA(1, 0), cA + kstep, voffA); PG8_STAGE(PG8_SB(1, 1), cB + hstepB + kstep, voffB);
        PG8_WAIT_V(6); PG8_BAR;
    } else {
        PG8_STAGE(PG8_SB(0, 0), cB, voffB); PG8_STAGE(PG8_SA(0, 0), cA, voffA); PG8_STAGE(PG8_SB(0, 1), cB + hstepB, voffB); PG8_STAGE(PG8_SA(0, 1), cA + hstepA, voffA);
        if (wr == 1) PG8_BAR;
        PG8_WAIT_V(4); PG8_BAR;
        PG8_STAGE(PG8_SB(1, 0), cB + kstep, voffB); PG8_STAGE(PG8_SA(1, 0), cA + kstep, voffA); PG8_STAGE(PG8_SB(1, 1), cB + hstepB + kstep, voffB);
        PG8_WAIT_V(6); PG8_BAR;
    }
    for (;;) {
        const bool has_next = S.next(ui + 1, nxt);
        const char* nA = has_next ? (const char*)g.A + (size_t)nxt.pm * tstepA : cA; const char* nB = has_next ? (const char*)g.Bt + (size_t)nxt.pn * tstepB : cB;
        for (int t = 0; t < nt; t += 2) {
            const bool last = (t == nt - 2);
            const char* a1 = cA + (size_t)(t + 1) * kstep;
            const char* a2 = last ? nA : cA + (size_t)(t + 2) * kstep; const char* b2 = last ? nB : cB + (size_t)(t + 2) * kstep;
            const char* a3 = a2 + kstep; const char* b3 = b2 + kstep;
            if (last && has_next) S.a_ready(nxt);
            if constexpr (SP2) {
            PG8_LDB(B0, 0, 0); PG8_LDB(B1, 0, 1); PG8_SCHED; PG8_LDA(At, 0, 0); PG8_STAGE(PG8_SA(1, 1), a1 + hstepA, voffA);
            PG8_WAIT_V(8); PG8_WAIT_L(0); PG8_BAR; PG8_MMA(0, 0, At, B0); PG8_MMA(0, 1, At, B1); PG8_BAR; PG8_SCHED;
            PG8_LDA(At, 0, 1); PG8_STAGE(PG8_SB(0, 0), b2, voffB); PG8_STAGE(PG8_SB(0, 1), b2 + hstepB, voffB); PG8_STAGE(PG8_SA(0, 0), a2, voffA);
            PG8_WAIT_V(8); PG8_WAIT_L(0); PG8_BAR; PG8_MMA(1, 0, At, B0); PG8_MMA(1, 1, At, B1); PG8_BAR; PG8_SCHED;
            PG8_LDB(B0, 1, 0); PG8_LDB(B1, 1, 1); PG8_SCHED; PG8_LDA(At, 1, 0); PG8_STAGE(PG8_SA(0, 1), a2 + hstepA, voffA);
            PG8_WAIT_V(8); PG8_WAIT_L(0); PG8_BAR; PG8_MMA(0, 0, At, B0); PG8_MMA(0, 1, At, B1); PG8_BAR; PG8_SCHED;
            PG8_LDA(At, 1, 1); PG8_STAGE(PG8_SB(1, 0), b3, voffB); PG8_STAGE(PG8_SB(1, 1), b3 + hstepB, voffB); PG8_STAGE(PG8_SA(1, 0), a3, voffA);
            PG8_WAIT_V(8); PG8_WAIT_L(0); PG8_BAR; PG8_MMA(1, 0, At, B0); PG8_MMA(1, 1, At, B1); PG8_BAR; PG8_SCHED;
            } else {
            PG8_LDB(B0, 0, 0); PG8_SCHED; PG8_LDA(At, 0, 0); PG8_STAGE(PG8_SA(1, 1), a1 + hstepA, voffA);
            PG8_WAIT_L(8); PG8_BAR; PG8_WAIT_L(0); PG8_MMA(0, 0, At, B0); PG8_BAR; PG8_SCHED;
            PG8_LDB(B1, 0, 1); PG8_STAGE(PG8_SB(0, 0), b2, voffB);
            PG8_BAR; PG8_WAIT_L(0); PG8_MMA(0, 1, At, B1); PG8_BAR;
            PG8_LDA(At, 0, 1); PG8_STAGE(PG8_SA(0, 0), a2, voffA);
            PG8_BAR; PG8_WAIT_L(0); PG8_MMA(1, 0, At, B0); PG8_BAR; PG8_SCHED;
            PG8_STAGE(PG8_SB(0, 1), b2 + hstepB, voffB);
            PG8_WAIT_V(6); PG8_BAR; PG8_MMA(1, 1, At, B1); PG8_BAR;
            PG8_LDB(B0, 1, 0); PG8_SCHED; PG8_LDA(At, 1, 0); PG8_STAGE(PG8_SA(0, 1), a2 + hstepA, voffA);
            PG8_WAIT_L(8); PG8_BAR; PG8_WAIT_L(0); PG8_MMA(0, 0, At, B0); PG8_BAR; PG8_SCHED;
            PG8_LDB(B1, 1, 1); PG8_STAGE(PG8_SB(1, 0), b3, voffB);
            PG8_BAR; PG8_WAIT_L(0); PG8_MMA(0, 1, At, B1); PG8_BAR;
            PG8_LDA(At, 1, 1); PG8_STAGE(PG8_SA(1, 0), a3, voffA);
            PG8_BAR; PG8_WAIT_L(0); PG8_MMA(1, 0, At, B0); PG8_BAR; PG8_SCHED;
            PG8_STAGE(PG8_SB(1, 1), b3 + hstepB, voffB);
            PG8_WAIT_V(6); PG8_BAR; PG8_MMA(1, 1, At, B1); PG8_BAR;
            }
        }
        if constexpr (ALIGN_EPI) { if (wr == 0) PG8_BAR; }
        if constexpr (!Epi::AFTER_DRAIN) { E(acc, cur, wr, wc, fr, fq); S.done(cur); }
        if (!has_next) break;
#pragma unroll
        for (int a = 0; a < 2; ++a)
#pragma unroll
            for (int b = 0; b < 2; ++b)
#pragma unroll
                for (int m = 0; m < 4; ++m)
#pragma unroll
                    for (int n = 0; n < 2; ++n) acc[a][b][m][n] = (f32x4){0.f, 0.f, 0.f, 0.f};
        cur = nxt; cA = nA; cB = nB; ++ui;
        if constexpr (ALIGN_EPI) { if (wr == 1) PG8_BAR; }
    }
    PG8_WAIT_V(0);
    if constexpr (!ALIGN_EPI) { if (wr == 0) PG8_BAR; }
    PG8_BAR;
    if constexpr (Epi::AFTER_DRAIN) { E.fused(acc, cur, wr, wc, fr, fq, lds, wid, lane); S.done(cur); }
#undef PG8_SA
#undef PG8_SB
#undef PG8_STAGE
#undef PG8_LDA
#undef PG8_LDB
#undef PG8_MMA
#undef PG8_WAIT_V
#undef PG8_WAIT_L
#undef PG8_BAR
#undef PG8_SCHED
}
}

#define LAS __attribute__((address_space(3)))
typedef unsigned short bf16;
typedef short bf16x8 __attribute__((ext_vector_type(8)));
typedef short s16x4 __attribute__((ext_vector_type(4)));
typedef short v4i16_t __attribute__((ext_vector_type(4)));
typedef float f32x16 __attribute__((ext_vector_type(16)));
typedef float f32x4 __attribute__((ext_vector_type(4)));
typedef float f32x2_t __attribute__((ext_vector_type(2)));
typedef __bf16 bf16x2_t __attribute__((ext_vector_type(2)));
typedef unsigned u32x4 __attribute__((ext_vector_type(4)));
typedef unsigned u32x2 __attribute__((ext_vector_type(2)));

constexpr int D = 1024, SEQ = 2048, NB = 8, M = NB * SEQ, NMEM = 256, MMEM = NB * NMEM, DIN = 6656, DFF = 2816;
constexpr int LDQ = 6656;
constexpr int C_AQ = 0, C_AK = 512, C_AV = 1024, C_BQ = 1536, C_BK = 3072, C_BV = 4608, C_CQ = 6144;
constexpr int C_GATE = 3072;
constexpr int C_H2 = 0, C_ACT = 1024;
constexpr float L2E = 1.4426950408889634f;
constexpr float EPS = 1e-6f;

constexpr size_t WS_WIN = 0;
constexpr size_t WS_WG = WS_WIN + (size_t)DIN * D * 2;
constexpr size_t WS_WMEM = WS_WG + (size_t)3 * D * D * 2;
constexpr size_t WS_WBR = WS_WMEM + (size_t)D * D * 2;
constexpr size_t WS_WOUT3 = WS_WBR + (size_t)3 * D * 512 * 2;
constexpr size_t WS_WGU = WS_WOUT3 + (size_t)D * 3 * D * 2;
constexpr size_t WS_WDN = WS_WGU + (size_t)2 * DFF * D * 2;
constexpr size_t WS_LB = WS_WDN + (size_t)D * DFF * 2;
constexpr size_t WS_R = WS_LB + (size_t)3 * M * 4 * 4;
constexpr size_t WS_END = WS_R + (size_t)M * LDQ * 2;
static_assert(WS_END <= (size_t)256 * 1024 * 1024, "d_ws map");
constexpr size_t DO_XN = 0;
constexpr size_t DO_MN = DO_XN + (size_t)M * D * 2;
constexpr size_t DO_CKV = DO_MN + (size_t)MMEM * D * 2;
static_assert(DO_CKV + (size_t)MMEM * D * 2 <= (size_t)M * D * 4, "d_out scratch map");

constexpr int LDS_BYTES = 155648;
constexpr int XCH_OFF = 131072, GT_OFF = 131072 + 8192;
constexpr int KP = 272, VP = 320;

__device__ __forceinline__ unsigned cvtpk(float lo, float hi) { f32x2_t v = {lo, hi}; bf16x2_t b = __builtin_convertvector(v, bf16x2_t); return __builtin_bit_cast(unsigned, b); }
__device__ __forceinline__ float wave_sum(float v) {
#pragma unroll
    for (int o = 1; o < 64; o <<= 1) v += __shfl_xor(v, o);
    return v;
}
__device__ __forceinline__ float wave_max(float v) {
#pragma unroll
    for (int o = 1; o < 64; o <<= 1) v = fmaxf(v, __shfl_xor(v, o));
    return v;
}
__device__ __forceinline__ float absmax_vec(const float* g, int n, int lane) {
    float v = fabsf(g[lane]); if (n > 64) v = fmaxf(v, fabsf(g[lane + 64]));
    return wave_max(v);
}

__device__ __forceinline__ void tr_item(const float* W, int N, int k0, int n0, bf16* WT, int dst_pitch, int dst_row0, int dst_k0, int ncopies, int copy_stride, LAS float* scr, int lane) {
#pragma unroll 8
    for (int i = 0; i < 32; ++i) { const int kk = 2 * i + (lane >> 5); scr[kk * 33 + (lane & 31)] = W[(size_t)(k0 + kk) * N + n0 + (lane & 31)]; }
    asm volatile("s_waitcnt lgkmcnt(0)" ::: "memory");
    const int c = lane & 7;
#pragma unroll
    for (int j = 0; j < 4; ++j) { const int n = (lane >> 3) + 8 * j; const LAS float* s = scr + (8 * c) * 33 + n;
        u32x4 o; o.x = cvtpk(s[0 * 33], s[1 * 33]); o.y = cvtpk(s[2 * 33], s[3 * 33]); o.z = cvtpk(s[4 * 33], s[5 * 33]); o.w = cvtpk(s[6 * 33], s[7 * 33]);
        bf16* dst = WT + (size_t)(dst_row0 + n0 + n) * dst_pitch + dst_k0 + k0 + 8 * c;
        for (int cp = 0; cp < ncopies; ++cp) *(u32x4*)(dst + (size_t)cp * copy_stride) = o; }
    asm volatile("s_waitcnt lgkmcnt(0)" ::: "memory");
}
__device__ __forceinline__ void rms_row_to_bf16(const float* xrow, const float* gain, bf16* orow, int lane) {
    const f32x4* xr = (const f32x4*)xrow + lane; const f32x4* gr = (const f32x4*)gain + lane;
    f32x4 v[4]; float s = 0.f;
#pragma unroll
    for (int j = 0; j < 4; ++j) { v[j] = xr[64 * j]; s += (v[j][0] * v[j][0] + v[j][1] * v[j][1]) + (v[j][2] * v[j][2] + v[j][3] * v[j][3]); }
    const float rstd = 1.f / sqrtf(wave_sum(s) * (1.f / 1024.f) + EPS);
    u32x2* o8 = (u32x2*)orow + lane;
#pragma unroll
    for (int j = 0; j < 4; ++j) { const f32x4 g = gr[64 * j]; u32x2 w; w.x = cvtpk(v[j][0] * rstd * g[0], v[j][1] * rstd * g[1]); w.y = cvtpk(v[j][2] * rstd * g[2], v[j][3] * rstd * g[3]); o8[64 * j] = w; }
}

__device__ __forceinline__ s16x4 vtr(const LAS char* p) { return __builtin_bit_cast(s16x4, __builtin_amdgcn_ds_read_tr16_b64_v4i16((LAS v4i16_t*)p)); }

template <int NK>
__device__ __forceinline__ void qk32(f32x16& S, const LAS char* Kp, const bf16x8* Q, int ks0, int r32, int hi) {
    const LAS char* kb = Kp + r32 * KP + hi * 16 + ks0 * 32;
#pragma unroll
    for (int ks = 0; ks < NK; ++ks) { const bf16x8 kf = *(const LAS bf16x8*)(kb + ks * 32); S = __builtin_amdgcn_mfma_f32_32x32x16_bf16(kf, Q[ks0 + ks], S, 0, 0, 0); }
}
__device__ __forceinline__ void pv32(f32x16 (&O)[4], const bf16x8 (&P)[2], const LAS char* Vp, int lane) {
    const int i = lane & 15, q = i >> 2, p = i & 3, dsel = (lane >> 4) & 1, h = lane >> 5;
    const LAS char* vb = Vp + (4 * h + q) * VP + (16 * dsel + 4 * p) * 2;
#pragma unroll
    for (int s = 0; s < 2; ++s)
#pragma unroll
        for (int db = 0; db < 4; ++db) {
            const s16x4 lo = vtr(vb + (16 * s) * VP + db * 64), hi4 = vtr(vb + (16 * s + 8) * VP + db * 64);
            const bf16x8 a = (bf16x8){lo[0], lo[1], lo[2], lo[3], hi4[0], hi4[1], hi4[2], hi4[3]};
            O[db] = __builtin_amdgcn_mfma_f32_32x32x16_bf16(a, P[s], O[db], 0, 0, 0);
        }
}
template <int MODE>
__device__ __forceinline__ void soft32(const f32x16& S, bf16x8 (&P)[2], float& l, float dbase, float nslope) {
    float p[16];
#pragma unroll
    for (int r = 0; r < 16; ++r) {
        float s = S[r];
        if (MODE >= 1) { const float a = fabsf(dbase - (float)((r & 3) + 8 * (r >> 2))); s = fmaf(nslope, a, s); float e = __builtin_amdgcn_exp2f(s); if (MODE == 2) e = (a <= 64.f) ? e : 0.f; p[r] = e; }
        else p[r] = __builtin_amdgcn_exp2f(s);
        l += p[r];
    }
#pragma unroll
    for (int s = 0; s < 2; ++s) { u32x4 w; w.x = cvtpk(p[8 * s + 0], p[8 * s + 1]); w.y = cvtpk(p[8 * s + 2], p[8 * s + 3]); w.z = cvtpk(p[8 * s + 4], p[8 * s + 5]); w.w = cvtpk(p[8 * s + 6], p[8 * s + 7]); P[s] = __builtin_bit_cast(bf16x8, w); }
}
__device__ __forceinline__ void zero16(f32x16& v) {
#pragma unroll
    for (int r = 0; r < 16; ++r) v[r] = 0.f;
}

template <int NC>
__device__ __forceinline__ void attn_shared_unit(LAS char* lds, bf16* qrow, const bf16* Kg, const bf16* Vg, int kvp, int nt, int qpos, float nslope, float negM0, float lam, const float* subln) {
    int tid = threadIdx.x; asm volatile("" : "+v"(tid));
    const int lane = tid & 63, r32 = lane & 31, hi = lane >> 5;
    const int wv = __builtin_amdgcn_readfirstlane(tid >> 6), cm = (NC == 2) ? (wv & 1) : 0;
    constexpr int NQ = (NC == 2) ? 4 : 8;
    bf16x8 Q[NQ];
#pragma unroll
    for (int ks = 0; ks < NQ; ++ks) Q[ks] = *(const bf16x8*)(qrow + cm * 64 + 16 * ks + 8 * hi);
    f32x16 O[4]; float l = 0.f;
#pragma unroll
    for (int db = 0; db < 4; ++db) zero16(O[db]);
    const int lrow = tid >> 3, lcb = (tid & 7) * 32;
    const char* kgp = (const char*)(Kg + (size_t)lrow * kvp) + lcb; const char* vgp = (const char*)(Vg + (size_t)lrow * kvp) + lcb;
    const size_t tstep = (size_t)64 * kvp * 2;
    u32x4 kr0, kr1, vr0, vr1;
    kr0 = *(const u32x4*)kgp; kr1 = *(const u32x4*)(kgp + 16); vr0 = *(const u32x4*)vgp; vr1 = *(const u32x4*)(vgp + 16);
    __syncthreads();
    { LAS char* kb = lds + lrow * KP + lcb; LAS char* vb = lds + 64 * KP + lrow * VP + lcb;
      *(LAS u32x4*)kb = kr0; *(LAS u32x4*)(kb + 16) = kr1; *(LAS u32x4*)vb = vr0; *(LAS u32x4*)(vb + 16) = vr1; }
    __syncthreads();
    constexpr int BUFB = 64 * KP + 64 * VP;
#pragma unroll 1
    for (int t = 0; t < nt; ++t) {
        const bool more = (t + 1 < nt);
        if (more) { const char* kp = kgp + (size_t)(t + 1) * tstep; const char* vp = vgp + (size_t)(t + 1) * tstep;
            kr0 = *(const u32x4*)kp; kr1 = *(const u32x4*)(kp + 16); vr0 = *(const u32x4*)vp; vr1 = *(const u32x4*)(vp + 16); }
        const LAS char* Kb = lds + (t & 1) * BUFB; const LAS char* Vb = Kb + 64 * KP;
#pragma unroll
        for (int half = 0; half < 2; ++half) {
            const float dbase = (float)(qpos - (t * 64 + half * 32 + 4 * hi));
            f32x16 S;
#pragma unroll
            for (int r = 0; r < 16; ++r) S[r] = negM0;
            qk32<NQ>(S, Kb + half * 32 * KP + cm * 128, Q, 0, r32, hi);
            bf16x8 P[2];
            soft32<(NC == 2) ? 1 : 0>(S, P, l, dbase, nslope);
            pv32(O, P, Vb + half * 32 * VP, lane);
        }
        if (more) { LAS char* kb = lds + ((t + 1) & 1) * BUFB + lrow * KP + lcb; LAS char* vb = lds + ((t + 1) & 1) * BUFB + 64 * KP + lrow * VP + lcb;
            *(LAS u32x4*)kb = kr0; *(LAS u32x4*)(kb + 16) = kr1; *(LAS u32x4*)vb = vr0; *(LAS u32x4*)(vb + 16) = vr1; }
        __syncthreads();
    }
    l += __shfl_xor(l, 32);
    if (NC == 2) {
        LAS float* XO = (LAS float*)lds + (wv >> 1) * 4096 + lane;
        if (cm == 1) { const float i2 = lam / l;
#pragma unroll
            for (int db = 0; db < 4; ++db)
#pragma unroll
                for (int r = 0; r < 16; ++r) XO[(db * 16 + r) * 64] = O[db][r] * i2; }
        __syncthreads();
        if (cm == 0) {
            const float i1 = 1.f / l; float ss = 0.f;
#pragma unroll
            for (int db = 0; db < 4; ++db)
#pragma unroll
                for (int r = 0; r < 16; ++r) { const float o = O[db][r] * i1 - XO[(db * 16 + r) * 64]; O[db][r] = o; ss += o * o; }
            ss += __shfl_xor(ss, 32);
            const float rstd = (1.f / sqrtf(ss * (1.f / 128.f) + EPS)) * 0.8f;
#pragma unroll
            for (int db = 0; db < 4; ++db)
#pragma unroll
                for (int g4 = 0; g4 < 4; ++g4) { const int d = 32 * db + 8 * g4 + 4 * hi; const f32x4 gn = *(const f32x4*)(subln + d);
                    u32x2 w; w.x = cvtpk(O[db][4 * g4 + 0] * rstd * gn[0], O[db][4 * g4 + 1] * rstd * gn[1]); w.y = cvtpk(O[db][4 * g4 + 2] * rstd * gn[2], O[db][4 * g4 + 3] * rstd * gn[3]);
                    *(u32x2*)(qrow + d) = w; }
        }
    } else {
        const float i1 = 1.f / l;
#pragma unroll
        for (int db = 0; db < 4; ++db)
#pragma unroll
            for (int g4 = 0; g4 < 4; ++g4) { const int d = 32 * db + 8 * g4 + 4 * hi;
                u32x2 w; w.x = cvtpk(O[db][4 * g4 + 0] * i1, O[db][4 * g4 + 1] * i1); w.y = cvtpk(O[db][4 * g4 + 2] * i1, O[db][4 * g4 + 3] * i1);
                *(u32x2*)(qrow + d) = w; }
    }
}

__device__ __forceinline__ void attn_b_wave_unit(LAS char* wl, bf16* R, float* LB, int wu, float negM0, int lane_in) {
    int lane = lane_in; asm volatile("" : "+v"(lane));
    const int r32 = lane & 31, hi = lane >> 5;
    const int idx = wu & 63, j = (wu >> 6) & 3, bg = wu >> 8, g = bg % 3, b = bg / 3;
    const int dil = (g == 0) ? 1 : ((g == 1) ? 4 : 16), nqb = 64 / dil, sub_len = SEQ / dil;
    const int res = idx / nqb, qb = idx % nqb;
    const float slope = __builtin_amdgcn_exp2f(-8.f * (float)(g * 4 + j + 1) / 12.f);
    const float nslope = -slope * (float)dil * L2E;
    const int qsub = 32 * qb + r32;
    const size_t qrow_i = (size_t)b * SEQ + (size_t)qsub * dil + res;
    const int hcol = (g * 4 + j) * 128;
    bf16* qrow = R + qrow_i * LDQ + C_BQ + hcol;
    bf16x8 Q[8];
#pragma unroll
    for (int ks = 0; ks < 8; ++ks) Q[ks] = *(const bf16x8*)(qrow + 16 * ks + 8 * hi);
    f32x16 O[4]; float l = 0.f;
#pragma unroll
    for (int db = 0; db < 4; ++db) zero16(O[db]);
    const int lr = lane >> 4, lc = (lane & 15) * 8;
#pragma unroll 1
    for (int kt = 0; kt < 5; ++kt) {
        const int kb = 32 * qb - 64 + 32 * kt;
        if (kb < 0 || kb >= sub_len) continue;
        u32x4 kr[8], vr[8];
#pragma unroll
        for (int n = 0; n < 8; ++n) { const size_t krow = (size_t)b * SEQ + (size_t)(kb + 4 * n + lr) * dil + res;
            kr[n] = *(const u32x4*)(R + krow * LDQ + C_BK + hcol + lc); vr[n] = *(const u32x4*)(R + krow * LDQ + C_BV + hcol + lc); }
#pragma unroll
        for (int n = 0; n < 8; ++n) { *(LAS u32x4*)(wl + (4 * n + lr) * KP + lc * 2) = kr[n]; *(LAS u32x4*)(wl + 32 * KP + (4 * n + lr) * VP + lc * 2) = vr[n]; }
        asm volatile("s_waitcnt lgkmcnt(0)" ::: "memory");
        f32x16 S;
#pragma unroll
        for (int r = 0; r < 16; ++r) S[r] = negM0;
        qk32<8>(S, wl, Q, 0, r32, hi);
        bf16x8 P[2];
        soft32<2>(S, P, l, (float)(qsub - (kb + 4 * hi)), nslope);
        pv32(O, P, wl + 32 * KP, lane);
        asm volatile("s_waitcnt lgkmcnt(0)" ::: "memory");
    }
    l += __shfl_xor(l, 32);
    const float i1 = 1.f / l;
#pragma unroll
    for (int db = 0; db < 4; ++db)
#pragma unroll
        for (int g4 = 0; g4 < 4; ++g4) { const int d = 32 * db + 8 * g4 + 4 * hi;
            u32x2 w; w.x = cvtpk(O[db][4 * g4 + 0] * i1, O[db][4 * g4 + 1] * i1); w.y = cvtpk(O[db][4 * g4 + 2] * i1, O[db][4 * g4 + 3] * i1);
            *(u32x2*)(qrow + d) = w; }
    if (hi == 0) LB[((size_t)g * M + qrow_i) * 4 + j] = l;
}

#ifndef MK_LAUNCHES
#define MK_LAUNCHES 1
#endif
struct Args { const float* in[25]; float* out; unsigned char* ws; int ph_lo, ph_hi; };

__global__ void __launch_bounds__(512, 2) fwd_megakernel(Args a) {
    extern __shared__ __attribute__((aligned(16))) unsigned char lds_raw[];
    LAS unsigned char* lds = (LAS unsigned char*)lds_raw;
    cg::grid_group grid = cg::this_grid();
    const int wave = __builtin_amdgcn_readfirstlane((int)threadIdx.x >> 6);
#define FRESH_LANE int tid_ = threadIdx.x; asm volatile("" : "+v"(tid_)); const int lane = tid_ & 63;
    const int G = gridDim.x, bid = blockIdx.x;
    const int gw = bid * 8 + wave, NGW = G * 8;
    unsigned char* ws = a.ws;
    const float* x = a.in[0]; const float* mem = a.in[1];
    bf16* W_IN = (bf16*)(ws + WS_WIN); bf16* W_G = (bf16*)(ws + WS_WG); bf16* W_MEM = (bf16*)(ws + WS_WMEM); bf16* W_BR = (bf16*)(ws + WS_WBR);
    bf16* W_OUT3 = (bf16*)(ws + WS_WOUT3); bf16* W_GU = (bf16*)(ws + WS_WGU); bf16* W_DN = (bf16*)(ws + WS_WDN);
    float* LB = (float*)(ws + WS_LB); bf16* R = (bf16*)(ws + WS_R);
    unsigned char* dob = (unsigned char*)a.out;
    bf16* XN = (bf16*)(dob + DO_XN); bf16* MN = (bf16*)(dob + DO_MN); bf16* CKV = (bf16*)(dob + DO_CKV);

    if (a.ph_lo <= 0 && 0 < a.ph_hi) {
    {
        FRESH_LANE
        LAS float* scr = (LAS float*)(lds + wave * 8704);
        constexpr int I_IN = 16 * (DIN / 32), I_G = 16 * (3 * D / 32), I_MEM = 16 * (D / 32), I_BR = 8 * (D / 32), I_OUT = 16 * (D / 32), I_FF = 16 * (DFF / 32), I_DN = (DFF / 64) * (D / 32);
        constexpr int NITEMS = I_IN + I_G + I_MEM + 3 * I_BR + I_OUT + 2 * I_FF + I_DN;
        for (int it = gw; it < NITEMS; it += NGW) {
            int r = it;
            if (r < I_IN) { const int nb = DIN / 32; tr_item(a.in[3], DIN, 64 * (r / nb), 32 * (r % nb), W_IN, D, 0, 0, 1, 0, scr, lane); continue; } r -= I_IN;
            if (r < I_G) { const int nb = 3 * D / 32; tr_item(a.in[4], 3 * D, 64 * (r / nb), 32 * (r % nb), W_G, D, 0, 0, 1, 0, scr, lane); continue; } r -= I_G;
            if (r < I_MEM) { const int nb = D / 32; tr_item(a.in[16], D, 64 * (r / nb), 32 * (r % nb), W_MEM, D, 0, 0, 1, 0, scr, lane); continue; } r -= I_MEM;
            if (r < 3 * I_BR) { const int gI = r / I_BR, rr = r % I_BR, nb = D / 32; tr_item(a.in[19] + (size_t)gI * 512 * D, D, 64 * (rr / nb), 32 * (rr % nb), W_BR + (size_t)gI * D * 512, 512, 0, 0, 1, 0, scr, lane); continue; } r -= 3 * I_BR;
            if (r < I_OUT) { const int nb = D / 32; tr_item(a.in[20], D, 64 * (r / nb), 32 * (r % nb), W_OUT3, 3 * D, 0, 0, 3, D, scr, lane); continue; } r -= I_OUT;
            if (r < 2 * I_FF) { const int s = r / I_FF, rr = r % I_FF, nb = DFF / 32; const int n0 = 32 * (rr % nb);
                tr_item(a.in[22 + s], DFF, 64 * (rr / nb), n0, W_GU, D, 256 * (n0 / 128) + 128 * s + (n0 % 128) - n0, 0, 1, 0, scr, lane); continue; } r -= 2 * I_FF;
            { const int nb = D / 32; tr_item(a.in[24], D, 64 * (r / nb), 32 * (r % nb), W_DN, DFF, 0, 0, 1, 0, scr, lane); }
        }
        for (int m = gw; m < M + MMEM; m += NGW) {
            if (m < M) rms_row_to_bf16(x + (size_t)m * D, a.in[2], XN + (size_t)m * D, lane);
            else rms_row_to_bf16(mem + (size_t)(m - M) * D, a.in[15], MN + (size_t)(m - M) * D, lane);
        }
    }
    if (a.ph_hi - a.ph_lo > 1) grid.sync();

    }
    if (a.ph_lo <= 1 && 1 < a.ph_hi) {
    {
        LAS float* GT = (LAS float*)(lds + GT_OFF);
        { int t2 = threadIdx.x; asm volatile("" : "+v"(t2));
          if (t2 < 64) { GT[t2] = a.in[6][t2]; GT[64 + t2] = a.in[7][t2]; }
          if (t2 < 128) { GT[128 + t2] = a.in[13][t2]; GT[256 + t2] = a.in[14][t2]; GT[384 + t2] = a.in[17][t2]; GT[512 + t2] = a.in[18][t2]; } }
        __syncthreads();
        { const pg8::EpiQKV E{R, LDQ, 0, GT, (LAS float*)(lds + XCH_OFF)};
          pg8::Gemm g{XN, W_IN, M, DIN, D, D}; pg8::StaticOrder S; S.init(M, DIN, G, bid);
          pg8::gemm_phase<pg8::EpiQKV, pg8::StaticOrder, true, true>(lds, g, S, E); }
        { const pg8::EpiQKV E{CKV, D, 1, GT, (LAS float*)(lds + XCH_OFF)};
          pg8::Gemm g{MN, W_MEM, MMEM, D, D, D}; pg8::StaticOrder S; S.init(MMEM, D, G, bid);
          pg8::gemm_phase<pg8::EpiQKV, pg8::StaticOrder, true, true>(lds, g, S, E); }
    }
    if (a.ph_hi - a.ph_lo > 1) grid.sync();

    }
    if (a.ph_lo <= 2 && 2 < a.ph_hi) {
    {
        FRESH_LANE
        const float m_aq = absmax_vec(a.in[6], 64, lane), m_ak = absmax_vec(a.in[7], 64, lane);
        const float m_bq = absmax_vec(a.in[13], 128, lane), m_bk = absmax_vec(a.in[14], 128, lane);
        const float m_cq = absmax_vec(a.in[17], 128, lane), m_ck = absmax_vec(a.in[18], 128, lane);
        const float negM_a = -8.f * m_aq * m_ak * L2E, negM_b = -11.313708499f * m_bq * m_bk * L2E, negM_c = -11.313708499f * m_cq * m_ck * L2E;
        const float s1 = wave_sum(a.in[8][lane] * a.in[9][lane]), s2 = wave_sum(a.in[10][lane] * a.in[11][lane]);
        const float lam = expf(s1) - expf(s2) + 0.2f;
        for (int u = bid; u < 512; u += G) {
            const int b = u >> 6, h = (u >> 4) & 3, qblk = u & 15;
            const int qpos = qblk * 128 + (wave >> 1) * 32 + (lane & 31);
            bf16* qrow = R + ((size_t)b * SEQ + qpos) * LDQ + C_AQ + h * 128;
            const bf16* Kg = R + (size_t)b * SEQ * LDQ + C_AK + h * 128; const bf16* Vg = R + (size_t)b * SEQ * LDQ + C_AV + h * 128;
            const float nslope = -__builtin_amdgcn_exp2f(-2.f * (float)(h + 1)) * L2E;
            attn_shared_unit<2>((LAS char*)lds, qrow, Kg, Vg, LDQ, SEQ / 64, qpos, nslope, negM_a, lam, a.in[12]);
        }
        for (int u = bid; u < 256; u += G) {
            const int b = u >> 5, h = (u >> 3) & 3, qblk = u & 7;
            const int qpos = qblk * 256 + wave * 32 + (lane & 31);
            bf16* qrow = R + ((size_t)b * SEQ + qpos) * LDQ + C_CQ + h * 128;
            const bf16* Kg = CKV + (size_t)b * NMEM * D + h * 128; const bf16* Vg = Kg + 512;
            attn_shared_unit<1>((LAS char*)lds, qrow, Kg, Vg, D, NMEM / 64, qpos, 0.f, negM_c, 0.f, a.in[12]);
        }
        __syncthreads();
        for (int wu = gw; wu < NB * 3 * 4 * 64; wu += NGW) attn_b_wave_unit((LAS char*)lds + wave * (32 * KP + 32 * VP), R, LB, wu, negM_b, lane);
    }
    if (a.ph_hi - a.ph_lo > 1) grid.sync();

    }
    if (a.ph_lo <= 3 && 3 < a.ph_hi) {
    { FRESH_LANE
    for (int m = gw; m < M; m += NGW) {
        const int j = lane >> 4, d8 = (lane & 15) * 8;
        const float l0 = LB[((size_t)0 * M + m) * 4 + j], l1 = LB[((size_t)1 * M + m) * 4 + j], l2 = LB[((size_t)2 * M + m) * 4 + j];
        const float inv = 1.f / (l0 + l1 + l2); const float w0 = l0 * inv, w1 = l1 * inv, w2 = l2 * inv;
        bf16* p0 = R + (size_t)m * LDQ + C_BQ + j * 128 + d8;
        const u32x4 o0 = *(const u32x4*)p0, o1 = *(const u32x4*)(p0 + 512), o2 = *(const u32x4*)(p0 + 1024);
        u32x4 w;
#pragma unroll
        for (int e = 0; e < 4; ++e) {
            const float lo = w0 * pg8::bf_lo(o0[e]) + w1 * pg8::bf_lo(o1[e]) + w2 * pg8::bf_lo(o2[e]);
            const float hi = w0 * pg8::bf_hi(o0[e]) + w1 * pg8::bf_hi(o1[e]) + w2 * pg8::bf_hi(o2[e]);
            w[e] = cvtpk(lo, hi);
        }
        *(u32x4*)p0 = w;
    } }
    {
        pg8::Gemm g{XN, W_G, M, 3 * D, D, D}; pg8::StaticOrder S; S.init(M, 3 * D, G, bid);
        pg8::EpiGate E{R + C_GATE, LDQ, a.in[5]};
        pg8::gemm_phase<pg8::EpiGate, pg8::StaticOrder, true, true>(lds, g, S, E);
    }
    if (a.ph_hi - a.ph_lo > 1) grid.sync();

    }
    if (a.ph_lo <= 4 && 4 < a.ph_hi) {
    for (int gI = 0; gI < 3; ++gI) {
        const int acol = (gI == 0) ? C_AQ : ((gI == 1) ? C_BQ : C_CQ);
        pg8::Gemm g{R + acol, W_BR + (size_t)gI * D * 512, M, D, 512, LDQ}; pg8::StaticOrder S; S.init(M, D, G, bid);
        pg8::EpiBranch E{R + C_GATE + gI * D, LDQ};
        pg8::gemm_phase<pg8::EpiBranch, pg8::StaticOrder, true, true>(lds, g, S, E);
    }
    if (a.ph_hi - a.ph_lo > 1) grid.sync();

    }
    if (a.ph_lo <= 5 && 5 < a.ph_hi) {
    {
        pg8::Gemm g{R + C_GATE, W_OUT3, M, D, 3 * D, LDQ}; pg8::StaticOrder S; S.init(M, D, G, bid);
        pg8::EpiResid E{x, a.out, D};
        pg8::gemm_phase<pg8::EpiResid, pg8::StaticOrder, true, true>(lds, g, S, E);
    }
    if (a.ph_hi - a.ph_lo > 1) grid.sync();

    }
    if (a.ph_lo <= 6 && 6 < a.ph_hi) {
    { FRESH_LANE
    for (int m = gw; m < M; m += NGW) {
        const f32x4* xr = (const f32x4*)(a.out + (size_t)m * D) + lane; const f32x4* gr = (const f32x4*)a.in[21] + lane;
        f32x4 v[4]; float s = 0.f;
#pragma unroll
        for (int j = 0; j < 4; ++j) { v[j] = xr[64 * j]; s += (v[j][0] * v[j][0] + v[j][1] * v[j][1]) + (v[j][2] * v[j][2] + v[j][3] * v[j][3]); }
        const float rstd = 1.f / sqrtf(wave_sum(s) * (1.f / 1024.f) + EPS);
        u32x2* o8 = (u32x2*)(R + (size_t)m * LDQ + C_H2) + lane;
#pragma unroll
        for (int j = 0; j < 4; ++j) { const f32x4 gn = gr[64 * j]; u32x2 w; w.x = cvtpk(v[j][0] * rstd * gn[0], v[j][1] * rstd * gn[1]); w.y = cvtpk(v[j][2] * rstd * gn[2], v[j][3] * rstd * gn[3]); o8[64 * j] = w; }
    } }
    if (a.ph_hi - a.ph_lo > 1) grid.sync();

    }
    if (a.ph_lo <= 7 && 7 < a.ph_hi) {
    {
        pg8::Gemm g{R + C_H2, W_GU, M, 2 * DFF, D, LDQ}; pg8::StaticOrder S; S.init(M, 2 * DFF, G, bid);
        pg8::EpiSwiGLU E{R + C_ACT, LDQ};
        pg8::gemm_phase<pg8::EpiSwiGLU, pg8::StaticOrder, true, true>(lds, g, S, E);
    }
    if (a.ph_hi - a.ph_lo > 1) grid.sync();

    }
    if (a.ph_lo <= 8 && 8 < a.ph_hi) {
    {
        pg8::Gemm g{R + C_ACT, W_DN, M, D, DFF, LDQ}; pg8::StaticOrder S; S.init(M, D, G, bid);
        pg8::EpiResid E{a.out, a.out, D};
        pg8::gemm_phase<pg8::EpiResid, pg8::StaticOrder, true, true>(lds, g, S, E);
    }
    }
}

extern "C" void kernel_launch(void* const* d_in, const int* in_sizes, int n_in, void* d_out, int out_size, void* d_ws, size_t ws_size, hipStream_t stream) {
    static int grid = 0;
    if (grid == 0) {
        if (n_in != 25 || out_size != M * D || ws_size < WS_END) { fprintf(stderr, "kernel_launch: unexpected problem shape (n_in %d out %d ws %zu)\n", n_in, out_size, ws_size); grid = -1; return; }
        int dev = 0, cus = 0, per_cu = 0;
        hipGetDevice(&dev);
        hipDeviceGetAttribute(&cus, hipDeviceAttributeMultiprocessorCount, dev);
        if (hipFuncSetAttribute((const void*)fwd_megakernel, hipFuncAttributeMaxDynamicSharedMemorySize, LDS_BYTES) != hipSuccess) { fprintf(stderr, "kernel_launch: hipFuncSetAttribute failed\n"); }
        hipOccupancyMaxActiveBlocksPerMultiprocessor(&per_cu, (const void*)fwd_megakernel, 512, LDS_BYTES);
        (void)hipGetLastError();
        if (per_cu < 1) per_cu = 1;
        grid = cus;
        fprintf(stderr, "kernel_launch: cus %d per_cu %d grid %d\n", cus, per_cu, grid);
    }
    if (grid < 0) return;
    Args a{};
    for (int i = 0; i < 25; ++i) a.in[i] = (const float*)d_in[i];
    a.out = (float*)d_out; a.ws = (unsigned char*)d_ws;
    hipError_t e = hipSuccess;
#if MK_LAUNCHES == 1
    a.ph_lo = 0; a.ph_hi = 9;
    void* args[] = {&a};
    e = hipLaunchCooperativeKernel((const void*)fwd_megakernel, dim3(grid), dim3(512), args, LDS_BYTES, stream);
#else
    for (int k = 0; k < 9; ++k) { a.ph_lo = k; a.ph_hi = k + 1; hipLaunchKernelGGL(fwd_megakernel, dim3(grid), dim3(512), LDS_BYTES, stream, a); }
    e = hipPeekAtLastError();
#endif
    if (e != hipSuccess) fprintf(stderr, "cooperative launch failed: %s (grid %d)\n", hipGetErrorString(e), grid);
}
```

```cpp
#include <hip/hip_runtime.h>
#include <hip/hip_cooperative_groups.h>
#include <cstdio>
#include <cstdint>
namespace cg = cooperative_groups;
namespace pg8 {
#define PG8_LAS __attribute__((address_space(3)))
typedef unsigned short bf16_t;
typedef short bf16x8 __attribute__((ext_vector_type(8)));
typedef float f32x4 __attribute__((ext_vector_type(4)));
typedef unsigned u32x4 __attribute__((ext_vector_type(4)));
constexpr int BM = 256, BK = 64, HALF = 128, HTB = HALF * BK * 2  , STAGE_BYTES = 8 * HTB, NXCD = 8, WGM = 8;

__host__ __device__ __forceinline__ int lds_byte(int r, int c) { const int st = (r >> 4) * 2 + (c >> 5), rr = r & 15, cc = c & 31, ob = rr * 64 + cc * 2; return st * 1024 + (ob ^ (((ob >> 9) & 1) << 5)); }
__host__ __device__ __forceinline__ void stage_rc(int b, int& R, int& C) { const int st = b / 1024, sb = b % 1024, swz = sb ^ (((sb >> 9) & 1) << 5); R = (st >> 1) * 16 + swz / 64; C = (st & 1) * 32 + (swz % 64) / 2; }
__host__ __device__ __forceinline__ int perm32(int rho) { const int n = rho >> 4, i = rho & 15; return 8 * (i >> 2) + 4 * n + (i & 3); }

struct Unit { int pm, pn; };
struct Gemm { const bf16_t* A; const bf16_t* Bt; int M, N, K, lda; };

struct StaticOrder {
    int nM, nN, nwg, G, c;
    __host__ __device__ void init(int M, int N, int G_, int c_) { nM = M / BM; nN = N / BM; nwg = nM * nN; G = G_; c = c_; }
    __host__ __device__ bool next(int i, Unit& u) const {
        const long L = (long)i * G + c; if (L >= nwg) return false;
        int wgid = (int)L; { const int q = nwg / NXCD, r = nwg % NXCD, xcd = wgid % NXCD, off = wgid / NXCD; wgid = (xcd < r ? xcd * (q + 1) : r * (q + 1) + (xcd - r) * q) + off; }
        const int nig = WGM * nN, gid = wgid / nig, fm = gid * WGM, gsz = (nM - fm) < WGM ? (nM - fm) : WGM;
        u.pm = fm + ((wgid % nig) % gsz); u.pn = (wgid % nig) / gsz; return true;
    }
    __device__ __forceinline__ void a_ready(const Unit&) const {}
    __device__ __forceinline__ void done(const Unit&) const {}
};

typedef float f32x2v_t __attribute__((ext_vector_type(2))); typedef __bf16 bf16x2v_t __attribute__((ext_vector_type(2)));
__device__ __forceinline__ unsigned cvt_pk_bf16(float lo, float hi) { f32x2v_t v = {lo, hi}; bf16x2v_t b = __builtin_convertvector(v, bf16x2v_t); return __builtin_bit_cast(unsigned, b); }
__device__ __forceinline__ float bf_lo(unsigned w) { return __builtin_bit_cast(float, w << 16); }
__device__ __forceinline__ float bf_hi(unsigned w) { return __builtin_bit_cast(float, w & 0xffff0000u); }
#define PG8_ACC const f32x4 (&acc)[2][2][4][2]

struct EpiQKV {
    static constexpr bool PERM = true, AFTER_DRAIN = false;
    bf16_t* O; int ldc; int mode;
    PG8_LAS const float* GT;
    PG8_LAS float* X;
    __device__ __forceinline__ void operator()(PG8_ACC, const Unit& u, int wr, int wc, int fr, int fq) const {
        const int pn = u.pn;
        int kind, gp; float sc = 1.f;
        constexpr float L2E = 1.4426950408889634f;
        if (mode == 0) {
            if (pn < 2) { kind = 1; gp = 0; sc = 0.125f * L2E; }
            else if (pn < 4) { kind = 1; gp = 64; }
            else if (pn < 6) { kind = 0; gp = 64; }
            else if (pn < 12) { kind = 2; gp = 128; sc = 0.08838834764831845f * L2E; }
            else if (pn < 18) { kind = 2; gp = 256; }
            else if (pn < 24) { kind = 0; gp = 256; }
            else { kind = 2; gp = 384; sc = 0.08838834764831845f * L2E; }
        } else {
            if (pn < 2) { kind = 2; gp = 512; } else { kind = 0; gp = 512; }
        }
        const int row0 = u.pm * BM + wr * 64 + fr, col0 = pn * BM + wc * 32 + 8 * fq;
        float rs[2][4][2];
        f32x4 gv[2];
        if (kind != 0) {
#pragma unroll
            for (int ai = 0; ai < 2; ++ai)
#pragma unroll
                for (int m = 0; m < 4; ++m)
#pragma unroll
                    for (int bj = 0; bj < 2; ++bj) {
                        const f32x4 a = acc[ai][bj][m][0], b = acc[ai][bj][m][1];
                        float s = (a[0] * a[0] + a[1] * a[1]) + (a[2] * a[2] + a[3] * a[3]) + (b[0] * b[0] + b[1] * b[1]) + (b[2] * b[2] + b[3] * b[3]);
                        s += __shfl_xor(s, 16); s += __shfl_xor(s, 32);
                        if (fq == 0) X[((ai * 128 + wr * 64 + m * 16 + fr) * 2 + bj) * 4 + wc] = s;
                    }
            asm volatile("s_waitcnt lgkmcnt(0)" ::: "memory"); __builtin_amdgcn_s_barrier(); asm volatile("" ::: "memory");
            const int hd = (kind == 1) ? 64 : 128;
            const float inv_hd = (kind == 1) ? (1.f / 64.f) : (1.f / 128.f);
#pragma unroll
            for (int ai = 0; ai < 2; ++ai)
#pragma unroll
                for (int m = 0; m < 4; ++m)
#pragma unroll
                    for (int bj = 0; bj < 2; ++bj) {
                        const f32x4 xs = *(const PG8_LAS f32x4*)(X + ((ai * 128 + wr * 64 + m * 16 + fr) * 2 + bj) * 4);
                        float tot;
                        if (kind == 1) tot = (wc < 2) ? (xs[0] + xs[1]) : (xs[2] + xs[3]);
                        else tot = (xs[0] + xs[1]) + (xs[2] + xs[3]);
                        rs[ai][m][bj] = __builtin_amdgcn_rsqf(tot * inv_hd + 1e-6f) * sc;
                    }
            const int gc = ((wc * 32 + 8 * fq) & (hd - 1));
            gv[0] = *(const PG8_LAS f32x4*)(GT + gp + gc); gv[1] = *(const PG8_LAS f32x4*)(GT + gp + gc + 4);
        } else {
#pragma unroll
            for (int ai = 0; ai < 2; ++ai)
#pragma unroll
                for (int m = 0; m < 4; ++m)
#pragma unroll
                    for (int bj = 0; bj < 2; ++bj) rs[ai][m][bj] = 1.f;
            gv[0] = (f32x4){1.f, 1.f, 1.f, 1.f}; gv[1] = gv[0];
        }
#pragma unroll
        for (int ai = 0; ai < 2; ++ai)
#pragma unroll
            for (int m = 0; m < 4; ++m) { bf16_t* rowp = O + (size_t)(row0 + ai * HALF + m * 16) * ldc + col0;
#pragma unroll
                for (int bj = 0; bj < 2; ++bj) { const float r = rs[ai][m][bj];
                    const f32x4 v0 = acc[ai][bj][m][0] * gv[0] * r, v1 = acc[ai][bj][m][1] * gv[1] * r;
                    u32x4 w; w.x = cvt_pk_bf16(v0[0], v0[1]); w.y = cvt_pk_bf16(v0[2], v0[3]); w.z = cvt_pk_bf16(v1[0], v1[1]); w.w = cvt_pk_bf16(v1[2], v1[3]);
                    *(u32x4*)(rowp + bj * HALF) = w; } }
    }
};

struct EpiGate {
    static constexpr bool PERM = true, AFTER_DRAIN = false;
    bf16_t* O; int ldc; const float* bias;
    __device__ __forceinline__ void operator()(PG8_ACC, const Unit& u, int wr, int wc, int fr, int fq) const {
        const int row0 = u.pm * BM + wr * 64 + fr, col0 = u.pn * BM + wc * 32 + 8 * fq;
        f32x4 bv[2][2];
#pragma unroll
        for (int bj = 0; bj < 2; ++bj)
#pragma unroll
            for (int n = 0; n < 2; ++n) bv[bj][n] = *(const f32x4*)(bias + col0 + bj * HALF + 4 * n);
#pragma unroll
        for (int ai = 0; ai < 2; ++ai)
#pragma unroll
            for (int m = 0; m < 4; ++m) { bf16_t* rowp = O + (size_t)(row0 + ai * HALF + m * 16) * ldc + col0;
#pragma unroll
                for (int bj = 0; bj < 2; ++bj) { f32x4 v0 = acc[ai][bj][m][0] + bv[bj][0], v1 = acc[ai][bj][m][1] + bv[bj][1];
#pragma unroll
                    for (int e = 0; e < 4; ++e) { v0[e] = __builtin_amdgcn_rcpf(1.f + __builtin_amdgcn_exp2f(-1.4426950408889634f * v0[e])); v1[e] = __builtin_amdgcn_rcpf(1.f + __builtin_amdgcn_exp2f(-1.4426950408889634f * v1[e])); }
                    u32x4 w; w.x = cvt_pk_bf16(v0[0], v0[1]); w.y = cvt_pk_bf16(v0[2], v0[3]); w.z = cvt_pk_bf16(v1[0], v1[1]); w.w = cvt_pk_bf16(v1[2], v1[3]);
                    *(u32x4*)(rowp + bj * HALF) = w; } }
    }
};

struct EpiBranch {
    static constexpr bool PERM = true, AFTER_DRAIN = false;
    bf16_t* G; int ldc;
    __device__ __forceinline__ void operator()(PG8_ACC, const Unit& u, int wr, int wc, int fr, int fq) const {
        const int row0 = u.pm * BM + wr * 64 + fr, col0 = u.pn * BM + wc * 32 + 8 * fq;
#pragma unroll
        for (int ai = 0; ai < 2; ++ai)
#pragma unroll
            for (int m = 0; m < 4; ++m) { bf16_t* rowp = G + (size_t)(row0 + ai * HALF + m * 16) * ldc + col0;
#pragma unroll
                for (int bj = 0; bj < 2; ++bj) { const u32x4 gt = *(const u32x4*)(rowp + bj * HALF);
                    const f32x4 a = acc[ai][bj][m][0], b = acc[ai][bj][m][1];
                    u32x4 w; w.x = cvt_pk_bf16(a[0] * bf_lo(gt.x), a[1] * bf_hi(gt.x)); w.y = cvt_pk_bf16(a[2] * bf_lo(gt.y), a[3] * bf_hi(gt.y));
                    w.z = cvt_pk_bf16(b[0] * bf_lo(gt.z), b[1] * bf_hi(gt.z)); w.w = cvt_pk_bf16(b[2] * bf_lo(gt.w), b[3] * bf_hi(gt.w));
                    *(u32x4*)(rowp + bj * HALF) = w; } }
    }
};

struct EpiResid {
    static constexpr bool PERM = true, AFTER_DRAIN = false;
    const float* res; float* out; int ld;
    __device__ __forceinline__ void operator()(PG8_ACC, const Unit& u, int wr, int wc, int fr, int fq) const {
        const int row0 = u.pm * BM + wr * 64 + fr, col0 = u.pn * BM + wc * 32 + 8 * fq;
#pragma unroll
        for (int ai = 0; ai < 2; ++ai)
#pragma unroll
            for (int m = 0; m < 4; ++m) { const size_t off = (size_t)(row0 + ai * HALF + m * 16) * ld + col0;
#pragma unroll
                for (int bj = 0; bj < 2; ++bj) {
                    const f32x4 r0 = *(const f32x4*)(res + off + bj * HALF), r1 = *(const f32x4*)(res + off + bj * HALF + 4);
                    const f32x4 v0 = acc[ai][bj][m][0] + r0, v1 = acc[ai][bj][m][1] + r1;
                    *(f32x4*)(out + off + bj * HALF) = v0; *(f32x4*)(out + off + bj * HALF + 4) = v1; } }
    }
};

struct EpiSwiGLU {
    static constexpr bool PERM = true, AFTER_DRAIN = false;
    bf16_t* O; int ldc;
    __device__ __forceinline__ void operator()(PG8_ACC, const Unit& u, int wr, int wc, int fr, int fq) const {
        const int row0 = u.pm * BM + wr * 64 + fr, col0 = u.pn * HALF + wc * 32 + 8 * fq;
#pragma unroll
        for (int ai = 0; ai < 2; ++ai)
#pragma unroll
            for (int m = 0; m < 4; ++m) { bf16_t* rowp = O + (size_t)(row0 + ai * HALF + m * 16) * ldc + col0;
                f32x4 v[2];
#pragma unroll
                for (int n = 0; n < 2; ++n) { const f32x4 gt = acc[ai][0][m][n], up = acc[ai][1][m][n];
#pragma unroll
                    for (int e = 0; e < 4; ++e) v[n][e] = gt[e] * __builtin_amdgcn_rcpf(1.f + __builtin_amdgcn_exp2f(-1.4426950408889634f * gt[e])) * up[e]; }
                u32x4 w; w.x = cvt_pk_bf16(v[0][0], v[0][1]); w.y = cvt_pk_bf16(v[0][2], v[0][3]); w.z = cvt_pk_bf16(v[1][0], v[1][1]); w.w = cvt_pk_bf16(v[1][2], v[1][3]);
                *(u32x4*)rowp = w; }
    }
};

template <class Epi, class Sched, bool ALIGN_EPI = false, bool SP2 = false>
__device__ __forceinline__ void gemm_phase(PG8_LAS unsigned char* lds, const Gemm g, const Sched& S, const Epi& E) {
    int tid = threadIdx.x; asm volatile("" : "+v"(tid));
    const int wid = __builtin_amdgcn_readfirstlane(tid >> 6), lane = tid & 63, wr = wid >> 2, wc = wid & 3, fr = lane & 15, fq = lane >> 4;
    const int K = g.K, nt = K / BK;
    unsigned voffA[2], voffB[2];
#pragma unroll
    for (int i = 0; i < 2; ++i) { int R, C; stage_rc(tid * 16 + i * 8192, R, C); const int Rb = Epi::PERM ? ((R & ~31) + perm32(R & 31)) : R;
        voffA[i] = (unsigned)(R * g.lda + C) * 2u; voffB[i] = (unsigned)(Rb * K + C) * 2u; }
    const size_t kstep = (size_t)(BK * 2);
    const size_t hstepA = (size_t)HALF * g.lda * 2, hstepB = (size_t)HALF * K * 2;
    const size_t tstepA = 2 * hstepA, tstepB = 2 * hstepB;
    const unsigned ldsw = (unsigned)wid * 1024u;
    const int aoff = lds_byte(wr * 64 + fr, fq * 8), boff = lds_byte(wc * 32 + fr, fq * 8);
#define PG8_SA(b, h) (((b) * 2 + (h)) * HTB)
#define PG8_SB(b, h) ((4 + (b) * 2 + (h)) * HTB)
#define PG8_STAGE(bufoff, gbase, voff) do { _Pragma("unroll") for (int _i = 0; _i < 2; ++_i) \
        __builtin_amdgcn_global_load_lds((const unsigned*)((const char*)(gbase) + (voff)[_i]), (PG8_LAS unsigned*)(lds + (bufoff) + ldsw + _i * 8192), 16, 0, 0); } while (0)
#define PG8_LDA(dst, b, h) do { _Pragma("unroll") for (int m = 0; m < 4; ++m) _Pragma("unroll") for (int k = 0; k < 2; ++k) dst[m][k] = *(const PG8_LAS bf16x8*)(lds + PG8_SA(b, h) + aoff + m * 2048 + k * 1024); } while (0)
#define PG8_LDB(dst, b, h) do { _Pragma("unroll") for (int n = 0; n < 2; ++n) _Pragma("unroll") for (int k = 0; k < 2; ++k) dst[n][k] = *(const PG8_LAS bf16x8*)(lds + PG8_SB(b, h) + boff + n * 2048 + k * 1024); } while (0)
#define PG8_MMA(ai, bj, At, Bt) do { __builtin_amdgcn_s_setprio(1); _Pragma("unroll") for (int m = 0; m < 4; ++m) _Pragma("unroll") for (int n = 0; n < 2; ++n) _Pragma("unroll") for (int k = 0; k < 2; ++k) \
        acc[ai][bj][m][n] = __builtin_amdgcn_mfma_f32_16x16x32_bf16(Bt[n][k], At[m][k], acc[ai][bj][m][n], 0, 0, 0); __builtin_amdgcn_s_setprio(0); } while (0)
#define PG8_WAIT_V(n) asm volatile("s_waitcnt vmcnt(" #n ")" ::: "memory")
#define PG8_WAIT_L(n) asm volatile("s_waitcnt lgkmcnt(" #n ")" ::: "memory")
#define PG8_BAR __builtin_amdgcn_s_barrier()
#define PG8_SCHED __builtin_amdgcn_sched_barrier(0)
    Unit cur, nxt; int ui = 0;
    if (!S.next(0, cur)) return;
    f32x4 acc[2][2][4][2];
#pragma unroll
    for (int a = 0; a < 2; ++a)
#pragma unroll
        for (int b = 0; b < 2; ++b)
#pragma unroll
            for (int m = 0; m < 4; ++m)
#pragma unroll
                for (int n = 0; n < 2; ++n) acc[a][b][m][n] = (f32x4){0.f, 0.f, 0.f, 0.f};
    bf16x8 At[4][2], B0[2][2], B1[2][2];
    const char* cA = (const char*)g.A + (size_t)cur.pm * tstepA; const char* cB = (const char*)g.Bt + (size_t)cur.pn * tstepB;
    S.a_ready(cur);
    if constexpr (SP2) {
        PG8_STAGE(PG8_SB(0, 0), cB, voffB); PG8_STAGE(PG8_SB(0, 1), cB + hstepB, voffB); PG8_STAGE(PG8_SA(0, 0), cA, voffA); PG8_STAGE(PG8_SA(0, 1), cA + hstepA, voffA);
        if (wr == 1) PG8_BAR;
        PG8_WAIT_V(2); PG8_BAR;
        PG8_STAGE(PG8_SB(1, 0), cB + kstep, voffB); PG8_STAGE(PG8_SA(1, 0), cA + kstep, voffA); PG8_STAGE(PG8_SB(1, 1), cB + hstepB + kstep, voffB);
        PG8_WAIT_V(6); PG8_BAR;
    } else {
        PG8_STAGE(PG8_SB(0, 0), cB, voffB); PG8_STAGE(PG8_SA(0, 0), cA, voffA); PG8_STAGE(PG8_SB(0, 1), cB + hstepB, voffB); PG8_STAGE(PG8_SA(0, 1), cA + hstepA, voffA);
        if (wr == 1) PG8_BAR;
        PG8_WAIT_V(4); PG8_BAR;
        PG8_STAGE(PG8_SB(1, 0), cB + kstep, voffB); PG8_STAGE(PG8_SA(1, 0), cA + kstep, voffA); PG8_STAGE(PG8_SB(1, 1), cB + hstepB + kstep, voffB);
        PG8_WAIT_V(6); PG8_BAR;
    }
    for (;;) {
        const bool has_next = S.next(ui + 1, nxt);
        const char* nA = has_next ? (const char*)g.A + (size_t)nxt.pm * tstepA : cA; const char* nB = has_next ? (const char*)g.Bt + (size_t)nxt.pn * tstepB : cB;
        for (int t = 0; t < nt; t += 2) {
            const bool last = (t == nt - 2);
            const char* a1 = cA + (size_t)(t + 1) * kstep;
            const char* a2 = last ? nA : cA + (size_t)(t + 2) * kstep; const char* b2 = last ? nB : cB + (size_t)(t + 2) * kstep;
            const char* a3 = a2 + kstep; const char* b3 = b2 + kstep;
            if (last && has_next) S.a_ready(nxt);
            if constexpr (SP2) {
            PG8_LDB(B0, 0, 0); PG8_LDB(B1, 0, 1); PG8_SCHED; PG8_LDA(At, 0, 0); PG8_STAGE(PG8_SA(1, 1), a1 + hstepA, voffA);
            PG8_WAIT_V(8); PG8_WAIT_L(0); PG8_BAR; PG8_MMA(0, 0, At, B0); PG8_MMA(0, 1, At, B1); PG8_BAR; PG8_SCHED;
            PG8_LDA(At, 0, 1); PG8_STAGE(PG8_SB(0, 0), b2, voffB); PG8_STAGE(PG8_SB(0, 1), b2 + hstepB, voffB); PG8_STAGE(PG8_SA(0, 0), a2, voffA);
            PG8_WAIT_V(8); PG8_WAIT_L(0); PG8_BAR; PG8_MMA(1, 0, At, B0); PG8_MMA(1, 1, At, B1); PG8_BAR; PG8_SCHED;
            PG8_LDB(B0, 1, 0); PG8_LDB(B1, 1, 1); PG8_SCHED; PG8_LDA(At, 1, 0); PG8_STAGE(PG8_SA(0, 1), a2 + hstepA, voffA);
            PG8_WAIT_V(8); PG8_WAIT_L(0); PG8_BAR; PG8_MMA(0, 0, At, B0); PG8_MMA(0, 1, At, B1); PG8_BAR; PG8_SCHED;
            PG8_LDA(At, 1, 1); PG8_STAGE(PG8_SB(1, 0), b3, voffB); PG8_STAGE(PG8_SB(1, 1), b3 + hstepB, voffB); PG8_STAGE(PG8_SA(1, 0), a3, voffA);
            PG8_WAIT_V(8); PG8_WAIT_L(0); PG8_BAR; PG8_MMA(1, 0, At, B0); PG8_MMA(1, 1, At, B1); PG8_BAR; PG8_SCHED;
            } else {
            PG8_LDB(B0, 0, 0); PG8_SCHED; PG8_LDA(At, 0, 0); PG8_STAGE(PG8_SA(1, 1), a1 + hstepA, voffA);
            PG8_WAIT_L(8); PG8_BAR; PG8_WAIT_L(0); PG8_MMA(0, 0, At, B0); PG8_BAR; PG8_SCHED;
            PG8_LDB(B1, 0, 1); PG8_STAGE(PG8_SB(0, 0), b2, voffB);
            PG8_BAR; PG8_WAIT_L(0); PG8_MMA(0, 1, At, B1); PG8_BAR;
            PG8_LDA(At, 0, 1); PG8_STAGE(PG8_SA(0, 0), a2, voffA);
            PG8_BAR; PG8_WAIT_L(0); PG8_MMA(1, 0, At, B0); PG8_BAR; PG8_SCHED;
            PG8_STAGE(PG8_SB(0, 1), b2 + hstepB, voffB);
            PG8_WAIT_V(6); PG8_BAR; PG8_MMA(1, 1, At, B1); PG8_BAR;
            PG8_LDB(B0, 1, 0); PG8_SCHED; PG8_LDA(At, 1, 0); PG8_STAGE(PG8_SA(0, 1), a2 + hstepA, voffA);
            PG8_WAIT_L(8); PG8_BAR; PG8_WAIT_L(0); PG8_MMA(0, 0, At, B0); PG8_BAR; PG8_SCHED;
            PG8_LDB(B1, 1, 1); PG8_STAGE(PG8_SB(1, 0), b3, voffB);
            PG8_BAR; PG8_WAIT_L(0); PG8_MMA(0, 1, At, B1); PG8_BAR;
            PG8_LDA(At, 1, 1); PG8_STAGE(PG8_SA(1, 0), a3, voffA);
            PG8_BAR; PG8_WAIT_L(0); PG8_MMA(1, 0, At, B0); PG8_BAR; PG8_SCHED;
            PG8_STAGE(PG8_SB(1, 1), b3 + hstepB, voffB);
            PG8_WAIT_V(6); PG8_BAR; PG8_MMA(1, 1, At, B1); PG8_BAR;
            }
        }
        if constexpr (ALIGN_EPI) { if (wr == 0) PG8_BAR; }
        if constexpr (!Epi::AFTER_DRAIN) { E(acc, cur, wr, wc, fr, fq); S.done(cur); }
        if (!has_next) break;
#pragma unroll
        for (int a = 0; a < 2; ++a)
#pragma unroll
            for (int b = 0; b < 2; ++b)
#pragma unroll
                for (int m = 0; m < 4; ++m)
#pragma unroll
                    for (int n = 0; n < 2; ++n) acc[a][b][m][n] = (f32x4){0.f, 0.f, 0.f, 0.f};
        cur = nxt; cA = nA; cB = nB; ++ui;
        if constexpr (ALIGN_EPI) { if (wr == 1) PG8_BAR; }
    }
    PG8_WAIT_V(0);
    if constexpr (!ALIGN_EPI) { if (wr == 0) PG8_BAR; }
    PG8_BAR;
    if constexpr (Epi::AFTER_DRAIN) { E.fused(acc, cur, wr, wc, fr, fq, lds, wid, lane); S.done(cur); }
#undef PG8_SA
#undef PG8_SB
#undef PG8_STAGE
#undef PG8_LDA
#undef PG8_LDB
#undef PG8_MMA
#undef PG8_WAIT_V
#undef PG8_WAIT_L
#undef PG8_BAR
#undef PG8_SCHED
}
}

#define LAS __attribute__((address_space(3)))
typedef unsigned short bf16;
typedef short bf16x8 __attribute__((ext_vector_type(8)));
typedef short s16x4 __attribute__((ext_vector_type(4)));
typedef short v4i16_t __attribute__((ext_vector_type(4)));
typedef float f32x16 __attribute__((ext_vector_type(16)));
typedef float f32x4 __attribute__((ext_vector_type(4)));
typedef float f32x2_t __attribute__((ext_vector_type(2)));
typedef __bf16 bf16x2_t __attribute__((ext_vector_type(2)));
typedef unsigned u32x4 __attribute__((ext_vector_type(4)));
typedef unsigned u32x2 __attribute__((ext_vector_type(2)));

constexpr int D = 1024, SEQ = 2048, NB = 8, M = NB * SEQ, NMEM = 256, MMEM = NB * NMEM, DIN = 6656, DFF = 2816;
constexpr int LDQ = 6656;
constexpr int C_AQ = 0, C_AK = 512, C_AV = 1024, C_BQ = 1536, C_BK = 3072, C_BV = 4608, C_CQ = 6144;
constexpr int C_GATE = 3072;
constexpr int C_H2 = 0, C_ACT = 1024;
constexpr float L2E = 1.4426950408889634f;
constexpr float EPS = 1e-6f;

constexpr size_t WS_WIN = 0;
constexpr size_t WS_WG = WS_WIN + (size_t)DIN * D * 2;
constexpr size_t WS_WMEM = WS_WG + (size_t)3 * D * D * 2;
constexpr size_t WS_WBR = WS_WMEM + (size_t)D * D * 2;
constexpr size_t WS_WOUT3 = WS_WBR + (size_t)3 * D * 512 * 2;
constexpr size_t WS_WGU = WS_WOUT3 + (size_t)D * 3 * D * 2;
constexpr size_t WS_WDN = WS_WGU + (size_t)2 * DFF * D * 2;
constexpr size_t WS_LB = WS_WDN + (size_t)D * DFF * 2;
constexpr size_t WS_R = WS_LB + (size_t)3 * M * 4 * 4;
constexpr size_t WS_BAR = WS_R + (size_t)M * LDQ * 2;
constexpr size_t WS_END = WS_BAR + 16384;
static_assert(WS_END <= (size_t)256 * 1024 * 1024, "d_ws map");
constexpr size_t DO_XN = 0;
constexpr size_t DO_MN = DO_XN + (size_t)M * D * 2;
constexpr size_t DO_CKV = DO_MN + (size_t)MMEM * D * 2;
static_assert(DO_CKV + (size_t)MMEM * D * 2 <= (size_t)M * D * 4, "d_out scratch map");

constexpr int LDS_BYTES = 155648;
constexpr int XCH_OFF = 131072, GT_OFF = 131072 + 8192;
constexpr int MISC_OFF = LDS_BYTES - 64;
constexpr int KP = 272, VP = 320;

__device__ __forceinline__ unsigned cvtpk(float lo, float hi) { f32x2_t v = {lo, hi}; bf16x2_t b = __builtin_convertvector(v, bf16x2_t); return __builtin_bit_cast(unsigned, b); }
__device__ __forceinline__ float wave_sum(float v) {
#pragma unroll
    for (int o = 1; o < 64; o <<= 1) v += __shfl_xor(v, o);
    return v;
}
__device__ __forceinline__ float wave_max(float v) {
#pragma unroll
    for (int o = 1; o < 64; o <<= 1) v = fmaxf(v, __shfl_xor(v, o));
    return v;
}
__device__ __forceinline__ float absmax_vec(const float* g, int n, int lane) {
    float v = fabsf(g[lane]); if (n > 64) v = fmaxf(v, fabsf(g[lane + 64]));
    return wave_max(v);
}

__device__ __forceinline__ void tr_item(const float* W, int N, int k0, int n0, bf16* WT, int dst_pitch, int dst_row0, int dst_k0, int ncopies, int copy_stride, LAS float* scr, int lane) {
#pragma unroll 8
    for (int i = 0; i < 32; ++i) { const int kk = 2 * i + (lane >> 5); scr[kk * 33 + (lane & 31)] = W[(size_t)(k0 + kk) * N + n0 + (lane & 31)]; }
    asm volatile("s_waitcnt lgkmcnt(0)" ::: "memory");
    const int c = lane & 7;
#pragma unroll
    for (int j = 0; j < 4; ++j) { const int n = (lane >> 3) + 8 * j; const LAS float* s = scr + (8 * c) * 33 + n;
        u32x4 o; o.x = cvtpk(s[0 * 33], s[1 * 33]); o.y = cvtpk(s[2 * 33], s[3 * 33]); o.z = cvtpk(s[4 * 33], s[5 * 33]); o.w = cvtpk(s[6 * 33], s[7 * 33]);
        bf16* dst = WT + (size_t)(dst_row0 + n0 + n) * dst_pitch + dst_k0 + k0 + 8 * c;
        for (int cp = 0; cp < ncopies; ++cp) *(u32x4*)(dst + (size_t)cp * copy_stride) = o; }
    asm volatile("s_waitcnt lgkmcnt(0)" ::: "memory");
}
__device__ __forceinline__ void rms_row_to_bf16(const float* xrow, const float* gain, bf16* orow, int lane) {
    const f32x4* xr = (const f32x4*)xrow + lane; const f32x4* gr = (const f32x4*)gain + lane;
    f32x4 v[4]; float s = 0.f;
#pragma unroll
    for (int j = 0; j < 4; ++j) { v[j] = xr[64 * j]; s += (v[j][0] * v[j][0] + v[j][1] * v[j][1]) + (v[j][2] * v[j][2] + v[j][3] * v[j][3]); }
    const float rstd = 1.f / sqrtf(wave_sum(s) * (1.f / 1024.f) + EPS);
    u32x2* o8 = (u32x2*)orow + lane;
#pragma unroll
    for (int j = 0; j < 4; ++j) { const f32x4 g = gr[64 * j]; u32x2 w; w.x = cvtpk(v[j][0] * rstd * g[0], v[j][1] * rstd * g[1]); w.y = cvtpk(v[j][2] * rstd * g[2], v[j][3] * rstd * g[3]); o8[64 * j] = w; }
}

__device__ __forceinline__ s16x4 vtr(const LAS char* p) { return __builtin_bit_cast(s16x4, __builtin_amdgcn_ds_read_tr16_b64_v4i16((LAS v4i16_t*)p)); }

template <int NK>
__device__ __forceinline__ void qk32(f32x16& S, const LAS char* Kp, const bf16x8* Q, int ks0, int r32, int hi) {
    const LAS char* kb = Kp + r32 * KP + hi * 16 + ks0 * 32;
#pragma unroll
    for (int ks = 0; ks < NK; ++ks) { const bf16x8 kf = *(const LAS bf16x8*)(kb + ks * 32); S = __builtin_amdgcn_mfma_f32_32x32x16_bf16(kf, Q[ks0 + ks], S, 0, 0, 0); }
}
__device__ __forceinline__ void pv32(f32x16 (&O)[4], const bf16x8 (&P)[2], const LAS char* Vp, int lane) {
    const int i = lane & 15, q = i >> 2, p = i & 3, dsel = (lane >> 4) & 1, h = lane >> 5;
    const LAS char* vb = Vp + (4 * h + q) * VP + (16 * dsel + 4 * p) * 2;
#pragma unroll
    for (int s = 0; s < 2; ++s)
#pragma unroll
        for (int db = 0; db < 4; ++db) {
            const s16x4 lo = vtr(vb + (16 * s) * VP + db * 64), hi4 = vtr(vb + (16 * s + 8) * VP + db * 64);
            const bf16x8 a = (bf16x8){lo[0], lo[1], lo[2], lo[3], hi4[0], hi4[1], hi4[2], hi4[3]};
            O[db] = __builtin_amdgcn_mfma_f32_32x32x16_bf16(a, P[s], O[db], 0, 0, 0);
        }
}
template <int MODE>
__device__ __forceinline__ void soft32(const f32x16& S, bf16x8 (&P)[2], float& l, float dbase, float nslope) {
    float p[16];
#pragma unroll
    for (int r = 0; r < 16; ++r) {
        float s = S[r];
        if (MODE >= 1) { const float a = fabsf(dbase - (float)((r & 3) + 8 * (r >> 2))); s = fmaf(nslope, a, s); float e = __builtin_amdgcn_exp2f(s); if (MODE == 2) e = (a <= 64.f) ? e : 0.f; p[r] = e; }
        else p[r] = __builtin_amdgcn_exp2f(s);
        l += p[r];
    }
#pragma unroll
    for (int s = 0; s < 2; ++s) { u32x4 w; w.x = cvtpk(p[8 * s + 0], p[8 * s + 1]); w.y = cvtpk(p[8 * s + 2], p[8 * s + 3]); w.z = cvtpk(p[8 * s + 4], p[8 * s + 5]); w.w = cvtpk(p[8 * s + 6], p[8 * s + 7]); P[s] = __builtin_bit_cast(bf16x8, w); }
}
__device__ __forceinline__ void zero16(f32x16& v) {
#pragma unroll
    for (int r = 0; r < 16; ++r) v[r] = 0.f;
}

template <int NC>
__device__ __forceinline__ void attn_shared_unit(LAS char* lds, bf16* qrow, const bf16* Kg, const bf16* Vg, int kvp, int nt, int qpos, float nslope, float negM0, float lam, const float* subln) {
    int tid = threadIdx.x; asm volatile("" : "+v"(tid));
    const int lane = tid & 63, r32 = lane & 31, hi = lane >> 5;
    const int wv = __builtin_amdgcn_readfirstlane(tid >> 6), cm = (NC == 2) ? (wv & 1) : 0;
    constexpr int NQ = (NC == 2) ? 4 : 8;
    bf16x8 Q[NQ];
#pragma unroll
    for (int ks = 0; ks < NQ; ++ks) Q[ks] = *(const bf16x8*)(qrow + cm * 64 + 16 * ks + 8 * hi);
    f32x16 O[4]; float l = 0.f;
#pragma unroll
    for (int db = 0; db < 4; ++db) zero16(O[db]);
    const int lrow = tid >> 3, lcb = (tid & 7) * 32;
    const char* kgp = (const char*)(Kg + (size_t)lrow * kvp) + lcb; const char* vgp = (const char*)(Vg + (size_t)lrow * kvp) + lcb;
    const size_t tstep = (size_t)64 * kvp * 2;
    u32x4 kr0, kr1, vr0, vr1;
    kr0 = *(const u32x4*)kgp; kr1 = *(const u32x4*)(kgp + 16); vr0 = *(const u32x4*)vgp; vr1 = *(const u32x4*)(vgp + 16);
    __syncthreads();
    { LAS char* kb = lds + lrow * KP + lcb; LAS char* vb = lds + 64 * KP + lrow * VP + lcb;
      *(LAS u32x4*)kb = kr0; *(LAS u32x4*)(kb + 16) = kr1; *(LAS u32x4*)vb = vr0; *(LAS u32x4*)(vb + 16) = vr1; }
    __syncthreads();
    constexpr int BUFB = 64 * KP + 64 * VP;
#pragma unroll 1
    for (int t = 0; t < nt; ++t) {
        const bool more = (t + 1 < nt);
        if (more) { const char* kp = kgp + (size_t)(t + 1) * tstep; const char* vp = vgp + (size_t)(t + 1) * tstep;
            kr0 = *(const u32x4*)kp; kr1 = *(const u32x4*)(kp + 16); vr0 = *(const u32x4*)vp; vr1 = *(const u32x4*)(vp + 16); }
        const LAS char* Kb = lds + (t & 1) * BUFB; const LAS char* Vb = Kb + 64 * KP;
#pragma unroll
        for (int half = 0; half < 2; ++half) {
            const float dbase = (float)(qpos - (t * 64 + half * 32 + 4 * hi));
            f32x16 S;
#pragma unroll
            for (int r = 0; r < 16; ++r) S[r] = negM0;
            qk32<NQ>(S, Kb + half * 32 * KP + cm * 128, Q, 0, r32, hi);
            bf16x8 P[2];
            soft32<(NC == 2) ? 1 : 0>(S, P, l, dbase, nslope);
            pv32(O, P, Vb + half * 32 * VP, lane);
        }
        if (more) { LAS char* kb = lds + ((t + 1) & 1) * BUFB + lrow * KP + lcb; LAS char* vb = lds + ((t + 1) & 1) * BUFB + 64 * KP + lrow * VP + lcb;
            *(LAS u32x4*)kb = kr0; *(LAS u32x4*)(kb + 16) = kr1; *(LAS u32x4*)vb = vr0; *(LAS u32x4*)(vb + 16) = vr1; }
        __syncthreads();
    }
    l += __shfl_xor(l, 32);
    if (NC == 2) {
        LAS float* XO = (LAS float*)lds + (wv >> 1) * 4096 + lane;
        if (cm == 1) { const float i2 = lam / l;
#pragma unroll
            for (int db = 0; db < 4; ++db)
#pragma unroll
                for (int r = 0; r < 16; ++r) XO[(db * 16 + r) * 64] = O[db][r] * i2; }
        __syncthreads();
        if (cm == 0) {
            const float i1 = 1.f / l; float ss = 0.f;
#pragma unroll
            for (int db = 0; db < 4; ++db)
#pragma unroll
                for (int r = 0; r < 16; ++r) { const float o = O[db][r] * i1 - XO[(db * 16 + r) * 64]; O[db][r] = o; ss += o * o; }
            ss += __shfl_xor(ss, 32);
            const float rstd = (1.f / sqrtf(ss * (1.f / 128.f) + EPS)) * 0.8f;
#pragma unroll
            for (int db = 0; db < 4; ++db)
#pragma unroll
                for (int g4 = 0; g4 < 4; ++g4) { const int d = 32 * db + 8 * g4 + 4 * hi; const f32x4 gn = *(const f32x4*)(subln + d);
                    u32x2 w; w.x = cvtpk(O[db][4 * g4 + 0] * rstd * gn[0], O[db][4 * g4 + 1] * rstd * gn[1]); w.y = cvtpk(O[db][4 * g4 + 2] * rstd * gn[2], O[db][4 * g4 + 3] * rstd * gn[3]);
                    *(u32x2*)(qrow + d) = w; }
        }
    } else {
        const float i1 = 1.f / l;
#pragma unroll
        for (int db = 0; db < 4; ++db)
#pragma unroll
            for (int g4 = 0; g4 < 4; ++g4) { const int d = 32 * db + 8 * g4 + 4 * hi;
                u32x2 w; w.x = cvtpk(O[db][4 * g4 + 0] * i1, O[db][4 * g4 + 1] * i1); w.y = cvtpk(O[db][4 * g4 + 2] * i1, O[db][4 * g4 + 3] * i1);
                *(u32x2*)(qrow + d) = w; }
    }
}

__device__ __forceinline__ void attn_b_wave_unit(LAS char* wl, bf16* R, float* LB, int wu, float negM0, int lane_in) {
    int lane = lane_in; asm volatile("" : "+v"(lane));
    const int r32 = lane & 31, hi = lane >> 5;
    const int idx = wu & 63, j = (wu >> 6) & 3, bg = wu >> 8, g = bg % 3, b = bg / 3;
    const int dil = (g == 0) ? 1 : ((g == 1) ? 4 : 16), nqb = 64 / dil, sub_len = SEQ / dil;
    const int res = idx / nqb, qb = idx % nqb;
    const float slope = __builtin_amdgcn_exp2f(-8.f * (float)(g * 4 + j + 1) / 12.f);
    const float nslope = -slope * (float)dil * L2E;
    const int qsub = 32 * qb + r32;
    const size_t qrow_i = (size_t)b * SEQ + (size_t)qsub * dil + res;
    const int hcol = (g * 4 + j) * 128;
    bf16* qrow = R + qrow_i * LDQ + C_BQ + hcol;
    bf16x8 Q[8];
#pragma unroll
    for (int ks = 0; ks < 8; ++ks) Q[ks] = *(const bf16x8*)(qrow + 16 * ks + 8 * hi);
    f32x16 O[4]; float l = 0.f;
#pragma unroll
    for (int db = 0; db < 4; ++db) zero16(O[db]);
    const int lr = lane >> 4, lc = (lane & 15) * 8;
#pragma unroll 1
    for (int kt = 0; kt < 5; ++kt) {
        const int kb = 32 * qb - 64 + 32 * kt;
        if (kb < 0 || kb >= sub_len) continue;
        u32x4 kr[8], vr[8];
#pragma unroll
        for (int n = 0; n < 8; ++n) { const size_t krow = (size_t)b * SEQ + (size_t)(kb + 4 * n + lr) * dil + res;
            kr[n] = *(const u32x4*)(R + krow * LDQ + C_BK + hcol + lc); vr[n] = *(const u32x4*)(R + krow * LDQ + C_BV + hcol + lc); }
#pragma unroll
        for (int n = 0; n < 8; ++n) { *(LAS u32x4*)(wl + (4 * n + lr) * KP + lc * 2) = kr[n]; *(LAS u32x4*)(wl + 32 * KP + (4 * n + lr) * VP + lc * 2) = vr[n]; }
        asm volatile("s_waitcnt lgkmcnt(0)" ::: "memory");
        f32x16 S;
#pragma unroll
        for (int r = 0; r < 16; ++r) S[r] = negM0;
        qk32<8>(S, wl, Q, 0, r32, hi);
        bf16x8 P[2];
        soft32<2>(S, P, l, (float)(qsub - (kb + 4 * hi)), nslope);
        pv32(O, P, wl + 32 * KP, lane);
        asm volatile("s_waitcnt lgkmcnt(0)" ::: "memory");
    }
    l += __shfl_xor(l, 32);
    const float i1 = 1.f / l;
#pragma unroll
    for (int db = 0; db < 4; ++db)
#pragma unroll
        for (int g4 = 0; g4 < 4; ++g4) { const int d = 32 * db + 8 * g4 + 4 * hi;
            u32x2 w; w.x = cvtpk(O[db][4 * g4 + 0] * i1, O[db][4 * g4 + 1] * i1); w.y = cvtpk(O[db][4 * g4 + 2] * i1, O[db][4 * g4 + 3] * i1);
            *(u32x2*)(qrow + d) = w; }
    if (hi == 0) LB[((size_t)g * M + qrow_i) * 4 + j] = l;
}

#define XB_TMO      128
#define XB_XCNT(j)  (256  + 64 * (j))
#define XB_XSUB(j)  (1280 + 64 * (j))
#define XB_XGEN(j)  (2304 + 64 * (j))
#define XB_TOP      3328
#define XB_TOPGEN   3392
#define XCD_BAR_WORDS 3456
#define XB_SPIN_CAP (1u << 18)

__device__ __forceinline__ unsigned xb_ld(unsigned* p)              { return __hip_atomic_load(p, __ATOMIC_RELAXED, __HIP_MEMORY_SCOPE_AGENT); }
__device__ __forceinline__ unsigned xb_add(unsigned* p, unsigned v) { return __hip_atomic_fetch_add(p, v, __ATOMIC_RELAXED, __HIP_MEMORY_SCOPE_AGENT); }
__device__ __forceinline__ unsigned xb_xcc_id() { return (unsigned)__builtin_amdgcn_s_getreg((3 << 11) | 20) & 0xFu; }
#define XB_SPIN(cond, bar) do { unsigned _sp = 0; while (cond) { __builtin_amdgcn_s_sleep(1); \
    if ((++_sp & 255u) == 0u) { if (xb_ld(&(bar)[XB_TMO])) break; if (_sp > XB_SPIN_CAP) { atomicAdd(&(bar)[XB_TMO], 1u); break; } } } } while (0)

struct XcdBarrier {
    unsigned* bar; unsigned x;
    volatile LAS unsigned* st;
};

__device__ __forceinline__ XcdBarrier xcd_barrier_post(unsigned* bar, volatile LAS unsigned* st) {
    XcdBarrier b; b.bar = bar; b.x = xb_xcc_id(); b.st = st;
    if (threadIdx.x == 0) (void)xb_add(&bar[XB_XCNT(b.x)], 1u);
    return b;
}
__device__ __forceinline__ void xcd_barrier_complete(unsigned* bar, unsigned x, unsigned& nloc, unsigned& nx) {
    const unsigned G = gridDim.x * gridDim.y * gridDim.z;
    unsigned sum, cnt, mine, sp = 0u;
    for (;;) {
        sum = 0u; cnt = 0u; mine = 0u;
#pragma unroll
        for (unsigned j = 0; j < 16; ++j) { const unsigned c = xb_ld(&bar[XB_XCNT(j)]); sum += c; cnt += (c > 0u) ? 1u : 0u; mine = (j == x) ? c : mine; }
        if (sum == G) break;
        __builtin_amdgcn_s_sleep(1);
        if ((++sp & 255u) == 0u) { if (xb_ld(&bar[XB_TMO])) break; if (sp > XB_SPIN_CAP) { atomicAdd(&bar[XB_TMO], 1u); break; } }
    }
    nloc = mine > 0u ? mine : 1u; nx = cnt > 0u ? cnt : 1u;
}

__device__ __forceinline__ void xcd_barrier(const XcdBarrier& b) {
    asm volatile("s_waitcnt vmcnt(0)" ::: "memory");
    __syncthreads();
    if (threadIdx.x == 0) {
        unsigned* bar = b.bar;
        __builtin_amdgcn_s_waitcnt(0);
        unsigned nloc = b.st[0], nx = b.st[1];
        if (nloc == 0u) { xcd_barrier_complete(bar, b.x, nloc, nx); b.st[0] = nloc; b.st[1] = nx; }
        const unsigned old = xb_add(&bar[XB_XSUB(b.x)], 1u);
        const unsigned gen = old / nloc;
        if (old + 1u == (gen + 1u) * nloc) {
            __builtin_amdgcn_fence(__ATOMIC_RELEASE, "agent");
            asm volatile("s_waitcnt vmcnt(0)" ::: "memory");
            const unsigned og = xb_add(&bar[XB_TOP], 1u);
            const unsigned tg = og / nx;
            if (og + 1u == (tg + 1u) * nx) xb_add(&bar[XB_TOPGEN], 1u);
            else XB_SPIN(xb_ld(&bar[XB_TOPGEN]) == tg, bar);
            __builtin_amdgcn_fence(__ATOMIC_ACQUIRE, "agent");
            xb_add(&bar[XB_XGEN(b.x)], 1u);
            asm volatile("s_waitcnt vmcnt(0)" ::: "memory");
        } else {
            XB_SPIN(xb_ld(&bar[XB_XGEN(b.x)]) == gen, bar);
            __builtin_amdgcn_fence(__ATOMIC_ACQUIRE, "agent");
            asm volatile("s_waitcnt vmcnt(0)" ::: "memory");
        }
    }
    __syncthreads();
}

struct Args { const float* in[25]; float* out; unsigned char* ws; };

__global__ void __launch_bounds__(512, 2) fwd_megakernel(Args a) {
    extern __shared__ __attribute__((aligned(16))) unsigned char lds_raw[];
    LAS unsigned char* lds = (LAS unsigned char*)lds_raw;
    cg::grid_group grid = cg::this_grid();
    const int wave = __builtin_amdgcn_readfirstlane((int)threadIdx.x >> 6);
#define FRESH_LANE int tid_ = threadIdx.x; asm volatile("" : "+v"(tid_)); const int lane = tid_ & 63;
    const int G = gridDim.x, bid = blockIdx.x;
    const int gw = bid * 8 + wave, NGW = G * 8;
    unsigned char* ws = a.ws;
    const float* x = a.in[0]; const float* mem = a.in[1];
    bf16* W_IN = (bf16*)(ws + WS_WIN); bf16* W_G = (bf16*)(ws + WS_WG); bf16* W_MEM = (bf16*)(ws + WS_WMEM); bf16* W_BR = (bf16*)(ws + WS_WBR);
    bf16* W_OUT3 = (bf16*)(ws + WS_WOUT3); bf16* W_GU = (bf16*)(ws + WS_WGU); bf16* W_DN = (bf16*)(ws + WS_WDN);
    float* LB = (float*)(ws + WS_LB); bf16* R = (bf16*)(ws + WS_R);
    unsigned char* dob = (unsigned char*)a.out;
    bf16* XN = (bf16*)(dob + DO_XN); bf16* MN = (bf16*)(dob + DO_MN); bf16* CKV = (bf16*)(dob + DO_CKV);

    volatile LAS unsigned* MISC = (volatile LAS unsigned*)(lds + MISC_OFF);
    unsigned* barw = (unsigned*)(ws + WS_BAR);
    if (threadIdx.x < 16) MISC[threadIdx.x] = 0u;
    if (bid == 0) for (int i = threadIdx.x; i < XCD_BAR_WORDS; i += 512) barw[i] = 0u;
    {
        FRESH_LANE
        LAS float* scr = (LAS float*)(lds + wave * 8704);
        constexpr int I_IN = 16 * (DIN / 32), I_G = 16 * (3 * D / 32), I_MEM = 16 * (D / 32), I_BR = 8 * (D / 32), I_OUT = 16 * (D / 32), I_FF = 16 * (DFF / 32), I_DN = (DFF / 64) * (D / 32);
        constexpr int NITEMS = I_IN + I_G + I_MEM + 3 * I_BR + I_OUT + 2 * I_FF + I_DN;
        for (int it = gw; it < NITEMS; it += NGW) {
            int r = it;
            if (r < I_IN) { const int nb = DIN / 32; tr_item(a.in[3], DIN, 64 * (r / nb), 32 * (r % nb), W_IN, D, 0, 0, 1, 0, scr, lane); continue; } r -= I_IN;
            if (r < I_G) { const int nb = 3 * D / 32; tr_item(a.in[4], 3 * D, 64 * (r / nb), 32 * (r % nb), W_G, D, 0, 0, 1, 0, scr, lane); continue; } r -= I_G;
            if (r < I_MEM) { const int nb = D / 32; tr_item(a.in[16], D, 64 * (r / nb), 32 * (r % nb), W_MEM, D, 0, 0, 1, 0, scr, lane); continue; } r -= I_MEM;
            if (r < 3 * I_BR) { const int gI = r / I_BR, rr = r % I_BR, nb = D / 32; tr_item(a.in[19] + (size_t)gI * 512 * D, D, 64 * (rr / nb), 32 * (rr % nb), W_BR + (size_t)gI * D * 512, 512, 0, 0, 1, 0, scr, lane); continue; } r -= 3 * I_BR;
            if (r < I_OUT) { const int nb = D / 32; tr_item(a.in[20], D, 64 * (r / nb), 32 * (r % nb), W_OUT3, 3 * D, 0, 0, 3, D, scr, lane); continue; } r -= I_OUT;
            if (r < 2 * I_FF) { const int s = r / I_FF, rr = r % I_FF, nb = DFF / 32; const int n0 = 32 * (rr % nb);
                tr_item(a.in[22 + s], DFF, 64 * (rr / nb), n0, W_GU, D, 256 * (n0 / 128) + 128 * s + (n0 % 128) - n0, 0, 1, 0, scr, lane); continue; } r -= 2 * I_FF;
            { const int nb = D / 32; tr_item(a.in[24], D, 64 * (r / nb), 32 * (r % nb), W_DN, DFF, 0, 0, 1, 0, scr, lane); }
        }
        for (int m = gw; m < M + MMEM; m += NGW) {
            if (m < M) rms_row_to_bf16(x + (size_t)m * D, a.in[2], XN + (size_t)m * D, lane);
            else rms_row_to_bf16(mem + (size_t)(m - M) * D, a.in[15], MN + (size_t)(m - M) * D, lane);
        }
    }
    grid.sync();
    XcdBarrier bar = xcd_barrier_post(barw, MISC);

    {
        LAS float* GT = (LAS float*)(lds + GT_OFF);
        { int t2 = threadIdx.x; asm volatile("" : "+v"(t2));
          if (t2 < 64) { GT[t2] = a.in[6][t2]; GT[64 + t2] = a.in[7][t2]; }
          if (t2 < 128) { GT[128 + t2] = a.in[13][t2]; GT[256 + t2] = a.in[14][t2]; GT[384 + t2] = a.in[17][t2]; GT[512 + t2] = a.in[18][t2]; } }
        __syncthreads();
        { const pg8::EpiQKV E{R, LDQ, 0, GT, (LAS float*)(lds + XCH_OFF)};
          pg8::Gemm g{XN, W_IN, M, DIN, D, D}; pg8::StaticOrder S; S.init(M, DIN, G, bid);
          pg8::gemm_phase<pg8::EpiQKV, pg8::StaticOrder, true, true>(lds, g, S, E); }
        { const pg8::EpiQKV E{CKV, D, 1, GT, (LAS float*)(lds + XCH_OFF)};
          pg8::Gemm g{MN, W_MEM, MMEM, D, D, D}; pg8::StaticOrder S; S.init(MMEM, D, G, bid);
          pg8::gemm_phase<pg8::EpiQKV, pg8::StaticOrder, true, true>(lds, g, S, E); }
    }
    xcd_barrier(bar);

    {
        FRESH_LANE
        const float m_aq = absmax_vec(a.in[6], 64, lane), m_ak = absmax_vec(a.in[7], 64, lane);
        const float m_bq = absmax_vec(a.in[13], 128, lane), m_bk = absmax_vec(a.in[14], 128, lane);
        const float m_cq = absmax_vec(a.in[17], 128, lane), m_ck = absmax_vec(a.in[18], 128, lane);
        const float negM_a = -8.f * m_aq * m_ak * L2E, negM_b = -11.313708499f * m_bq * m_bk * L2E, negM_c = -11.313708499f * m_cq * m_ck * L2E;
        const float s1 = wave_sum(a.in[8][lane] * a.in[9][lane]), s2 = wave_sum(a.in[10][lane] * a.in[11][lane]);
        const float lam = expf(s1) - expf(s2) + 0.2f;
        for (int u = bid; u < 512; u += G) {
            const int b = u >> 6, h = (u >> 4) & 3, qblk = u & 15;
            const int qpos = qblk * 128 + (wave >> 1) * 32 + (lane & 31);
            bf16* qrow = R + ((size_t)b * SEQ + qpos) * LDQ + C_AQ + h * 128;
            const bf16* Kg = R + (size_t)b * SEQ * LDQ + C_AK + h * 128; const bf16* Vg = R + (size_t)b * SEQ * LDQ + C_AV + h * 128;
            const float nslope = -__builtin_amdgcn_exp2f(-2.f * (float)(h + 1)) * L2E;
            attn_shared_unit<2>((LAS char*)lds, qrow, Kg, Vg, LDQ, SEQ / 64, qpos, nslope, negM_a, lam, a.in[12]);
        }
        for (int u = bid; u < 256; u += G) {
            const int b = u >> 5, h = (u >> 3) & 3, qblk = u & 7;
            const int qpos = qblk * 256 + wave * 32 + (lane & 31);
            bf16* qrow = R + ((size_t)b * SEQ + qpos) * LDQ + C_CQ + h * 128;
            const bf16* Kg = CKV + (size_t)b * NMEM * D + h * 128; const bf16* Vg = Kg + 512;
            attn_shared_unit<1>((LAS char*)lds, qrow, Kg, Vg, D, NMEM / 64, qpos, 0.f, negM_c, 0.f, a.in[12]);
        }
        __syncthreads();
        for (int wu = gw; wu < NB * 3 * 4 * 64; wu += NGW) attn_b_wave_unit((LAS char*)lds + wave * (32 * KP + 32 * VP), R, LB, wu, negM_b, lane);
    }
    xcd_barrier(bar);

    { FRESH_LANE
    for (int m = gw; m < M; m += NGW) {
        const int j = lane >> 4, d8 = (lane & 15) * 8;
        const float l0 = LB[((size_t)0 * M + m) * 4 + j], l1 = LB[((size_t)1 * M + m) * 4 + j], l2 = LB[((size_t)2 * M + m) * 4 + j];
        const float inv = 1.f / (l0 + l1 + l2); const float w0 = l0 * inv, w1 = l1 * inv, w2 = l2 * inv;
        bf16* p0 = R + (size_t)m * LDQ + C_BQ + j * 128 + d8;
        const u32x4 o0 = *(const u32x4*)p0, o1 = *(const u32x4*)(p0 + 512), o2 = *(const u32x4*)(p0 + 1024);
        u32x4 w;
#pragma unroll
        for (int e = 0; e < 4; ++e) {
            const float lo = w0 * pg8::bf_lo(o0[e]) + w1 * pg8::bf_lo(o1[e]) + w2 * pg8::bf_lo(o2[e]);
            const float hi = w0 * pg8::bf_hi(o0[e]) + w1 * pg8::bf_hi(o1[e]) + w2 * pg8::bf_hi(o2[e]);
            w[e] = cvtpk(lo, hi);
        }
        *(u32x4*)p0 = w;
    } }
    {
        pg8::Gemm g{XN, W_G, M, 3 * D, D, D}; pg8::StaticOrder S; S.init(M, 3 * D, G, bid);
        pg8::EpiGate E{R + C_GATE, LDQ, a.in[5]};
        pg8::gemm_phase<pg8::EpiGate, pg8::StaticOrder, true, true>(lds, g, S, E);
    }
    xcd_barrier(bar);

    for (int gI = 0; gI < 3; ++gI) {
        const int acol = (gI == 0) ? C_AQ : ((gI == 1) ? C_BQ : C_CQ);
        pg8::Gemm g{R + acol, W_BR + (size_t)gI * D * 512, M, D, 512, LDQ}; pg8::StaticOrder S; S.init(M, D, G, bid);
        pg8::EpiBranch E{R + C_GATE + gI * D, LDQ};
        pg8::gemm_phase<pg8::EpiBranch, pg8::StaticOrder, true, true>(lds, g, S, E);
    }
    xcd_barrier(bar);

    {
        pg8::Gemm g{R + C_GATE, W_OUT3, M, D, 3 * D, LDQ}; pg8::StaticOrder S; S.init(M, D, G, bid);
        pg8::EpiResid E{x, a.out, D};
        pg8::gemm_phase<pg8::EpiResid, pg8::StaticOrder, true, true>(lds, g, S, E);
    }
    xcd_barrier(bar);

    { FRESH_LANE
    for (int m = gw; m < M; m += NGW) {
        const f32x4* xr = (const f32x4*)(a.out + (size_t)m * D) + lane; const f32x4* gr = (const f32x4*)a.in[21] + lane;
        f32x4 v[4]; float s = 0.f;
#pragma unroll
        for (int j = 0; j < 4; ++j) { v[j] = xr[64 * j]; s += (v[j][0] * v[j][0] + v[j][1] * v[j][1]) + (v[j][2] * v[j][2] + v[j][3] * v[j][3]); }
        const float rstd = 1.f / sqrtf(wave_sum(s) * (1.f / 1024.f) + EPS);
        u32x2* o8 = (u32x2*)(R + (size_t)m * LDQ + C_H2) + lane;
#pragma unroll
        for (int j = 0; j < 4; ++j) { const f32x4 gn = gr[64 * j]; u32x2 w; w.x = cvtpk(v[j][0] * rstd * gn[0], v[j][1] * rstd * gn[1]); w.y = cvtpk(v[j][2] * rstd * gn[2], v[j][3] * rstd * gn[3]); o8[64 * j] = w; }
    } }
    xcd_barrier(bar);

    {
        pg8::Gemm g{R + C_H2, W_GU, M, 2 * DFF, D, LDQ}; pg8::StaticOrder S; S.init(M, 2 * DFF, G, bid);
        pg8::EpiSwiGLU E{R + C_ACT, LDQ};
        pg8::gemm_phase<pg8::EpiSwiGLU, pg8::StaticOrder, true, true>(lds, g, S, E);
    }
    xcd_barrier(bar);

    {
        pg8::Gemm g{R + C_ACT, W_DN, M, D, DFF, LDQ}; pg8::StaticOrder S; S.init(M, D, G, bid);
        pg8::EpiResid E{a.out, a.out, D};
        pg8::gemm_phase<pg8::EpiResid, pg8::StaticOrder, true, true>(lds, g, S, E);
    }
}

extern "C" void kernel_launch(void* const* d_in, const int* in_sizes, int n_in, void* d_out, int out_size, void* d_ws, size_t ws_size, hipStream_t stream) {
    static int grid = 0;
    if (grid == 0) {
        if (n_in != 25 || out_size != M * D || ws_size < WS_END) { fprintf(stderr, "kernel_launch: unexpected problem shape (n_in %d out %d ws %zu)\n", n_in, out_size, ws_size); grid = -1; return; }
        int dev = 0, cus = 0, per_cu = 0;
        hipGetDevice(&dev);
        hipDeviceGetAttribute(&cus, hipDeviceAttributeMultiprocessorCount, dev);
        if (hipFuncSetAttribute((const void*)fwd_megakernel, hipFuncAttributeMaxDynamicSharedMemorySize, LDS_BYTES) != hipSuccess) { fprintf(stderr, "kernel_launch: hipFuncSetAttribute failed\n"); }
        hipOccupancyMaxActiveBlocksPerMultiprocessor(&per_cu, (const void*)fwd_megakernel, 512, LDS_BYTES);
        (void)hipGetLastError();
        if (per_cu < 1) per_cu = 1;
        grid = cus;
        fprintf(stderr, "kernel_launch: cus %d per_cu %d grid %d\n", cus, per_cu, grid);
    }
    if (grid < 0) return;
    Args a{};
    for (int i = 0; i < 25; ++i) a.in[i] = (const float*)d_in[i];
    a.out = (float*)d_out; a.ws = (unsigned char*)d_ws;
    void* args[] = {&a};
    hipError_t e = hipLaunchCooperativeKernel((const void*)fwd_megakernel, dim3(grid), dim3(512), args, LDS_BYTES, stream);
    if (e != hipSuccess) fprintf(stderr, "cooperative launch failed: %s (grid %d)\n", hipGetErrorString(e), grid);
}
```

```cpp
#include <hip/hip_runtime.h>
#include <hip/hip_cooperative_groups.h>
#include <cstdio>
#include <cstdint>
namespace cg = cooperative_groups;
namespace pg8 {
#define PG8_LAS __attribute__((address_space(3)))
typedef unsigned short bf16_t;
typedef short bf16x8 __attribute__((ext_vector_type(8)));
typedef float f32x4 __attribute__((ext_vector_type(4)));
typedef unsigned u32x4 __attribute__((ext_vector_type(4)));
constexpr int BM = 256, BK = 64, HALF = 128, HTB = HALF * BK * 2  , STAGE_BYTES = 8 * HTB, NXCD = 8, WGM = 8;

__host__ __device__ __forceinline__ int lds_byte(int r, int c) { const int st = (r >> 4) * 2 + (c >> 5), rr = r & 15, cc = c & 31, ob = rr * 64 + cc * 2; return st * 1024 + (ob ^ (((ob >> 9) & 1) << 5)); }
__host__ __device__ __forceinline__ void stage_rc(int b, int& R, int& C) { const int st = b / 1024, sb = b % 1024, swz = sb ^ (((sb >> 9) & 1) << 5); R = (st >> 1) * 16 + swz / 64; C = (st & 1) * 32 + (swz % 64) / 2; }
__host__ __device__ __forceinline__ int perm32(int rho) { const int n = rho >> 4, i = rho & 15; return 8 * (i >> 2) + 4 * n + (i & 3); }

struct Unit { int pm, pn; };
struct Gemm { const bf16_t* A; const bf16_t* Bt; int M, N, K, lda; };

struct StaticOrder {
    int nM, nN, nwg, G, c;
    __host__ __device__ void init(int M, int N, int G_, int c_) { nM = M / BM; nN = N / BM; nwg = nM * nN; G = G_; c = c_; }
    __host__ __device__ bool next(int i, Unit& u) const {
        const long L = (long)i * G + c; if (L >= nwg) return false;
        int wgid = (int)L; { const int q = nwg / NXCD, r = nwg % NXCD, xcd = wgid % NXCD, off = wgid / NXCD; wgid = (xcd < r ? xcd * (q + 1) : r * (q + 1) + (xcd - r) * q) + off; }
        const int nig = WGM * nN, gid = wgid / nig, fm = gid * WGM, gsz = (nM - fm) < WGM ? (nM - fm) : WGM;
        u.pm = fm + ((wgid % nig) % gsz); u.pn = (wgid % nig) / gsz; return true;
    }
    __device__ __forceinline__ void a_ready(const Unit&) const {}
    __device__ __forceinline__ void done(const Unit&) const {}
};

typedef float f32x2v_t __attribute__((ext_vector_type(2))); typedef __bf16 bf16x2v_t __attribute__((ext_vector_type(2)));
__device__ __forceinline__ unsigned cvt_pk_bf16(float lo, float hi) { f32x2v_t v = {lo, hi}; bf16x2v_t b = __builtin_convertvector(v, bf16x2v_t); return __builtin_bit_cast(unsigned, b); }
__device__ __forceinline__ float bf_lo(unsigned w) { return __builtin_bit_cast(float, w << 16); }
__device__ __forceinline__ float bf_hi(unsigned w) { return __builtin_bit_cast(float, w & 0xffff0000u); }
#define PG8_ACC const f32x4 (&acc)[2][2][4][2]

struct EpiQKV {
    static constexpr bool PERM = true, AFTER_DRAIN = false;
    bf16_t* O; int ldc; int mode;
    PG8_LAS const float* GT;
    PG8_LAS float* X;
    __device__ __forceinline__ void operator()(PG8_ACC, const Unit& u, int wr, int wc, int fr, int fq) const {
        const int pn = u.pn;
        int kind, gp; float sc = 1.f;
        constexpr float L2E = 1.4426950408889634f;
        if (mode == 0) {
            if (pn < 2) { kind = 1; gp = 0; sc = 0.125f * L2E; }
            else if (pn < 4) { kind = 1; gp = 64; }
            else if (pn < 6) { kind = 0; gp = 64; }
            else if (pn < 12) { kind = 2; gp = 128; sc = 0.08838834764831845f * L2E; }
            else if (pn < 18) { kind = 2; gp = 256; }
            else if (pn < 24) { kind = 0; gp = 256; }
            else { kind = 2; gp = 384; sc = 0.08838834764831845f * L2E; }
        } else {
            if (pn < 2) { kind = 2; gp = 512; } else { kind = 0; gp = 512; }
        }
        const int row0 = u.pm * BM + wr * 64 + fr, col0 = pn * BM + wc * 32 + 8 * fq;
        float rs[2][4][2];
        f32x4 gv[2];
        if (kind != 0) {
#pragma unroll
            for (int ai = 0; ai < 2; ++ai)
#pragma unroll
                for (int m = 0; m < 4; ++m)
#pragma unroll
                    for (int bj = 0; bj < 2; ++bj) {
                        const f32x4 a = acc[ai][bj][m][0], b = acc[ai][bj][m][1];
                        float s = (a[0] * a[0] + a[1] * a[1]) + (a[2] * a[2] + a[3] * a[3]) + (b[0] * b[0] + b[1] * b[1]) + (b[2] * b[2] + b[3] * b[3]);
                        s += __shfl_xor(s, 16); s += __shfl_xor(s, 32);
                        if (fq == 0) X[((ai * 128 + wr * 64 + m * 16 + fr) * 2 + bj) * 4 + wc] = s;
                    }
            asm volatile("s_waitcnt lgkmcnt(0)" ::: "memory"); __builtin_amdgcn_s_barrier(); asm volatile("" ::: "memory");
            const int hd = (kind == 1) ? 64 : 128;
            const float inv_hd = (kind == 1) ? (1.f / 64.f) : (1.f / 128.f);
#pragma unroll
            for (int ai = 0; ai < 2; ++ai)
#pragma unroll
                for (int m = 0; m < 4; ++m)
#pragma unroll
                    for (int bj = 0; bj < 2; ++bj) {
                        const f32x4 xs = *(const PG8_LAS f32x4*)(X + ((ai * 128 + wr * 64 + m * 16 + fr) * 2 + bj) * 4);
                        float tot;
                        if (kind == 1) tot = (wc < 2) ? (xs[0] + xs[1]) : (xs[2] + xs[3]);
                        else tot = (xs[0] + xs[1]) + (xs[2] + xs[3]);
                        rs[ai][m][bj] = __builtin_amdgcn_rsqf(tot * inv_hd + 1e-6f) * sc;
                    }
            const int gc = ((wc * 32 + 8 * fq) & (hd - 1));
            gv[0] = *(const PG8_LAS f32x4*)(GT + gp + gc); gv[1] = *(const PG8_LAS f32x4*)(GT + gp + gc + 4);
        } else {
#pragma unroll
            for (int ai = 0; ai < 2; ++ai)
#pragma unroll
                for (int m = 0; m < 4; ++m)
#pragma unroll
                    for (int bj = 0; bj < 2; ++bj) rs[ai][m][bj] = 1.f;
            gv[0] = (f32x4){1.f, 1.f, 1.f, 1.f}; gv[1] = gv[0];
        }
#pragma unroll
        for (int ai = 0; ai < 2; ++ai)
#pragma unroll
            for (int m = 0; m < 4; ++m) { bf16_t* rowp = O + (size_t)(row0 + ai * HALF + m * 16) * ldc + col0;
#pragma unroll
                for (int bj = 0; bj < 2; ++bj) { const float r = rs[ai][m][bj];
                    const f32x4 v0 = acc[ai][bj][m][0] * gv[0] * r, v1 = acc[ai][bj][m][1] * gv[1] * r;
                    u32x4 w; w.x = cvt_pk_bf16(v0[0], v0[1]); w.y = cvt_pk_bf16(v0[2], v0[3]); w.z = cvt_pk_bf16(v1[0], v1[1]); w.w = cvt_pk_bf16(v1[2], v1[3]);
                    *(u32x4*)(rowp + bj * HALF) = w; } }
    }
};

struct EpiGate {
    static constexpr bool PERM = true, AFTER_DRAIN = false;
    bf16_t* O; int ldc; const float* bias;
    __device__ __forceinline__ void operator()(PG8_ACC, const Unit& u, int wr, int wc, int fr, int fq) const {
        const int row0 = u.pm * BM + wr * 64 + fr, col0 = u.pn * BM + wc * 32 + 8 * fq;
        f32x4 bv[2][2];
#pragma unroll
        for (int bj = 0; bj < 2; ++bj)
#pragma unroll
            for (int n = 0; n < 2; ++n) bv[bj][n] = *(const f32x4*)(bias + col0 + bj * HALF + 4 * n);
#pragma unroll
        for (int ai = 0; ai < 2; ++ai)
#pragma unroll
            for (int m = 0; m < 4; ++m) { bf16_t* rowp = O + (size_t)(row0 + ai * HALF + m * 16) * ldc + col0;
#pragma unroll
                for (int bj = 0; bj < 2; ++bj) { f32x4 v0 = acc[ai][bj][m][0] + bv[bj][0], v1 = acc[ai][bj][m][1] + bv[bj][1];
#pragma unroll
                    for (int e = 0; e < 4; ++e) { v0[e] = __builtin_amdgcn_rcpf(1.f + __builtin_amdgcn_exp2f(-1.4426950408889634f * v0[e])); v1[e] = __builtin_amdgcn_rcpf(1.f + __builtin_amdgcn_exp2f(-1.4426950408889634f * v1[e])); }
                    u32x4 w; w.x = cvt_pk_bf16(v0[0], v0[1]); w.y = cvt_pk_bf16(v0[2], v0[3]); w.z = cvt_pk_bf16(v1[0], v1[1]); w.w = cvt_pk_bf16(v1[2], v1[3]);
                    *(u32x4*)(rowp + bj * HALF) = w; } }
    }
};

struct EpiBranch {
    static constexpr bool PERM = true, AFTER_DRAIN = false;
    bf16_t* MIX; const bf16_t* GATE; int ldc; int accum;
    __device__ __forceinline__ void operator()(PG8_ACC, const Unit& u, int wr, int wc, int fr, int fq) const {
        const int row0 = u.pm * BM + wr * 64 + fr, col0 = u.pn * BM + wc * 32 + 8 * fq;
#pragma unroll
        for (int ai = 0; ai < 2; ++ai)
#pragma unroll
            for (int m = 0; m < 4; ++m) { const size_t off = (size_t)(row0 + ai * HALF + m * 16) * ldc + col0;
#pragma unroll
                for (int bj = 0; bj < 2; ++bj) { const u32x4 gt = *(const u32x4*)(GATE + off + bj * HALF);
                    f32x4 a = acc[ai][bj][m][0], b = acc[ai][bj][m][1];
                    a[0] *= bf_lo(gt.x); a[1] *= bf_hi(gt.x); a[2] *= bf_lo(gt.y); a[3] *= bf_hi(gt.y); b[0] *= bf_lo(gt.z); b[1] *= bf_hi(gt.z); b[2] *= bf_lo(gt.w); b[3] *= bf_hi(gt.w);
                    if (accum) { const u32x4 mx = *(const u32x4*)(MIX + off + bj * HALF);
                        a[0] += bf_lo(mx.x); a[1] += bf_hi(mx.x); a[2] += bf_lo(mx.y); a[3] += bf_hi(mx.y); b[0] += bf_lo(mx.z); b[1] += bf_hi(mx.z); b[2] += bf_lo(mx.w); b[3] += bf_hi(mx.w); }
                    u32x4 w; w.x = cvt_pk_bf16(a[0], a[1]); w.y = cvt_pk_bf16(a[2], a[3]); w.z = cvt_pk_bf16(b[0], b[1]); w.w = cvt_pk_bf16(b[2], b[3]);
                    *(u32x4*)(MIX + off + bj * HALF) = w; } }
    }
};

struct EpiResid {
    static constexpr bool PERM = true, AFTER_DRAIN = false;
    const float* res; float* out; int ld;
    __device__ __forceinline__ void operator()(PG8_ACC, const Unit& u, int wr, int wc, int fr, int fq) const {
        const int row0 = u.pm * BM + wr * 64 + fr, col0 = u.pn * BM + wc * 32 + 8 * fq;
#pragma unroll
        for (int ai = 0; ai < 2; ++ai)
#pragma unroll
            for (int m = 0; m < 4; ++m) { const size_t off = (size_t)(row0 + ai * HALF + m * 16) * ld + col0;
#pragma unroll
                for (int bj = 0; bj < 2; ++bj) {
                    const f32x4 r0 = *(const f32x4*)(res + off + bj * HALF), r1 = *(const f32x4*)(res + off + bj * HALF + 4);
                    const f32x4 v0 = acc[ai][bj][m][0] + r0, v1 = acc[ai][bj][m][1] + r1;
                    *(f32x4*)(out + off + bj * HALF) = v0; *(f32x4*)(out + off + bj * HALF + 4) = v1; } }
    }
};

struct EpiSwiGLU {
    static constexpr bool PERM = true, AFTER_DRAIN = false;
    bf16_t* O; int ldc;
    __device__ __forceinline__ void operator()(PG8_ACC, const Unit& u, int wr, int wc, int fr, int fq) const {
        const int row0 = u.pm * BM + wr * 64 + fr, col0 = u.pn * HALF + wc * 32 + 8 * fq;
#pragma unroll
        for (int ai = 0; ai < 2; ++ai)
#pragma unroll
            for (int m = 0; m < 4; ++m) { bf16_t* rowp = O + (size_t)(row0 + ai * HALF + m * 16) * ldc + col0;
                f32x4 v[2];
#pragma unroll
                for (int n = 0; n < 2; ++n) { const f32x4 gt = acc[ai][0][m][n], up = acc[ai][1][m][n];
#pragma unroll
                    for (int e = 0; e < 4; ++e) v[n][e] = gt[e] * __builtin_amdgcn_rcpf(1.f + __builtin_amdgcn_exp2f(-1.4426950408889634f * gt[e])) * up[e]; }
                u32x4 w; w.x = cvt_pk_bf16(v[0][0], v[0][1]); w.y = cvt_pk_bf16(v[0][2], v[0][3]); w.z = cvt_pk_bf16(v[1][0], v[1][1]); w.w = cvt_pk_bf16(v[1][2], v[1][3]);
                *(u32x4*)rowp = w; }
    }
};

template <class Epi, class Sched, bool ALIGN_EPI = false, bool SP2 = false>
__device__ __forceinline__ void gemm_phase(PG8_LAS unsigned char* lds, const Gemm g, const Sched& S, const Epi& E) {
    int tid = threadIdx.x; asm volatile("" : "+v"(tid));
    const int wid = __builtin_amdgcn_readfirstlane(tid >> 6), lane = tid & 63, wr = wid >> 2, wc = wid & 3, fr = lane & 15, fq = lane >> 4;
    const int K = g.K, nt = K / BK;
    unsigned voffA[2], voffB[2];
#pragma unroll
    for (int i = 0; i < 2; ++i) { int R, C; stage_rc(tid * 16 + i * 8192, R, C); const int Rb = Epi::PERM ? ((R & ~31) + perm32(R & 31)) : R;
        voffA[i] = (unsigned)(R * g.lda + C) * 2u; voffB[i] = (unsigned)(Rb * K + C) * 2u; }
    const size_t kstep = (size_t)(BK * 2);
    const size_t hstepA = (size_t)HALF * g.lda * 2, hstepB = (size_t)HALF * K * 2;
    const size_t tstepA = 2 * hstepA, tstepB = 2 * hstepB;
    const unsigned ldsw = (unsigned)wid * 1024u;
    const int aoff = lds_byte(wr * 64 + fr, fq * 8), boff = lds_byte(wc * 32 + fr, fq * 8);
#define PG8_SA(b, h) (((b) * 2 + (h)) * HTB)
#define PG8_SB(b, h) ((4 + (b) * 2 + (h)) * HTB)
#define PG8_STAGE(bufoff, gbase, voff) do { _Pragma("unroll") for (int _i = 0; _i < 2; ++_i) \
        __builtin_amdgcn_global_load_lds((const unsigned*)((const char*)(gbase) + (voff)[_i]), (PG8_LAS unsigned*)(lds + (bufoff) + ldsw + _i * 8192), 16, 0, 0); } while (0)
#define PG8_LDA(dst, b, h) do { _Pragma("unroll") for (int m = 0; m < 4; ++m) _Pragma("unroll") for (int k = 0; k < 2; ++k) dst[m][k] = *(const PG8_LAS bf16x8*)(lds + PG8_SA(b, h) + aoff + m * 2048 + k * 1024); } while (0)
#define PG8_LDB(dst, b, h) do { _Pragma("unroll") for (int n = 0; n < 2; ++n) _Pragma("unroll") for (int k = 0; k < 2; ++k) dst[n][k] = *(const PG8_LAS bf16x8*)(lds + PG8_SB(b, h) + boff + n * 2048 + k * 1024); } while (0)
#define PG8_MMA(ai, bj, At, Bt) do { __builtin_amdgcn_s_setprio(1); _Pragma("unroll") for (int m = 0; m < 4; ++m) _Pragma("unroll") for (int n = 0; n < 2; ++n) _Pragma("unroll") for (int k = 0; k < 2; ++k) \
        acc[ai][bj][m][n] = __builtin_amdgcn_mfma_f32_16x16x32_bf16(Bt[n][k], At[m][k], acc[ai][bj][m][n], 0, 0, 0); __builtin_amdgcn_s_setprio(0); } while (0)
#define PG8_WAIT_V(n) asm volatile("s_waitcnt vmcnt(" #n ")" ::: "memory")
#define PG8_WAIT_L(n) asm volatile("s_waitcnt lgkmcnt(" #n ")" ::: "memory")
#define PG8_BAR __builtin_amdgcn_s_barrier()
#define PG8_SCHED __builtin_amdgcn_sched_barrier(0)
    Unit cur, nxt; int ui = 0;
    if (!S.next(0, cur)) return;
    f32x4 acc[2][2][4][2];
#pragma unroll
    for (int a = 0; a < 2; ++a)
#pragma unroll
        for (int b = 0; b < 2; ++b)
#pragma unroll
            for (int m = 0; m < 4; ++m)
#pragma unroll
                for (int n = 0; n < 2; ++n) acc[a][b][m][n] = (f32x4){0.f, 0.f, 0.f, 0.f};
    bf16x8 At[4][2], B0[2][2], B1[2][2];
    const char* cA = (const char*)g.A + (size_t)cur.pm * tstepA; const char* cB = (const char*)g.Bt + (size_t)cur.pn * tstepB;
    S.a_ready(cur);
    if constexpr (SP2) {
        PG8_STAGE(PG8_SB(0, 0), cB, voffB); PG8_STAGE(PG8_SB(0, 1), cB + hstepB, voffB); PG8_STAGE(PG8_SA(0, 0), cA, voffA); PG8_STAGE(PG8_SA(0, 1), cA + hstepA, voffA);
        if (wr == 1) PG8_BAR;
        PG8_WAIT_V(2); PG8_BAR;
        PG8_STAGE(PG8_SB(1, 0), cB + kstep, voffB); PG8_STAGE(PG8_SA(1, 0), cA + kstep, voffA); PG8_STAGE(PG8_SB(1, 1), cB + hstepB + kstep, voffB);
        PG8_WAIT_V(6); PG8_BAR;
    } else {
        PG8_STAGE(PG8_SB(0, 0), cB, voffB); PG8_STAGE(PG8_SA(0, 0), cA, voffA); PG8_STAGE(PG8_SB(0, 1), cB + hstepB, voffB); PG8_STAGE(PG8_SA(0, 1), cA + hstepA, voffA);
        if (wr == 1) PG8_BAR;
        PG8_WAIT_V(4); PG8_BAR;
        PG8_STAGE(PG8_SB(1, 0), cB + kstep, voffB); PG8_STAGE(PG8_SA(1, 0), cA + kstep, voffA); PG8_STAGE(PG8_SB(1, 1), cB + hstepB + kstep, voffB);
        PG8_WAIT_V(6); PG8_BAR;
    }
    for (;;) {
        const bool has_next = S.next(ui + 1, nxt);
        const char* nA = has_next ? (const char*)g.A + (size_t)nxt.pm * tstepA : cA; const char* nB = has_next ? (const char*)g.Bt + (size_t)nxt.pn * tstepB : cB;
        for (int t = 0; t < nt; t += 2) {
            const bool last = (t == nt - 2);
            const char* a1 = cA + (size_t)(t + 1) * kstep;
            const char* a2 = last ? nA : cA + (size_t)(t + 2) * kstep; const char* b2 = last ? nB : cB + (size_t)(t + 2) * kstep;
            const char* a3 = a2 + kstep; const char* b3 = b2 + kstep;
            if (last && has_next) S.a_ready(nxt);
            if constexpr (SP2) {
            PG8_LDB(B0, 0, 0); PG8_LDB(B1, 0, 1); PG8_SCHED; PG8_LDA(At, 0, 0); PG8_STAGE(PG8_SA(1, 1), a1 + hstepA, voffA);
            PG8_WAIT_V(8); PG8_WAIT_L(0); PG8_BAR; PG8_MMA(0, 0, At, B0); PG8_MMA(0, 1, At, B1); PG8_BAR; PG8_SCHED;
            PG8_LDA(At, 0, 1); PG8_STAGE(PG8_SB(0, 0), b2, voffB); PG8_STAGE(PG8_SB(0, 1), b2 + hstepB, voffB); PG8_STAGE(PG8_SA(0, 0), a2, voffA);
            PG8_WAIT_V(8); PG8_WAIT_L(0); PG8_BAR; PG8_MMA(1, 0, At, B0); PG8_MMA(1, 1, At, B1); PG8_BAR; PG8_SCHED;
            PG8_LDB(B0, 1, 0); PG8_LDB(B1, 1, 1); PG8_SCHED; PG8_LDA(At, 1, 0); PG8_STAGE(PG8_SA(0, 1), a2 + hstepA, voffA);
            PG8_WAIT_V(8); PG8_WAIT_L(0); PG8_BAR; PG8_MMA(0, 0, At, B0); PG8_MMA(0, 1, At, B1); PG8_BAR; PG8_SCHED;
            PG8_LDA(At, 1, 1); PG8_STAGE(PG8_SB(1, 0), b3, voffB); PG8_STAGE(PG8_SB(1, 1), b3 + hstepB, voffB); PG8_STAGE(PG8_SA(1, 0), a3, voffA);
            PG8_WAIT_V(8); PG8_WAIT_L(0); PG8_BAR; PG8_MMA(1, 0, At, B0); PG8_MMA(1, 1, At, B1); PG8_BAR; PG8_SCHED;
            } else {
            PG8_LDB(B0, 0, 0); PG8_SCHED; PG8_LDA(At, 0, 0); PG8_STAGE(PG8_SA(1, 1), a1 + hstepA, voffA);
            PG8_WAIT_L(8); PG8_BAR; PG8_WAIT_L(0); PG8_MMA(0, 0, At, B0); PG8_BAR; PG8_SCHED;
            PG8_LDB(B1, 0, 1); PG8_STAGE(PG8_SB(0, 0), b2, voffB);
            PG8_BAR; PG8_WAIT_L(0); PG8_MMA(0, 1, At, B1); PG8_BAR;
            PG8_LDA(At, 0, 1); PG8_STAGE(PG8_SA(0, 0), a2, voffA);
            PG8_BAR; PG8_WAIT_L(0); PG8_MMA(1, 0, At, B0); PG8_BAR; PG8_SCHED;
            PG8_STAGE(PG8_SB(0, 1), b2 + hstepB, voffB);
            PG8_WAIT_V(6); PG8_BAR; PG8_MMA(1, 1, At, B1); PG8_BAR;
            PG8_LDB(B0, 1, 0); PG8_SCHED; PG8_LDA(At, 1, 0); PG8_STAGE(PG8_SA(0, 1), a2 + hstepA, voffA);
            PG8_WAIT_L(8); PG8_BAR; PG8_WAIT_L(0); PG8_MMA(0, 0, At, B0); PG8_BAR; PG8_SCHED;
            PG8_LDB(B1, 1, 1); PG8_STAGE(PG8_SB(1, 0), b3, voffB);
            PG8_BAR; PG8_WAIT_L(0); PG8_MMA(0, 1, At, B1); PG8_BAR;
            PG8_LDA(At, 1, 1); PG8_STAGE(PG8_SA(1, 0), a3, voffA);
            PG8_BAR; PG8_WAIT_L(0); PG8_MMA(1, 0, At, B0); PG8_BAR; PG8_SCHED;
            PG8_STAGE(PG8_SB(1, 1), b3 + hstepB, voffB);
            PG8_WAIT_V(6); PG8_BAR; PG8_MMA(1, 1, At, B1); PG8_BAR;
            }
        }
        if constexpr (ALIGN_EPI) { if (wr == 0) PG8_BAR; }
        if constexpr (!Epi::AFTER_DRAIN) { E(acc, cur, wr, wc, fr, fq); S.done(cur); }
        if (!has_next) break;
#pragma unroll
        for (int a = 0; a < 2; ++a)
#pragma unroll
            for (int b = 0; b < 2; ++b)
#pragma unroll
                for (int m = 0; m < 4; ++m)
#pragma unroll
                    for (int n = 0; n < 2; ++n) acc[a][b][m][n] = (f32x4){0.f, 0.f, 0.f, 0.f};
        cur = nxt; cA = nA; cB = nB; ++ui;
        if constexpr (ALIGN_EPI) { if (wr == 1) PG8_BAR; }
    }
    PG8_WAIT_V(0);
    if constexpr (!ALIGN_EPI) { if (wr == 0) PG8_BAR; }
    PG8_BAR;
    if constexpr (Epi::AFTER_DRAIN) { E.fused(acc, cur, wr, wc, fr, fq, lds, wid, lane); S.done(cur); }
#undef PG8_SA
#undef PG8_SB
#undef PG8_STAGE
#undef PG8_LDA
#undef PG8_LDB
#undef PG8_MMA
#undef PG8_WAIT_V
#undef PG8_WAIT_L
#undef PG8_BAR
#undef PG8_SCHED
}
}

#define LAS __attribute__((address_space(3)))
typedef unsigned short bf16;
typedef short bf16x8 __attribute__((ext_vector_type(8)));
typedef short s16x4 __attribute__((ext_vector_type(4)));
typedef short v4i16_t __attribute__((ext_vector_type(4)));
typedef float f32x16 __attribute__((ext_vector_type(16)));
typedef float f32x4 __attribute__((ext_vector_type(4)));
typedef float f32x2_t __attribute__((ext_vector_type(2)));
typedef __bf16 bf16x2_t __attribute__((ext_vector_type(2)));
typedef unsigned u32x4 __attribute__((ext_vector_type(4)));
typedef unsigned u32x2 __attribute__((ext_vector_type(2)));

constexpr int D = 1024, SEQ = 2048, NB = 8, M = NB * SEQ, NMEM = 256, MMEM = NB * NMEM, DIN = 6656, DFF = 2816;
constexpr int LDQ = 6656;
constexpr int C_AQ = 0, C_AK = 512, C_AV = 1024, C_BQ = 1536, C_BK = 3072, C_BV = 4608, C_CQ = 6144;
constexpr int C_GATE = 3072;
constexpr int C_H2 = 0, C_ACT = 1024;
constexpr float L2E = 1.4426950408889634f;
constexpr float EPS = 1e-6f;

constexpr size_t WS_WIN = 0;
constexpr size_t WS_WG = WS_WIN + (size_t)DIN * D * 2;
constexpr size_t WS_WMEM = WS_WG + (size_t)3 * D * D * 2;
constexpr size_t WS_WBR = WS_WMEM + (size_t)D * D * 2;
constexpr size_t WS_WOUT3 = WS_WBR + (size_t)3 * D * 512 * 2;
constexpr size_t WS_WGU = WS_WOUT3 + (size_t)D * 3 * D * 2;
constexpr size_t WS_WDN = WS_WGU + (size_t)2 * DFF * D * 2;
constexpr size_t WS_LB = WS_WDN + (size_t)D * DFF * 2;
constexpr size_t WS_R = WS_LB + (size_t)3 * M * 4 * 4;
constexpr size_t WS_BAR = WS_R + (size_t)M * LDQ * 2;
constexpr size_t WS_END = WS_BAR + 16384;
static_assert(WS_END <= (size_t)256 * 1024 * 1024, "d_ws map");
constexpr size_t DO_XN = 0;
constexpr size_t DO_MN = DO_XN + (size_t)M * D * 2;
constexpr size_t DO_CKV = DO_MN + (size_t)MMEM * D * 2;
static_assert(DO_CKV + (size_t)MMEM * D * 2 <= (size_t)M * D * 4, "d_out scratch map");

constexpr int LDS_BYTES = 155648;
constexpr int XCH_OFF = 131072, GT_OFF = 131072 + 8192;
constexpr int MISC_OFF = LDS_BYTES - 64;
constexpr int KP = 272, VP = 320;

__device__ __forceinline__ unsigned cvtpk(float lo, float hi) { f32x2_t v = {lo, hi}; bf16x2_t b = __builtin_convertvector(v, bf16x2_t); return __builtin_bit_cast(unsigned, b); }
__device__ __forceinline__ float wave_sum(float v) {
#pragma unroll
    for (int o = 1; o < 64; o <<= 1) v += __shfl_xor(v, o);
    return v;
}
__device__ __forceinline__ float wave_max(float v) {
#pragma unroll
    for (int o = 1; o < 64; o <<= 1) v = fmaxf(v, __shfl_xor(v, o));
    return v;
}
__device__ __forceinline__ float absmax_vec(const float* g, int n, int lane) {
    float v = fabsf(g[lane]); if (n > 64) v = fmaxf(v, fabsf(g[lane + 64]));
    return wave_max(v);
}

__device__ __forceinline__ void tr_item(const float* W, int N, int k0, int n0, bf16* WT, int dst_pitch, int dst_row0, int dst_k0, int ncopies, int copy_stride, LAS float* scr, int lane) {
#pragma unroll 8
    for (int i = 0; i < 32; ++i) { const int kk = 2 * i + (lane >> 5); scr[kk * 33 + (lane & 31)] = W[(size_t)(k0 + kk) * N + n0 + (lane & 31)]; }
    asm volatile("s_waitcnt lgkmcnt(0)" ::: "memory");
    const int c = lane & 7;
#pragma unroll
    for (int j = 0; j < 4; ++j) { const int n = (lane >> 3) + 8 * j; const LAS float* s = scr + (8 * c) * 33 + n;
        u32x4 o; o.x = cvtpk(s[0 * 33], s[1 * 33]); o.y = cvtpk(s[2 * 33], s[3 * 33]); o.z = cvtpk(s[4 * 33], s[5 * 33]); o.w = cvtpk(s[6 * 33], s[7 * 33]);
        bf16* dst = WT + (size_t)(dst_row0 + n0 + n) * dst_pitch + dst_k0 + k0 + 8 * c;
        for (int cp = 0; cp < ncopies; ++cp) *(u32x4*)(dst + (size_t)cp * copy_stride) = o; }
    asm volatile("s_waitcnt lgkmcnt(0)" ::: "memory");
}
__device__ __forceinline__ void rms_row_to_bf16(const float* xrow, const float* gain, bf16* orow, int lane) {
    const f32x4* xr = (const f32x4*)xrow + lane; const f32x4* gr = (const f32x4*)gain + lane;
    f32x4 v[4]; float s = 0.f;
#pragma unroll
    for (int j = 0; j < 4; ++j) { v[j] = xr[64 * j]; s += (v[j][0] * v[j][0] + v[j][1] * v[j][1]) + (v[j][2] * v[j][2] + v[j][3] * v[j][3]); }
    const float rstd = 1.f / sqrtf(wave_sum(s) * (1.f / 1024.f) + EPS);
    u32x2* o8 = (u32x2*)orow + lane;
#pragma unroll
    for (int j = 0; j < 4; ++j) { const f32x4 g = gr[64 * j]; u32x2 w; w.x = cvtpk(v[j][0] * rstd * g[0], v[j][1] * rstd * g[1]); w.y = cvtpk(v[j][2] * rstd * g[2], v[j][3] * rstd * g[3]); o8[64 * j] = w; }
}

__device__ __forceinline__ s16x4 vtr(const LAS char* p) { return __builtin_bit_cast(s16x4, __builtin_amdgcn_ds_read_tr16_b64_v4i16((LAS v4i16_t*)p)); }

template <int NK>
__device__ __forceinline__ void qk32(f32x16& S, const LAS char* Kp, const bf16x8* Q, int ks0, int r32, int hi) {
    const LAS char* kb = Kp + r32 * KP + hi * 16 + ks0 * 32;
#pragma unroll
    for (int ks = 0; ks < NK; ++ks) { const bf16x8 kf = *(const LAS bf16x8*)(kb + ks * 32); S = __builtin_amdgcn_mfma_f32_32x32x16_bf16(kf, Q[ks0 + ks], S, 0, 0, 0); }
}
__device__ __forceinline__ void pv32(f32x16 (&O)[4], const bf16x8 (&P)[2], const LAS char* Vp, int lane) {
    const int i = lane & 15, q = i >> 2, p = i & 3, dsel = (lane >> 4) & 1, h = lane >> 5;
    const LAS char* vb = Vp + (4 * h + q) * VP + (16 * dsel + 4 * p) * 2;
#pragma unroll
    for (int s = 0; s < 2; ++s)
#pragma unroll
        for (int db = 0; db < 4; ++db) {
            const s16x4 lo = vtr(vb + (16 * s) * VP + db * 64), hi4 = vtr(vb + (16 * s + 8) * VP + db * 64);
            const bf16x8 a = (bf16x8){lo[0], lo[1], lo[2], lo[3], hi4[0], hi4[1], hi4[2], hi4[3]};
            O[db] = __builtin_amdgcn_mfma_f32_32x32x16_bf16(a, P[s], O[db], 0, 0, 0);
        }
}
template <int MODE>
__device__ __forceinline__ void soft32(const f32x16& S, bf16x8 (&P)[2], float& l, float dbase, float nslope) {
    float p[16];
#pragma unroll
    for (int r = 0; r < 16; ++r) {
        float s = S[r];
        if (MODE >= 1) { const float a = fabsf(dbase - (float)((r & 3) + 8 * (r >> 2))); s = fmaf(nslope, a, s); float e = __builtin_amdgcn_exp2f(s); if (MODE == 2) e = (a <= 64.f) ? e : 0.f; p[r] = e; }
        else p[r] = __builtin_amdgcn_exp2f(s);
        l += p[r];
    }
#pragma unroll
    for (int s = 0; s < 2; ++s) { u32x4 w; w.x = cvtpk(p[8 * s + 0], p[8 * s + 1]); w.y = cvtpk(p[8 * s + 2], p[8 * s + 3]); w.z = cvtpk(p[8 * s + 4], p[8 * s + 5]); w.w = cvtpk(p[8 * s + 6], p[8 * s + 7]); P[s] = __builtin_bit_cast(bf16x8, w); }
}
__device__ __forceinline__ void zero16(f32x16& v) {
#pragma unroll
    for (int r = 0; r < 16; ++r) v[r] = 0.f;
}

template <int NC>
__device__ __forceinline__ void attn_shared_unit(LAS char* lds, bf16* qrow, const bf16* Kg, const bf16* Vg, int kvp, int nt, int qpos, float nslope, float negM0, float lam, const float* subln) {
    int tid = threadIdx.x; asm volatile("" : "+v"(tid));
    const int lane = tid & 63, r32 = lane & 31, hi = lane >> 5;
    const int wv = __builtin_amdgcn_readfirstlane(tid >> 6), cm = (NC == 2) ? (wv & 1) : 0;
    constexpr int NQ = (NC == 2) ? 4 : 8;
    bf16x8 Q[NQ];
#pragma unroll
    for (int ks = 0; ks < NQ; ++ks) Q[ks] = *(const bf16x8*)(qrow + cm * 64 + 16 * ks + 8 * hi);
    f32x16 O[4]; float l = 0.f;
#pragma unroll
    for (int db = 0; db < 4; ++db) zero16(O[db]);
    const int lrow = tid >> 3, lcb = (tid & 7) * 32;
    const char* kgp = (const char*)(Kg + (size_t)lrow * kvp) + lcb; const char* vgp = (const char*)(Vg + (size_t)lrow * kvp) + lcb;
    const size_t tstep = (size_t)64 * kvp * 2;
    u32x4 kr0, kr1, vr0, vr1;
    kr0 = *(const u32x4*)kgp; kr1 = *(const u32x4*)(kgp + 16); vr0 = *(const u32x4*)vgp; vr1 = *(const u32x4*)(vgp + 16);
    __syncthreads();
    { LAS char* kb = lds + lrow * KP + lcb; LAS char* vb = lds + 64 * KP + lrow * VP + lcb;
      *(LAS u32x4*)kb = kr0; *(LAS u32x4*)(kb + 16) = kr1; *(LAS u32x4*)vb = vr0; *(LAS u32x4*)(vb + 16) = vr1; }
    __syncthreads();
    constexpr int BUFB = 64 * KP + 64 * VP;
#pragma unroll 1
    for (int t = 0; t < nt; ++t) {
        const bool more = (t + 1 < nt);
        if (more) { const char* kp = kgp + (size_t)(t + 1) * tstep; const char* vp = vgp + (size_t)(t + 1) * tstep;
            kr0 = *(const u32x4*)kp; kr1 = *(const u32x4*)(kp + 16); vr0 = *(const u32x4*)vp; vr1 = *(const u32x4*)(vp + 16); }
        const LAS char* Kb = lds + (t & 1) * BUFB; const LAS char* Vb = Kb + 64 * KP;
#pragma unroll
        for (int half = 0; half < 2; ++half) {
            const float dbase = (float)(qpos - (t * 64 + half * 32 + 4 * hi));
            f32x16 S;
#pragma unroll
            for (int r = 0; r < 16; ++r) S[r] = negM0;
            qk32<NQ>(S, Kb + half * 32 * KP + cm * 128, Q, 0, r32, hi);
            bf16x8 P[2];
            soft32<(NC == 2) ? 1 : 0>(S, P, l, dbase, nslope);
            pv32(O, P, Vb + half * 32 * VP, lane);
        }
        if (more) { LAS char* kb = lds + ((t + 1) & 1) * BUFB + lrow * KP + lcb; LAS char* vb = lds + ((t + 1) & 1) * BUFB + 64 * KP + lrow * VP + lcb;
            *(LAS u32x4*)kb = kr0; *(LAS u32x4*)(kb + 16) = kr1; *(LAS u32x4*)vb = vr0; *(LAS u32x4*)(vb + 16) = vr1; }
        __syncthreads();
    }
    l += __shfl_xor(l, 32);
    if (NC == 2) {
        LAS float* XO = (LAS float*)lds + (wv >> 1) * 4096 + lane;
        if (cm == 1) { const float i2 = lam / l;
#pragma unroll
            for (int db = 0; db < 4; ++db)
#pragma unroll
                for (int r = 0; r < 16; ++r) XO[(db * 16 + r) * 64] = O[db][r] * i2; }
        __syncthreads();
        if (cm == 0) {
            const float i1 = 1.f / l; float ss = 0.f;
#pragma unroll
            for (int db = 0; db < 4; ++db)
#pragma unroll
                for (int r = 0; r < 16; ++r) { const float o = O[db][r] * i1 - XO[(db * 16 + r) * 64]; O[db][r] = o; ss += o * o; }
            ss += __shfl_xor(ss, 32);
            const float rstd = (1.f / sqrtf(ss * (1.f / 128.f) + EPS)) * 0.8f;
#pragma unroll
            for (int db = 0; db < 4; ++db)
#pragma unroll
                for (int g4 = 0; g4 < 4; ++g4) { const int d = 32 * db + 8 * g4 + 4 * hi; const f32x4 gn = *(const f32x4*)(subln + d);
                    u32x2 w; w.x = cvtpk(O[db][4 * g4 + 0] * rstd * gn[0], O[db][4 * g4 + 1] * rstd * gn[1]); w.y = cvtpk(O[db][4 * g4 + 2] * rstd * gn[2], O[db][4 * g4 + 3] * rstd * gn[3]);
                    *(u32x2*)(qrow + d) = w; }
        }
    } else {
        const float i1 = 1.f / l;
#pragma unroll
        for (int db = 0; db < 4; ++db)
#pragma unroll
            for (int g4 = 0; g4 < 4; ++g4) { const int d = 32 * db + 8 * g4 + 4 * hi;
                u32x2 w; w.x = cvtpk(O[db][4 * g4 + 0] * i1, O[db][4 * g4 + 1] * i1); w.y = cvtpk(O[db][4 * g4 + 2] * i1, O[db][4 * g4 + 3] * i1);
                *(u32x2*)(qrow + d) = w; }
    }
}

__device__ __forceinline__ void attn_b_wave_unit(LAS char* wl, bf16* R, float* LB, int wu, float negM0, int lane_in) {
    int lane = lane_in; asm volatile("" : "+v"(lane));
    const int r32 = lane & 31, hi = lane >> 5;
    const int idx = wu & 63, j = (wu >> 6) & 3, bg = wu >> 8, g = bg % 3, b = bg / 3;
    const int dil = (g == 0) ? 1 : ((g == 1) ? 4 : 16), nqb = 64 / dil, sub_len = SEQ / dil;
    const int res = idx / nqb, qb = idx % nqb;
    const float slope = __builtin_amdgcn_exp2f(-8.f * (float)(g * 4 + j + 1) / 12.f);
    const float nslope = -slope * (float)dil * L2E;
    const int qsub = 32 * qb + r32;
    const size_t qrow_i = (size_t)b * SEQ + (size_t)qsub * dil + res;
    const int hcol = (g * 4 + j) * 128;
    bf16* qrow = R + qrow_i * LDQ + C_BQ + hcol;
    bf16x8 Q[8];
#pragma unroll
    for (int ks = 0; ks < 8; ++ks) Q[ks] = *(const bf16x8*)(qrow + 16 * ks + 8 * hi);
    f32x16 O[4]; float l = 0.f;
#pragma unroll
    for (int db = 0; db < 4; ++db) zero16(O[db]);
    const int lr = lane >> 4, lc = (lane & 15) * 8;
#pragma unroll 1
    for (int kt = 0; kt < 5; ++kt) {
        const int kb = 32 * qb - 64 + 32 * kt;
        if (kb < 0 || kb >= sub_len) continue;
        u32x4 kr[8], vr[8];
#pragma unroll
        for (int n = 0; n < 8; ++n) { const size_t krow = (size_t)b * SEQ + (size_t)(kb + 4 * n + lr) * dil + res;
            kr[n] = *(const u32x4*)(R + krow * LDQ + C_BK + hcol + lc); vr[n] = *(const u32x4*)(R + krow * LDQ + C_BV + hcol + lc); }
#pragma unroll
        for (int n = 0; n < 8; ++n) { *(LAS u32x4*)(wl + (4 * n + lr) * KP + lc * 2) = kr[n]; *(LAS u32x4*)(wl + 32 * KP + (4 * n + lr) * VP + lc * 2) = vr[n]; }
        asm volatile("s_waitcnt lgkmcnt(0)" ::: "memory");
        f32x16 S;
#pragma unroll
        for (int r = 0; r < 16; ++r) S[r] = negM0;
        qk32<8>(S, wl, Q, 0, r32, hi);
        bf16x8 P[2];
        soft32<2>(S, P, l, (float)(qsub - (kb + 4 * hi)), nslope);
        pv32(O, P, wl + 32 * KP, lane);
        asm volatile("s_waitcnt lgkmcnt(0)" ::: "memory");
    }
    l += __shfl_xor(l, 32);
    const float i1 = 1.f / l;
#pragma unroll
    for (int db = 0; db < 4; ++db)
#pragma unroll
        for (int g4 = 0; g4 < 4; ++g4) { const int d = 32 * db + 8 * g4 + 4 * hi;
            u32x2 w; w.x = cvtpk(O[db][4 * g4 + 0] * i1, O[db][4 * g4 + 1] * i1); w.y = cvtpk(O[db][4 * g4 + 2] * i1, O[db][4 * g4 + 3] * i1);
            *(u32x2*)(qrow + d) = w; }
    if (hi == 0) LB[((size_t)g * M + qrow_i) * 4 + j] = l;
}

#define XB_TMO      128
#define XB_XCNT(j)  (256  + 64 * (j))
#define XB_XSUB(j)  (1280 + 64 * (j))
#define XB_XGEN(j)  (2304 + 64 * (j))
#define XB_TOP      3328
#define XB_TOPGEN   3392
#define XCD_BAR_WORDS 3456
#define XB_SPIN_CAP (1u << 18)

__device__ __forceinline__ unsigned xb_ld(unsigned* p)              { return __hip_atomic_load(p, __ATOMIC_RELAXED, __HIP_MEMORY_SCOPE_AGENT); }
__device__ __forceinline__ unsigned xb_add(unsigned* p, unsigned v) { return __hip_atomic_fetch_add(p, v, __ATOMIC_RELAXED, __HIP_MEMORY_SCOPE_AGENT); }
__device__ __forceinline__ unsigned xb_xcc_id() { return (unsigned)__builtin_amdgcn_s_getreg((3 << 11) | 20) & 0xFu; }
#define XB_SPIN(cond, bar) do { unsigned _sp = 0; while (cond) { __builtin_amdgcn_s_sleep(1); \
    if ((++_sp & 255u) == 0u) { if (xb_ld(&(bar)[XB_TMO])) break; if (_sp > XB_SPIN_CAP) { atomicAdd(&(bar)[XB_TMO], 1u); break; } } } } while (0)

struct XcdBarrier {
    unsigned* bar; unsigned x;
    volatile LAS unsigned* st;
};

__device__ __forceinline__ XcdBarrier xcd_barrier_post(unsigned* bar, volatile LAS unsigned* st) {
    XcdBarrier b; b.bar = bar; b.x = xb_xcc_id(); b.st = st;
    if (threadIdx.x == 0) (void)xb_add(&bar[XB_XCNT(b.x)], 1u);
    return b;
}
__device__ __forceinline__ void xcd_barrier_complete(unsigned* bar, unsigned x, unsigned& nloc, unsigned& nx) {
    const unsigned G = gridDim.x * gridDim.y * gridDim.z;
    unsigned sum, cnt, mine, sp = 0u;
    for (;;) {
        sum = 0u; cnt = 0u; mine = 0u;
#pragma unroll
        for (unsigned j = 0; j < 16; ++j) { const unsigned c = xb_ld(&bar[XB_XCNT(j)]); sum += c; cnt += (c > 0u) ? 1u : 0u; mine = (j == x) ? c : mine; }
        if (sum == G) break;
        __builtin_amdgcn_s_sleep(1);
        if ((++sp & 255u) == 0u) { if (xb_ld(&bar[XB_TMO])) break; if (sp > XB_SPIN_CAP) { atomicAdd(&bar[XB_TMO], 1u); break; } }
    }
    nloc = mine > 0u ? mine : 1u; nx = cnt > 0u ? cnt : 1u;
}

__device__ __forceinline__ void xcd_barrier(const XcdBarrier& b) {
    asm volatile("s_waitcnt vmcnt(0)" ::: "memory");
    __syncthreads();
    if (threadIdx.x == 0) {
        unsigned* bar = b.bar;
        __builtin_amdgcn_s_waitcnt(0);
        unsigned nloc = b.st[0], nx = b.st[1];
        if (nloc == 0u) { xcd_barrier_complete(bar, b.x, nloc, nx); b.st[0] = nloc; b.st[1] = nx; }
        const unsigned old = xb_add(&bar[XB_XSUB(b.x)], 1u);
        const unsigned gen = old / nloc;
        if (old + 1u == (gen + 1u) * nloc) {
            __builtin_amdgcn_fence(__ATOMIC_RELEASE, "agent");
            asm volatile("s_waitcnt vmcnt(0)" ::: "memory");
            const unsigned og = xb_add(&bar[XB_TOP], 1u);
            const unsigned tg = og / nx;
            if (og + 1u == (tg + 1u) * nx) xb_add(&bar[XB_TOPGEN], 1u);
            else XB_SPIN(xb_ld(&bar[XB_TOPGEN]) == tg, bar);
            __builtin_amdgcn_fence(__ATOMIC_ACQUIRE, "agent");
            xb_add(&bar[XB_XGEN(b.x)], 1u);
            asm volatile("s_waitcnt vmcnt(0)" ::: "memory");
        } else {
            XB_SPIN(xb_ld(&bar[XB_XGEN(b.x)]) == gen, bar);
            __builtin_amdgcn_fence(__ATOMIC_ACQUIRE, "agent");
            asm volatile("s_waitcnt vmcnt(0)" ::: "memory");
        }
    }
    __syncthreads();
}

struct Args { const float* in[25]; float* out; unsigned char* ws; };

__global__ void __launch_bounds__(512, 2) fwd_megakernel(Args a) {
    extern __shared__ __attribute__((aligned(16))) unsigned char lds_raw[];
    LAS unsigned char* lds = (LAS unsigned char*)lds_raw;
    cg::grid_group grid = cg::this_grid();
    const int wave = __builtin_amdgcn_readfirstlane((int)threadIdx.x >> 6);
#define FRESH_LANE int tid_ = threadIdx.x; asm volatile("" : "+v"(tid_)); const int lane = tid_ & 63;
    const int G = gridDim.x, bid = blockIdx.x;
    const int gw = bid * 8 + wave, NGW = G * 8;
    unsigned char* ws = a.ws;
    const float* x = a.in[0]; const float* mem = a.in[1];
    bf16* W_IN = (bf16*)(ws + WS_WIN); bf16* W_G = (bf16*)(ws + WS_WG); bf16* W_MEM = (bf16*)(ws + WS_WMEM); bf16* W_BR = (bf16*)(ws + WS_WBR);
    bf16* W_OUT = (bf16*)(ws + WS_WOUT3); bf16* W_GU = (bf16*)(ws + WS_WGU); bf16* W_DN = (bf16*)(ws + WS_WDN);
    float* LB = (float*)(ws + WS_LB); bf16* R = (bf16*)(ws + WS_R);
    unsigned char* dob = (unsigned char*)a.out;
    bf16* XN = (bf16*)(dob + DO_XN); bf16* MN = (bf16*)(dob + DO_MN); bf16* CKV = (bf16*)(dob + DO_CKV);

    volatile LAS unsigned* MISC = (volatile LAS unsigned*)(lds + MISC_OFF);
    unsigned* barw = (unsigned*)(ws + WS_BAR);
    if (threadIdx.x < 16) MISC[threadIdx.x] = 0u;
    if (a.ws == nullptr) grid.sync();
    XcdBarrier bar = xcd_barrier_post(barw, MISC);
    __syncthreads();
    {
        FRESH_LANE
        LAS float* scr = (LAS float*)(lds + wave * 8704);
        constexpr int I_IN = 16 * (DIN / 32), I_G = 16 * (3 * D / 32), I_MEM = 16 * (D / 32), I_BR = 8 * (D / 32), I_OUT = 16 * (D / 32), I_FF = 16 * (DFF / 32), I_DN = (DFF / 64) * (D / 32);
        constexpr int NITEMS = I_IN + I_G + I_MEM + 3 * I_BR + I_OUT + 2 * I_FF + I_DN;
        for (int it = gw; it < NITEMS; it += NGW) {
            int r = it;
            if (r < I_IN) { const int nb = DIN / 32; tr_item(a.in[3], DIN, 64 * (r / nb), 32 * (r % nb), W_IN, D, 0, 0, 1, 0, scr, lane); continue; } r -= I_IN;
            if (r < I_G) { const int nb = 3 * D / 32; tr_item(a.in[4], 3 * D, 64 * (r / nb), 32 * (r % nb), W_G, D, 0, 0, 1, 0, scr, lane); continue; } r -= I_G;
            if (r < I_MEM) { const int nb = D / 32; tr_item(a.in[16], D, 64 * (r / nb), 32 * (r % nb), W_MEM, D, 0, 0, 1, 0, scr, lane); continue; } r -= I_MEM;
            if (r < 3 * I_BR) { const int gI = r / I_BR, rr = r % I_BR, nb = D / 32; tr_item(a.in[19] + (size_t)gI * 512 * D, D, 64 * (rr / nb), 32 * (rr % nb), W_BR + (size_t)gI * D * 512, 512, 0, 0, 1, 0, scr, lane); continue; } r -= 3 * I_BR;
            if (r < I_OUT) { const int nb = D / 32; tr_item(a.in[20], D, 64 * (r / nb), 32 * (r % nb), W_OUT, D, 0, 0, 1, 0, scr, lane); continue; } r -= I_OUT;
            if (r < 2 * I_FF) { const int s = r / I_FF, rr = r % I_FF, nb = DFF / 32; const int n0 = 32 * (rr % nb);
                tr_item(a.in[22 + s], DFF, 64 * (rr / nb), n0, W_GU, D, 256 * (n0 / 128) + 128 * s + (n0 % 128) - n0, 0, 1, 0, scr, lane); continue; } r -= 2 * I_FF;
            { const int nb = D / 32; tr_item(a.in[24], D, 64 * (r / nb), 32 * (r % nb), W_DN, DFF, 0, 0, 1, 0, scr, lane); }
        }
        for (int m = gw; m < M + MMEM; m += NGW) {
            if (m < M) rms_row_to_bf16(x + (size_t)m * D, a.in[2], XN + (size_t)m * D, lane);
            else rms_row_to_bf16(mem + (size_t)(m - M) * D, a.in[15], MN + (size_t)(m - M) * D, lane);
        }
    }
    xcd_barrier(bar);

    {
        LAS float* GT = (LAS float*)(lds + GT_OFF);
        { int t2 = threadIdx.x; asm volatile("" : "+v"(t2));
          if (t2 < 64) { GT[t2] = a.in[6][t2]; GT[64 + t2] = a.in[7][t2]; }
          if (t2 < 128) { GT[128 + t2] = a.in[13][t2]; GT[256 + t2] = a.in[14][t2]; GT[384 + t2] = a.in[17][t2]; GT[512 + t2] = a.in[18][t2]; } }
        __syncthreads();
        { const pg8::EpiQKV E{R, LDQ, 0, GT, (LAS float*)(lds + XCH_OFF)};
          pg8::Gemm g{XN, W_IN, M, DIN, D, D}; pg8::StaticOrder S; S.init(M, DIN, G, bid);
          pg8::gemm_phase<pg8::EpiQKV, pg8::StaticOrder, true, true>(lds, g, S, E); }
        { const pg8::EpiQKV E{CKV, D, 1, GT, (LAS float*)(lds + XCH_OFF)};
          pg8::Gemm g{MN, W_MEM, MMEM, D, D, D}; pg8::StaticOrder S; S.init(MMEM, D, G, bid);
          pg8::gemm_phase<pg8::EpiQKV, pg8::StaticOrder, true, true>(lds, g, S, E); }
    }
    xcd_barrier(bar);

    {
        FRESH_LANE
        const float m_aq = absmax_vec(a.in[6], 64, lane), m_ak = absmax_vec(a.in[7], 64, lane);
        const float m_bq = absmax_vec(a.in[13], 128, lane), m_bk = absmax_vec(a.in[14], 128, lane);
        const float m_cq = absmax_vec(a.in[17], 128, lane), m_ck = absmax_vec(a.in[18], 128, lane);
        const float negM_a = -8.f * m_aq * m_ak * L2E, negM_b = -11.313708499f * m_bq * m_bk * L2E, negM_c = -11.313708499f * m_cq * m_ck * L2E;
        const float s1 = wave_sum(a.in[8][lane] * a.in[9][lane]), s2 = wave_sum(a.in[10][lane] * a.in[11][lane]);
        const float lam = expf(s1) - expf(s2) + 0.2f;
        for (int u = bid; u < 512; u += G) {
            const int b = u >> 6, h = (u >> 4) & 3, qblk = u & 15;
            const int qpos = qblk * 128 + (wave >> 1) * 32 + (lane & 31);
            bf16* qrow = R + ((size_t)b * SEQ + qpos) * LDQ + C_AQ + h * 128;
            const bf16* Kg = R + (size_t)b * SEQ * LDQ + C_AK + h * 128; const bf16* Vg = R + (size_t)b * SEQ * LDQ + C_AV + h * 128;
            const float nslope = -__builtin_amdgcn_exp2f(-2.f * (float)(h + 1)) * L2E;
            attn_shared_unit<2>((LAS char*)lds, qrow, Kg, Vg, LDQ, SEQ / 64, qpos, nslope, negM_a, lam, a.in[12]);
        }
        for (int u = bid; u < 256; u += G) {
            const int b = u >> 5, h = (u >> 3) & 3, qblk = u & 7;
            const int qpos = qblk * 256 + wave * 32 + (lane & 31);
            bf16* qrow = R + ((size_t)b * SEQ + qpos) * LDQ + C_CQ + h * 128;
            const bf16* Kg = CKV + (size_t)b * NMEM * D + h * 128; const bf16* Vg = Kg + 512;
            attn_shared_unit<1>((LAS char*)lds, qrow, Kg, Vg, D, NMEM / 64, qpos, 0.f, negM_c, 0.f, a.in[12]);
        }
        __syncthreads();
        for (int wu = gw; wu < NB * 3 * 4 * 64; wu += NGW) attn_b_wave_unit((LAS char*)lds + wave * (32 * KP + 32 * VP), R, LB, wu, negM_b, lane);
    }
    xcd_barrier(bar);

    { FRESH_LANE
    for (int m = gw; m < M; m += NGW) {
        const int j = lane >> 4, d8 = (lane & 15) * 8;
        const float l0 = LB[((size_t)0 * M + m) * 4 + j], l1 = LB[((size_t)1 * M + m) * 4 + j], l2 = LB[((size_t)2 * M + m) * 4 + j];
        const float inv = 1.f / (l0 + l1 + l2); const float w0 = l0 * inv, w1 = l1 * inv, w2 = l2 * inv;
        bf16* p0 = R + (size_t)m * LDQ + C_BQ + j * 128 + d8;
        const u32x4 o0 = *(const u32x4*)p0, o1 = *(const u32x4*)(p0 + 512), o2 = *(const u32x4*)(p0 + 1024);
        u32x4 w;
#pragma unroll
        for (int e = 0; e < 4; ++e) {
            const float lo = w0 * pg8::bf_lo(o0[e]) + w1 * pg8::bf_lo(o1[e]) + w2 * pg8::bf_lo(o2[e]);
            const float hi = w0 * pg8::bf_hi(o0[e]) + w1 * pg8::bf_hi(o1[e]) + w2 * pg8::bf_hi(o2[e]);
            w[e] = cvtpk(lo, hi);
        }
        *(u32x4*)p0 = w;
    } }
    {
        pg8::Gemm g{XN, W_G, M, 3 * D, D, D}; pg8::StaticOrder S; S.init(M, 3 * D, G, bid);
        pg8::EpiGate E{R + C_GATE, LDQ, a.in[5]};
        pg8::gemm_phase<pg8::EpiGate, pg8::StaticOrder, true, true>(lds, g, S, E);
    }
    xcd_barrier(bar);

    for (int gI = 0; gI < 3; ++gI) {
        const int acol = (gI == 0) ? C_AQ : ((gI == 1) ? C_BQ : C_CQ);
        pg8::Gemm g{R + acol, W_BR + (size_t)gI * D * 512, M, D, 512, LDQ}; pg8::StaticOrder S; S.init(M, D, G, bid);
        pg8::EpiBranch E{R + C_GATE, R + C_GATE + gI * D, LDQ, gI};
        pg8::gemm_phase<pg8::EpiBranch, pg8::StaticOrder, true, true>(lds, g, S, E);
    }
    xcd_barrier(bar);

    {
        pg8::Gemm g{R + C_GATE, W_OUT, M, D, D, LDQ}; pg8::StaticOrder S; S.init(M, D, G, bid);
        pg8::EpiResid E{x, a.out, D};
        pg8::gemm_phase<pg8::EpiResid, pg8::StaticOrder, true, true>(lds, g, S, E);
    }
    xcd_barrier(bar);

    { FRESH_LANE
    for (int m = gw; m < M; m += NGW) {
        const f32x4* xr = (const f32x4*)(a.out + (size_t)m * D) + lane; const f32x4* gr = (const f32x4*)a.in[21] + lane;
        f32x4 v[4]; float s = 0.f;
#pragma unroll
        for (int j = 0; j < 4; ++j) { v[j] = xr[64 * j]; s += (v[j][0] * v[j][0] + v[j][1] * v[j][1]) + (v[j][2] * v[j][2] + v[j][3] * v[j][3]); }
        const float rstd = 1.f / sqrtf(wave_sum(s) * (1.f / 1024.f) + EPS);
        u32x2* o8 = (u32x2*)(R + (size_t)m * LDQ + C_H2) + lane;
#pragma unroll
        for (int j = 0; j < 4; ++j) { const f32x4 gn = gr[64 * j]; u32x2 w; w.x = cvtpk(v[j][0] * rstd * gn[0], v[j][1] * rstd * gn[1]); w.y = cvtpk(v[j][2] * rstd * gn[2], v[j][3] * rstd * gn[3]); o8[64 * j] = w; }
    } }
    xcd_barrier(bar);

    {
        pg8::Gemm g{R + C_H2, W_GU, M, 2 * DFF, D, LDQ}; pg8::StaticOrder S; S.init(M, 2 * DFF, G, bid);
        pg8::EpiSwiGLU E{R + C_ACT, LDQ};
        pg8::gemm_phase<pg8::EpiSwiGLU, pg8::StaticOrder, true, true>(lds, g, S, E);
    }
    xcd_barrier(bar);

    {
        pg8::Gemm g{R + C_ACT, W_DN, M, D, DFF, LDQ}; pg8::StaticOrder S; S.init(M, D, G, bid);
        pg8::EpiResid E{a.out, a.out, D};
        pg8::gemm_phase<pg8::EpiResid, pg8::StaticOrder, true, true>(lds, g, S, E);
    }
}

extern "C" void kernel_launch(void* const* d_in, const int* in_sizes, int n_in, void* d_out, int out_size, void* d_ws, size_t ws_size, hipStream_t stream) {
    static int grid = 0;
    if (grid == 0) {
        if (n_in != 25 || out_size != M * D || ws_size < WS_END) { fprintf(stderr, "kernel_launch: unexpected problem shape (n_in %d out %d ws %zu)\n", n_in, out_size, ws_size); grid = -1; return; }
        int dev = 0, cus = 0, per_cu = 0;
        hipGetDevice(&dev);
        hipDeviceGetAttribute(&cus, hipDeviceAttributeMultiprocessorCount, dev);
        if (hipFuncSetAttribute((const void*)fwd_megakernel, hipFuncAttributeMaxDynamicSharedMemorySize, LDS_BYTES) != hipSuccess) { fprintf(stderr, "kernel_launch: hipFuncSetAttribute failed\n"); }
        hipOccupancyMaxActiveBlocksPerMultiprocessor(&per_cu, (const void*)fwd_megakernel, 512, LDS_BYTES);
        (void)hipGetLastError();
        if (per_cu < 1) per_cu = 1;
        grid = cus;
        fprintf(stderr, "kernel_launch: cus %d per_cu %d grid %d\n", cus, per_cu, grid);
    }
    if (grid < 0) return;
    if (hipMemsetAsync((char*)d_ws + WS_BAR, 0, 16384, stream) != hipSuccess) { fprintf(stderr, "kernel_launch: memset of the barrier words failed\n"); return; }
    Args a{};
    for (int i = 0; i < 25; ++i) a.in[i] = (const float*)d_in[i];
    a.out = (float*)d_out; a.ws = (unsigned char*)d_ws;
    void* args[] = {&a};
    hipError_t e = hipLaunchCooperativeKernel((const void*)fwd_megakernel, dim3(grid), dim3(512), args, LDS_BYTES, stream);
    if (e != hipSuccess) fprintf(stderr, "cooperative launch failed: %s (grid %d)\n", hipGetErrorString(e), grid);
}
```

```cpp
#include <hip/hip_runtime.h>
#include <hip/hip_cooperative_groups.h>
#include <cstdio>
#include <cstdint>
namespace cg = cooperative_groups;
namespace pg8 {
#define PG8_LAS __attribute__((address_space(3)))
typedef unsigned short bf16_t;
typedef short bf16x8 __attribute__((ext_vector_type(8)));
typedef float f32x4 __attribute__((ext_vector_type(4)));
typedef unsigned u32x4 __attribute__((ext_vector_type(4)));
constexpr int BM = 256, BK = 64, HALF = 128, HTB = HALF * BK * 2  , STAGE_BYTES = 8 * HTB, NXCD = 8, WGM = 8;

__host__ __device__ __forceinline__ int lds_byte(int r, int c) { const int st = (r >> 4) * 2 + (c >> 5), rr = r & 15, cc = c & 31, ob = rr * 64 + cc * 2; return st * 1024 + (ob ^ (((ob >> 9) & 1) << 5)); }
__host__ __device__ __forceinline__ void stage_rc(int b, int& R, int& C) { const int st = b / 1024, sb = b % 1024, swz = sb ^ (((sb >> 9) & 1) << 5); R = (st >> 1) * 16 + swz / 64; C = (st & 1) * 32 + (swz % 64) / 2; }
__host__ __device__ __forceinline__ int perm32(int rho) { const int n = rho >> 4, i = rho & 15; return 8 * (i >> 2) + 4 * n + (i & 3); }

struct Unit { int pm, pn; };
struct Gemm { const bf16_t* A; const bf16_t* Bt; int M, N, K, lda; };

struct StaticOrder {
    int nM, nN, nwg, G, c;
    __host__ __device__ void init(int M, int N, int G_, int c_) { nM = M / BM; nN = N / BM; nwg = nM * nN; G = G_; c = c_; }
    __host__ __device__ bool next(int i, Unit& u) const {
        const long L = (long)i * G + c; if (L >= nwg) return false;
        int wgid = (int)L; { const int q = nwg / NXCD, r = nwg % NXCD, xcd = wgid % NXCD, off = wgid / NXCD; wgid = (xcd < r ? xcd * (q + 1) : r * (q + 1) + (xcd - r) * q) + off; }
        const int nig = WGM * nN, gid = wgid / nig, fm = gid * WGM, gsz = (nM - fm) < WGM ? (nM - fm) : WGM;
        u.pm = fm + ((wgid % nig) % gsz); u.pn = (wgid % nig) / gsz; return true;
    }
    __device__ __forceinline__ void a_ready(const Unit&) const {}
    __device__ __forceinline__ void done(const Unit&) const {}
};

__device__ __forceinline__ int lane_id_fresh() { int z = 0; asm volatile("" : "+s"(z)); return __builtin_amdgcn_mbcnt_hi(~0u, __builtin_amdgcn_mbcnt_lo(~0u, z)); }
__device__ __forceinline__ int tid_fresh(int wave) { return wave * 64 + lane_id_fresh(); }
typedef float f32x2v_t __attribute__((ext_vector_type(2))); typedef __bf16 bf16x2v_t __attribute__((ext_vector_type(2)));
__device__ __forceinline__ unsigned cvt_pk_bf16(float lo, float hi) { f32x2v_t v = {lo, hi}; bf16x2v_t b = __builtin_convertvector(v, bf16x2v_t); return __builtin_bit_cast(unsigned, b); }
__device__ __forceinline__ float bf_lo(unsigned w) { return __builtin_bit_cast(float, w << 16); }
__device__ __forceinline__ float bf_hi(unsigned w) { return __builtin_bit_cast(float, w & 0xffff0000u); }
#define PG8_ACC const f32x4 (&acc)[2][2][4][2]

struct EpiQKV {
    static constexpr bool PERM = true, AFTER_DRAIN = false;
    bf16_t* O; int ldc; int mode;
    PG8_LAS const float* GT;
    PG8_LAS float* X;
    __device__ __forceinline__ void operator()(PG8_ACC, const Unit& u, int wr, int wc, int fr, int fq) const {
        const int pn = u.pn;
        int kind, gp; float sc = 1.f;
        constexpr float L2E = 1.4426950408889634f;
        if (mode == 0) {
            if (pn < 2) { kind = 1; gp = 0; sc = 0.125f * L2E; }
            else if (pn < 4) { kind = 1; gp = 64; }
            else if (pn < 6) { kind = 0; gp = 64; }
            else if (pn < 12) { kind = 2; gp = 128; sc = 0.08838834764831845f * L2E; }
            else if (pn < 18) { kind = 2; gp = 256; }
            else if (pn < 24) { kind = 0; gp = 256; }
            else { kind = 2; gp = 384; sc = 0.08838834764831845f * L2E; }
        } else {
            if (pn < 2) { kind = 2; gp = 512; } else { kind = 0; gp = 512; }
        }
        const int row0 = u.pm * BM + wr * 64 + fr, col0 = pn * BM + wc * 32 + 8 * fq;
        float rs[2][4][2];
        f32x4 gv[2];
        if (kind != 0) {
#pragma unroll
            for (int ai = 0; ai < 2; ++ai)
#pragma unroll
                for (int m = 0; m < 4; ++m)
#pragma unroll
                    for (int bj = 0; bj < 2; ++bj) {
                        const f32x4 a = acc[ai][bj][m][0], b = acc[ai][bj][m][1];
                        float s = (a[0] * a[0] + a[1] * a[1]) + (a[2] * a[2] + a[3] * a[3]) + (b[0] * b[0] + b[1] * b[1]) + (b[2] * b[2] + b[3] * b[3]);
                        s += __shfl_xor(s, 16); s += __shfl_xor(s, 32);
                        if (fq == 0) X[((ai * 128 + wr * 64 + m * 16 + fr) * 2 + bj) * 4 + wc] = s;
                    }
            asm volatile("s_waitcnt lgkmcnt(0)" ::: "memory"); __builtin_amdgcn_s_barrier(); asm volatile("" ::: "memory");
            const int hd = (kind == 1) ? 64 : 128;
            const float inv_hd = (kind == 1) ? (1.f / 64.f) : (1.f / 128.f);
#pragma unroll
            for (int ai = 0; ai < 2; ++ai)
#pragma unroll
                for (int m = 0; m < 4; ++m)
#pragma unroll
                    for (int bj = 0; bj < 2; ++bj) {
                        const f32x4 xs = *(const PG8_LAS f32x4*)(X + ((ai * 128 + wr * 64 + m * 16 + fr) * 2 + bj) * 4);
                        float tot;
                        if (kind == 1) tot = (wc < 2) ? (xs[0] + xs[1]) : (xs[2] + xs[3]);
                        else tot = (xs[0] + xs[1]) + (xs[2] + xs[3]);
                        rs[ai][m][bj] = __builtin_amdgcn_rsqf(tot * inv_hd + 1e-6f) * sc;
                    }
            const int gc = ((wc * 32 + 8 * fq) & (hd - 1));
            gv[0] = *(const PG8_LAS f32x4*)(GT + gp + gc); gv[1] = *(const PG8_LAS f32x4*)(GT + gp + gc + 4);
        } else {
#pragma unroll
            for (int ai = 0; ai < 2; ++ai)
#pragma unroll
                for (int m = 0; m < 4; ++m)
#pragma unroll
                    for (int bj = 0; bj < 2; ++bj) rs[ai][m][bj] = 1.f;
            gv[0] = (f32x4){1.f, 1.f, 1.f, 1.f}; gv[1] = gv[0];
        }
#pragma unroll
        for (int ai = 0; ai < 2; ++ai)
#pragma unroll
            for (int m = 0; m < 4; ++m) { bf16_t* rowp = O + (size_t)(row0 + ai * HALF + m * 16) * ldc + col0;
#pragma unroll
                for (int bj = 0; bj < 2; ++bj) { const float r = rs[ai][m][bj];
                    const f32x4 v0 = acc[ai][bj][m][0] * gv[0] * r, v1 = acc[ai][bj][m][1] * gv[1] * r;
                    u32x4 w; w.x = cvt_pk_bf16(v0[0], v0[1]); w.y = cvt_pk_bf16(v0[2], v0[3]); w.z = cvt_pk_bf16(v1[0], v1[1]); w.w = cvt_pk_bf16(v1[2], v1[3]);
                    *(u32x4*)(rowp + bj * HALF) = w; } }
    }
};

struct EpiGate {
    static constexpr bool PERM = true, AFTER_DRAIN = false;
    bf16_t* O; int ldc; const float* bias;
    __device__ __forceinline__ void operator()(PG8_ACC, const Unit& u, int wr, int wc, int fr, int fq) const {
        const int row0 = u.pm * BM + wr * 64 + fr, col0 = u.pn * BM + wc * 32 + 8 * fq;
        f32x4 bv[2][2];
#pragma unroll
        for (int bj = 0; bj < 2; ++bj)
#pragma unroll
            for (int n = 0; n < 2; ++n) bv[bj][n] = *(const f32x4*)(bias + col0 + bj * HALF + 4 * n);
#pragma unroll
        for (int ai = 0; ai < 2; ++ai)
#pragma unroll
            for (int m = 0; m < 4; ++m) { bf16_t* rowp = O + (size_t)(row0 + ai * HALF + m * 16) * ldc + col0;
#pragma unroll
                for (int bj = 0; bj < 2; ++bj) { f32x4 v0 = acc[ai][bj][m][0] + bv[bj][0], v1 = acc[ai][bj][m][1] + bv[bj][1];
#pragma unroll
                    for (int e = 0; e < 4; ++e) { v0[e] = __builtin_amdgcn_rcpf(1.f + __builtin_amdgcn_exp2f(-1.4426950408889634f * v0[e])); v1[e] = __builtin_amdgcn_rcpf(1.f + __builtin_amdgcn_exp2f(-1.4426950408889634f * v1[e])); }
                    u32x4 w; w.x = cvt_pk_bf16(v0[0], v0[1]); w.y = cvt_pk_bf16(v0[2], v0[3]); w.z = cvt_pk_bf16(v1[0], v1[1]); w.w = cvt_pk_bf16(v1[2], v1[3]);
                    *(u32x4*)(rowp + bj * HALF) = w; } }
    }
};

struct EpiBranch {
    static constexpr bool PERM = true, AFTER_DRAIN = false;
    bf16_t* MIX; const bf16_t* GATE; int ldc; int accum;
    __device__ __forceinline__ void operator()(PG8_ACC, const Unit& u, int wr, int wc, int fr, int fq) const {
        const int row0 = u.pm * BM + wr * 64 + fr, col0 = u.pn * BM + wc * 32 + 8 * fq;
#pragma unroll
        for (int ai = 0; ai < 2; ++ai)
#pragma unroll
            for (int m = 0; m < 4; ++m) { const size_t off = (size_t)(row0 + ai * HALF + m * 16) * ldc + col0;
#pragma unroll
                for (int bj = 0; bj < 2; ++bj) { const u32x4 gt = *(const u32x4*)(GATE + off + bj * HALF);
                    f32x4 a = acc[ai][bj][m][0], b = acc[ai][bj][m][1];
                    a[0] *= bf_lo(gt.x); a[1] *= bf_hi(gt.x); a[2] *= bf_lo(gt.y); a[3] *= bf_hi(gt.y); b[0] *= bf_lo(gt.z); b[1] *= bf_hi(gt.z); b[2] *= bf_lo(gt.w); b[3] *= bf_hi(gt.w);
                    if (accum) { const u32x4 mx = *(const u32x4*)(MIX + off + bj * HALF);
                        a[0] += bf_lo(mx.x); a[1] += bf_hi(mx.x); a[2] += bf_lo(mx.y); a[3] += bf_hi(mx.y); b[0] += bf_lo(mx.z); b[1] += bf_hi(mx.z); b[2] += bf_lo(mx.w); b[3] += bf_hi(mx.w); }
                    u32x4 w; w.x = cvt_pk_bf16(a[0], a[1]); w.y = cvt_pk_bf16(a[2], a[3]); w.z = cvt_pk_bf16(b[0], b[1]); w.w = cvt_pk_bf16(b[2], b[3]);
                    *(u32x4*)(MIX + off + bj * HALF) = w; } }
    }
};

struct EpiResid {
    static constexpr bool PERM = true, AFTER_DRAIN = false;
    const float* res; float* out; int ld;
    __device__ __forceinline__ void operator()(PG8_ACC, const Unit& u, int wr, int wc, int fr, int fq) const {
        const int row0 = u.pm * BM + wr * 64 + fr, col0 = u.pn * BM + wc * 32 + 8 * fq;
#pragma unroll
        for (int ai = 0; ai < 2; ++ai)
#pragma unroll
            for (int m = 0; m < 4; ++m) { const size_t off = (size_t)(row0 + ai * HALF + m * 16) * ld + col0;
#pragma unroll
                for (int bj = 0; bj < 2; ++bj) {
                    const f32x4 r0 = *(const f32x4*)(res + off + bj * HALF), r1 = *(const f32x4*)(res + off + bj * HALF + 4);
                    const f32x4 v0 = acc[ai][bj][m][0] + r0, v1 = acc[ai][bj][m][1] + r1;
                    *(f32x4*)(out + off + bj * HALF) = v0; *(f32x4*)(out + off + bj * HALF + 4) = v1; } }
    }
};

struct EpiResidNorm {
    static constexpr bool PERM = true, AFTER_DRAIN = false;
    const float* res; float* out; int ld; const float* gain; bf16_t* H; int ldh; float* SSQ;
    __device__ __forceinline__ void operator()(PG8_ACC, const Unit& u, int wr, int wc, int fr, int fq) const {
        const int row0 = u.pm * BM + wr * 64 + fr, col0 = u.pn * BM + wc * 32 + 8 * fq;
        f32x4 gv[2][2];
#pragma unroll
        for (int bj = 0; bj < 2; ++bj)
#pragma unroll
            for (int n = 0; n < 2; ++n) gv[bj][n] = *(const f32x4*)(gain + col0 + bj * HALF + 4 * n);
#pragma unroll
        for (int ai = 0; ai < 2; ++ai)
#pragma unroll
            for (int m = 0; m < 4; ++m) { const int row = row0 + ai * HALF + m * 16; const size_t off = (size_t)row * ld + col0; float s = 0.f;
#pragma unroll
                for (int bj = 0; bj < 2; ++bj) {
                    const f32x4 r0 = *(const f32x4*)(res + off + bj * HALF), r1 = *(const f32x4*)(res + off + bj * HALF + 4);
                    const f32x4 v0 = acc[ai][bj][m][0] + r0, v1 = acc[ai][bj][m][1] + r1;
                    *(f32x4*)(out + off + bj * HALF) = v0; *(f32x4*)(out + off + bj * HALF + 4) = v1;
                    s += (v0[0] * v0[0] + v0[1] * v0[1]) + (v0[2] * v0[2] + v0[3] * v0[3]) + (v1[0] * v1[0] + v1[1] * v1[1]) + (v1[2] * v1[2] + v1[3] * v1[3]);
                    const f32x4 h0 = v0 * gv[bj][0], h1 = v1 * gv[bj][1];
                    u32x4 w; w.x = cvt_pk_bf16(h0[0], h0[1]); w.y = cvt_pk_bf16(h0[2], h0[3]); w.z = cvt_pk_bf16(h1[0], h1[1]); w.w = cvt_pk_bf16(h1[2], h1[3]);
                    *(u32x4*)(H + (size_t)row * ldh + col0 + bj * HALF) = w; }
                s += __shfl_xor(s, 16); s += __shfl_xor(s, 32);
                if (fq == 0) atomicAdd(SSQ + row, s); }
    }
};

struct EpiSwiGLU {
    static constexpr bool PERM = true, AFTER_DRAIN = false;
    bf16_t* O; int ldc; const float* SSQ;
    __device__ __forceinline__ void operator()(PG8_ACC, const Unit& u, int wr, int wc, int fr, int fq) const {
        const int row0 = u.pm * BM + wr * 64 + fr, col0 = u.pn * HALF + wc * 32 + 8 * fq;
#pragma unroll
        for (int ai = 0; ai < 2; ++ai)
#pragma unroll
            for (int m = 0; m < 4; ++m) { bf16_t* rowp = O + (size_t)(row0 + ai * HALF + m * 16) * ldc + col0;
                const float rstd = __builtin_amdgcn_rsqf(SSQ[row0 + ai * HALF + m * 16] * (1.f / 1024.f) + 1e-6f);
                f32x4 v[2];
#pragma unroll
                for (int n = 0; n < 2; ++n) { const f32x4 gt = acc[ai][0][m][n] * rstd, up = acc[ai][1][m][n] * rstd;
#pragma unroll
                    for (int e = 0; e < 4; ++e) v[n][e] = gt[e] * __builtin_amdgcn_rcpf(1.f + __builtin_amdgcn_exp2f(-1.4426950408889634f * gt[e])) * up[e]; }
                u32x4 w; w.x = cvt_pk_bf16(v[0][0], v[0][1]); w.y = cvt_pk_bf16(v[0][2], v[0][3]); w.z = cvt_pk_bf16(v[1][0], v[1][1]); w.w = cvt_pk_bf16(v[1][2], v[1][3]);
                *(u32x4*)rowp = w; }
    }
};

template <class Epi, class Sched, bool ALIGN_EPI = false, bool SP2 = false>
__device__ __forceinline__ void gemm_phase(PG8_LAS unsigned char* lds, const Gemm g, const Sched& S, const Epi& E, int wave_id) {
    const int tid = tid_fresh(wave_id);
    const int wid = __builtin_amdgcn_readfirstlane(tid >> 6), lane = tid & 63, wr = wid >> 2, wc = wid & 3, fr = lane & 15, fq = lane >> 4;
    const int K = g.K, nt = K / BK;
    unsigned voffA[2], voffB[2];
#pragma unroll
    for (int i = 0; i < 2; ++i) { int R, C; stage_rc(tid * 16 + i * 8192, R, C); const int Rb = Epi::PERM ? ((R & ~31) + perm32(R & 31)) : R;
        voffA[i] = (unsigned)(R * g.lda + C) * 2u; voffB[i] = (unsigned)(Rb * K + C) * 2u; }
    const size_t kstep = (size_t)(BK * 2);
    const size_t hstepA = (size_t)HALF * g.lda * 2, hstepB = (size_t)HALF * K * 2;
    const size_t tstepA = 2 * hstepA, tstepB = 2 * hstepB;
    const unsigned ldsw = (unsigned)wid * 1024u;
    const int aoff = lds_byte(wr * 64 + fr, fq * 8), boff = lds_byte(wc * 32 + fr, fq * 8);
#define PG8_SA(b, h) (((b) * 2 + (h)) * HTB)
#define PG8_SB(b, h) ((4 + (b) * 2 + (h)) * HTB)
#define PG8_STAGE(bufoff, gbase, voff) do { _Pragma("unroll") for (int _i = 0; _i < 2; ++_i) \
        __builtin_amdgcn_global_load_lds((const unsigned*)((const char*)(gbase) + (voff)[_i]), (PG8_LAS unsigned*)(lds + (bufoff) + ldsw + _i * 8192), 16, 0, 0); } while (0)
#define PG8_LDA(dst, b, h) do { _Pragma("unroll") for (int m = 0; m < 4; ++m) _Pragma("unroll") for (int k = 0; k < 2; ++k) dst[m][k] = *(const PG8_LAS bf16x8*)(lds + PG8_SA(b, h) + aoff + m * 2048 + k * 1024); } while (0)
#define PG8_LDB(dst, b, h) do { _Pragma("unroll") for (int n = 0; n < 2; ++n) _Pragma("unroll") for (int k = 0; k < 2; ++k) dst[n][k] = *(const PG8_LAS bf16x8*)(lds + PG8_SB(b, h) + boff + n * 2048 + k * 1024); } while (0)
#define PG8_MMA(ai, bj, At, Bt) do { __builtin_amdgcn_s_setprio(1); _Pragma("unroll") for (int m = 0; m < 4; ++m) _Pragma("unroll") for (int n = 0; n < 2; ++n) _Pragma("unroll") for (int k = 0; k < 2; ++k) \
        acc[ai][bj][m][n] = __builtin_amdgcn_mfma_f32_16x16x32_bf16(Bt[n][k], At[m][k], acc[ai][bj][m][n], 0, 0, 0); __builtin_amdgcn_s_setprio(0); } while (0)
#define PG8_WAIT_V(n) asm volatile("s_waitcnt vmcnt(" #n ")" ::: "memory")
#define PG8_WAIT_L(n) asm volatile("s_waitcnt lgkmcnt(" #n ")" ::: "memory")
#define PG8_BAR __builtin_amdgcn_s_barrier()
#define PG8_SCHED __builtin_amdgcn_sched_barrier(0)
    Unit cur, nxt; int ui = 0;
    if (!S.next(0, cur)) return;
    f32x4 acc[2][2][4][2];
#pragma unroll
    for (int a = 0; a < 2; ++a)
#pragma unroll
        for (int b = 0; b < 2; ++b)
#pragma unroll
            for (int m = 0; m < 4; ++m)
#pragma unroll
                for (int n = 0; n < 2; ++n) acc[a][b][m][n] = (f32x4){0.f, 0.f, 0.f, 0.f};
    bf16x8 At[4][2], B0[2][2], B1[2][2];
    const char* cA = (const char*)g.A + (size_t)cur.pm * tstepA; const char* cB = (const char*)g.Bt + (size_t)cur.pn * tstepB;
    S.a_ready(cur);
    if constexpr (SP2) {
        PG8_STAGE(PG8_SB(0, 0), cB, voffB); PG8_STAGE(PG8_SB(0, 1), cB + hstepB, voffB); PG8_STAGE(PG8_SA(0, 0), cA, voffA); PG8_STAGE(PG8_SA(0, 1), cA + hstepA, voffA);
        if (wr == 1) PG8_BAR;
        PG8_WAIT_V(2); PG8_BAR;
        PG8_STAGE(PG8_SB(1, 0), cB + kstep, voffB); PG8_STAGE(PG8_SA(1, 0), cA + kstep, voffA); PG8_STAGE(PG8_SB(1, 1), cB + hstepB + kstep, voffB);
        PG8_WAIT_V(6); PG8_BAR;
    } else {
        PG8_STAGE(PG8_SB(0, 0), cB, voffB); PG8_STAGE(PG8_SA(0, 0), cA, voffA); PG8_STAGE(PG8_SB(0, 1), cB + hstepB, voffB); PG8_STAGE(PG8_SA(0, 1), cA + hstepA, voffA);
        if (wr == 1) PG8_BAR;
        PG8_WAIT_V(4); PG8_BAR;
        PG8_STAGE(PG8_SB(1, 0), cB + kstep, voffB); PG8_STAGE(PG8_SA(1, 0), cA + kstep, voffA); PG8_STAGE(PG8_SB(1, 1), cB + hstepB + kstep, voffB);
        PG8_WAIT_V(6); PG8_BAR;
    }
    for (;;) {
        const bool has_next = S.next(ui + 1, nxt);
        const char* nA = has_next ? (const char*)g.A + (size_t)nxt.pm * tstepA : cA; const char* nB = has_next ? (const char*)g.Bt + (size_t)nxt.pn * tstepB : cB;
        for (int t = 0; t < nt; t += 2) {
            const bool last = (t == nt - 2);
            const char* a1 = cA + (size_t)(t + 1) * kstep;
            const char* a2 = last ? nA : cA + (size_t)(t + 2) * kstep; const char* b2 = last ? nB : cB + (size_t)(t + 2) * kstep;
            const char* a3 = a2 + kstep; const char* b3 = b2 + kstep;
            if (last && has_next) S.a_ready(nxt);
            if constexpr (SP2) {
            PG8_LDB(B0, 0, 0); PG8_LDB(B1, 0, 1); PG8_SCHED; PG8_LDA(At, 0, 0); PG8_STAGE(PG8_SA(1, 1), a1 + hstepA, voffA);
            PG8_WAIT_V(8); PG8_WAIT_L(0); PG8_BAR; PG8_MMA(0, 0, At, B0); PG8_MMA(0, 1, At, B1); PG8_BAR; PG8_SCHED;
            PG8_LDA(At, 0, 1); PG8_STAGE(PG8_SB(0, 0), b2, voffB); PG8_STAGE(PG8_SB(0, 1), b2 + hstepB, voffB); PG8_STAGE(PG8_SA(0, 0), a2, voffA);
            PG8_WAIT_V(8); PG8_WAIT_L(0); PG8_BAR; PG8_MMA(1, 0, At, B0); PG8_MMA(1, 1, At, B1); PG8_BAR; PG8_SCHED;
            PG8_LDB(B0, 1, 0); PG8_LDB(B1, 1, 1); PG8_SCHED; PG8_LDA(At, 1, 0); PG8_STAGE(PG8_SA(0, 1), a2 + hstepA, voffA);
            PG8_WAIT_V(8); PG8_WAIT_L(0); PG8_BAR; PG8_MMA(0, 0, At, B0); PG8_MMA(0, 1, At, B1); PG8_BAR; PG8_SCHED;
            PG8_LDA(At, 1, 1); PG8_STAGE(PG8_SB(1, 0), b3, voffB); PG8_STAGE(PG8_SB(1, 1), b3 + hstepB, voffB); PG8_STAGE(PG8_SA(1, 0), a3, voffA);
            PG8_WAIT_V(8); PG8_WAIT_L(0); PG8_BAR; PG8_MMA(1, 0, At, B0); PG8_MMA(1, 1, At, B1); PG8_BAR; PG8_SCHED;
            } else {
            PG8_LDB(B0, 0, 0); PG8_SCHED; PG8_LDA(At, 0, 0); PG8_STAGE(PG8_SA(1, 1), a1 + hstepA, voffA);
            PG8_WAIT_L(8); PG8_BAR; PG8_WAIT_L(0); PG8_MMA(0, 0, At, B0); PG8_BAR; PG8_SCHED;
            PG8_LDB(B1, 0, 1); PG8_STAGE(PG8_SB(0, 0), b2, voffB);
            PG8_BAR; PG8_WAIT_L(0); PG8_MMA(0, 1, At, B1); PG8_BAR;
            PG8_LDA(At, 0, 1); PG8_STAGE(PG8_SA(0, 0), a2, voffA);
            PG8_BAR; PG8_WAIT_L(0); PG8_MMA(1, 0, At, B0); PG8_BAR; PG8_SCHED;
            PG8_STAGE(PG8_SB(0, 1), b2 + hstepB, voffB);
            PG8_WAIT_V(6); PG8_BAR; PG8_MMA(1, 1, At, B1); PG8_BAR;
            PG8_LDB(B0, 1, 0); PG8_SCHED; PG8_LDA(At, 1, 0); PG8_STAGE(PG8_SA(0, 1), a2 + hstepA, voffA);
            PG8_WAIT_L(8); PG8_BAR; PG8_WAIT_L(0); PG8_MMA(0, 0, At, B0); PG8_BAR; PG8_SCHED;
            PG8_LDB(B1, 1, 1); PG8_STAGE(PG8_SB(1, 0), b3, voffB);
            PG8_BAR; PG8_WAIT_L(0); PG8_MMA(0, 1, At, B1); PG8_BAR;
            PG8_LDA(At, 1, 1); PG8_STAGE(PG8_SA(1, 0), a3, voffA);
            PG8_BAR; PG8_WAIT_L(0); PG8_MMA(1, 0, At, B0); PG8_BAR; PG8_SCHED;
            PG8_STAGE(PG8_SB(1, 1), b3 + hstepB, voffB);
            PG8_WAIT_V(6); PG8_BAR; PG8_MMA(1, 1, At, B1); PG8_BAR;
            }
        }
        if constexpr (ALIGN_EPI) { if (wr == 0) PG8_BAR; }
        if constexpr (!Epi::AFTER_DRAIN) { E(acc, cur, wr, wc, fr, fq); S.done(cur); }
        if (!has_next) break;
#pragma unroll
        for (int a = 0; a < 2; ++a)
#pragma unroll
            for (int b = 0; b < 2; ++b)
#pragma unroll
                for (int m = 0; m < 4; ++m)
#pragma unroll
                    for (int n = 0; n < 2; ++n) acc[a][b][m][n] = (f32x4){0.f, 0.f, 0.f, 0.f};
        cur = nxt; cA = nA; cB = nB; ++ui;
        if constexpr (ALIGN_EPI) { if (wr == 1) PG8_BAR; }
    }
    PG8_WAIT_V(0);
    if constexpr (!ALIGN_EPI) { if (wr == 0) PG8_BAR; }
    PG8_BAR;
    if constexpr (Epi::AFTER_DRAIN) { E.fused(acc, cur, wr, wc, fr, fq, lds, wid, lane); S.done(cur); }
#undef PG8_SA
#undef PG8_SB
#undef PG8_STAGE
#undef PG8_LDA
#undef PG8_LDB
#undef PG8_MMA
#undef PG8_WAIT_V
#undef PG8_WAIT_L
#undef PG8_BAR
#undef PG8_SCHED
}
}

#define LAS __attribute__((address_space(3)))
typedef unsigned short bf16;
typedef short bf16x8 __attribute__((ext_vector_type(8)));
typedef short s16x4 __attribute__((ext_vector_type(4)));
typedef short v4i16_t __attribute__((ext_vector_type(4)));
typedef float f32x16 __attribute__((ext_vector_type(16)));
typedef float f32x4 __attribute__((ext_vector_type(4)));
typedef float f32x2_t __attribute__((ext_vector_type(2)));
typedef __bf16 bf16x2_t __attribute__((ext_vector_type(2)));
typedef unsigned u32x4 __attribute__((ext_vector_type(4)));
typedef unsigned u32x2 __attribute__((ext_vector_type(2)));

constexpr int D = 1024, SEQ = 2048, NB = 8, M = NB * SEQ, NMEM = 256, MMEM = NB * NMEM, DIN = 6656, DFF = 2816;
constexpr int LDQ = 6656;
constexpr int C_AQ = 0, C_AK = 512, C_AV = 1024, C_BQ = 1536, C_BK = 3072, C_BV = 4608, C_CQ = 6144;
constexpr int C_GATE = 3072;
constexpr int C_H2 = 0, C_ACT = 1024;
constexpr float L2E = 1.4426950408889634f;
constexpr float EPS = 1e-6f;

constexpr size_t WS_WIN = 0;
constexpr size_t WS_WG = WS_WIN + (size_t)DIN * D * 2;
constexpr size_t WS_WMEM = WS_WG + (size_t)3 * D * D * 2;
constexpr size_t WS_WBR = WS_WMEM + (size_t)D * D * 2;
constexpr size_t WS_WOUT3 = WS_WBR + (size_t)3 * D * 512 * 2;
constexpr size_t WS_WGU = WS_WOUT3 + (size_t)D * 3 * D * 2;
constexpr size_t WS_WDN = WS_WGU + (size_t)2 * DFF * D * 2;
constexpr size_t WS_LB = WS_WDN + (size_t)D * DFF * 2;
constexpr size_t WS_R = WS_LB + (size_t)3 * M * 4 * 4;
constexpr size_t WS_BAR = WS_R + (size_t)M * LDQ * 2;
constexpr size_t WS_SSQ = WS_BAR + 16384;
constexpr size_t WS_END = WS_SSQ + (size_t)M * 4;
static_assert(WS_END <= (size_t)256 * 1024 * 1024, "d_ws map");
constexpr size_t DO_XN = 0;
constexpr size_t DO_MN = DO_XN + (size_t)M * D * 2;
constexpr size_t DO_CKV = DO_MN + (size_t)MMEM * D * 2;
static_assert(DO_CKV + (size_t)MMEM * D * 2 <= (size_t)M * D * 4, "d_out scratch map");

constexpr int LDS_BYTES = 155648;
constexpr int XCH_OFF = 131072, GT_OFF = 131072 + 8192;
constexpr int MISC_OFF = LDS_BYTES - 64;
constexpr int KP = 272, VP = 320;

__device__ __forceinline__ unsigned cvtpk(float lo, float hi) { f32x2_t v = {lo, hi}; bf16x2_t b = __builtin_convertvector(v, bf16x2_t); return __builtin_bit_cast(unsigned, b); }
__device__ __forceinline__ float wave_sum(float v) {
#pragma unroll
    for (int o = 1; o < 64; o <<= 1) v += __shfl_xor(v, o);
    return v;
}
__device__ __forceinline__ float wave_max(float v) {
#pragma unroll
    for (int o = 1; o < 64; o <<= 1) v = fmaxf(v, __shfl_xor(v, o));
    return v;
}
__device__ __forceinline__ float absmax_vec(const float* g, int n, int lane) {
    float v = fabsf(g[lane]); if (n > 64) v = fmaxf(v, fabsf(g[lane + 64]));
    return wave_max(v);
}

__device__ __forceinline__ void tr_item(const float* W, int N, int k0, int n0, bf16* WT, int dst_pitch, int dst_row0, int dst_k0, int ncopies, int copy_stride, LAS float* scr, int lane) {
#pragma unroll 8
    for (int i = 0; i < 32; ++i) { const int kk = 2 * i + (lane >> 5); scr[kk * 33 + (lane & 31)] = W[(size_t)(k0 + kk) * N + n0 + (lane & 31)]; }
    asm volatile("s_waitcnt lgkmcnt(0)" ::: "memory");
    const int c = lane & 7;
#pragma unroll
    for (int j = 0; j < 4; ++j) { const int n = (lane >> 3) + 8 * j; const LAS float* s = scr + (8 * c) * 33 + n;
        u32x4 o; o.x = cvtpk(s[0 * 33], s[1 * 33]); o.y = cvtpk(s[2 * 33], s[3 * 33]); o.z = cvtpk(s[4 * 33], s[5 * 33]); o.w = cvtpk(s[6 * 33], s[7 * 33]);
        bf16* dst = WT + (size_t)(dst_row0 + n0 + n) * dst_pitch + dst_k0 + k0 + 8 * c;
        for (int cp = 0; cp < ncopies; ++cp) *(u32x4*)(dst + (size_t)cp * copy_stride) = o; }
    asm volatile("s_waitcnt lgkmcnt(0)" ::: "memory");
}
__device__ __forceinline__ void rms_row_to_bf16(const float* xrow, const float* gain, bf16* orow, int lane) {
    const f32x4* xr = (const f32x4*)xrow + lane; const f32x4* gr = (const f32x4*)gain + lane;
    f32x4 v[4]; float s = 0.f;
#pragma unroll
    for (int j = 0; j < 4; ++j) { v[j] = xr[64 * j]; s += (v[j][0] * v[j][0] + v[j][1] * v[j][1]) + (v[j][2] * v[j][2] + v[j][3] * v[j][3]); }
    const float rstd = 1.f / sqrtf(wave_sum(s) * (1.f / 1024.f) + EPS);
    u32x2* o8 = (u32x2*)orow + lane;
#pragma unroll
    for (int j = 0; j < 4; ++j) { const f32x4 g = gr[64 * j]; u32x2 w; w.x = cvtpk(v[j][0] * rstd * g[0], v[j][1] * rstd * g[1]); w.y = cvtpk(v[j][2] * rstd * g[2], v[j][3] * rstd * g[3]); o8[64 * j] = w; }
}

__device__ __forceinline__ s16x4 vtr(const LAS char* p) { return __builtin_bit_cast(s16x4, __builtin_amdgcn_ds_read_tr16_b64_v4i16((LAS v4i16_t*)p)); }

template <int NK>
__device__ __forceinline__ void qk32(f32x16& S, const LAS char* Kp, const bf16x8* Q, int ks0, int r32, int hi) {
    const LAS char* kb = Kp + r32 * KP + hi * 16 + ks0 * 32;
#pragma unroll
    for (int ks = 0; ks < NK; ++ks) { const bf16x8 kf = *(const LAS bf16x8*)(kb + ks * 32); S = __builtin_amdgcn_mfma_f32_32x32x16_bf16(kf, Q[ks0 + ks], S, 0, 0, 0); }
}
__device__ __forceinline__ void pv32(f32x16 (&O)[4], const bf16x8 (&P)[2], const LAS char* Vp, int lane) {
    const int i = lane & 15, q = i >> 2, p = i & 3, dsel = (lane >> 4) & 1, h = lane >> 5;
    const LAS char* vb = Vp + (4 * h + q) * VP + (16 * dsel + 4 * p) * 2;
#pragma unroll
    for (int s = 0; s < 2; ++s)
#pragma unroll
        for (int db = 0; db < 4; ++db) {
            const s16x4 lo = vtr(vb + (16 * s) * VP + db * 64), hi4 = vtr(vb + (16 * s + 8) * VP + db * 64);
            const bf16x8 a = (bf16x8){lo[0], lo[1], lo[2], lo[3], hi4[0], hi4[1], hi4[2], hi4[3]};
            O[db] = __builtin_amdgcn_mfma_f32_32x32x16_bf16(a, P[s], O[db], 0, 0, 0);
        }
}
struct VFrag { s16x4 lo[2][4], hi[2][4]; };
__device__ __forceinline__ void vload32(VFrag& f, const LAS char* Vp, int lane) {
    const int i = lane & 15, q = i >> 2, p = i & 3, dsel = (lane >> 4) & 1, h = lane >> 5;
    const LAS char* vb = Vp + (4 * h + q) * VP + (16 * dsel + 4 * p) * 2;
#pragma unroll
    for (int s = 0; s < 2; ++s)
#pragma unroll
        for (int db = 0; db < 4; ++db) { f.lo[s][db] = vtr(vb + (16 * s) * VP + db * 64); f.hi[s][db] = vtr(vb + (16 * s + 8) * VP + db * 64); }
}
__device__ __forceinline__ void pvmm32(f32x16 (&O)[4], const bf16x8 (&P)[2], const VFrag& f) {
#pragma unroll
    for (int s = 0; s < 2; ++s)
#pragma unroll
        for (int db = 0; db < 4; ++db) {
            const bf16x8 a = (bf16x8){f.lo[s][db][0], f.lo[s][db][1], f.lo[s][db][2], f.lo[s][db][3], f.hi[s][db][0], f.hi[s][db][1], f.hi[s][db][2], f.hi[s][db][3]};
            O[db] = __builtin_amdgcn_mfma_f32_32x32x16_bf16(a, P[s], O[db], 0, 0, 0);
        }
}
template <int NK>
__device__ __forceinline__ void kload32(bf16x8 (&kf)[NK], const LAS char* Kp, int r32, int hi) {
    const LAS char* kb = Kp + r32 * KP + hi * 16;
#pragma unroll
    for (int ks = 0; ks < NK; ++ks) kf[ks] = *(const LAS bf16x8*)(kb + ks * 32);
}
template <int NK>
__device__ __forceinline__ void qkmm32(f32x16& S, const bf16x8 (&kf)[NK], const bf16x8* Q) {
#pragma unroll
    for (int ks = 0; ks < NK; ++ks) S = __builtin_amdgcn_mfma_f32_32x32x16_bf16(kf[ks], Q[ks], S, 0, 0, 0);
}
#define SCHED_FENCE() __builtin_amdgcn_sched_barrier(0)
template <int MODE>
__device__ __forceinline__ void soft32(const f32x16& S, bf16x8 (&P)[2], float& l, float dbase, float nslope) {
    float p[16];
#pragma unroll
    for (int r = 0; r < 16; ++r) {
        float s = S[r];
        if (MODE >= 1) { const float a = fabsf(dbase - (float)((r & 3) + 8 * (r >> 2))); s = fmaf(nslope, a, s); float e = __builtin_amdgcn_exp2f(s); if (MODE == 2) e = (a <= 64.f) ? e : 0.f; p[r] = e; }
        else p[r] = __builtin_amdgcn_exp2f(s);
        l += p[r];
    }
#pragma unroll
    for (int s = 0; s < 2; ++s) { u32x4 w; w.x = cvtpk(p[8 * s + 0], p[8 * s + 1]); w.y = cvtpk(p[8 * s + 2], p[8 * s + 3]); w.z = cvtpk(p[8 * s + 4], p[8 * s + 5]); w.w = cvtpk(p[8 * s + 6], p[8 * s + 7]); P[s] = __builtin_bit_cast(bf16x8, w); }
}
__device__ __forceinline__ void zero16(f32x16& v) {
#pragma unroll
    for (int r = 0; r < 16; ++r) v[r] = 0.f;
}

template <int NC>
__device__ __forceinline__ void attn_shared_unit(LAS char* lds, bf16* qrow, const bf16* Kg, const bf16* Vg, int kvp, int nt, int qpos, int qw, float nslope, float negM0, float lam, const float* subln, int wave_id) {
    const int wv = wave_id, tid = pg8::tid_fresh(wave_id);
    const int lane = tid & 63, r32 = lane & 31, hi = lane >> 5;
    const int cm = (NC == 2) ? (wv & 1) : 0;
    constexpr int NQ = (NC == 2) ? 4 : 8;
    bf16x8 Q[NQ];
#pragma unroll
    for (int ks = 0; ks < NQ; ++ks) Q[ks] = *(const bf16x8*)(qrow + cm * 64 + 16 * ks + 8 * hi);
    f32x16 O[4]; float l = 0.f;
#pragma unroll
    for (int db = 0; db < 4; ++db) zero16(O[db]);
    const int lrow = tid >> 3, lcb = (tid & 7) * 32;
    const char* kgp = (const char*)(Kg + (size_t)lrow * kvp) + lcb; const char* vgp = (const char*)(Vg + (size_t)lrow * kvp) + lcb;
    const size_t tstep = (size_t)64 * kvp * 2;
    u32x4 kr0, kr1, vr0, vr1;
    kr0 = *(const u32x4*)kgp; kr1 = *(const u32x4*)(kgp + 16); vr0 = *(const u32x4*)vgp; vr1 = *(const u32x4*)(vgp + 16);
    __syncthreads();
    { LAS char* kb = lds + lrow * KP + lcb; LAS char* vb = lds + 64 * KP + lrow * VP + lcb;
      *(LAS u32x4*)kb = kr0; *(LAS u32x4*)(kb + 16) = kr1; *(LAS u32x4*)vb = vr0; *(LAS u32x4*)(vb + 16) = vr1; }
    __syncthreads();
    constexpr int BUFB = 64 * KP + 64 * VP;
    const float qd = (float)(qpos - 4 * hi);
#pragma unroll 1
    for (int t = 0; t < nt; ++t) {
        const bool more = (t + 1 < nt);
        if (more) { const char* kp = kgp + (size_t)(t + 1) * tstep; const char* vp = vgp + (size_t)(t + 1) * tstep;
            kr0 = *(const u32x4*)kp; kr1 = *(const u32x4*)(kp + 16); vr0 = *(const u32x4*)vp; vr1 = *(const u32x4*)(vp + 16); }
        const LAS char* Kb = lds + (t & 1) * BUFB + cm * 128; const LAS char* Vb = lds + (t & 1) * BUFB + 64 * KP;
        f32x16 S0, S1; bf16x8 P0[2], P1[2];
        const int k0 = t * 64, k1 = k0 + 32;
        if (NC == 2) {
            const float ns0 = (k0 < qw) ? nslope : ((k0 > qw) ? -nslope : 0.f), ns1 = (k1 < qw) ? nslope : ((k1 > qw) ? -nslope : 0.f);
            const float b0 = fmaf(ns0, qd - (float)k0, negM0), b1 = fmaf(ns1, qd - (float)k1, negM0);
#pragma unroll
            for (int r = 0; r < 16; ++r) { S0[r] = fmaf(-ns0, (float)((r & 3) + 8 * (r >> 2)), b0); S1[r] = fmaf(-ns1, (float)((r & 3) + 8 * (r >> 2)), b1); }
        } else {
#pragma unroll
            for (int r = 0; r < 16; ++r) { S0[r] = negM0; S1[r] = negM0; }
        }
        VFrag vf0, vf1;
        if (NC == 2) {
            bf16x8 kf0[NQ], kf1[NQ];
            kload32<NQ>(kf0, Kb, r32, hi); kload32<NQ>(kf1, Kb + 32 * KP, r32, hi);
            SCHED_FENCE();
            qkmm32<NQ>(S0, kf0, Q);
            vload32(vf0, Vb, lane);
            qkmm32<NQ>(S1, kf1, Q);
        } else {
            bf16x8 kf[NQ];
            kload32<NQ>(kf, Kb, r32, hi);
            SCHED_FENCE();
            qkmm32<NQ>(S0, kf, Q);
            kload32<NQ>(kf, Kb + 32 * KP, r32, hi);
            vload32(vf0, Vb, lane);
            qkmm32<NQ>(S1, kf, Q);
        }
        SCHED_FENCE();
        if (NC == 2 && k0 == qw) {
#pragma unroll
            for (int r = 0; r < 16; ++r) S0[r] = fmaf(nslope, fabsf(qd - (float)k0 - (float)((r & 3) + 8 * (r >> 2))), S0[r]);
        }
        soft32<0>(S0, P0, l, 0.f, 0.f);
        vload32(vf1, Vb + 32 * VP, lane);
        SCHED_FENCE();
        pvmm32(O, P0, vf0);
        if (NC == 2 && k1 == qw) {
#pragma unroll
            for (int r = 0; r < 16; ++r) S1[r] = fmaf(nslope, fabsf(qd - (float)k1 - (float)((r & 3) + 8 * (r >> 2))), S1[r]);
        }
        soft32<0>(S1, P1, l, 0.f, 0.f);
        SCHED_FENCE();
        pvmm32(O, P1, vf1);
        if (more) { LAS char* kb = lds + ((t + 1) & 1) * BUFB + lrow * KP + lcb; LAS char* vb = lds + ((t + 1) & 1) * BUFB + 64 * KP + lrow * VP + lcb;
            *(LAS u32x4*)kb = kr0; *(LAS u32x4*)(kb + 16) = kr1; *(LAS u32x4*)vb = vr0; *(LAS u32x4*)(vb + 16) = vr1; }
        __syncthreads();
    }
    l += __shfl_xor(l, 32);
    if (NC == 2) {
        LAS float* XO = (LAS float*)lds + (wv >> 1) * 4096 + lane;
        if (cm == 1) { const float i2 = lam / l;
#pragma unroll
            for (int db = 0; db < 4; ++db)
#pragma unroll
                for (int r = 0; r < 16; ++r) XO[(db * 16 + r) * 64] = O[db][r] * i2; }
        __syncthreads();
        if (cm == 0) {
            const float i1 = 1.f / l; float ss = 0.f;
#pragma unroll
            for (int db = 0; db < 4; ++db)
#pragma unroll
                for (int r = 0; r < 16; ++r) { const float o = O[db][r] * i1 - XO[(db * 16 + r) * 64]; O[db][r] = o; ss += o * o; }
            ss += __shfl_xor(ss, 32);
            const float rstd = (1.f / sqrtf(ss * (1.f / 128.f) + EPS)) * 0.8f;
#pragma unroll
            for (int db = 0; db < 4; ++db)
#pragma unroll
                for (int g4 = 0; g4 < 4; ++g4) { const int d = 32 * db + 8 * g4 + 4 * hi; const f32x4 gn = *(const f32x4*)(subln + d);
                    u32x2 w; w.x = cvtpk(O[db][4 * g4 + 0] * rstd * gn[0], O[db][4 * g4 + 1] * rstd * gn[1]); w.y = cvtpk(O[db][4 * g4 + 2] * rstd * gn[2], O[db][4 * g4 + 3] * rstd * gn[3]);
                    *(u32x2*)(qrow + d) = w; }
        }
    } else {
        const float i1 = 1.f / l;
#pragma unroll
        for (int db = 0; db < 4; ++db)
#pragma unroll
            for (int g4 = 0; g4 < 4; ++g4) { const int d = 32 * db + 8 * g4 + 4 * hi;
                u32x2 w; w.x = cvtpk(O[db][4 * g4 + 0] * i1, O[db][4 * g4 + 1] * i1); w.y = cvtpk(O[db][4 * g4 + 2] * i1, O[db][4 * g4 + 3] * i1);
                *(u32x2*)(qrow + d) = w; }
    }
}

__device__ __forceinline__ void attn_b_wave_unit(LAS char* wl, bf16* R, float* LB, int b, int g, int j, int idx, float negM0, int lane_in) {
    int lane = lane_in; asm volatile("" : "+v"(lane));
    const int r32 = lane & 31, hi = lane >> 5;
    const int dil = (g == 0) ? 1 : ((g == 1) ? 4 : 16), nqb = 64 / dil, sub_len = SEQ / dil;
    const int res = idx / nqb, qb = idx % nqb;
    const float slope = __builtin_amdgcn_exp2f(-8.f * (float)(g * 4 + j + 1) / 12.f);
    const float nslope = -slope * (float)dil * L2E;
    const int qsub = 32 * qb + r32;
    const size_t qrow_i = (size_t)b * SEQ + (size_t)qsub * dil + res;
    const int hcol = (g * 4 + j) * 128;
    bf16* qrow = R + qrow_i * LDQ + C_BQ + hcol;
    bf16x8 Q[8];
#pragma unroll
    for (int ks = 0; ks < 8; ++ks) Q[ks] = *(const bf16x8*)(qrow + 16 * ks + 8 * hi);
    f32x16 O[4]; float l = 0.f;
#pragma unroll
    for (int db = 0; db < 4; ++db) zero16(O[db]);
    const int lr = lane >> 4, lc = (lane & 15) * 8;
#pragma unroll 1
    for (int kt = 0; kt < 5; ++kt) {
        const int kb = 32 * qb - 64 + 32 * kt;
        if (kb < 0 || kb >= sub_len) continue;
        u32x4 kr[8], vr[8];
#pragma unroll
        for (int n = 0; n < 8; ++n) { const size_t krow = (size_t)b * SEQ + (size_t)(kb + 4 * n + lr) * dil + res;
            kr[n] = *(const u32x4*)(R + krow * LDQ + C_BK + hcol + lc); vr[n] = *(const u32x4*)(R + krow * LDQ + C_BV + hcol + lc); }
#pragma unroll
        for (int n = 0; n < 8; ++n) { *(LAS u32x4*)(wl + (4 * n + lr) * KP + lc * 2) = kr[n]; *(LAS u32x4*)(wl + 32 * KP + (4 * n + lr) * VP + lc * 2) = vr[n]; }
        asm volatile("s_waitcnt lgkmcnt(0)" ::: "memory");
        f32x16 S;
#pragma unroll
        for (int r = 0; r < 16; ++r) S[r] = negM0;
        qk32<8>(S, wl, Q, 0, r32, hi);
        bf16x8 P[2];
        soft32<2>(S, P, l, (float)(qsub - (kb + 4 * hi)), nslope);
        pv32(O, P, wl + 32 * KP, lane);
        asm volatile("s_waitcnt lgkmcnt(0)" ::: "memory");
    }
    l += __shfl_xor(l, 32);
    const float i1 = 1.f / l;
#pragma unroll
    for (int db = 0; db < 4; ++db)
#pragma unroll
        for (int g4 = 0; g4 < 4; ++g4) { const int d = 32 * db + 8 * g4 + 4 * hi;
            u32x2 w; w.x = cvtpk(O[db][4 * g4 + 0] * i1, O[db][4 * g4 + 1] * i1); w.y = cvtpk(O[db][4 * g4 + 2] * i1, O[db][4 * g4 + 3] * i1);
            *(u32x2*)(qrow + d) = w; }
    if (hi == 0) LB[((size_t)g * M + qrow_i) * 4 + j] = l;
}

#define XB_TMO      128
#define XB_XCNT(j)  (256  + 64 * (j))
#define XB_XSUB(j)  (1280 + 64 * (j))
#define XB_XGEN(j)  (2304 + 64 * (j))
#define XB_TOP      3328
#define XB_TOPGEN   3392
#define XCD_BAR_WORDS 3456
#define XB_SPIN_CAP (1u << 18)

__device__ __forceinline__ unsigned xb_ld(unsigned* p)              { return __hip_atomic_load(p, __ATOMIC_RELAXED, __HIP_MEMORY_SCOPE_AGENT); }
__device__ __forceinline__ unsigned xb_add(unsigned* p, unsigned v) { return __hip_atomic_fetch_add(p, v, __ATOMIC_RELAXED, __HIP_MEMORY_SCOPE_AGENT); }
__device__ __forceinline__ unsigned xb_xcc_id() { return (unsigned)__builtin_amdgcn_s_getreg((3 << 11) | 20) & 0xFu; }
#define XB_SPIN(cond, bar) do { unsigned _sp = 0; while (cond) { __builtin_amdgcn_s_sleep(1); \
    if ((++_sp & 255u) == 0u) { if (xb_ld(&(bar)[XB_TMO])) break; if (_sp > XB_SPIN_CAP) { atomicAdd(&(bar)[XB_TMO], 1u); break; } } } } while (0)

struct XcdBarrier {
    unsigned* bar; unsigned x;
    volatile LAS unsigned* st;
};

__device__ __forceinline__ XcdBarrier xcd_barrier_post(unsigned* bar, volatile LAS unsigned* st) {
    XcdBarrier b; b.bar = bar; b.x = xb_xcc_id(); b.st = st;
    if (threadIdx.x == 0) (void)xb_add(&bar[XB_XCNT(b.x)], 1u);
    return b;
}
__device__ __forceinline__ void xcd_barrier_complete(unsigned* bar, unsigned x, unsigned& nloc, unsigned& nx) {
    const unsigned G = gridDim.x * gridDim.y * gridDim.z;
    unsigned sum, cnt, mine, sp = 0u;
    for (;;) {
        sum = 0u; cnt = 0u; mine = 0u;
#pragma unroll
        for (unsigned j = 0; j < 16; ++j) { const unsigned c = xb_ld(&bar[XB_XCNT(j)]); sum += c; cnt += (c > 0u) ? 1u : 0u; mine = (j == x) ? c : mine; }
        if (sum == G) break;
        __builtin_amdgcn_s_sleep(1);
        if ((++sp & 255u) == 0u) { if (xb_ld(&bar[XB_TMO])) break; if (sp > XB_SPIN_CAP) { atomicAdd(&bar[XB_TMO], 1u); break; } }
    }
    nloc = mine > 0u ? mine : 1u; nx = cnt > 0u ? cnt : 1u;
}

__device__ __forceinline__ void xcd_barrier(const XcdBarrier& b, int wave_id) {
    asm volatile("s_waitcnt vmcnt(0)" ::: "memory");
    __syncthreads();
    if (pg8::tid_fresh(wave_id) == 0) {
        unsigned* bar = b.bar;
        __builtin_amdgcn_s_waitcnt(0);
        unsigned nloc = b.st[0], nx = b.st[1];
        if (nloc == 0u) { xcd_barrier_complete(bar, b.x, nloc, nx); b.st[0] = nloc; b.st[1] = nx; }
        const unsigned old = xb_add(&bar[XB_XSUB(b.x)], 1u);
        const unsigned gen = old / nloc;
        if (old + 1u == (gen + 1u) * nloc) {
            __builtin_amdgcn_fence(__ATOMIC_RELEASE, "agent");
            asm volatile("s_waitcnt vmcnt(0)" ::: "memory");
            const unsigned og = xb_add(&bar[XB_TOP], 1u);
            const unsigned tg = og / nx;
            if (og + 1u == (tg + 1u) * nx) xb_add(&bar[XB_TOPGEN], 1u);
            else XB_SPIN(xb_ld(&bar[XB_TOPGEN]) == tg, bar);
            __builtin_amdgcn_fence(__ATOMIC_ACQUIRE, "agent");
            xb_add(&bar[XB_XGEN(b.x)], 1u);
            asm volatile("s_waitcnt vmcnt(0)" ::: "memory");
        } else {
            XB_SPIN(xb_ld(&bar[XB_XGEN(b.x)]) == gen, bar);
            __builtin_amdgcn_fence(__ATOMIC_ACQUIRE, "agent");
            asm volatile("s_waitcnt vmcnt(0)" ::: "memory");
        }
    }
    __syncthreads();
}

struct Args { const float* in[25]; float* out; unsigned char* ws; };

__global__ void __launch_bounds__(512, 2) fwd_megakernel(Args a) {
    extern __shared__ __attribute__((aligned(16))) unsigned char lds_raw[];
    LAS unsigned char* lds = (LAS unsigned char*)lds_raw;
    cg::grid_group grid = cg::this_grid();
    const int wave = __builtin_amdgcn_readfirstlane((int)threadIdx.x >> 6);
#define FRESH_LANE const int lane = pg8::lane_id_fresh();
    const int G = gridDim.x, bid = blockIdx.x;
    const int gw = bid * 8 + wave, NGW = G * 8;
    unsigned char* ws = a.ws;
    const float* x = a.in[0]; const float* mem = a.in[1];
    bf16* W_IN = (bf16*)(ws + WS_WIN); bf16* W_G = (bf16*)(ws + WS_WG); bf16* W_MEM = (bf16*)(ws + WS_WMEM); bf16* W_BR = (bf16*)(ws + WS_WBR);
    bf16* W_OUT = (bf16*)(ws + WS_WOUT3); bf16* W_GU = (bf16*)(ws + WS_WGU); bf16* W_DN = (bf16*)(ws + WS_WDN);
    float* LB = (float*)(ws + WS_LB); bf16* R = (bf16*)(ws + WS_R);
    unsigned char* dob = (unsigned char*)a.out;
    bf16* XN = (bf16*)(dob + DO_XN); bf16* MN = (bf16*)(dob + DO_MN); bf16* CKV = (bf16*)(dob + DO_CKV);

    volatile LAS unsigned* MISC = (volatile LAS unsigned*)(lds + MISC_OFF);
    unsigned* barw = (unsigned*)(ws + WS_BAR);
    if (threadIdx.x < 16) MISC[threadIdx.x] = 0u;
    if (a.ws == nullptr) grid.sync();
    XcdBarrier bar = xcd_barrier_post(barw, MISC);
    __syncthreads();
    {
        FRESH_LANE
        LAS float* scr = (LAS float*)(lds + wave * 8704);
        constexpr int I_IN = 16 * (DIN / 32), I_G = 16 * (3 * D / 32), I_MEM = 16 * (D / 32), I_BR = 8 * (D / 32), I_OUT = 16 * (D / 32), I_FF = 16 * (DFF / 32), I_DN = (DFF / 64) * (D / 32);
        constexpr int NITEMS = I_IN + I_G + I_MEM + 3 * I_BR + I_OUT + 2 * I_FF + I_DN;
        for (int it = gw; it < NITEMS; it += NGW) {
            int r = it;
            if (r < I_IN) { const int nb = DIN / 32; tr_item(a.in[3], DIN, 64 * (r / nb), 32 * (r % nb), W_IN, D, 0, 0, 1, 0, scr, lane); continue; } r -= I_IN;
            if (r < I_G) { const int nb = 3 * D / 32; tr_item(a.in[4], 3 * D, 64 * (r / nb), 32 * (r % nb), W_G, D, 0, 0, 1, 0, scr, lane); continue; } r -= I_G;
            if (r < I_MEM) { const int nb = D / 32; tr_item(a.in[16], D, 64 * (r / nb), 32 * (r % nb), W_MEM, D, 0, 0, 1, 0, scr, lane); continue; } r -= I_MEM;
            if (r < 3 * I_BR) { const int gI = r / I_BR, rr = r % I_BR, nb = D / 32; tr_item(a.in[19] + (size_t)gI * 512 * D, D, 64 * (rr / nb), 32 * (rr % nb), W_BR + (size_t)gI * D * 512, 512, 0, 0, 1, 0, scr, lane); continue; } r -= 3 * I_BR;
            if (r < I_OUT) { const int nb = D / 32; tr_item(a.in[20], D, 64 * (r / nb), 32 * (r % nb), W_OUT, D, 0, 0, 1, 0, scr, lane); continue; } r -= I_OUT;
            if (r < 2 * I_FF) { const int s = r / I_FF, rr = r % I_FF, nb = DFF / 32; const int n0 = 32 * (rr % nb);
                tr_item(a.in[22 + s], DFF, 64 * (rr / nb), n0, W_GU, D, 256 * (n0 / 128) + 128 * s + (n0 % 128) - n0, 0, 1, 0, scr, lane); continue; } r -= 2 * I_FF;
            { const int nb = D / 32; tr_item(a.in[24], D, 64 * (r / nb), 32 * (r % nb), W_DN, DFF, 0, 0, 1, 0, scr, lane); }
        }
        { float* SSQ0 = (float*)(ws + WS_SSQ); for (int i = gw * 64 + lane; i < M; i += NGW * 64) SSQ0[i] = 0.f; }
        for (int m = gw; m < M + MMEM; m += NGW) {
            if (m < M) rms_row_to_bf16(x + (size_t)m * D, a.in[2], XN + (size_t)m * D, lane);
            else rms_row_to_bf16(mem + (size_t)(m - M) * D, a.in[15], MN + (size_t)(m - M) * D, lane);
        }
    }
    xcd_barrier(bar, wave);

    {
        LAS float* GT = (LAS float*)(lds + GT_OFF);
        { const int t2 = pg8::tid_fresh(wave);
          if (t2 < 64) { GT[t2] = a.in[6][t2]; GT[64 + t2] = a.in[7][t2]; }
          if (t2 < 128) { GT[128 + t2] = a.in[13][t2]; GT[256 + t2] = a.in[14][t2]; GT[384 + t2] = a.in[17][t2]; GT[512 + t2] = a.in[18][t2]; } }
        __syncthreads();
        { const pg8::EpiQKV E{R, LDQ, 0, GT, (LAS float*)(lds + XCH_OFF)};
          pg8::Gemm g{XN, W_IN, M, DIN, D, D}; pg8::StaticOrder S; S.init(M, DIN, G, bid);
          pg8::gemm_phase<pg8::EpiQKV, pg8::StaticOrder, true, true>(lds, g, S, E, wave); }
        { const pg8::EpiQKV E{CKV, D, 1, GT, (LAS float*)(lds + XCH_OFF)};
          pg8::Gemm g{MN, W_MEM, MMEM, D, D, D}; pg8::StaticOrder S; S.init(MMEM, D, G, bid);
          pg8::gemm_phase<pg8::EpiQKV, pg8::StaticOrder, true, true>(lds, g, S, E, wave); }
    }
    xcd_barrier(bar, wave);

    {
        FRESH_LANE
#define UNIFORM_F(v) __builtin_bit_cast(float, __builtin_amdgcn_readfirstlane(__builtin_bit_cast(int, (float)(v))))
        const float negM_a = UNIFORM_F(-8.f * absmax_vec(a.in[6], 64, lane) * absmax_vec(a.in[7], 64, lane) * L2E);
        const float negM_b = UNIFORM_F(-11.313708499f * absmax_vec(a.in[13], 128, lane) * absmax_vec(a.in[14], 128, lane) * L2E);
        const float negM_c = UNIFORM_F(-11.313708499f * absmax_vec(a.in[17], 128, lane) * absmax_vec(a.in[18], 128, lane) * L2E);
        const float lam = UNIFORM_F(expf(wave_sum(a.in[8][lane] * a.in[9][lane])) - expf(wave_sum(a.in[10][lane] * a.in[11][lane])) + 0.2f);
        for (int rr = 0; rr < (512 + G - 1) / G; ++rr) {
            int u;
            if (G == 256) { const int k = rr * 32 + (bid >> 3), bh = (bid & 7) + 8 * (k >> 4); u = bh * 16 + (k & 15); }
            else { u = rr * G + bid; if (u >= 512) break; }
            const int b = u >> 6, h = (u >> 4) & 3, qblk = u & 15;
            const int ta_ = pg8::lane_id_fresh();
            const int qpos = qblk * 128 + (wave >> 1) * 32 + (ta_ & 31);
            bf16* qrow = R + ((size_t)b * SEQ + qpos) * LDQ + C_AQ + h * 128;
            const bf16* Kg = R + (size_t)b * SEQ * LDQ + C_AK + h * 128; const bf16* Vg = R + (size_t)b * SEQ * LDQ + C_AV + h * 128;
            const float nslope = -__builtin_amdgcn_exp2f(-2.f * (float)(h + 1)) * L2E;
            attn_shared_unit<2>((LAS char*)lds, qrow, Kg, Vg, LDQ, SEQ / 64, qpos, qblk * 128 + (wave >> 1) * 32, nslope, negM_a, lam, a.in[12], wave);
        }
        for (int u = bid; u < 256; u += G) {
            const int b = u >> 5, h = (u >> 3) & 3, qblk = u & 7;
            const int tc_ = pg8::lane_id_fresh();
            const int qpos = qblk * 256 + wave * 32 + (tc_ & 31);
            bf16* qrow = R + ((size_t)b * SEQ + qpos) * LDQ + C_CQ + h * 128;
            const bf16* Kg = CKV + (size_t)b * NMEM * D + h * 128; const bf16* Vg = Kg + 512;
            attn_shared_unit<1>((LAS char*)lds, qrow, Kg, Vg, D, NMEM / 64, qpos, 0, 0.f, negM_c, 0.f, a.in[12], wave);
        }
        __syncthreads();
        { const int tb_ = pg8::lane_id_fresh();
          for (int rr = 0; rr < (6144 + NGW - 1) / NGW; ++rr) {
              int wu;
              if (G == 256) { const int k = rr * 256 + (bid >> 3) * 8 + wave, sid = (bid & 7) + 8 * (k >> 6); wu = sid * 64 + (k & 63); }
              else { wu = rr * NGW + gw; if (wu >= 6144) break; }
              const int sid = wu >> 6;
              attn_b_wave_unit((LAS char*)lds + wave * (32 * KP + 32 * VP), R, LB, sid / 12, (sid % 12) >> 2, sid & 3, wu & 63, negM_b, tb_ & 63);
          } }
    }
    xcd_barrier(bar, wave);

    { FRESH_LANE
    for (int m = gw; m < M; m += NGW) {
        const int j = lane >> 4, d8 = (lane & 15) * 8;
        const float l0 = LB[((size_t)0 * M + m) * 4 + j], l1 = LB[((size_t)1 * M + m) * 4 + j], l2 = LB[((size_t)2 * M + m) * 4 + j];
        const float inv = 1.f / (l0 + l1 + l2); const float w0 = l0 * inv, w1 = l1 * inv, w2 = l2 * inv;
        bf16* p0 = R + (size_t)m * LDQ + C_BQ + j * 128 + d8;
        const u32x4 o0 = *(const u32x4*)p0, o1 = *(const u32x4*)(p0 + 512), o2 = *(const u32x4*)(p0 + 1024);
        u32x4 w;
#pragma unroll
        for (int e = 0; e < 4; ++e) {
            const float lo = w0 * pg8::bf_lo(o0[e]) + w1 * pg8::bf_lo(o1[e]) + w2 * pg8::bf_lo(o2[e]);
            const float hi = w0 * pg8::bf_hi(o0[e]) + w1 * pg8::bf_hi(o1[e]) + w2 * pg8::bf_hi(o2[e]);
            w[e] = cvtpk(lo, hi);
        }
        *(u32x4*)p0 = w;
    } }
    {
        pg8::Gemm g{XN, W_G, M, 3 * D, D, D}; pg8::StaticOrder S; S.init(M, 3 * D, G, bid);
        pg8::EpiGate E{R + C_GATE, LDQ, a.in[5]};
        pg8::gemm_phase<pg8::EpiGate, pg8::StaticOrder, true, true>(lds, g, S, E, wave);
    }
    xcd_barrier(bar, wave);

    for (int gI = 0; gI < 3; ++gI) {
        const int acol = (gI == 0) ? C_AQ : ((gI == 1) ? C_BQ : C_CQ);
        pg8::Gemm g{R + acol, W_BR + (size_t)gI * D * 512, M, D, 512, LDQ}; pg8::StaticOrder S; S.init(M, D, G, bid);
        pg8::EpiBranch E{R + C_GATE, R + C_GATE + gI * D, LDQ, gI};
        pg8::gemm_phase<pg8::EpiBranch, pg8::StaticOrder, true, true>(lds, g, S, E, wave);
    }
    xcd_barrier(bar, wave);

    {
        pg8::Gemm g{R + C_GATE, W_OUT, M, D, D, LDQ}; pg8::StaticOrder S; S.init(M, D, G, bid);
        pg8::EpiResidNorm E{x, a.out, D, a.in[21], R + C_H2, LDQ, (float*)(ws + WS_SSQ)};
        pg8::gemm_phase<pg8::EpiResidNorm, pg8::StaticOrder, true, true>(lds, g, S, E, wave);
    }
    xcd_barrier(bar, wave);

    {
        pg8::Gemm g{R + C_H2, W_GU, M, 2 * DFF, D, LDQ}; pg8::StaticOrder S; S.init(M, 2 * DFF, G, bid);
        pg8::EpiSwiGLU E{R + C_ACT, LDQ, (const float*)(ws + WS_SSQ)};
        pg8::gemm_phase<pg8::EpiSwiGLU, pg8::StaticOrder, true, true>(lds, g, S, E, wave);
    }
    xcd_barrier(bar, wave);

    {
        pg8::Gemm g{R + C_ACT, W_DN, M, D, DFF, LDQ}; pg8::StaticOrder S; S.init(M, D, G, bid);
        pg8::EpiResid E{a.out, a.out, D};
        pg8::gemm_phase<pg8::EpiResid, pg8::StaticOrder, true, true>(lds, g, S, E, wave);
    }
}

extern "C" void kernel_launch(void* const* d_in, const int* in_sizes, int n_in, void* d_out, int out_size, void* d_ws, size_t ws_size, hipStream_t stream) {
    static int grid = 0;
    if (grid == 0) {
        if (n_in != 25 || out_size != M * D || ws_size < WS_END) { fprintf(stderr, "kernel_launch: unexpected problem shape (n_in %d out %d ws %zu)\n", n_in, out_size, ws_size); grid = -1; return; }
        int dev = 0, cus = 0, per_cu = 0;
        hipGetDevice(&dev);
        hipDeviceGetAttribute(&cus, hipDeviceAttributeMultiprocessorCount, dev);
        if (hipFuncSetAttribute((const void*)fwd_megakernel, hipFuncAttributeMaxDynamicSharedMemorySize, LDS_BYTES) != hipSuccess) { fprintf(stderr, "kernel_launch: hipFuncSetAttribute failed\n"); }
        hipOccupancyMaxActiveBlocksPerMultiprocessor(&per_cu, (const void*)fwd_megakernel, 512, LDS_BYTES);
        (void)hipGetLastError();
        if (per_cu < 1) per_cu = 1;
        grid = cus;
        fprintf(stderr, "kernel_launch: cus %d per_cu %d grid %d\n", cus, per_cu, grid);
    }
    if (grid < 0) return;
    if (hipMemsetAsync((char*)d_ws + WS_BAR, 0, 16384, stream) != hipSuccess) { fprintf(stderr, "kernel_launch: memset of the barrier words failed\n"); return; }
    Args a{};
    for (int i = 0; i < 25; ++i) a.in[i] = (const float*)d_in[i];
    a.out = (float*)d_out; a.ws = (unsigned char*)d_ws;
    void* args[] = {&a};
    hipError_t e = hipLaunchCooperativeKernel((const void*)fwd_megakernel, dim3(grid), dim3(512), args, LDS_BYTES, stream);
    if (e != hipSuccess) fprintf(stderr, "cooperative launch failed: %s (grid %d)\n", hipGetErrorString(e), grid);
}
```

```cpp
#include <hip/hip_runtime.h>
#include <hip/hip_cooperative_groups.h>
#include <cstdio>
#include <cstdint>
namespace cg = cooperative_groups;
namespace pg8 {
#define PG8_LAS __attribute__((address_space(3)))
typedef unsigned short bf16_t;
typedef short bf16x8 __attribute__((ext_vector_type(8)));
typedef float f32x4 __attribute__((ext_vector_type(4)));
typedef unsigned u32x4 __attribute__((ext_vector_type(4)));
constexpr int BM = 256, BK = 64, HALF = 128, HTB = HALF * BK * 2  , STAGE_BYTES = 8 * HTB, NXCD = 8, WGM = 8;

__host__ __device__ __forceinline__ int lds_byte(int r, int c) { const int st = (r >> 4) * 2 + (c >> 5), rr = r & 15, cc = c & 31, ob = rr * 64 + cc * 2; return st * 1024 + (ob ^ (((ob >> 9) & 1) << 5)); }
__host__ __device__ __forceinline__ void stage_rc(int b, int& R, int& C) { const int st = b / 1024, sb = b % 1024, swz = sb ^ (((sb >> 9) & 1) << 5); R = (st >> 1) * 16 + swz / 64; C = (st & 1) * 32 + (swz % 64) / 2; }
__host__ __device__ __forceinline__ int perm32(int rho) { const int n = rho >> 4, i = rho & 15; return 8 * (i >> 2) + 4 * n + (i & 3); }

struct Unit { int pm, pn, src; };
struct Gemm { const bf16_t* A; const bf16_t* Bt; int M, N, K, lda; const bf16_t* A2; const bf16_t* Bt2; };

struct StaticOrder {
    int nM, nN, nwg, G, c;
    __host__ __device__ void init(int M, int N, int G_, int c_) { nM = M / BM; nN = N / BM; nwg = nM * nN; G = G_; c = c_; }
    __host__ __device__ bool next(int i, Unit& u) const {
        const long L = (long)i * G + c; if (L >= nwg) return false;
        int wgid = (int)L; { const int q = nwg / NXCD, r = nwg % NXCD, xcd = wgid % NXCD, off = wgid / NXCD; wgid = (xcd < r ? xcd * (q + 1) : r * (q + 1) + (xcd - r) * q) + off; }
        const int nig = WGM * nN, gid = wgid / nig, fm = gid * WGM, gsz = (nM - fm) < WGM ? (nM - fm) : WGM;
        u.pm = fm + ((wgid % nig) % gsz); u.pn = (wgid % nig) / gsz; u.src = 0; return true;
    }
    __device__ __forceinline__ void a_ready(const Unit&) const {}
    __device__ __forceinline__ void done(const Unit&) const {}
};

struct DualOrder {
    StaticOrder S1; int nM2, nN2;
    __host__ __device__ void init(int M, int N, int M2, int N2, int G_, int c_) { S1.init(M, N, G_, c_); nM2 = M2 / BM; nN2 = N2 / BM; }
    __host__ __device__ bool next(int i, Unit& u) const {
        if (S1.next(i, u)) return true;
        const long L = (long)i * S1.G + S1.c - S1.nwg; if (L < 0 || L >= (long)nM2 * nN2) return false;
        u.pm = (int)L % nM2; u.pn = (int)L / nM2; u.src = 1; return true;
    }
    __device__ __forceinline__ void a_ready(const Unit&) const {}
    __device__ __forceinline__ void done(const Unit&) const {}
};

template <int K> __device__ __forceinline__ float shx(float v) {
    return __builtin_bit_cast(float, __builtin_amdgcn_ds_swizzle(__builtin_bit_cast(int, v), (K << 10) | 0x1f)); }
__device__ __forceinline__ float sum_halves(float v) {
    auto rr = __builtin_amdgcn_permlane32_swap(__builtin_bit_cast(unsigned, v), __builtin_bit_cast(unsigned, v), false, false);
    return __builtin_bit_cast(float, (unsigned)rr[0]) + __builtin_bit_cast(float, (unsigned)rr[1]); }
__device__ __forceinline__ float max_halves(float v) {
    auto rr = __builtin_amdgcn_permlane32_swap(__builtin_bit_cast(unsigned, v), __builtin_bit_cast(unsigned, v), false, false);
    return fmaxf(__builtin_bit_cast(float, (unsigned)rr[0]), __builtin_bit_cast(float, (unsigned)rr[1])); }
__device__ __forceinline__ int lane_id_fresh() { int z = 0; asm volatile("" : "+s"(z)); return __builtin_amdgcn_mbcnt_hi(~0u, __builtin_amdgcn_mbcnt_lo(~0u, z)); }
__device__ __forceinline__ int tid_fresh(int wave) { return wave * 64 + lane_id_fresh(); }
typedef float f32x2v_t __attribute__((ext_vector_type(2))); typedef __bf16 bf16x2v_t __attribute__((ext_vector_type(2)));
__device__ __forceinline__ unsigned cvt_pk_bf16(float lo, float hi) { f32x2v_t v = {lo, hi}; bf16x2v_t b = __builtin_convertvector(v, bf16x2v_t); return __builtin_bit_cast(unsigned, b); }
__device__ __forceinline__ float bf_lo(unsigned w) { return __builtin_bit_cast(float, w << 16); }
__device__ __forceinline__ float bf_hi(unsigned w) { return __builtin_bit_cast(float, w & 0xffff0000u); }
#define PG8_ACC const f32x4 (&acc)[2][2][4][2]

struct EpiQKV {
    static constexpr bool PERM = true, AFTER_DRAIN = false;
    bf16_t* O; int ldc; bf16_t* O2; int ldc2;
    PG8_LAS const float* GT;
    PG8_LAS float* X;
    __device__ __forceinline__ void operator()(PG8_ACC, const Unit& u, int wr, int wc, int fr, int fq) const {
        const int pn = u.pn;
        int kind, gp; float sc = 1.f;
        constexpr float L2E = 1.4426950408889634f;
        const int mode = u.src;
        if (mode == 0) {
            if (pn < 2) { kind = 1; gp = 0; sc = 0.125f * L2E; }
            else if (pn < 4) { kind = 1; gp = 64; }
            else if (pn < 6) { kind = 0; gp = 64; }
            else if (pn < 12) { kind = 2; gp = 128; sc = 0.08838834764831845f * L2E; }
            else if (pn < 18) { kind = 2; gp = 256; }
            else if (pn < 24) { kind = 0; gp = 256; }
            else { kind = 2; gp = 384; sc = 0.08838834764831845f * L2E; }
        } else {
            if (pn < 2) { kind = 2; gp = 512; } else { kind = 0; gp = 512; }
        }
        const int row0 = u.pm * BM + wr * 64 + fr, col0 = pn * BM + wc * 32 + 8 * fq;
        float rs[2][4][2];
        f32x4 gv[2];
        if (kind != 0) {
#pragma unroll
            for (int ai = 0; ai < 2; ++ai)
#pragma unroll
                for (int m = 0; m < 4; ++m)
#pragma unroll
                    for (int bj = 0; bj < 2; ++bj) {
                        const f32x4 a = acc[ai][bj][m][0], b = acc[ai][bj][m][1];
                        float s = (a[0] * a[0] + a[1] * a[1]) + (a[2] * a[2] + a[3] * a[3]) + (b[0] * b[0] + b[1] * b[1]) + (b[2] * b[2] + b[3] * b[3]);
                        s += shx<16>(s); s = sum_halves(s);
                        if (fq == 0) X[((ai * 128 + wr * 64 + m * 16 + fr) * 2 + bj) * 4 + wc] = s;
                    }
            asm volatile("s_waitcnt lgkmcnt(0)" ::: "memory"); __builtin_amdgcn_s_barrier(); asm volatile("" ::: "memory");
            const int hd = (kind == 1) ? 64 : 128;
            const float inv_hd = (kind == 1) ? (1.f / 64.f) : (1.f / 128.f);
#pragma unroll
            for (int ai = 0; ai < 2; ++ai)
#pragma unroll
                for (int m = 0; m < 4; ++m)
#pragma unroll
                    for (int bj = 0; bj < 2; ++bj) {
                        const f32x4 xs = *(const PG8_LAS f32x4*)(X + ((ai * 128 + wr * 64 + m * 16 + fr) * 2 + bj) * 4);
                        float tot;
                        if (kind == 1) tot = (wc < 2) ? (xs[0] + xs[1]) : (xs[2] + xs[3]);
                        else tot = (xs[0] + xs[1]) + (xs[2] + xs[3]);
                        rs[ai][m][bj] = __builtin_amdgcn_rsqf(tot * inv_hd + 1e-6f) * sc;
                    }
            const int gc = ((wc * 32 + 8 * fq) & (hd - 1));
            gv[0] = *(const PG8_LAS f32x4*)(GT + gp + gc); gv[1] = *(const PG8_LAS f32x4*)(GT + gp + gc + 4);
        } else {
#pragma unroll
            for (int ai = 0; ai < 2; ++ai)
#pragma unroll
                for (int m = 0; m < 4; ++m)
#pragma unroll
                    for (int bj = 0; bj < 2; ++bj) rs[ai][m][bj] = 1.f;
            gv[0] = (f32x4){1.f, 1.f, 1.f, 1.f}; gv[1] = gv[0];
        }
#pragma unroll
        for (int ai = 0; ai < 2; ++ai)
#pragma unroll
            for (int m = 0; m < 4; ++m) { bf16_t* rowp = (mode ? O2 : O) + (size_t)(row0 + ai * HALF + m * 16) * (mode ? ldc2 : ldc) + col0;
#pragma unroll
                for (int bj = 0; bj < 2; ++bj) { const float r = rs[ai][m][bj];
                    const f32x4 v0 = acc[ai][bj][m][0] * gv[0] * r, v1 = acc[ai][bj][m][1] * gv[1] * r;
                    u32x4 w; w.x = cvt_pk_bf16(v0[0], v0[1]); w.y = cvt_pk_bf16(v0[2], v0[3]); w.z = cvt_pk_bf16(v1[0], v1[1]); w.w = cvt_pk_bf16(v1[2], v1[3]);
                    *(u32x4*)(rowp + bj * HALF) = w; } }
    }
};

struct EpiGate {
    static constexpr bool PERM = true, AFTER_DRAIN = false;
    bf16_t* O; int ldc; const float* bias;
    __device__ __forceinline__ void operator()(PG8_ACC, const Unit& u, int wr, int wc, int fr, int fq) const {
        const int row0 = u.pm * BM + wr * 64 + fr, col0 = u.pn * BM + wc * 32 + 8 * fq;
        f32x4 bv[2][2];
#pragma unroll
        for (int bj = 0; bj < 2; ++bj)
#pragma unroll
            for (int n = 0; n < 2; ++n) bv[bj][n] = *(const f32x4*)(bias + col0 + bj * HALF + 4 * n);
#pragma unroll
        for (int ai = 0; ai < 2; ++ai)
#pragma unroll
            for (int m = 0; m < 4; ++m) { bf16_t* rowp = O + (size_t)(row0 + ai * HALF + m * 16) * ldc + col0;
#pragma unroll
                for (int bj = 0; bj < 2; ++bj) { f32x4 v0 = acc[ai][bj][m][0] + bv[bj][0], v1 = acc[ai][bj][m][1] + bv[bj][1];
#pragma unroll
                    for (int e = 0; e < 4; ++e) { v0[e] = __builtin_amdgcn_rcpf(1.f + __builtin_amdgcn_exp2f(-1.4426950408889634f * v0[e])); v1[e] = __builtin_amdgcn_rcpf(1.f + __builtin_amdgcn_exp2f(-1.4426950408889634f * v1[e])); }
                    u32x4 w; w.x = cvt_pk_bf16(v0[0], v0[1]); w.y = cvt_pk_bf16(v0[2], v0[3]); w.z = cvt_pk_bf16(v1[0], v1[1]); w.w = cvt_pk_bf16(v1[2], v1[3]);
                    *(u32x4*)(rowp + bj * HALF) = w; } }
    }
};

struct EpiBranch {
    static constexpr bool PERM = true, AFTER_DRAIN = false;
    bf16_t* MIX; const bf16_t* GATE; int ldc; int accum;
    __device__ __forceinline__ void operator()(PG8_ACC, const Unit& u, int wr, int wc, int fr, int fq) const {
        const int row0 = u.pm * BM + wr * 64 + fr, col0 = u.pn * BM + wc * 32 + 8 * fq;
#pragma unroll
        for (int ai = 0; ai < 2; ++ai)
#pragma unroll
            for (int m = 0; m < 4; ++m) { const size_t off = (size_t)(row0 + ai * HALF + m * 16) * ldc + col0;
#pragma unroll
                for (int bj = 0; bj < 2; ++bj) { const u32x4 gt = *(const u32x4*)(GATE + off + bj * HALF);
                    f32x4 a = acc[ai][bj][m][0], b = acc[ai][bj][m][1];
                    a[0] *= bf_lo(gt.x); a[1] *= bf_hi(gt.x); a[2] *= bf_lo(gt.y); a[3] *= bf_hi(gt.y); b[0] *= bf_lo(gt.z); b[1] *= bf_hi(gt.z); b[2] *= bf_lo(gt.w); b[3] *= bf_hi(gt.w);
                    if (accum) { const u32x4 mx = *(const u32x4*)(MIX + off + bj * HALF);
                        a[0] += bf_lo(mx.x); a[1] += bf_hi(mx.x); a[2] += bf_lo(mx.y); a[3] += bf_hi(mx.y); b[0] += bf_lo(mx.z); b[1] += bf_hi(mx.z); b[2] += bf_lo(mx.w); b[3] += bf_hi(mx.w); }
                    u32x4 w; w.x = cvt_pk_bf16(a[0], a[1]); w.y = cvt_pk_bf16(a[2], a[3]); w.z = cvt_pk_bf16(b[0], b[1]); w.w = cvt_pk_bf16(b[2], b[3]);
                    *(u32x4*)(MIX + off + bj * HALF) = w; } }
    }
};

struct EpiResid {
    static constexpr bool PERM = true, AFTER_DRAIN = false;
    const float* res; float* out; int ld;
    __device__ __forceinline__ void operator()(PG8_ACC, const Unit& u, int wr, int wc, int fr, int fq) const {
        const int row0 = u.pm * BM + wr * 64 + fr, col0 = u.pn * BM + wc * 32 + 8 * fq;
#pragma unroll
        for (int ai = 0; ai < 2; ++ai)
#pragma unroll
            for (int m = 0; m < 4; ++m) { const size_t off = (size_t)(row0 + ai * HALF + m * 16) * ld + col0;
#pragma unroll
                for (int bj = 0; bj < 2; ++bj) {
                    const f32x4 r0 = *(const f32x4*)(res + off + bj * HALF), r1 = *(const f32x4*)(res + off + bj * HALF + 4);
                    const f32x4 v0 = acc[ai][bj][m][0] + r0, v1 = acc[ai][bj][m][1] + r1;
                    *(f32x4*)(out + off + bj * HALF) = v0; *(f32x4*)(out + off + bj * HALF + 4) = v1; } }
    }
};

struct EpiResidNorm {
    static constexpr bool PERM = true, AFTER_DRAIN = false;
    const float* res; float* out; int ld; const float* gain; bf16_t* H; int ldh; float* SSQ;
    __device__ __forceinline__ void operator()(PG8_ACC, const Unit& u, int wr, int wc, int fr, int fq) const {
        const int row0 = u.pm * BM + wr * 64 + fr, col0 = u.pn * BM + wc * 32 + 8 * fq;
        f32x4 gv[2][2];
#pragma unroll
        for (int bj = 0; bj < 2; ++bj)
#pragma unroll
            for (int n = 0; n < 2; ++n) gv[bj][n] = *(const f32x4*)(gain + col0 + bj * HALF + 4 * n);
#pragma unroll
        for (int ai = 0; ai < 2; ++ai)
#pragma unroll
            for (int m = 0; m < 4; ++m) { const int row = row0 + ai * HALF + m * 16; const size_t off = (size_t)row * ld + col0; float s = 0.f;
#pragma unroll
                for (int bj = 0; bj < 2; ++bj) {
                    const f32x4 r0 = *(const f32x4*)(res + off + bj * HALF), r1 = *(const f32x4*)(res + off + bj * HALF + 4);
                    const f32x4 v0 = acc[ai][bj][m][0] + r0, v1 = acc[ai][bj][m][1] + r1;
                    *(f32x4*)(out + off + bj * HALF) = v0; *(f32x4*)(out + off + bj * HALF + 4) = v1;
                    s += (v0[0] * v0[0] + v0[1] * v0[1]) + (v0[2] * v0[2] + v0[3] * v0[3]) + (v1[0] * v1[0] + v1[1] * v1[1]) + (v1[2] * v1[2] + v1[3] * v1[3]);
                    const f32x4 h0 = v0 * gv[bj][0], h1 = v1 * gv[bj][1];
                    u32x4 w; w.x = cvt_pk_bf16(h0[0], h0[1]); w.y = cvt_pk_bf16(h0[2], h0[3]); w.z = cvt_pk_bf16(h1[0], h1[1]); w.w = cvt_pk_bf16(h1[2], h1[3]);
                    *(u32x4*)(H + (size_t)row * ldh + col0 + bj * HALF) = w; }
                s += shx<16>(s); s = sum_halves(s);
                if (fq == 0) atomicAdd(SSQ + row, s); }
    }
};

struct EpiSwiGLU {
    static constexpr bool PERM = true, AFTER_DRAIN = false;
    bf16_t* O; int ldc; const float* SSQ;
    __device__ __forceinline__ void operator()(PG8_ACC, const Unit& u, int wr, int wc, int fr, int fq) const {
        const int row0 = u.pm * BM + wr * 64 + fr, col0 = u.pn * HALF + wc * 32 + 8 * fq;
#pragma unroll
        for (int ai = 0; ai < 2; ++ai)
#pragma unroll
            for (int m = 0; m < 4; ++m) { bf16_t* rowp = O + (size_t)(row0 + ai * HALF + m * 16) * ldc + col0;
                const float rstd = __builtin_amdgcn_rsqf(SSQ[row0 + ai * HALF + m * 16] * (1.f / 1024.f) + 1e-6f);
                f32x4 v[2];
#pragma unroll
                for (int n = 0; n < 2; ++n) { const f32x4 gt = acc[ai][0][m][n] * rstd, up = acc[ai][1][m][n] * rstd;
#pragma unroll
                    for (int e = 0; e < 4; ++e) v[n][e] = gt[e] * __builtin_amdgcn_rcpf(1.f + __builtin_amdgcn_exp2f(-1.4426950408889634f * gt[e])) * up[e]; }
                u32x4 w; w.x = cvt_pk_bf16(v[0][0], v[0][1]); w.y = cvt_pk_bf16(v[0][2], v[0][3]); w.z = cvt_pk_bf16(v[1][0], v[1][1]); w.w = cvt_pk_bf16(v[1][2], v[1][3]);
                *(u32x4*)rowp = w; }
    }
};

template <class Epi, class Sched, bool ALIGN_EPI = false, bool SP2 = false>
__device__ __forceinline__ void gemm_phase(PG8_LAS unsigned char* lds, const Gemm g, const Sched& S, const Epi& E, int wave_id) {
    const int tid = tid_fresh(wave_id);
    const int wid = __builtin_amdgcn_readfirstlane(tid >> 6), lane = tid & 63, wr = wid >> 2, wc = wid & 3, fr = lane & 15, fq = lane >> 4;
    const int K = g.K, nt = K / BK;
    unsigned voffA[2], voffB[2];
#pragma unroll
    for (int i = 0; i < 2; ++i) { int R, C; stage_rc(tid * 16 + i * 8192, R, C); const int Rb = Epi::PERM ? ((R & ~31) + perm32(R & 31)) : R;
        voffA[i] = (unsigned)(R * g.lda + C) * 2u; voffB[i] = (unsigned)(Rb * K + C) * 2u; }
    const size_t kstep = (size_t)(BK * 2);
    const size_t hstepA = (size_t)HALF * g.lda * 2, hstepB = (size_t)HALF * K * 2;
    const size_t tstepA = 2 * hstepA, tstepB = 2 * hstepB;
    const unsigned ldsw = (unsigned)wid * 1024u;
    const int aoff = lds_byte(wr * 64 + fr, fq * 8), boff = lds_byte(wc * 32 + fr, fq * 8);
#define PG8_SA(b, h) (((b) * 2 + (h)) * HTB)
#define PG8_SB(b, h) ((4 + (b) * 2 + (h)) * HTB)
#define PG8_STAGE(bufoff, gbase, voff) do { _Pragma("unroll") for (int _i = 0; _i < 2; ++_i) \
        __builtin_amdgcn_global_load_lds((const unsigned*)((const char*)(gbase) + (voff)[_i]), (PG8_LAS unsigned*)(lds + (bufoff) + ldsw + _i * 8192), 16, 0, 0); } while (0)
#define PG8_LDA(dst, b, h) do { _Pragma("unroll") for (int m = 0; m < 4; ++m) _Pragma("unroll") for (int k = 0; k < 2; ++k) dst[m][k] = *(const PG8_LAS bf16x8*)(lds + PG8_SA(b, h) + aoff + m * 2048 + k * 1024); } while (0)
#define PG8_LDB(dst, b, h) do { _Pragma("unroll") for (int n = 0; n < 2; ++n) _Pragma("unroll") for (int k = 0; k < 2; ++k) dst[n][k] = *(const PG8_LAS bf16x8*)(lds + PG8_SB(b, h) + boff + n * 2048 + k * 1024); } while (0)
#define PG8_MMA(ai, bj, At, Bt) do { __builtin_amdgcn_s_setprio(1); _Pragma("unroll") for (int m = 0; m < 4; ++m) _Pragma("unroll") for (int n = 0; n < 2; ++n) _Pragma("unroll") for (int k = 0; k < 2; ++k) \
        acc[ai][bj][m][n] = __builtin_amdgcn_mfma_f32_16x16x32_bf16(Bt[n][k], At[m][k], acc[ai][bj][m][n], 0, 0, 0); __builtin_amdgcn_s_setprio(0); } while (0)
#define PG8_WAIT_V(n) asm volatile("s_waitcnt vmcnt(" #n ")" ::: "memory")
#define PG8_WAIT_L(n) asm volatile("s_waitcnt lgkmcnt(" #n ")" ::: "memory")
#define PG8_BAR __builtin_amdgcn_s_barrier()
#define PG8_SCHED __builtin_amdgcn_sched_barrier(0)
    Unit cur, nxt; int ui = 0;
    if (!S.next(0, cur)) return;
    f32x4 acc[2][2][4][2];
#pragma unroll
    for (int a = 0; a < 2; ++a)
#pragma unroll
        for (int b = 0; b < 2; ++b)
#pragma unroll
            for (int m = 0; m < 4; ++m)
#pragma unroll
                for (int n = 0; n < 2; ++n) acc[a][b][m][n] = (f32x4){0.f, 0.f, 0.f, 0.f};
    bf16x8 At[4][2], B0[2][2], B1[2][2];
    const char* cA = (const char*)(cur.src ? g.A2 : g.A) + (size_t)cur.pm * tstepA; const char* cB = (const char*)(cur.src ? g.Bt2 : g.Bt) + (size_t)cur.pn * tstepB;
    S.a_ready(cur);
    if constexpr (SP2) {
        PG8_STAGE(PG8_SB(0, 0), cB, voffB); PG8_STAGE(PG8_SB(0, 1), cB + hstepB, voffB); PG8_STAGE(PG8_SA(0, 0), cA, voffA); PG8_STAGE(PG8_SA(0, 1), cA + hstepA, voffA);
        if (wr == 1) PG8_BAR;
        PG8_WAIT_V(2); PG8_BAR;
        PG8_STAGE(PG8_SB(1, 0), cB + kstep, voffB); PG8_STAGE(PG8_SA(1, 0), cA + kstep, voffA); PG8_STAGE(PG8_SB(1, 1), cB + hstepB + kstep, voffB);
        PG8_WAIT_V(6); PG8_BAR;
    } else {
        PG8_STAGE(PG8_SB(0, 0), cB, voffB); PG8_STAGE(PG8_SA(0, 0), cA, voffA); PG8_STAGE(PG8_SB(0, 1), cB + hstepB, voffB); PG8_STAGE(PG8_SA(0, 1), cA + hstepA, voffA);
        if (wr == 1) PG8_BAR;
        PG8_WAIT_V(4); PG8_BAR;
        PG8_STAGE(PG8_SB(1, 0), cB + kstep, voffB); PG8_STAGE(PG8_SA(1, 0), cA + kstep, voffA); PG8_STAGE(PG8_SB(1, 1), cB + hstepB + kstep, voffB);
        PG8_WAIT_V(6); PG8_BAR;
    }
    for (;;) {
        const bool has_next = S.next(ui + 1, nxt);
        const char* nA = has_next ? (const char*)(nxt.src ? g.A2 : g.A) + (size_t)nxt.pm * tstepA : cA; const char* nB = has_next ? (const char*)(nxt.src ? g.Bt2 : g.Bt) + (size_t)nxt.pn * tstepB : cB;
        for (int t = 0; t < nt; t += 2) {
            const bool last = (t == nt - 2);
            const char* a1 = cA + (size_t)(t + 1) * kstep;
            const char* a2 = last ? nA : cA + (size_t)(t + 2) * kstep; const char* b2 = last ? nB : cB + (size_t)(t + 2) * kstep;
            const char* a3 = a2 + kstep; const char* b3 = b2 + kstep;
            if (last && has_next) S.a_ready(nxt);
            if constexpr (SP2) {
            PG8_LDB(B0, 0, 0); PG8_LDB(B1, 0, 1); PG8_SCHED; PG8_LDA(At, 0, 0); PG8_STAGE(PG8_SA(1, 1), a1 + hstepA, voffA);
            PG8_WAIT_V(8); PG8_WAIT_L(0); PG8_BAR; PG8_MMA(0, 0, At, B0); PG8_MMA(0, 1, At, B1); PG8_BAR; PG8_SCHED;
            PG8_LDA(At, 0, 1); PG8_STAGE(PG8_SB(0, 0), b2, voffB); PG8_STAGE(PG8_SB(0, 1), b2 + hstepB, voffB); PG8_STAGE(PG8_SA(0, 0), a2, voffA);
            PG8_WAIT_V(8); PG8_WAIT_L(0); PG8_BAR; PG8_MMA(1, 0, At, B0); PG8_MMA(1, 1, At, B1); PG8_BAR; PG8_SCHED;
            PG8_LDB(B0, 1, 0); PG8_LDB(B1, 1, 1); PG8_SCHED; PG8_LDA(At, 1, 0); PG8_STAGE(PG8_SA(0, 1), a2 + hstepA, voffA);
            PG8_WAIT_V(8); PG8_WAIT_L(0); PG8_BAR; PG8_MMA(0, 0, At, B0); PG8_MMA(0, 1, At, B1); PG8_BAR; PG8_SCHED;
            PG8_LDA(At, 1, 1); PG8_STAGE(PG8_SB(1, 0), b3, voffB); PG8_STAGE(PG8_SB(1, 1), b3 + hstepB, voffB); PG8_STAGE(PG8_SA(1, 0), a3, voffA);
            PG8_WAIT_V(8); PG8_WAIT_L(0); PG8_BAR; PG8_MMA(1, 0, At, B0); PG8_MMA(1, 1, At, B1); PG8_BAR; PG8_SCHED;
            } else {
            PG8_LDB(B0, 0, 0); PG8_SCHED; PG8_LDA(At, 0, 0); PG8_STAGE(PG8_SA(1, 1), a1 + hstepA, voffA);
            PG8_WAIT_L(8); PG8_BAR; PG8_WAIT_L(0); PG8_MMA(0, 0, At, B0); PG8_BAR; PG8_SCHED;
            PG8_LDB(B1, 0, 1); PG8_STAGE(PG8_SB(0, 0), b2, voffB);
            PG8_BAR; PG8_WAIT_L(0); PG8_MMA(0, 1, At, B1); PG8_BAR;
            PG8_LDA(At, 0, 1); PG8_STAGE(PG8_SA(0, 0), a2, voffA);
            PG8_BAR; PG8_WAIT_L(0); PG8_MMA(1, 0, At, B0); PG8_BAR; PG8_SCHED;
            PG8_STAGE(PG8_SB(0, 1), b2 + hstepB, voffB);
            PG8_WAIT_V(6); PG8_BAR; PG8_MMA(1, 1, At, B1); PG8_BAR;
            PG8_LDB(B0, 1, 0); PG8_SCHED; PG8_LDA(At, 1, 0); PG8_STAGE(PG8_SA(0, 1), a2 + hstepA, voffA);
            PG8_WAIT_L(8); PG8_BAR; PG8_WAIT_L(0); PG8_MMA(0, 0, At, B0); PG8_BAR; PG8_SCHED;
            PG8_LDB(B1, 1, 1); PG8_STAGE(PG8_SB(1, 0), b3, voffB);
            PG8_BAR; PG8_WAIT_L(0); PG8_MMA(0, 1, At, B1); PG8_BAR;
            PG8_LDA(At, 1, 1); PG8_STAGE(PG8_SA(1, 0), a3, voffA);
            PG8_BAR; PG8_WAIT_L(0); PG8_MMA(1, 0, At, B0); PG8_BAR; PG8_SCHED;
            PG8_STAGE(PG8_SB(1, 1), b3 + hstepB, voffB);
            PG8_WAIT_V(6); PG8_BAR; PG8_MMA(1, 1, At, B1); PG8_BAR;
            }
        }
        if constexpr (ALIGN_EPI) { if (wr == 0) PG8_BAR; }
        if constexpr (!Epi::AFTER_DRAIN) { E(acc, cur, wr, wc, fr, fq); S.done(cur); }
        if (!has_next) break;
#pragma unroll
        for (int a = 0; a < 2; ++a)
#pragma unroll
            for (int b = 0; b < 2; ++b)
#pragma unroll
                for (int m = 0; m < 4; ++m)
#pragma unroll
                    for (int n = 0; n < 2; ++n) acc[a][b][m][n] = (f32x4){0.f, 0.f, 0.f, 0.f};
        cur = nxt; cA = nA; cB = nB; ++ui;
        if constexpr (ALIGN_EPI) { if (wr == 1) PG8_BAR; }
    }
    PG8_WAIT_V(0);
    if constexpr (!ALIGN_EPI) { if (wr == 0) PG8_BAR; }
    PG8_BAR;
    if constexpr (Epi::AFTER_DRAIN) { E.fused(acc, cur, wr, wc, fr, fq, lds, wid, lane); S.done(cur); }
#undef PG8_SA
#undef PG8_SB
#undef PG8_STAGE
#undef PG8_LDA
#undef PG8_LDB
#undef PG8_MMA
#undef PG8_WAIT_V
#undef PG8_WAIT_L
#undef PG8_BAR
#undef PG8_SCHED
}
}

#define LAS __attribute__((address_space(3)))
typedef unsigned short bf16;
typedef short bf16x8 __attribute__((ext_vector_type(8)));
typedef short s16x4 __attribute__((ext_vector_type(4)));
typedef short v4i16_t __attribute__((ext_vector_type(4)));
typedef float f32x16 __attribute__((ext_vector_type(16)));
typedef float f32x4 __attribute__((ext_vector_type(4)));
typedef float f32x2_t __attribute__((ext_vector_type(2)));
typedef __bf16 bf16x2_t __attribute__((ext_vector_type(2)));
typedef unsigned u32x4 __attribute__((ext_vector_type(4)));
typedef unsigned u32x2 __attribute__((ext_vector_type(2)));

constexpr int D = 1024, SEQ = 2048, NB = 8, M = NB * SEQ, NMEM = 256, MMEM = NB * NMEM, DIN = 6656, DFF = 2816;
constexpr int LDQ = 6656;
constexpr int C_AQ = 0, C_AK = 512, C_AV = 1024, C_BQ = 1536, C_BK = 3072, C_BV = 4608, C_CQ = 6144;
constexpr int C_GATE = 3072;
constexpr int C_H2 = 0, C_ACT = 1024;
constexpr float L2E = 1.4426950408889634f;
constexpr float EPS = 1e-6f;

constexpr size_t WS_WIN = 0;
constexpr size_t WS_WG = WS_WIN + (size_t)DIN * D * 2;
constexpr size_t WS_WMEM = WS_WG + (size_t)3 * D * D * 2;
constexpr size_t WS_WBR = WS_WMEM + (size_t)D * D * 2;
constexpr size_t WS_WOUT3 = WS_WBR + (size_t)3 * D * 512 * 2;
constexpr size_t WS_WGU = WS_WOUT3 + (size_t)D * 3 * D * 2;
constexpr size_t WS_WDN = WS_WGU + (size_t)2 * DFF * D * 2;
constexpr size_t WS_LB = WS_WDN + (size_t)D * DFF * 2;
constexpr size_t WS_R = WS_LB + (size_t)3 * M * 4 * 4;
constexpr size_t WS_BAR = WS_R + (size_t)M * LDQ * 2;
constexpr size_t WS_SSQ = WS_BAR + 16384;
constexpr size_t WS_END = WS_SSQ + (size_t)M * 4;
static_assert(WS_END <= (size_t)256 * 1024 * 1024, "d_ws map");
constexpr size_t DO_XN = 0;
constexpr size_t DO_MN = DO_XN + (size_t)M * D * 2;
constexpr size_t DO_CKV = DO_MN + (size_t)MMEM * D * 2;
static_assert(DO_CKV + (size_t)MMEM * D * 2 <= (size_t)M * D * 4, "d_out scratch map");

constexpr int LDS_BYTES = 155648;
constexpr int XCH_OFF = 131072, GT_OFF = 131072 + 8192;
constexpr int MISC_OFF = LDS_BYTES - 64;
constexpr int KP = 272, VP = 320;

__device__ __forceinline__ unsigned cvtpk(float lo, float hi) { f32x2_t v = {lo, hi}; bf16x2_t b = __builtin_convertvector(v, bf16x2_t); return __builtin_bit_cast(unsigned, b); }
__device__ __forceinline__ float wave_sum(float v) {
    v += pg8::shx<1>(v); v += pg8::shx<2>(v); v += pg8::shx<4>(v); v += pg8::shx<8>(v); v += pg8::shx<16>(v); v = pg8::sum_halves(v);
    return v;
}
__device__ __forceinline__ float wave_max(float v) {
    v = fmaxf(v, pg8::shx<1>(v)); v = fmaxf(v, pg8::shx<2>(v)); v = fmaxf(v, pg8::shx<4>(v)); v = fmaxf(v, pg8::shx<8>(v)); v = fmaxf(v, pg8::shx<16>(v)); v = pg8::max_halves(v);
    return v;
}
__device__ __forceinline__ float absmax_vec(const float* g, int n, int lane) {
    float v = fabsf(g[lane]); if (n > 64) v = fmaxf(v, fabsf(g[lane + 64]));
    return wave_max(v);
}

__device__ __forceinline__ void tr_item(const float* W, int N, int k0, int n0, bf16* WT, int dst_pitch, int dst_row0, int dst_k0, int ncopies, int copy_stride, LAS float* scr, int lane) {
#pragma unroll 8
    for (int i = 0; i < 32; ++i) { const int kk = 2 * i + (lane >> 5); scr[kk * 33 + (lane & 31)] = W[(size_t)(k0 + kk) * N + n0 + (lane & 31)]; }
    asm volatile("s_waitcnt lgkmcnt(0)" ::: "memory");
    const int c = lane & 7;
#pragma unroll
    for (int j = 0; j < 4; ++j) { const int n = (lane >> 3) + 8 * j; const LAS float* s = scr + (8 * c) * 33 + n;
        u32x4 o; o.x = cvtpk(s[0 * 33], s[1 * 33]); o.y = cvtpk(s[2 * 33], s[3 * 33]); o.z = cvtpk(s[4 * 33], s[5 * 33]); o.w = cvtpk(s[6 * 33], s[7 * 33]);
        bf16* dst = WT + (size_t)(dst_row0 + n0 + n) * dst_pitch + dst_k0 + k0 + 8 * c;
        for (int cp = 0; cp < ncopies; ++cp) *(u32x4*)(dst + (size_t)cp * copy_stride) = o; }
    asm volatile("s_waitcnt lgkmcnt(0)" ::: "memory");
}
__device__ __forceinline__ void rms_row_to_bf16(const float* xrow, const float* gain, bf16* orow, int lane) {
    const f32x4* xr = (const f32x4*)xrow + lane; const f32x4* gr = (const f32x4*)gain + lane;
    f32x4 v[4]; float s = 0.f;
#pragma unroll
    for (int j = 0; j < 4; ++j) { v[j] = xr[64 * j]; s += (v[j][0] * v[j][0] + v[j][1] * v[j][1]) + (v[j][2] * v[j][2] + v[j][3] * v[j][3]); }
    const float rstd = 1.f / sqrtf(wave_sum(s) * (1.f / 1024.f) + EPS);
    u32x2* o8 = (u32x2*)orow + lane;
#pragma unroll
    for (int j = 0; j < 4; ++j) { const f32x4 g = gr[64 * j]; u32x2 w; w.x = cvtpk(v[j][0] * rstd * g[0], v[j][1] * rstd * g[1]); w.y = cvtpk(v[j][2] * rstd * g[2], v[j][3] * rstd * g[3]); o8[64 * j] = w; }
}

__device__ __forceinline__ s16x4 vtr(const LAS char* p) { return __builtin_bit_cast(s16x4, __builtin_amdgcn_ds_read_tr16_b64_v4i16((LAS v4i16_t*)p)); }

template <int NK>
__device__ __forceinline__ void qk32(f32x16& S, const LAS char* Kp, const bf16x8* Q, int ks0, int r32, int hi) {
    const LAS char* kb = Kp + r32 * KP + hi * 16 + ks0 * 32;
#pragma unroll
    for (int ks = 0; ks < NK; ++ks) { const bf16x8 kf = *(const LAS bf16x8*)(kb + ks * 32); S = __builtin_amdgcn_mfma_f32_32x32x16_bf16(kf, Q[ks0 + ks], S, 0, 0, 0); }
}
__device__ __forceinline__ void pv32(f32x16 (&O)[4], const bf16x8 (&P)[2], const LAS char* Vp, int lane) {
    const int i = lane & 15, q = i >> 2, p = i & 3, dsel = (lane >> 4) & 1, h = lane >> 5;
    const LAS char* vb = Vp + (4 * h + q) * VP + (16 * dsel + 4 * p) * 2;
#pragma unroll
    for (int s = 0; s < 2; ++s)
#pragma unroll
        for (int db = 0; db < 4; ++db) {
            const s16x4 lo = vtr(vb + (16 * s) * VP + db * 64), hi4 = vtr(vb + (16 * s + 8) * VP + db * 64);
            const bf16x8 a = (bf16x8){lo[0], lo[1], lo[2], lo[3], hi4[0], hi4[1], hi4[2], hi4[3]};
            O[db] = __builtin_amdgcn_mfma_f32_32x32x16_bf16(a, P[s], O[db], 0, 0, 0);
        }
}
struct VFrag { bf16x8 a[2][4]; };
__device__ __forceinline__ void vload32(VFrag& f, const LAS char* Vp, int lane) {
    const int i = lane & 15, q = i >> 2, p = i & 3, dsel = (lane >> 4) & 1, h = lane >> 5;
    const LAS char* vb = Vp + (4 * h + q) * VP + (16 * dsel + 4 * p) * 2;
#pragma unroll
    for (int s = 0; s < 2; ++s)
#pragma unroll
        for (int db = 0; db < 4; ++db) { const s16x4 lo = vtr(vb + (16 * s) * VP + db * 64), hi4 = vtr(vb + (16 * s + 8) * VP + db * 64);
            f.a[s][db] = (bf16x8){lo[0], lo[1], lo[2], lo[3], hi4[0], hi4[1], hi4[2], hi4[3]}; }
}
template <int SS>
__device__ __forceinline__ void vload16(VFrag& f, const LAS char* Vp, int lane) {
    const int i = lane & 15, q = i >> 2, p = i & 3, dsel = (lane >> 4) & 1, h = lane >> 5;
    const LAS char* vb = Vp + (4 * h + q) * VP + (16 * dsel + 4 * p) * 2;
#pragma unroll
    for (int db = 0; db < 4; ++db) { const s16x4 lo = vtr(vb + (16 * SS) * VP + db * 64), hi4 = vtr(vb + (16 * SS + 8) * VP + db * 64);
        f.a[SS][db] = (bf16x8){lo[0], lo[1], lo[2], lo[3], hi4[0], hi4[1], hi4[2], hi4[3]}; }
}
__device__ __forceinline__ void pvmm32(f32x16 (&O)[4], const bf16x8 (&P)[2], const VFrag& f) {
#pragma unroll
    for (int s = 0; s < 2; ++s)
#pragma unroll
        for (int db = 0; db < 4; ++db) O[db] = __builtin_amdgcn_mfma_f32_32x32x16_bf16(f.a[s][db], P[s], O[db], 0, 0, 0);
}
template <int NK>
__device__ __forceinline__ void kload32(bf16x8 (&kf)[NK], const LAS char* Kp, int r32, int hi) {
    const LAS char* kb = Kp + r32 * KP + hi * 16;
#pragma unroll
    for (int ks = 0; ks < NK; ++ks) kf[ks] = *(const LAS bf16x8*)(kb + ks * 32);
}
template <int NK>
__device__ __forceinline__ void qkmm32(f32x16& S, const bf16x8 (&kf)[NK], const bf16x8* Q) {
#pragma unroll
    for (int ks = 0; ks < NK; ++ks) S = __builtin_amdgcn_mfma_f32_32x32x16_bf16(kf[ks], Q[ks], S, 0, 0, 0);
}
#define SCHED_FENCE() __builtin_amdgcn_sched_barrier(0)
template <int MODE>
__device__ __forceinline__ void soft32(const f32x16& S, bf16x8 (&P)[2], float& l, float dbase, float nslope) {
    float p[16];
#pragma unroll
    for (int r = 0; r < 16; ++r) {
        float s = S[r];
        if (MODE >= 1) { const float a = fabsf(dbase - (float)((r & 3) + 8 * (r >> 2))); s = fmaf(nslope, a, s); float e = __builtin_amdgcn_exp2f(s); if (MODE == 2) e = (a <= 64.f) ? e : 0.f; p[r] = e; }
        else p[r] = __builtin_amdgcn_exp2f(s);
        l += p[r];
    }
#pragma unroll
    for (int s = 0; s < 2; ++s) { u32x4 w; w.x = cvtpk(p[8 * s + 0], p[8 * s + 1]); w.y = cvtpk(p[8 * s + 2], p[8 * s + 3]); w.z = cvtpk(p[8 * s + 4], p[8 * s + 5]); w.w = cvtpk(p[8 * s + 6], p[8 * s + 7]); P[s] = __builtin_bit_cast(bf16x8, w); }
}
__device__ __forceinline__ void zero16(f32x16& v) {
#pragma unroll
    for (int r = 0; r < 16; ++r) v[r] = 0.f;
}

template <int NC, bool DIAG>
__device__ __forceinline__ void attn_tile(f32x16 (&O)[4], float& l, const bf16x8* Q, const LAS char* Kb, const LAS char* Vb, int r32, int hi, int lane, float qd, int k0, int qw, float nslope, float negM0) {
    constexpr int NQ = (NC == 2) ? 4 : 8;
    f32x16 S0, S1; bf16x8 P0[2], P1[2];
    const int k1 = k0 + 32;
    if (NC == 2) {
        const float ns0 = (k0 < qw) ? nslope : ((k0 > qw) ? -nslope : 0.f), ns1 = (k1 < qw) ? nslope : ((k1 > qw) ? -nslope : 0.f);
        const float b0 = fmaf(ns0, qd - (float)k0, negM0), b1 = fmaf(ns1, qd - (float)k1, negM0);
#pragma unroll
        for (int r = 0; r < 16; ++r) { S0[r] = fmaf(-ns0, (float)((r & 3) + 8 * (r >> 2)), b0); S1[r] = fmaf(-ns1, (float)((r & 3) + 8 * (r >> 2)), b1); }
    } else {
#pragma unroll
        for (int r = 0; r < 16; ++r) { S0[r] = negM0; S1[r] = negM0; }
    }
    VFrag vf0, vf1;
    if (NC == 2) {
        bf16x8 kf0[NQ], kf1[NQ];
        kload32<NQ>(kf0, Kb, r32, hi);
        SCHED_FENCE();
        qkmm32<NQ>(S0, kf0, Q);
        kload32<NQ>(kf1, Kb + 32 * KP, r32, hi);
        vload16<0>(vf0, Vb, lane);
        SCHED_FENCE();
        qkmm32<NQ>(S1, kf1, Q);
        if (DIAG) { const float nd = (k0 == qw) ? nslope : 0.f;
#pragma unroll
            for (int r = 0; r < 16; ++r) S0[r] = fmaf(nd, fabsf(qd - (float)k0 - (float)((r & 3) + 8 * (r >> 2))), S0[r]); }
        soft32<0>(S0, P0, l, 0.f, 0.f);
        vload16<1>(vf0, Vb, lane);
        SCHED_FENCE();
    } else {
        bf16x8 kf[NQ];
        kload32<NQ>(kf, Kb, r32, hi);
        SCHED_FENCE();
        qkmm32<NQ>(S0, kf, Q);
        kload32<NQ>(kf, Kb + 32 * KP, r32, hi);
        vload32(vf0, Vb, lane);
        SCHED_FENCE();
        qkmm32<NQ>(S1, kf, Q);
        soft32<0>(S0, P0, l, 0.f, 0.f);
        SCHED_FENCE();
    }
    pvmm32(O, P0, vf0);
    if (NC == 2 && DIAG) { const float nd = (k1 == qw) ? nslope : 0.f;
#pragma unroll
        for (int r = 0; r < 16; ++r) S1[r] = fmaf(nd, fabsf(qd - (float)k1 - (float)((r & 3) + 8 * (r >> 2))), S1[r]); }
    soft32<0>(S1, P1, l, 0.f, 0.f);
    if (NC == 2) {
    vload16<0>(vf1, Vb + 32 * VP, lane);
    SCHED_FENCE();
    vload16<1>(vf1, Vb + 32 * VP, lane);
    } else {
    vload32(vf1, Vb + 32 * VP, lane);
    SCHED_FENCE();
    }
    pvmm32(O, P1, vf1);
}

template <int NC>
__device__ __forceinline__ void attn_shared_unit(LAS char* lds, bf16* qbase, const bf16* Kg, const bf16* Vg, int kvp, int nt, int qpos, int qw, float nslope, float negM0, float lam, const float* subln, int wave_id) {
    const int wv = wave_id, tid = pg8::tid_fresh(wave_id);
    const int lane = tid & 63, r32 = lane & 31, hi = lane >> 5;
    const int cm = (NC == 2) ? (wv & 1) : 0;
    constexpr int NQ = (NC == 2) ? 4 : 8;
    bf16x8 Q[NQ];
    { const bf16* qrow0 = qbase + (size_t)r32 * LDQ;
#pragma unroll
    for (int ks = 0; ks < NQ; ++ks) Q[ks] = *(const bf16x8*)(qrow0 + cm * 64 + 16 * ks + 8 * hi); }
    f32x16 O[4]; float l = 0.f;
#pragma unroll
    for (int db = 0; db < 4; ++db) zero16(O[db]);
    const int lrow = tid >> 3, lcb = (tid & 7) * 32;
    const char* kgp = (const char*)(Kg + (size_t)lrow * kvp) + lcb; const char* vgp = (const char*)(Vg + (size_t)lrow * kvp) + lcb;
    const size_t tstep = (size_t)64 * kvp * 2;
    u32x4 ka0, ka1, va0, va1, kb0, kb1, vb0, vb1;
#define LOADA(tt) do { const char* kp_ = kgp + (size_t)(tt) * tstep; const char* vp_ = vgp + (size_t)(tt) * tstep; ka0 = *(const u32x4*)kp_; ka1 = *(const u32x4*)(kp_ + 16); va0 = *(const u32x4*)vp_; va1 = *(const u32x4*)(vp_ + 16); } while (0)
#define LOADB(tt) do { const char* kp_ = kgp + (size_t)(tt) * tstep; const char* vp_ = vgp + (size_t)(tt) * tstep; kb0 = *(const u32x4*)kp_; kb1 = *(const u32x4*)(kp_ + 16); vb0 = *(const u32x4*)vp_; vb1 = *(const u32x4*)(vp_ + 16); } while (0)
#define WRITEA(buf) do { LAS char* kw_ = lds + (buf) * BUFB + lrow * KP + lcb; LAS char* vw_ = lds + (buf) * BUFB + 64 * KP + lrow * VP + lcb; *(LAS u32x4*)kw_ = ka0; *(LAS u32x4*)(kw_ + 16) = ka1; *(LAS u32x4*)vw_ = va0; *(LAS u32x4*)(vw_ + 16) = va1; } while (0)
#define WRITEB(buf) do { LAS char* kw_ = lds + (buf) * BUFB + lrow * KP + lcb; LAS char* vw_ = lds + (buf) * BUFB + 64 * KP + lrow * VP + lcb; *(LAS u32x4*)kw_ = kb0; *(LAS u32x4*)(kw_ + 16) = kb1; *(LAS u32x4*)vw_ = vb0; *(LAS u32x4*)(vw_ + 16) = vb1; } while (0)
    constexpr int BUFB = 64 * KP + 64 * VP;
    const float qd = (float)(qpos - 4 * hi);
    const int td = qw >> 6;
    if (NC == 2) {
    LOADA(0); LOADB(1);
    __syncthreads();
    WRITEA(0);
    __syncthreads();
#pragma unroll 1
    for (int t = 0; t < nt; t += 2) {
        {
            if (t + 2 < nt) LOADA(t + 2);
            int k0v = t * 64; asm volatile("" : "+s"(k0v));
            const LAS char* Kb = lds + cm * 128; const LAS char* Vb = lds + 64 * KP;
            if (t == td) attn_tile<NC, true>(O, l, Q, Kb, Vb, r32, hi, lane, qd, k0v, qw, nslope, negM0);
            else attn_tile<NC, false>(O, l, Q, Kb, Vb, r32, hi, lane, qd, k0v, qw, nslope, negM0);
            WRITEB(1);
            __syncthreads();
        }
        {
            if (t + 3 < nt) LOADB(t + 3);
            int k0v = (t + 1) * 64; asm volatile("" : "+s"(k0v));
            const LAS char* Kb = lds + BUFB + cm * 128; const LAS char* Vb = lds + BUFB + 64 * KP;
            if (t + 1 == td) attn_tile<NC, true>(O, l, Q, Kb, Vb, r32, hi, lane, qd, k0v, qw, nslope, negM0);
            else attn_tile<NC, false>(O, l, Q, Kb, Vb, r32, hi, lane, qd, k0v, qw, nslope, negM0);
            if (t + 2 < nt) WRITEA(0);
            __syncthreads();
        }
    }
    } else {
    LOADA(0);
    __syncthreads();
    WRITEA(0);
    __syncthreads();
#pragma unroll 1
    for (int t = 0; t < nt; ++t) {
        const bool more = (t + 1 < nt);
        if (more) LOADA(t + 1);
        int k0v = t * 64; asm volatile("" : "+s"(k0v));
        const LAS char* Kb = lds + (t & 1) * BUFB; const LAS char* Vb = lds + (t & 1) * BUFB + 64 * KP;
        attn_tile<NC, false>(O, l, Q, Kb, Vb, r32, hi, lane, qd, k0v, qw, nslope, negM0);
        if (more) WRITEA((t + 1) & 1);
        __syncthreads();
    }
    }
#undef LOADA
#undef LOADB
#undef WRITEA
#undef WRITEB
    const int lane2 = pg8::lane_id_fresh(), hi2 = lane2 >> 5;
    bf16* qrow = qbase + (size_t)(lane2 & 31) * LDQ;
    l = pg8::sum_halves(l);
    if (NC == 2) {
        LAS float* XO = (LAS float*)lds + (wv >> 1) * 4096 + lane2;
        if (cm == 1) { const float i2 = *(const LAS float*)(lds + (LDS_BYTES - 64 + 32)) * __builtin_amdgcn_rcpf(l);
#pragma unroll
            for (int db = 0; db < 4; ++db)
#pragma unroll
                for (int r = 0; r < 16; ++r) XO[(db * 16 + r) * 64] = O[db][r] * i2; }
        __syncthreads();
        if (cm == 0) {
            const float i1 = 1.f / l; float ss = 0.f;
#pragma unroll
            for (int db = 0; db < 4; ++db)
#pragma unroll
                for (int r = 0; r < 16; ++r) { const float o = O[db][r] * i1 - XO[(db * 16 + r) * 64]; O[db][r] = o; ss += o * o; }
            ss = pg8::sum_halves(ss);
            const float rstd = (1.f / sqrtf(ss * (1.f / 128.f) + EPS)) * 0.8f;
#pragma unroll
            for (int db = 0; db < 4; ++db)
#pragma unroll
                for (int g4 = 0; g4 < 4; ++g4) { const int d = 32 * db + 8 * g4 + 4 * hi2; const f32x4 gn = *(const f32x4*)(subln + d);
                    u32x2 w; w.x = cvtpk(O[db][4 * g4 + 0] * rstd * gn[0], O[db][4 * g4 + 1] * rstd * gn[1]); w.y = cvtpk(O[db][4 * g4 + 2] * rstd * gn[2], O[db][4 * g4 + 3] * rstd * gn[3]);
                    *(u32x2*)(qrow + d) = w; }
        }
    } else {
        const float i1 = 1.f / l;
#pragma unroll
        for (int db = 0; db < 4; ++db)
#pragma unroll
            for (int g4 = 0; g4 < 4; ++g4) { const int d = 32 * db + 8 * g4 + 4 * hi2;
                u32x2 w; w.x = cvtpk(O[db][4 * g4 + 0] * i1, O[db][4 * g4 + 1] * i1); w.y = cvtpk(O[db][4 * g4 + 2] * i1, O[db][4 * g4 + 3] * i1);
                *(u32x2*)(qrow + d) = w; }
    }
}

__device__ __forceinline__ void attn_b_wave_unit(LAS char* wl, bf16* R, float* LB, int b, int g, int j, int idx, float negM0, int lane_in) {
    int lane = lane_in; asm volatile("" : "+v"(lane));
    const int r32 = lane & 31, hi = lane >> 5;
    const int dil = (g == 0) ? 1 : ((g == 1) ? 4 : 16), nqb = 64 / dil, sub_len = SEQ / dil;
    const int res = idx / nqb, qb = idx % nqb;
    const float slope = __builtin_amdgcn_exp2f(-8.f * (float)(g * 4 + j + 1) / 12.f);
    const float nslope = -slope * (float)dil * L2E;
    const int qsub = 32 * qb + r32;
    const size_t qrow_i = (size_t)b * SEQ + (size_t)qsub * dil + res;
    const int hcol = (g * 4 + j) * 128;
    bf16* qrow = R + qrow_i * LDQ + C_BQ + hcol;
    bf16x8 Q[8];
#pragma unroll
    for (int ks = 0; ks < 8; ++ks) Q[ks] = *(const bf16x8*)(qrow + 16 * ks + 8 * hi);
    f32x16 O[4]; float l = 0.f;
#pragma unroll
    for (int db = 0; db < 4; ++db) zero16(O[db]);
    const int lr = lane >> 4, lc = (lane & 15) * 8;
#pragma unroll 1
    for (int kt = 0; kt < 5; ++kt) {
        const int kb = 32 * qb - 64 + 32 * kt;
        if (kb < 0 || kb >= sub_len) continue;
        u32x4 kr[8], vr[8];
#pragma unroll
        for (int n = 0; n < 8; ++n) { const size_t krow = (size_t)b * SEQ + (size_t)(kb + 4 * n + lr) * dil + res;
            kr[n] = *(const u32x4*)(R + krow * LDQ + C_BK + hcol + lc); vr[n] = *(const u32x4*)(R + krow * LDQ + C_BV + hcol + lc); }
#pragma unroll
        for (int n = 0; n < 8; ++n) { *(LAS u32x4*)(wl + (4 * n + lr) * KP + lc * 2) = kr[n]; *(LAS u32x4*)(wl + 32 * KP + (4 * n + lr) * VP + lc * 2) = vr[n]; }
        asm volatile("s_waitcnt lgkmcnt(0)" ::: "memory");
        f32x16 S;
#pragma unroll
        for (int r = 0; r < 16; ++r) S[r] = negM0;
        qk32<8>(S, wl, Q, 0, r32, hi);
        bf16x8 P[2];
        soft32<2>(S, P, l, (float)(qsub - (kb + 4 * hi)), nslope);
        pv32(O, P, wl + 32 * KP, lane);
        asm volatile("s_waitcnt lgkmcnt(0)" ::: "memory");
    }
    l = pg8::sum_halves(l);
    const float i1 = 1.f / l;
#pragma unroll
    for (int db = 0; db < 4; ++db)
#pragma unroll
        for (int g4 = 0; g4 < 4; ++g4) { const int d = 32 * db + 8 * g4 + 4 * hi;
            u32x2 w; w.x = cvtpk(O[db][4 * g4 + 0] * i1, O[db][4 * g4 + 1] * i1); w.y = cvtpk(O[db][4 * g4 + 2] * i1, O[db][4 * g4 + 3] * i1);
            *(u32x2*)(qrow + d) = w; }
    if (hi == 0) LB[((size_t)g * M + qrow_i) * 4 + j] = l;
}

#define XB_TMO      128
#define XB_XCNT(j)  (256  + 64 * (j))
#define XB_XSUB(j)  (1280 + 64 * (j))
#define XB_XGEN(j)  (2304 + 64 * (j))
#define XB_TOP      3328
#define XB_TOPGEN   3392
#define XCD_BAR_WORDS 3456
#define XB_SPIN_CAP (1u << 18)

__device__ __forceinline__ unsigned xb_ld(unsigned* p)              { return __hip_atomic_load(p, __ATOMIC_RELAXED, __HIP_MEMORY_SCOPE_AGENT); }
__device__ __forceinline__ unsigned xb_add(unsigned* p, unsigned v) { return __hip_atomic_fetch_add(p, v, __ATOMIC_RELAXED, __HIP_MEMORY_SCOPE_AGENT); }
__device__ __forceinline__ unsigned xb_xcc_id() { return (unsigned)__builtin_amdgcn_s_getreg((3 << 11) | 20) & 0xFu; }
#define XB_SPIN(cond, bar) do { unsigned _sp = 0; while (cond) { __builtin_amdgcn_s_sleep(1); \
    if ((++_sp & 255u) == 0u) { if (xb_ld(&(bar)[XB_TMO])) break; if (_sp > XB_SPIN_CAP) { atomicAdd(&(bar)[XB_TMO], 1u); break; } } } } while (0)

struct XcdBarrier {
    unsigned* bar; unsigned x;
    volatile LAS unsigned* st;
};

__device__ __forceinline__ XcdBarrier xcd_barrier_post(unsigned* bar, volatile LAS unsigned* st) {
    XcdBarrier b; b.bar = bar; b.x = xb_xcc_id(); b.st = st;
    if (threadIdx.x == 0) (void)xb_add(&bar[XB_XCNT(b.x)], 1u);
    return b;
}
__device__ __forceinline__ void xcd_barrier_complete(unsigned* bar, unsigned x, unsigned& nloc, unsigned& nx) {
    const unsigned G = gridDim.x * gridDim.y * gridDim.z;
    unsigned sum, cnt, mine, sp = 0u;
    for (;;) {
        sum = 0u; cnt = 0u; mine = 0u;
#pragma unroll
        for (unsigned j = 0; j < 16; ++j) { const unsigned c = xb_ld(&bar[XB_XCNT(j)]); sum += c; cnt += (c > 0u) ? 1u : 0u; mine = (j == x) ? c : mine; }
        if (sum == G) break;
        __builtin_amdgcn_s_sleep(1);
        if ((++sp & 255u) == 0u) { if (xb_ld(&bar[XB_TMO])) break; if (sp > XB_SPIN_CAP) { atomicAdd(&bar[XB_TMO], 1u); break; } }
    }
    nloc = mine > 0u ? mine : 1u; nx = cnt > 0u ? cnt : 1u;
}

__device__ __forceinline__ void xcd_barrier(const XcdBarrier& b, int wave_id) {
    asm volatile("s_waitcnt vmcnt(0)" ::: "memory");
    __syncthreads();
    if (pg8::tid_fresh(wave_id) == 0) {
        unsigned* bar = b.bar;
        __builtin_amdgcn_s_waitcnt(0);
        unsigned nloc = b.st[0], nx = b.st[1];
        if (nloc == 0u) { xcd_barrier_complete(bar, b.x, nloc, nx); b.st[0] = nloc; b.st[1] = nx; }
        const unsigned old = xb_add(&bar[XB_XSUB(b.x)], 1u);
        const unsigned gen = old / nloc;
        if (old + 1u == (gen + 1u) * nloc) {
            __builtin_amdgcn_fence(__ATOMIC_RELEASE, "agent");
            asm volatile("s_waitcnt vmcnt(0)" ::: "memory");
            const unsigned og = xb_add(&bar[XB_TOP], 1u);
            const unsigned tg = og / nx;
            if (og + 1u == (tg + 1u) * nx) xb_add(&bar[XB_TOPGEN], 1u);
            else XB_SPIN(xb_ld(&bar[XB_TOPGEN]) == tg, bar);
            __builtin_amdgcn_fence(__ATOMIC_ACQUIRE, "agent");
            xb_add(&bar[XB_XGEN(b.x)], 1u);
            asm volatile("s_waitcnt vmcnt(0)" ::: "memory");
        } else {
            XB_SPIN(xb_ld(&bar[XB_XGEN(b.x)]) == gen, bar);
            __builtin_amdgcn_fence(__ATOMIC_ACQUIRE, "agent");
            asm volatile("s_waitcnt vmcnt(0)" ::: "memory");
        }
    }
    __syncthreads();
}

struct Args { const float* in[25]; float* out; unsigned char* ws; };

__global__ void __launch_bounds__(512, 2) fwd_megakernel(Args a) {
    extern __shared__ __attribute__((aligned(16))) unsigned char lds_raw[];
    LAS unsigned char* lds = (LAS unsigned char*)lds_raw;
    cg::grid_group grid = cg::this_grid();
    const int wave = __builtin_amdgcn_readfirstlane((int)threadIdx.x >> 6);
#define FRESH_LANE const int lane = pg8::lane_id_fresh();
    const int G = gridDim.x, bid = blockIdx.x;
    const int gw = bid * 8 + wave, NGW = G * 8;
    unsigned char* ws = a.ws;
    const float* x = a.in[0]; const float* mem = a.in[1];
    bf16* W_IN = (bf16*)(ws + WS_WIN); bf16* W_G = (bf16*)(ws + WS_WG); bf16* W_MEM = (bf16*)(ws + WS_WMEM); bf16* W_BR = (bf16*)(ws + WS_WBR);
    bf16* W_OUT = (bf16*)(ws + WS_WOUT3); bf16* W_GU = (bf16*)(ws + WS_WGU); bf16* W_DN = (bf16*)(ws + WS_WDN);
    float* LB = (float*)(ws + WS_LB); bf16* R = (bf16*)(ws + WS_R);
    unsigned char* dob = (unsigned char*)a.out;
    bf16* XN = (bf16*)(dob + DO_XN); bf16* MN = (bf16*)(dob + DO_MN); bf16* CKV = (bf16*)(dob + DO_CKV);

    volatile LAS unsigned* MISC = (volatile LAS unsigned*)(lds + MISC_OFF);
    unsigned* barw = (unsigned*)(ws + WS_BAR);
    if (threadIdx.x < 16) MISC[threadIdx.x] = 0u;
    if (a.ws == nullptr) grid.sync();
    XcdBarrier bar = xcd_barrier_post(barw, MISC);
    __syncthreads();
    {
        FRESH_LANE
        LAS float* scr = (LAS float*)(lds + wave * 8704);
        constexpr int I_IN = 16 * (DIN / 32), I_G = 16 * (3 * D / 32), I_MEM = 16 * (D / 32), I_BR = 8 * (D / 32), I_OUT = 16 * (D / 32), I_FF = 16 * (DFF / 32), I_DN = (DFF / 64) * (D / 32);
        constexpr int NITEMS = I_IN + I_G + I_MEM + 3 * I_BR + I_OUT + 2 * I_FF + I_DN;
        for (int it = gw; it < NITEMS; it += NGW) {
            int r = it;
            if (r < I_IN) { const int nb = DIN / 32; tr_item(a.in[3], DIN, 64 * (r / nb), 32 * (r % nb), W_IN, D, 0, 0, 1, 0, scr, lane); continue; } r -= I_IN;
            if (r < I_G) { const int nb = 3 * D / 32; tr_item(a.in[4], 3 * D, 64 * (r / nb), 32 * (r % nb), W_G, D, 0, 0, 1, 0, scr, lane); continue; } r -= I_G;
            if (r < I_MEM) { const int nb = D / 32; tr_item(a.in[16], D, 64 * (r / nb), 32 * (r % nb), W_MEM, D, 0, 0, 1, 0, scr, lane); continue; } r -= I_MEM;
            if (r < 3 * I_BR) { const int gI = r / I_BR, rr = r % I_BR, nb = D / 32; tr_item(a.in[19] + (size_t)gI * 512 * D, D, 64 * (rr / nb), 32 * (rr % nb), W_BR + (size_t)gI * D * 512, 512, 0, 0, 1, 0, scr, lane); continue; } r -= 3 * I_BR;
            if (r < I_OUT) { const int nb = D / 32; tr_item(a.in[20], D, 64 * (r / nb), 32 * (r % nb), W_OUT, D, 0, 0, 1, 0, scr, lane); continue; } r -= I_OUT;
            if (r < 2 * I_FF) { const int s = r / I_FF, rr = r % I_FF, nb = DFF / 32; const int n0 = 32 * (rr % nb);
                tr_item(a.in[22 + s], DFF, 64 * (rr / nb), n0, W_GU, D, 256 * (n0 / 128) + 128 * s + (n0 % 128) - n0, 0, 1, 0, scr, lane); continue; } r -= 2 * I_FF;
            { const int nb = D / 32; tr_item(a.in[24], D, 64 * (r / nb), 32 * (r % nb), W_DN, DFF, 0, 0, 1, 0, scr, lane); }
        }
        { float* SSQ0 = (float*)(ws + WS_SSQ); for (int i = gw * 64 + lane; i < M; i += NGW * 64) SSQ0[i] = 0.f; }
        for (int m = gw; m < M + MMEM; m += NGW) {
            if (m < M) rms_row_to_bf16(x + (size_t)m * D, a.in[2], XN + (size_t)m * D, lane);
            else rms_row_to_bf16(mem + (size_t)(m - M) * D, a.in[15], MN + (size_t)(m - M) * D, lane);
        }
    }
    xcd_barrier(bar, wave);

    {
        LAS float* GT = (LAS float*)(lds + GT_OFF);
        { const int t2 = pg8::tid_fresh(wave);
          if (t2 < 64) { GT[t2] = a.in[6][t2]; GT[64 + t2] = a.in[7][t2]; }
          if (t2 < 128) { GT[128 + t2] = a.in[13][t2]; GT[256 + t2] = a.in[14][t2]; GT[384 + t2] = a.in[17][t2]; GT[512 + t2] = a.in[18][t2]; } }
        __syncthreads();
        { const pg8::EpiQKV E{R, LDQ, CKV, D, GT, (LAS float*)(lds + XCH_OFF)};
          pg8::Gemm g{XN, W_IN, M, DIN, D, D, MN, W_MEM}; pg8::DualOrder S; S.init(M, DIN, MMEM, D, G, bid);
          pg8::gemm_phase<pg8::EpiQKV, pg8::DualOrder, true, true>(lds, g, S, E, wave); }
    }
    xcd_barrier(bar, wave);

    {
        FRESH_LANE
#define UNIFORM_F(v) __builtin_bit_cast(float, __builtin_amdgcn_readfirstlane(__builtin_bit_cast(int, (float)(v))))
        const float negM_a = UNIFORM_F(-8.f * absmax_vec(a.in[6], 64, lane) * absmax_vec(a.in[7], 64, lane) * L2E);
        const float lam = UNIFORM_F(expf(wave_sum(a.in[8][lane] * a.in[9][lane])) - expf(wave_sum(a.in[10][lane] * a.in[11][lane])) + 0.2f);
        *(LAS float*)(lds + (LDS_BYTES - 64 + 32)) = lam;
        for (int rr = 0; rr < (512 + G - 1) / G; ++rr) {
            int u;
            if (G == 256) { const int k = rr * 32 + (bid >> 3), bh = (bid & 7) + 8 * (k >> 4); u = bh * 16 + (k & 15); }
            else { u = rr * G + bid; if (u >= 512) break; }
            const int b = u >> 6, h = (u >> 4) & 3, qblk = u & 15;
            const int ta_ = pg8::lane_id_fresh();
            const int qpos = qblk * 128 + (wave >> 1) * 32 + (ta_ & 31);
            bf16* qrow = R + ((size_t)b * SEQ + qblk * 128 + (wave >> 1) * 32) * LDQ + C_AQ + h * 128;
            const bf16* Kg = R + (size_t)b * SEQ * LDQ + C_AK + h * 128; const bf16* Vg = R + (size_t)b * SEQ * LDQ + C_AV + h * 128;
            const float nslope = -__builtin_amdgcn_exp2f(-2.f * (float)(h + 1)) * L2E;
            attn_shared_unit<2>((LAS char*)lds, qrow, Kg, Vg, LDQ, SEQ / 64, qpos, qblk * 128 + (wave >> 1) * 32, nslope, negM_a, lam, a.in[12], wave);
        }
        const int lnc_ = pg8::lane_id_fresh();
        const float negM_c = UNIFORM_F(-11.313708499f * absmax_vec(a.in[17], 128, lnc_) * absmax_vec(a.in[18], 128, lnc_) * L2E);
        for (int u = bid; u < 256; u += G) {
            const int b = u >> 5, h = (u >> 3) & 3, qblk = u & 7;
            const int tc_ = pg8::lane_id_fresh();
            const int qpos = qblk * 256 + wave * 32 + (tc_ & 31);
            bf16* qrow = R + ((size_t)b * SEQ + qblk * 256 + wave * 32) * LDQ + C_CQ + h * 128;
            const bf16* Kg = CKV + (size_t)b * NMEM * D + h * 128; const bf16* Vg = Kg + 512;
            attn_shared_unit<1>((LAS char*)lds, qrow, Kg, Vg, D, NMEM / 64, qpos, 0, 0.f, negM_c, 0.f, a.in[12], wave);
        }
        __syncthreads();
        { const int tb_ = pg8::lane_id_fresh(); const int lnb_ = tb_;
          const float negM_b = UNIFORM_F(-11.313708499f * absmax_vec(a.in[13], 128, lnb_) * absmax_vec(a.in[14], 128, lnb_) * L2E);
          for (int rr = 0; rr < (6144 + NGW - 1) / NGW; ++rr) {
              int wu;
              if (G == 256) { const int k = rr * 256 + (bid >> 3) * 8 + wave, sid = (bid & 7) + 8 * (k >> 6); wu = sid * 64 + (k & 63); }
              else { wu = rr * NGW + gw; if (wu >= 6144) break; }
              const int sid = wu >> 6;
              attn_b_wave_unit((LAS char*)lds + wave * (32 * KP + 32 * VP), R, LB, sid / 12, (sid % 12) >> 2, sid & 3, wu & 63, negM_b, tb_ & 63);
          } }
    }
    xcd_barrier(bar, wave);

    { FRESH_LANE
    for (int m = gw; m < M; m += NGW) {
        const int j = lane >> 4, d8 = (lane & 15) * 8;
        const float l0 = LB[((size_t)0 * M + m) * 4 + j], l1 = LB[((size_t)1 * M + m) * 4 + j], l2 = LB[((size_t)2 * M + m) * 4 + j];
        const float inv = 1.f / (l0 + l1 + l2); const float w0 = l0 * inv, w1 = l1 * inv, w2 = l2 * inv;
        bf16* p0 = R + (size_t)m * LDQ + C_BQ + j * 128 + d8;
        const u32x4 o0 = *(const u32x4*)p0, o1 = *(const u32x4*)(p0 + 512), o2 = *(const u32x4*)(p0 + 1024);
        u32x4 w;
#pragma unroll
        for (int e = 0; e < 4; ++e) {
            const float lo = w0 * pg8::bf_lo(o0[e]) + w1 * pg8::bf_lo(o1[e]) + w2 * pg8::bf_lo(o2[e]);
            const float hi = w0 * pg8::bf_hi(o0[e]) + w1 * pg8::bf_hi(o1[e]) + w2 * pg8::bf_hi(o2[e]);
            w[e] = cvtpk(lo, hi);
        }
        *(u32x4*)p0 = w;
    } }
    {
        pg8::Gemm g{XN, W_G, M, 3 * D, D, D, nullptr, nullptr}; pg8::StaticOrder S; S.init(M, 3 * D, G, bid);
        pg8::EpiGate E{R + C_GATE, LDQ, a.in[5]};
        pg8::gemm_phase<pg8::EpiGate, pg8::StaticOrder, true, true>(lds, g, S, E, wave);
    }
    xcd_barrier(bar, wave);

    for (int gI = 0; gI < 3; ++gI) {
        const int acol = (gI == 0) ? C_AQ : ((gI == 1) ? C_BQ : C_CQ);
        pg8::Gemm g{R + acol, W_BR + (size_t)gI * D * 512, M, D, 512, LDQ, nullptr, nullptr}; pg8::StaticOrder S; S.init(M, D, G, bid);
        pg8::EpiBranch E{R + C_GATE, R + C_GATE + gI * D, LDQ, gI};
        pg8::gemm_phase<pg8::EpiBranch, pg8::StaticOrder, true, true>(lds, g, S, E, wave);
    }
    xcd_barrier(bar, wave);

    {
        pg8::Gemm g{R + C_GATE, W_OUT, M, D, D, LDQ, nullptr, nullptr}; pg8::StaticOrder S; S.init(M, D, G, bid);
        pg8::EpiResidNorm E{x, a.out, D, a.in[21], R + C_H2, LDQ, (float*)(ws + WS_SSQ)};
        pg8::gemm_phase<pg8::EpiResidNorm, pg8::StaticOrder, true, true>(lds, g, S, E, wave);
    }
    xcd_barrier(bar, wave);

    {
        pg8::Gemm g{R + C_H2, W_GU, M, 2 * DFF, D, LDQ, nullptr, nullptr}; pg8::StaticOrder S; S.init(M, 2 * DFF, G, bid);
        pg8::EpiSwiGLU E{R + C_ACT, LDQ, (const float*)(ws + WS_SSQ)};
        pg8::gemm_phase<pg8::EpiSwiGLU, pg8::StaticOrder, true, true>(lds, g, S, E, wave);
    }
    xcd_barrier(bar, wave);

    {
        pg8::Gemm g{R + C_ACT, W_DN, M, D, DFF, LDQ, nullptr, nullptr}; pg8::StaticOrder S; S.init(M, D, G, bid);
        pg8::EpiResid E{a.out, a.out, D};
        pg8::gemm_phase<pg8::EpiResid, pg8::StaticOrder, true, true>(lds, g, S, E, wave);
    }
}

extern "C" void kernel_launch(void* const* d_in, const int* in_sizes, int n_in, void* d_out, int out_size, void* d_ws, size_t ws_size, hipStream_t stream) {
    static int grid = 0;
    if (grid == 0) {
        if (n_in != 25 || out_size != M * D || ws_size < WS_END) { fprintf(stderr, "kernel_launch: unexpected problem shape (n_in %d out %d ws %zu)\n", n_in, out_size, ws_size); grid = -1; return; }
        int dev = 0, cus = 0, per_cu = 0;
        hipGetDevice(&dev);
        hipDeviceGetAttribute(&cus, hipDeviceAttributeMultiprocessorCount, dev);
        if (hipFuncSetAttribute((const void*)fwd_megakernel, hipFuncAttributeMaxDynamicSharedMemorySize, LDS_BYTES) != hipSuccess) { fprintf(stderr, "kernel_launch: hipFuncSetAttribute failed\n"); }
        hipOccupancyMaxActiveBlocksPerMultiprocessor(&per_cu, (const void*)fwd_megakernel, 512, LDS_BYTES);
        (void)hipGetLastError();
        if (per_cu < 1) per_cu = 1;
        grid = cus;
        fprintf(stderr, "kernel_launch: cus %d per_cu %d grid %d\n", cus, per_cu, grid);
    }
    if (grid < 0) return;
    if (hipMemsetAsync((char*)d_ws + WS_BAR, 0, 16384, stream) != hipSuccess) { fprintf(stderr, "kernel_launch: memset of the barrier words failed\n"); return; }
    Args a{};
    for (int i = 0; i < 25; ++i) a.in[i] = (const float*)d_in[i];
    a.out = (float*)d_out; a.ws = (unsigned char*)d_ws;
    void* args[] = {&a};
    hipError_t e = hipLaunchCooperativeKernel((const void*)fwd_megakernel, dim3(grid), dim3(512), args, LDS_BYTES, stream);
    if (e != hipSuccess) fprintf(stderr, "cooperative launch failed: %s (grid %d)\n", hipGetErrorString(e), grid);
}
```

```cpp
#include <hip/hip_runtime.h>
#include <hip/hip_cooperative_groups.h>
#include <cstdio>
#include <cstdint>
namespace cg = cooperative_groups;
namespace pg8 {
#define PG8_LAS __attribute__((address_space(3)))
typedef unsigned short bf16_t;
typedef short bf16x8 __attribute__((ext_vector_type(8)));
typedef float f32x4 __attribute__((ext_vector_type(4)));
typedef unsigned u32x4 __attribute__((ext_vector_type(4)));
constexpr int BM = 256, BK = 64, HALF = 128, HTB = HALF * BK * 2  , STAGE_BYTES = 8 * HTB, NXCD = 8, WGM = 8;

__host__ __device__ __forceinline__ int lds_byte(int r, int c) { const int st = (r >> 4) * 2 + (c >> 5), rr = r & 15, cc = c & 31, ob = rr * 64 + cc * 2; return st * 1024 + (ob ^ (((ob >> 9) & 1) << 5)); }
__host__ __device__ __forceinline__ void stage_rc(int b, int& R, int& C) { const int st = b / 1024, sb = b % 1024, swz = sb ^ (((sb >> 9) & 1) << 5); R = (st >> 1) * 16 + swz / 64; C = (st & 1) * 32 + (swz % 64) / 2; }
__host__ __device__ __forceinline__ int perm32(int rho) { const int n = rho >> 4, i = rho & 15; return 8 * (i >> 2) + 4 * n + (i & 3); }

struct Unit { int pm, pn, src; };
struct Gemm { const bf16_t* A; const bf16_t* Bt; int M, N, K, lda; const bf16_t* A2; const bf16_t* Bt2; const bf16_t* A3; const bf16_t* Bt3; };

struct StaticOrder {
    int nM, nN, nwg, G, c;
    __host__ __device__ void init(int M, int N, int G_, int c_) { nM = M / BM; nN = N / BM; nwg = nM * nN; G = G_; c = c_; }
    __host__ __device__ bool next(int i, Unit& u) const {
        const long L = (long)i * G + c; if (L >= nwg) return false;
        int wgid = (int)L; { const int q = nwg / NXCD, r = nwg % NXCD, xcd = wgid % NXCD, off = wgid / NXCD; wgid = (xcd < r ? xcd * (q + 1) : r * (q + 1) + (xcd - r) * q) + off; }
        const int nig = WGM * nN, gid = wgid / nig, fm = gid * WGM, gsz = (nM - fm) < WGM ? (nM - fm) : WGM;
        u.pm = fm + ((wgid % nig) % gsz); u.pn = (wgid % nig) / gsz; u.src = 0; return true;
    }
    __device__ __forceinline__ void a_ready(const Unit&) const {}
    __device__ __forceinline__ void done(const Unit&) const {}
};

struct DualOrder {
    StaticOrder S1; int nM2, nN2;
    __host__ __device__ void init(int M, int N, int M2, int N2, int G_, int c_) { S1.init(M, N, G_, c_); nM2 = M2 / BM; nN2 = N2 / BM; }
    __host__ __device__ bool next(int i, Unit& u) const {
        if (S1.next(i, u)) return true;
        const long L = (long)i * S1.G + S1.c - S1.nwg; if (L < 0 || L >= (long)nM2 * nN2) return false;
        u.pm = (int)L % nM2; u.pn = (int)L / nM2; u.src = 1; return true;
    }
    __device__ __forceinline__ void a_ready(const Unit&) const {}
    __device__ __forceinline__ void done(const Unit&) const {}
};

struct RepeatOrder {
    StaticOrder S1; int nrep;
    __host__ __device__ void init(int M, int N, int nrep_, int G_, int c_) { S1.init(M, N, G_, c_); nrep = nrep_; }
    __host__ __device__ bool next(int i, Unit& u) const { if (i >= nrep) return false; if (!S1.next(0, u)) return false; u.src = i; return true; }
    __device__ __forceinline__ void a_ready(const Unit&) const {}
    __device__ __forceinline__ void done(const Unit&) const {}
};

template <int K> __device__ __forceinline__ float shx(float v) {
    return __builtin_bit_cast(float, __builtin_amdgcn_ds_swizzle(__builtin_bit_cast(int, v), (K << 10) | 0x1f)); }
__device__ __forceinline__ float sum_halves(float v) {
    auto rr = __builtin_amdgcn_permlane32_swap(__builtin_bit_cast(unsigned, v), __builtin_bit_cast(unsigned, v), false, false);
    return __builtin_bit_cast(float, (unsigned)rr[0]) + __builtin_bit_cast(float, (unsigned)rr[1]); }
__device__ __forceinline__ float max_halves(float v) {
    auto rr = __builtin_amdgcn_permlane32_swap(__builtin_bit_cast(unsigned, v), __builtin_bit_cast(unsigned, v), false, false);
    return fmaxf(__builtin_bit_cast(float, (unsigned)rr[0]), __builtin_bit_cast(float, (unsigned)rr[1])); }
__device__ __forceinline__ int lane_id_fresh() { int z = 0; asm volatile("" : "+s"(z)); return __builtin_amdgcn_mbcnt_hi(~0u, __builtin_amdgcn_mbcnt_lo(~0u, z)); }
__device__ __forceinline__ int tid_fresh(int wave) { return wave * 64 + lane_id_fresh(); }
typedef float f32x2v_t __attribute__((ext_vector_type(2))); typedef __bf16 bf16x2v_t __attribute__((ext_vector_type(2)));
__device__ __forceinline__ unsigned cvt_pk_bf16(float lo, float hi) { f32x2v_t v = {lo, hi}; bf16x2v_t b = __builtin_convertvector(v, bf16x2v_t); return __builtin_bit_cast(unsigned, b); }
__device__ __forceinline__ float bf_lo(unsigned w) { return __builtin_bit_cast(float, w << 16); }
__device__ __forceinline__ float bf_hi(unsigned w) { return __builtin_bit_cast(float, w & 0xffff0000u); }
#define PG8_ACC const f32x4 (&acc)[2][2][4][2]

struct EpiQKV {
    static constexpr bool PERM = true, AFTER_DRAIN = false;
    bf16_t* O; int ldc; bf16_t* O2; int ldc2;
    PG8_LAS const float* GT;
    PG8_LAS float* X;
    __device__ __forceinline__ void operator()(PG8_ACC, const Unit& u, int wr, int wc, int fr, int fq) const {
        const int pn = u.pn;
        int kind, gp; float sc = 1.f;
        constexpr float L2E = 1.4426950408889634f;
        const int mode = u.src;
        if (mode == 0) {
            if (pn < 2) { kind = 1; gp = 0; sc = 0.125f * L2E; }
            else if (pn < 4) { kind = 1; gp = 64; }
            else if (pn < 6) { kind = 0; gp = 64; }
            else if (pn < 12) { kind = 2; gp = 128; sc = 0.08838834764831845f * L2E; }
            else if (pn < 18) { kind = 2; gp = 256; }
            else if (pn < 24) { kind = 0; gp = 256; }
            else { kind = 2; gp = 384; sc = 0.08838834764831845f * L2E; }
        } else {
            if (pn < 2) { kind = 2; gp = 512; } else { kind = 0; gp = 512; }
        }
        const int row0 = u.pm * BM + wr * 64 + fr, col0 = pn * BM + wc * 32 + 8 * fq;
        float rs[2][4][2];
        f32x4 gv[2];
        if (kind != 0) {
#pragma unroll
            for (int ai = 0; ai < 2; ++ai)
#pragma unroll
                for (int m = 0; m < 4; ++m)
#pragma unroll
                    for (int bj = 0; bj < 2; ++bj) {
                        const f32x4 a = acc[ai][bj][m][0], b = acc[ai][bj][m][1];
                        float s = (a[0] * a[0] + a[1] * a[1]) + (a[2] * a[2] + a[3] * a[3]) + (b[0] * b[0] + b[1] * b[1]) + (b[2] * b[2] + b[3] * b[3]);
                        s += shx<16>(s); s = sum_halves(s);
                        if (fq == 0) X[((ai * 128 + wr * 64 + m * 16 + fr) * 2 + bj) * 4 + wc] = s;
                    }
            asm volatile("s_waitcnt lgkmcnt(0)" ::: "memory"); __builtin_amdgcn_s_barrier(); asm volatile("" ::: "memory");
            const int hd = (kind == 1) ? 64 : 128;
            const float inv_hd = (kind == 1) ? (1.f / 64.f) : (1.f / 128.f);
#pragma unroll
            for (int ai = 0; ai < 2; ++ai)
#pragma unroll
                for (int m = 0; m < 4; ++m)
#pragma unroll
                    for (int bj = 0; bj < 2; ++bj) {
                        const f32x4 xs = *(const PG8_LAS f32x4*)(X + ((ai * 128 + wr * 64 + m * 16 + fr) * 2 + bj) * 4);
                        float tot;
                        if (kind == 1) tot = (wc < 2) ? (xs[0] + xs[1]) : (xs[2] + xs[3]);
                        else tot = (xs[0] + xs[1]) + (xs[2] + xs[3]);
                        rs[ai][m][bj] = __builtin_amdgcn_rsqf(tot * inv_hd + 1e-6f) * sc;
                    }
            const int gc = ((wc * 32 + 8 * fq) & (hd - 1));
            gv[0] = *(const PG8_LAS f32x4*)(GT + gp + gc); gv[1] = *(const PG8_LAS f32x4*)(GT + gp + gc + 4);
        } else {
#pragma unroll
            for (int ai = 0; ai < 2; ++ai)
#pragma unroll
                for (int m = 0; m < 4; ++m)
#pragma unroll
                    for (int bj = 0; bj < 2; ++bj) rs[ai][m][bj] = 1.f;
            gv[0] = (f32x4){1.f, 1.f, 1.f, 1.f}; gv[1] = gv[0];
        }
#pragma unroll
        for (int ai = 0; ai < 2; ++ai)
#pragma unroll
            for (int m = 0; m < 4; ++m) { bf16_t* rowp = (mode ? O2 : O) + (size_t)(row0 + ai * HALF + m * 16) * (mode ? ldc2 : ldc) + col0;
#pragma unroll
                for (int bj = 0; bj < 2; ++bj) { const float r = rs[ai][m][bj];
                    const f32x4 v0 = acc[ai][bj][m][0] * gv[0] * r, v1 = acc[ai][bj][m][1] * gv[1] * r;
                    u32x4 w; w.x = cvt_pk_bf16(v0[0], v0[1]); w.y = cvt_pk_bf16(v0[2], v0[3]); w.z = cvt_pk_bf16(v1[0], v1[1]); w.w = cvt_pk_bf16(v1[2], v1[3]);
                    *(u32x4*)(rowp + bj * HALF) = w; } }
    }
};

struct EpiGate {
    static constexpr bool PERM = true, AFTER_DRAIN = false;
    bf16_t* O; int ldc; const float* bias;
    __device__ __forceinline__ void operator()(PG8_ACC, const Unit& u, int wr, int wc, int fr, int fq) const {
        const int row0 = u.pm * BM + wr * 64 + fr, col0 = u.pn * BM + wc * 32 + 8 * fq;
        f32x4 bv[2][2];
#pragma unroll
        for (int bj = 0; bj < 2; ++bj)
#pragma unroll
            for (int n = 0; n < 2; ++n) bv[bj][n] = *(const f32x4*)(bias + col0 + bj * HALF + 4 * n);
#pragma unroll
        for (int ai = 0; ai < 2; ++ai)
#pragma unroll
            for (int m = 0; m < 4; ++m) { bf16_t* rowp = O + (size_t)(row0 + ai * HALF + m * 16) * ldc + col0;
#pragma unroll
                for (int bj = 0; bj < 2; ++bj) { f32x4 v0 = acc[ai][bj][m][0] + bv[bj][0], v1 = acc[ai][bj][m][1] + bv[bj][1];
#pragma unroll
                    for (int e = 0; e < 4; ++e) { v0[e] = __builtin_amdgcn_rcpf(1.f + __builtin_amdgcn_exp2f(-1.4426950408889634f * v0[e])); v1[e] = __builtin_amdgcn_rcpf(1.f + __builtin_amdgcn_exp2f(-1.4426950408889634f * v1[e])); }
                    u32x4 w; w.x = cvt_pk_bf16(v0[0], v0[1]); w.y = cvt_pk_bf16(v0[2], v0[3]); w.z = cvt_pk_bf16(v1[0], v1[1]); w.w = cvt_pk_bf16(v1[2], v1[3]);
                    *(u32x4*)(rowp + bj * HALF) = w; } }
    }
};

struct EpiBranch {
    static constexpr bool PERM = true, AFTER_DRAIN = false;
    bf16_t* MIX; const bf16_t* GATE0; int ldc; int gstride;
    __device__ __forceinline__ void operator()(PG8_ACC, const Unit& u, int wr, int wc, int fr, int fq) const {
        const int row0 = u.pm * BM + wr * 64 + fr, col0 = u.pn * BM + wc * 32 + 8 * fq;
        const bf16_t* GATE = GATE0 + (size_t)u.src * gstride; const int accum = u.src;
#pragma unroll
        for (int ai = 0; ai < 2; ++ai)
#pragma unroll
            for (int m = 0; m < 4; ++m) { const size_t off = (size_t)(row0 + ai * HALF + m * 16) * ldc + col0;
#pragma unroll
                for (int bj = 0; bj < 2; ++bj) { const u32x4 gt = *(const u32x4*)(GATE + off + bj * HALF);
                    f32x4 a = acc[ai][bj][m][0], b = acc[ai][bj][m][1];
                    a[0] *= bf_lo(gt.x); a[1] *= bf_hi(gt.x); a[2] *= bf_lo(gt.y); a[3] *= bf_hi(gt.y); b[0] *= bf_lo(gt.z); b[1] *= bf_hi(gt.z); b[2] *= bf_lo(gt.w); b[3] *= bf_hi(gt.w);
                    if (accum) { const u32x4 mx = *(const u32x4*)(MIX + off + bj * HALF);
                        a[0] += bf_lo(mx.x); a[1] += bf_hi(mx.x); a[2] += bf_lo(mx.y); a[3] += bf_hi(mx.y); b[0] += bf_lo(mx.z); b[1] += bf_hi(mx.z); b[2] += bf_lo(mx.w); b[3] += bf_hi(mx.w); }
                    u32x4 w; w.x = cvt_pk_bf16(a[0], a[1]); w.y = cvt_pk_bf16(a[2], a[3]); w.z = cvt_pk_bf16(b[0], b[1]); w.w = cvt_pk_bf16(b[2], b[3]);
                    *(u32x4*)(MIX + off + bj * HALF) = w; } }
    }
};

struct EpiResid {
    static constexpr bool PERM = true, AFTER_DRAIN = false;
    const float* res; float* out; int ld;
    __device__ __forceinline__ void operator()(PG8_ACC, const Unit& u, int wr, int wc, int fr, int fq) const {
        const int row0 = u.pm * BM + wr * 64 + fr, col0 = u.pn * BM + wc * 32 + 8 * fq;
#pragma unroll
        for (int ai = 0; ai < 2; ++ai)
#pragma unroll
            for (int m = 0; m < 4; ++m) { const size_t off = (size_t)(row0 + ai * HALF + m * 16) * ld + col0;
#pragma unroll
                for (int bj = 0; bj < 2; ++bj) {
                    const f32x4 r0 = *(const f32x4*)(res + off + bj * HALF), r1 = *(const f32x4*)(res + off + bj * HALF + 4);
                    const f32x4 v0 = acc[ai][bj][m][0] + r0, v1 = acc[ai][bj][m][1] + r1;
                    *(f32x4*)(out + off + bj * HALF) = v0; *(f32x4*)(out + off + bj * HALF + 4) = v1; } }
    }
};

struct EpiResidNorm {
    static constexpr bool PERM = true, AFTER_DRAIN = false;
    const float* res; float* out; int ld; const float* gain; bf16_t* H; int ldh; float* SSQ;
    __device__ __forceinline__ void operator()(PG8_ACC, const Unit& u, int wr, int wc, int fr, int fq) const {
        const int row0 = u.pm * BM + wr * 64 + fr, col0 = u.pn * BM + wc * 32 + 8 * fq;
        f32x4 gv[2][2];
#pragma unroll
        for (int bj = 0; bj < 2; ++bj)
#pragma unroll
            for (int n = 0; n < 2; ++n) gv[bj][n] = *(const f32x4*)(gain + col0 + bj * HALF + 4 * n);
#pragma unroll
        for (int ai = 0; ai < 2; ++ai)
#pragma unroll
            for (int m = 0; m < 4; ++m) { const int row = row0 + ai * HALF + m * 16; const size_t off = (size_t)row * ld + col0; float s = 0.f;
#pragma unroll
                for (int bj = 0; bj < 2; ++bj) {
                    const f32x4 r0 = *(const f32x4*)(res + off + bj * HALF), r1 = *(const f32x4*)(res + off + bj * HALF + 4);
                    const f32x4 v0 = acc[ai][bj][m][0] + r0, v1 = acc[ai][bj][m][1] + r1;
                    *(f32x4*)(out + off + bj * HALF) = v0; *(f32x4*)(out + off + bj * HALF + 4) = v1;
                    s += (v0[0] * v0[0] + v0[1] * v0[1]) + (v0[2] * v0[2] + v0[3] * v0[3]) + (v1[0] * v1[0] + v1[1] * v1[1]) + (v1[2] * v1[2] + v1[3] * v1[3]);
                    const f32x4 h0 = v0 * gv[bj][0], h1 = v1 * gv[bj][1];
                    u32x4 w; w.x = cvt_pk_bf16(h0[0], h0[1]); w.y = cvt_pk_bf16(h0[2], h0[3]); w.z = cvt_pk_bf16(h1[0], h1[1]); w.w = cvt_pk_bf16(h1[2], h1[3]);
                    *(u32x4*)(H + (size_t)row * ldh + col0 + bj * HALF) = w; }
                s += shx<16>(s); s = sum_halves(s);
                if (fq == 0) atomicAdd(SSQ + row, s); }
    }
};

struct EpiSwiGLU {
    static constexpr bool PERM = true, AFTER_DRAIN = false;
    bf16_t* O; int ldc; const float* SSQ;
    __device__ __forceinline__ void operator()(PG8_ACC, const Unit& u, int wr, int wc, int fr, int fq) const {
        const int row0 = u.pm * BM + wr * 64 + fr, col0 = u.pn * HALF + wc * 32 + 8 * fq;
#pragma unroll
        for (int ai = 0; ai < 2; ++ai)
#pragma unroll
            for (int m = 0; m < 4; ++m) { bf16_t* rowp = O + (size_t)(row0 + ai * HALF + m * 16) * ldc + col0;
                const float rstd = __builtin_amdgcn_rsqf(SSQ[row0 + ai * HALF + m * 16] * (1.f / 1024.f) + 1e-6f);
                f32x4 v[2];
#pragma unroll
                for (int n = 0; n < 2; ++n) { const f32x4 gt = acc[ai][0][m][n] * rstd, up = acc[ai][1][m][n] * rstd;
#pragma unroll
                    for (int e = 0; e < 4; ++e) v[n][e] = gt[e] * __builtin_amdgcn_rcpf(1.f + __builtin_amdgcn_exp2f(-1.4426950408889634f * gt[e])) * up[e]; }
                u32x4 w; w.x = cvt_pk_bf16(v[0][0], v[0][1]); w.y = cvt_pk_bf16(v[0][2], v[0][3]); w.z = cvt_pk_bf16(v[1][0], v[1][1]); w.w = cvt_pk_bf16(v[1][2], v[1][3]);
                *(u32x4*)rowp = w; }
    }
};

template <class Epi, class Sched, bool ALIGN_EPI = false, bool SP2 = false>
__device__ __forceinline__ void gemm_phase(PG8_LAS unsigned char* lds, const Gemm g, const Sched& S, const Epi& E, int wave_id) {
    const int tid = tid_fresh(wave_id);
    const int wid = __builtin_amdgcn_readfirstlane(tid >> 6), lane = tid & 63, wr = wid >> 2, wc = wid & 3, fr = lane & 15, fq = lane >> 4;
    const int K = g.K, nt = K / BK;
    unsigned voffA[2], voffB[2];
#pragma unroll
    for (int i = 0; i < 2; ++i) { int R, C; stage_rc(tid * 16 + i * 8192, R, C); const int Rb = Epi::PERM ? ((R & ~31) + perm32(R & 31)) : R;
        voffA[i] = (unsigned)(R * g.lda + C) * 2u; voffB[i] = (unsigned)(Rb * K + C) * 2u; }
    const size_t kstep = (size_t)(BK * 2);
    const size_t hstepA = (size_t)HALF * g.lda * 2, hstepB = (size_t)HALF * K * 2;
    const size_t tstepA = 2 * hstepA, tstepB = 2 * hstepB;
    const unsigned ldsw = (unsigned)wid * 1024u;
    const int aoff = lds_byte(wr * 64 + fr, fq * 8), boff = lds_byte(wc * 32 + fr, fq * 8);
#define PG8_SA(b, h) (((b) * 2 + (h)) * HTB)
#define PG8_SB(b, h) ((4 + (b) * 2 + (h)) * HTB)
#define PG8_STAGE(bufoff, gbase, voff) do { _Pragma("unroll") for (int _i = 0; _i < 2; ++_i) \
        __builtin_amdgcn_global_load_lds((const unsigned*)((const char*)(gbase) + (voff)[_i]), (PG8_LAS unsigned*)(lds + (bufoff) + ldsw + _i * 8192), 16, 0, 0); } while (0)
#define PG8_LDA(dst, b, h) do { _Pragma("unroll") for (int m = 0; m < 4; ++m) _Pragma("unroll") for (int k = 0; k < 2; ++k) dst[m][k] = *(const PG8_LAS bf16x8*)(lds + PG8_SA(b, h) + aoff + m * 2048 + k * 1024); } while (0)
#define PG8_LDB(dst, b, h) do { _Pragma("unroll") for (int n = 0; n < 2; ++n) _Pragma("unroll") for (int k = 0; k < 2; ++k) dst[n][k] = *(const PG8_LAS bf16x8*)(lds + PG8_SB(b, h) + boff + n * 2048 + k * 1024); } while (0)
#define PG8_MMA(ai, bj, At, Bt) do { __builtin_amdgcn_s_setprio(1); _Pragma("unroll") for (int m = 0; m < 4; ++m) _Pragma("unroll") for (int n = 0; n < 2; ++n) _Pragma("unroll") for (int k = 0; k < 2; ++k) \
        acc[ai][bj][m][n] = __builtin_amdgcn_mfma_f32_16x16x32_bf16(Bt[n][k], At[m][k], acc[ai][bj][m][n], 0, 0, 0); __builtin_amdgcn_s_setprio(0); } while (0)
#define PG8_WAIT_V(n) asm volatile("s_waitcnt vmcnt(" #n ")" ::: "memory")
#define PG8_WAIT_L(n) asm volatile("s_waitcnt lgkmcnt(" #n ")" ::: "memory")
#define PG8_BAR __builtin_amdgcn_s_barrier()
#define PG8_SCHED __builtin_amdgcn_sched_barrier(0)
    Unit cur, nxt; int ui = 0;
    if (!S.next(0, cur)) return;
    f32x4 acc[2][2][4][2];
#pragma unroll
    for (int a = 0; a < 2; ++a)
#pragma unroll
        for (int b = 0; b < 2; ++b)
#pragma unroll
            for (int m = 0; m < 4; ++m)
#pragma unroll
                for (int n = 0; n < 2; ++n) acc[a][b][m][n] = (f32x4){0.f, 0.f, 0.f, 0.f};
    bf16x8 At[4][2], B0[2][2], B1[2][2];
    const char* cA = (const char*)(cur.src == 0 ? g.A : (cur.src == 1 ? g.A2 : g.A3)) + (size_t)cur.pm * tstepA; const char* cB = (const char*)(cur.src == 0 ? g.Bt : (cur.src == 1 ? g.Bt2 : g.Bt3)) + (size_t)cur.pn * tstepB;
    S.a_ready(cur);
    if constexpr (SP2) {
        PG8_STAGE(PG8_SB(0, 0), cB, voffB); PG8_STAGE(PG8_SB(0, 1), cB + hstepB, voffB); PG8_STAGE(PG8_SA(0, 0), cA, voffA); PG8_STAGE(PG8_SA(0, 1), cA + hstepA, voffA);
        if (wr == 1) PG8_BAR;
        PG8_WAIT_V(2); PG8_BAR;
        PG8_STAGE(PG8_SB(1, 0), cB + kstep, voffB); PG8_STAGE(PG8_SA(1, 0), cA + kstep, voffA); PG8_STAGE(PG8_SB(1, 1), cB + hstepB + kstep, voffB);
        PG8_WAIT_V(6); PG8_BAR;
    } else {
        PG8_STAGE(PG8_SB(0, 0), cB, voffB); PG8_STAGE(PG8_SA(0, 0), cA, voffA); PG8_STAGE(PG8_SB(0, 1), cB + hstepB, voffB); PG8_STAGE(PG8_SA(0, 1), cA + hstepA, voffA);
        if (wr == 1) PG8_BAR;
        PG8_WAIT_V(4); PG8_BAR;
        PG8_STAGE(PG8_SB(1, 0), cB + kstep, voffB); PG8_STAGE(PG8_SA(1, 0), cA + kstep, voffA); PG8_STAGE(PG8_SB(1, 1), cB + hstepB + kstep, voffB);
        PG8_WAIT_V(6); PG8_BAR;
    }
    for (;;) {
        const bool has_next = S.next(ui + 1, nxt);
        const char* nA = has_next ? (const char*)(nxt.src == 0 ? g.A : (nxt.src == 1 ? g.A2 : g.A3)) + (size_t)nxt.pm * tstepA : cA; const char* nB = has_next ? (const char*)(nxt.src == 0 ? g.Bt : (nxt.src == 1 ? g.Bt2 : g.Bt3)) + (size_t)nxt.pn * tstepB : cB;
        for (int t = 0; t < nt; t += 2) {
            const bool last = (t == nt - 2);
            const char* a1 = cA + (size_t)(t + 1) * kstep;
            const char* a2 = last ? nA : cA + (size_t)(t + 2) * kstep; const char* b2 = last ? nB : cB + (size_t)(t + 2) * kstep;
            const char* a3 = a2 + kstep; const char* b3 = b2 + kstep;
            if (last && has_next) S.a_ready(nxt);
            if constexpr (SP2) {
            PG8_LDB(B0, 0, 0); PG8_LDB(B1, 0, 1); PG8_SCHED; PG8_LDA(At, 0, 0); PG8_STAGE(PG8_SA(1, 1), a1 + hstepA, voffA);
            PG8_WAIT_V(8); PG8_WAIT_L(0); PG8_BAR; PG8_MMA(0, 0, At, B0); PG8_MMA(0, 1, At, B1); PG8_BAR; PG8_SCHED;
            PG8_LDA(At, 0, 1); PG8_STAGE(PG8_SB(0, 0), b2, voffB); PG8_STAGE(PG8_SB(0, 1), b2 + hstepB, voffB); PG8_STAGE(PG8_SA(0, 0), a2, voffA);
            PG8_WAIT_V(8); PG8_WAIT_L(0); PG8_BAR; PG8_MMA(1, 0, At, B0); PG8_MMA(1, 1, At, B1); PG8_BAR; PG8_SCHED;
            PG8_LDB(B0, 1, 0); PG8_LDB(B1, 1, 1); PG8_SCHED; PG8_LDA(At, 1, 0); PG8_STAGE(PG8_SA(0, 1), a2 + hstepA, voffA);
            PG8_WAIT_V(8); PG8_WAIT_L(0); PG8_BAR; PG8_MMA(0, 0, At, B0); PG8_MMA(0, 1, At, B1); PG8_BAR; PG8_SCHED;
            PG8_LDA(At, 1, 1); PG8_STAGE(PG8_SB(1, 0), b3, voffB); PG8_STAGE(PG8_SB(1, 1), b3 + hstepB, voffB); PG8_STAGE(PG8_SA(1, 0), a3, voffA);
            PG8_WAIT_V(8); PG8_WAIT_L(0); PG8_BAR; PG8_MMA(1, 0, At, B0); PG8_MMA(1, 1, At, B1); PG8_BAR; PG8_SCHED;
            } else {
            PG8_LDB(B0, 0, 0); PG8_SCHED; PG8_LDA(At, 0, 0); PG8_STAGE(PG8_SA(1, 1), a1 + hstepA, voffA);
            PG8_WAIT_L(8); PG8_BAR; PG8_WAIT_L(0); PG8_MMA(0, 0, At, B0); PG8_BAR; PG8_SCHED;
            PG8_LDB(B1, 0, 1); PG8_STAGE(PG8_SB(0, 0), b2, voffB);
            PG8_BAR; PG8_WAIT_L(0); PG8_MMA(0, 1, At, B1); PG8_BAR;
            PG8_LDA(At, 0, 1); PG8_STAGE(PG8_SA(0, 0), a2, voffA);
            PG8_BAR; PG8_WAIT_L(0); PG8_MMA(1, 0, At, B0); PG8_BAR; PG8_SCHED;
            PG8_STAGE(PG8_SB(0, 1), b2 + hstepB, voffB);
            PG8_WAIT_V(6); PG8_BAR; PG8_MMA(1, 1, At, B1); PG8_BAR;
            PG8_LDB(B0, 1, 0); PG8_SCHED; PG8_LDA(At, 1, 0); PG8_STAGE(PG8_SA(0, 1), a2 + hstepA, voffA);
            PG8_WAIT_L(8); PG8_BAR; PG8_WAIT_L(0); PG8_MMA(0, 0, At, B0); PG8_BAR; PG8_SCHED;
            PG8_LDB(B1, 1, 1); PG8_STAGE(PG8_SB(1, 0), b3, voffB);
            PG8_BAR; PG8_WAIT_L(0); PG8_MMA(0, 1, At, B1); PG8_BAR;
            PG8_LDA(At, 1, 1); PG8_STAGE(PG8_SA(1, 0), a3, voffA);
            PG8_BAR; PG8_WAIT_L(0); PG8_MMA(1, 0, At, B0); PG8_BAR; PG8_SCHED;
            PG8_STAGE(PG8_SB(1, 1), b3 + hstepB, voffB);
            PG8_WAIT_V(6); PG8_BAR; PG8_MMA(1, 1, At, B1); PG8_BAR;
            }
        }
        if constexpr (ALIGN_EPI) { if (wr == 0) PG8_BAR; }
        if constexpr (!Epi::AFTER_DRAIN) { E(acc, cur, wr, wc, fr, fq); S.done(cur); }
        if (!has_next) break;
#pragma unroll
        for (int a = 0; a < 2; ++a)
#pragma unroll
            for (int b = 0; b < 2; ++b)
#pragma unroll
                for (int m = 0; m < 4; ++m)
#pragma unroll
                    for (int n = 0; n < 2; ++n) acc[a][b][m][n] = (f32x4){0.f, 0.f, 0.f, 0.f};
        cur = nxt; cA = nA; cB = nB; ++ui;
        if constexpr (ALIGN_EPI) { if (wr == 1) PG8_BAR; }
    }
    PG8_WAIT_V(0);
    if constexpr (!ALIGN_EPI) { if (wr == 0) PG8_BAR; }
    PG8_BAR;
    if constexpr (Epi::AFTER_DRAIN) { E.fused(acc, cur, wr, wc, fr, fq, lds, wid, lane); S.done(cur); }
#undef PG8_SA
#undef PG8_SB
#undef PG8_STAGE
#undef PG8_LDA
#undef PG8_LDB
#undef PG8_MMA
#undef PG8_WAIT_V
#undef PG8_WAIT_L
#undef PG8_BAR
#undef PG8_SCHED
}
}

#define LAS __attribute__((address_space(3)))
typedef unsigned short bf16;
typedef short bf16x8 __attribute__((ext_vector_type(8)));
typedef short s16x4 __attribute__((ext_vector_type(4)));
typedef short v4i16_t __attribute__((ext_vector_type(4)));
typedef float f32x16 __attribute__((ext_vector_type(16)));
typedef float f32x4 __attribute__((ext_vector_type(4)));
typedef float f32x2_t __attribute__((ext_vector_type(2)));
typedef __bf16 bf16x2_t __attribute__((ext_vector_type(2)));
typedef unsigned u32x4 __attribute__((ext_vector_type(4)));
typedef unsigned u32x2 __attribute__((ext_vector_type(2)));

constexpr int D = 1024, SEQ = 2048, NB = 8, M = NB * SEQ, NMEM = 256, MMEM = NB * NMEM, DIN = 6656, DFF = 2816;
constexpr int LDQ = 6656;
constexpr int C_AQ = 0, C_AK = 512, C_AV = 1024, C_BQ = 1536, C_BK = 3072, C_BV = 4608, C_CQ = 6144;
constexpr int C_GATE = 3072;
constexpr int C_H2 = 0, C_ACT = 1024;
constexpr float L2E = 1.4426950408889634f;
constexpr float EPS = 1e-6f;

constexpr size_t WS_WIN = 0;
constexpr size_t WS_WG = WS_WIN + (size_t)DIN * D * 2;
constexpr size_t WS_WMEM = WS_WG + (size_t)3 * D * D * 2;
constexpr size_t WS_WBR = WS_WMEM + (size_t)D * D * 2;
constexpr size_t WS_WOUT3 = WS_WBR + (size_t)3 * D * 512 * 2;
constexpr size_t WS_WGU = WS_WOUT3 + (size_t)D * 3 * D * 2;
constexpr size_t WS_WDN = WS_WGU + (size_t)2 * DFF * D * 2;
constexpr size_t WS_LB = WS_WDN + (size_t)D * DFF * 2;
constexpr size_t WS_R = WS_LB + (size_t)3 * M * 4 * 4;
constexpr size_t WS_BAR = WS_R + (size_t)M * LDQ * 2;
constexpr size_t WS_SSQ = WS_BAR + 16384;
constexpr size_t WS_END = WS_SSQ + (size_t)M * 4;
static_assert(WS_END <= (size_t)256 * 1024 * 1024, "d_ws map");
constexpr size_t DO_XN = 0;
constexpr size_t DO_MN = DO_XN + (size_t)M * D * 2;
constexpr size_t DO_CKV = DO_MN + (size_t)MMEM * D * 2;
static_assert(DO_CKV + (size_t)MMEM * D * 2 <= (size_t)M * D * 4, "d_out scratch map");

constexpr int LDS_BYTES = 155648;
constexpr int XCH_OFF = 131072, GT_OFF = 131072 + 8192;
constexpr int MISC_OFF = LDS_BYTES - 64;
constexpr int KP = 272, VP = 320;

__device__ __forceinline__ unsigned cvtpk(float lo, float hi) { f32x2_t v = {lo, hi}; bf16x2_t b = __builtin_convertvector(v, bf16x2_t); return __builtin_bit_cast(unsigned, b); }
__device__ __forceinline__ float wave_sum(float v) {
    v += pg8::shx<1>(v); v += pg8::shx<2>(v); v += pg8::shx<4>(v); v += pg8::shx<8>(v); v += pg8::shx<16>(v); v = pg8::sum_halves(v);
    return v;
}
__device__ __forceinline__ float wave_max(float v) {
    v = fmaxf(v, pg8::shx<1>(v)); v = fmaxf(v, pg8::shx<2>(v)); v = fmaxf(v, pg8::shx<4>(v)); v = fmaxf(v, pg8::shx<8>(v)); v = fmaxf(v, pg8::shx<16>(v)); v = pg8::max_halves(v);
    return v;
}
__device__ __forceinline__ float absmax_vec(const float* g, int n, int lane) {
    float v = fabsf(g[lane]); if (n > 64) v = fmaxf(v, fabsf(g[lane + 64]));
    return wave_max(v);
}

__device__ __forceinline__ void tr_item(const float* W, int N, int k0, int n0, bf16* WT, int dst_pitch, int dst_row0, int dst_k0, int ncopies, int copy_stride, LAS float* scr, int lane) {
#pragma unroll 8
    for (int i = 0; i < 32; ++i) { const int kk = 2 * i + (lane >> 5); scr[kk * 33 + (lane & 31)] = W[(size_t)(k0 + kk) * N + n0 + (lane & 31)]; }
    asm volatile("s_waitcnt lgkmcnt(0)" ::: "memory");
    const int c = lane & 7;
#pragma unroll
    for (int j = 0; j < 4; ++j) { const int n = (lane >> 3) + 8 * j; const LAS float* s = scr + (8 * c) * 33 + n;
        u32x4 o; o.x = cvtpk(s[0 * 33], s[1 * 33]); o.y = cvtpk(s[2 * 33], s[3 * 33]); o.z = cvtpk(s[4 * 33], s[5 * 33]); o.w = cvtpk(s[6 * 33], s[7 * 33]);
        bf16* dst = WT + (size_t)(dst_row0 + n0 + n) * dst_pitch + dst_k0 + k0 + 8 * c;
        for (int cp = 0; cp < ncopies; ++cp) *(u32x4*)(dst + (size_t)cp * copy_stride) = o; }
    asm volatile("s_waitcnt lgkmcnt(0)" ::: "memory");
}
__device__ __forceinline__ void rms_row_to_bf16(const float* xrow, const float* gain, bf16* orow, int lane) {
    const f32x4* xr = (const f32x4*)xrow + lane; const f32x4* gr = (const f32x4*)gain + lane;
    f32x4 v[4]; float s = 0.f;
#pragma unroll
    for (int j = 0; j < 4; ++j) { v[j] = xr[64 * j]; s += (v[j][0] * v[j][0] + v[j][1] * v[j][1]) + (v[j][2] * v[j][2] + v[j][3] * v[j][3]); }
    const float rstd = 1.f / sqrtf(wave_sum(s) * (1.f / 1024.f) + EPS);
    u32x2* o8 = (u32x2*)orow + lane;
#pragma unroll
    for (int j = 0; j < 4; ++j) { const f32x4 g = gr[64 * j]; u32x2 w; w.x = cvtpk(v[j][0] * rstd * g[0], v[j][1] * rstd * g[1]); w.y = cvtpk(v[j][2] * rstd * g[2], v[j][3] * rstd * g[3]); o8[64 * j] = w; }
}

__device__ __forceinline__ s16x4 vtr(const LAS char* p) { return __builtin_bit_cast(s16x4, __builtin_amdgcn_ds_read_tr16_b64_v4i16((LAS v4i16_t*)p)); }

template <int NK>
__device__ __forceinline__ void qk32(f32x16& S, const LAS char* Kp, const bf16x8* Q, int ks0, int r32, int hi) {
    const LAS char* kb = Kp + r32 * KP + hi * 16 + ks0 * 32;
#pragma unroll
    for (int ks = 0; ks < NK; ++ks) { const bf16x8 kf = *(const LAS bf16x8*)(kb + ks * 32); S = __builtin_amdgcn_mfma_f32_32x32x16_bf16(kf, Q[ks0 + ks], S, 0, 0, 0); }
}
__device__ __forceinline__ void pv32(f32x16 (&O)[4], const bf16x8 (&P)[2], const LAS char* Vp, int lane) {
    const int i = lane & 15, q = i >> 2, p = i & 3, dsel = (lane >> 4) & 1, h = lane >> 5;
    const LAS char* vb = Vp + (4 * h + q) * VP + (16 * dsel + 4 * p) * 2;
#pragma unroll
    for (int s = 0; s < 2; ++s)
#pragma unroll
        for (int db = 0; db < 4; ++db) {
            const s16x4 lo = vtr(vb + (16 * s) * VP + db * 64), hi4 = vtr(vb + (16 * s + 8) * VP + db * 64);
            const bf16x8 a = (bf16x8){lo[0], lo[1], lo[2], lo[3], hi4[0], hi4[1], hi4[2], hi4[3]};
            O[db] = __builtin_amdgcn_mfma_f32_32x32x16_bf16(a, P[s], O[db], 0, 0, 0);
        }
}
struct VFrag { bf16x8 a[2][4]; };
__device__ __forceinline__ void vload32(VFrag& f, const LAS char* Vp, int lane) {
    const int i = lane & 15, q = i >> 2, p = i & 3, dsel = (lane >> 4) & 1, h = lane >> 5;
    const LAS char* vb = Vp + (4 * h + q) * VP + (16 * dsel + 4 * p) * 2;
#pragma unroll
    for (int s = 0; s < 2; ++s)
#pragma unroll
        for (int db = 0; db < 4; ++db) { const s16x4 lo = vtr(vb + (16 * s) * VP + db * 64), hi4 = vtr(vb + (16 * s + 8) * VP + db * 64);
            f.a[s][db] = (bf16x8){lo[0], lo[1], lo[2], lo[3], hi4[0], hi4[1], hi4[2], hi4[3]}; }
}
template <int SS>
__device__ __forceinline__ void vload16(VFrag& f, const LAS char* Vp, int lane) {
    const int i = lane & 15, q = i >> 2, p = i & 3, dsel = (lane >> 4) & 1, h = lane >> 5;
    const LAS char* vb = Vp + (4 * h + q) * VP + (16 * dsel + 4 * p) * 2;
#pragma unroll
    for (int db = 0; db < 4; ++db) { const s16x4 lo = vtr(vb + (16 * SS) * VP + db * 64), hi4 = vtr(vb + (16 * SS + 8) * VP + db * 64);
        f.a[SS][db] = (bf16x8){lo[0], lo[1], lo[2], lo[3], hi4[0], hi4[1], hi4[2], hi4[3]}; }
}
__device__ __forceinline__ void pvmm32(f32x16 (&O)[4], const bf16x8 (&P)[2], const VFrag& f) {
#pragma unroll
    for (int s = 0; s < 2; ++s)
#pragma unroll
        for (int db = 0; db < 4; ++db) O[db] = __builtin_amdgcn_mfma_f32_32x32x16_bf16(f.a[s][db], P[s], O[db], 0, 0, 0);
}
template <int NK>
__device__ __forceinline__ void kload32(bf16x8 (&kf)[NK], const LAS char* Kp, int r32, int hi) {
    const LAS char* kb = Kp + r32 * KP + hi * 16;
#pragma unroll
    for (int ks = 0; ks < NK; ++ks) kf[ks] = *(const LAS bf16x8*)(kb + ks * 32);
}
template <int NK>
__device__ __forceinline__ void qkmm32(f32x16& S, const bf16x8 (&kf)[NK], const bf16x8* Q) {
#pragma unroll
    for (int ks = 0; ks < NK; ++ks) S = __builtin_amdgcn_mfma_f32_32x32x16_bf16(kf[ks], Q[ks], S, 0, 0, 0);
}
#define SCHED_FENCE() __builtin_amdgcn_sched_barrier(0)
template <int MODE>
__device__ __forceinline__ void soft32(const f32x16& S, bf16x8 (&P)[2], float& l, float dbase, float nslope) {
    float p[16];
#pragma unroll
    for (int r = 0; r < 16; ++r) {
        float s = S[r];
        if (MODE >= 1) { const float a = fabsf(dbase - (float)((r & 3) + 8 * (r >> 2))); s = fmaf(nslope, a, s); float e = __builtin_amdgcn_exp2f(s); if (MODE == 2) e = (a <= 64.f) ? e : 0.f; p[r] = e; }
        else p[r] = __builtin_amdgcn_exp2f(s);
        l += p[r];
    }
#pragma unroll
    for (int s = 0; s < 2; ++s) { u32x4 w; w.x = cvtpk(p[8 * s + 0], p[8 * s + 1]); w.y = cvtpk(p[8 * s + 2], p[8 * s + 3]); w.z = cvtpk(p[8 * s + 4], p[8 * s + 5]); w.w = cvtpk(p[8 * s + 6], p[8 * s + 7]); P[s] = __builtin_bit_cast(bf16x8, w); }
}
__device__ __forceinline__ void zero16(f32x16& v) {
#pragma unroll
    for (int r = 0; r < 16; ++r) v[r] = 0.f;
}

template <int NC, bool DIAG>
__device__ __forceinline__ void attn_tile(f32x16 (&O)[4], float& l, const bf16x8* Q, const LAS char* Kb, const LAS char* Vb, int r32, int hi, int lane, float qd, int k0, int qw, float nslope, float negM0) {
    constexpr int NQ = (NC == 2) ? 4 : 8;
    f32x16 S0, S1; bf16x8 P0[2], P1[2];
    const int k1 = k0 + 32;
    if (NC == 2) {
        const float ns0 = (k0 < qw) ? nslope : ((k0 > qw) ? -nslope : 0.f), ns1 = (k1 < qw) ? nslope : ((k1 > qw) ? -nslope : 0.f);
        const float b0 = fmaf(ns0, qd - (float)k0, negM0), b1 = fmaf(ns1, qd - (float)k1, negM0);
#pragma unroll
        for (int r = 0; r < 16; ++r) { S0[r] = fmaf(-ns0, (float)((r & 3) + 8 * (r >> 2)), b0); S1[r] = fmaf(-ns1, (float)((r & 3) + 8 * (r >> 2)), b1); }
    } else {
#pragma unroll
        for (int r = 0; r < 16; ++r) { S0[r] = negM0; S1[r] = negM0; }
    }
    VFrag vf0, vf1;
    if (NC == 2) {
        bf16x8 kf0[NQ], kf1[NQ];
        kload32<NQ>(kf0, Kb, r32, hi);
        SCHED_FENCE();
        qkmm32<NQ>(S0, kf0, Q);
        kload32<NQ>(kf1, Kb + 32 * KP, r32, hi);
        vload16<0>(vf0, Vb, lane);
        SCHED_FENCE();
        qkmm32<NQ>(S1, kf1, Q);
        if (DIAG) { const float nd = (k0 == qw) ? nslope : 0.f;
#pragma unroll
            for (int r = 0; r < 16; ++r) S0[r] = fmaf(nd, fabsf(qd - (float)k0 - (float)((r & 3) + 8 * (r >> 2))), S0[r]); }
        soft32<0>(S0, P0, l, 0.f, 0.f);
        vload16<1>(vf0, Vb, lane);
        SCHED_FENCE();
    } else {
        bf16x8 kf[NQ];
        kload32<NQ>(kf, Kb, r32, hi);
        SCHED_FENCE();
        qkmm32<NQ>(S0, kf, Q);
        kload32<NQ>(kf, Kb + 32 * KP, r32, hi);
        vload32(vf0, Vb, lane);
        SCHED_FENCE();
        qkmm32<NQ>(S1, kf, Q);
        soft32<0>(S0, P0, l, 0.f, 0.f);
        SCHED_FENCE();
    }
    pvmm32(O, P0, vf0);
    if (NC == 2 && DIAG) { const float nd = (k1 == qw) ? nslope : 0.f;
#pragma unroll
        for (int r = 0; r < 16; ++r) S1[r] = fmaf(nd, fabsf(qd - (float)k1 - (float)((r & 3) + 8 * (r >> 2))), S1[r]); }
    soft32<0>(S1, P1, l, 0.f, 0.f);
    if (NC == 2) {
    vload16<0>(vf1, Vb + 32 * VP, lane);
    SCHED_FENCE();
    vload16<1>(vf1, Vb + 32 * VP, lane);
    } else {
    vload32(vf1, Vb + 32 * VP, lane);
    SCHED_FENCE();
    }
    pvmm32(O, P1, vf1);
}

template <int NC>
__device__ __forceinline__ void attn_shared_unit(LAS char* lds, bf16* qbase, const bf16* Kg, const bf16* Vg, int kvp, int nt, int qpos, int qw, float nslope, float negM0, float lam, const float* subln, int wave_id) {
    const int wv = wave_id, tid = pg8::tid_fresh(wave_id);
    const int lane = tid & 63, r32 = lane & 31, hi = lane >> 5;
    const int cm = (NC == 2) ? (wv & 1) : 0;
    constexpr int NQ = (NC == 2) ? 4 : 8;
    bf16x8 Q[NQ];
    { const bf16* qrow0 = qbase + (size_t)r32 * LDQ;
#pragma unroll
    for (int ks = 0; ks < NQ; ++ks) Q[ks] = *(const bf16x8*)(qrow0 + cm * 64 + 16 * ks + 8 * hi); }
    f32x16 O[4]; float l = 0.f;
#pragma unroll
    for (int db = 0; db < 4; ++db) zero16(O[db]);
    const int lrow = tid >> 3, lcb = (tid & 7) * 32;
    const char* kgp = (const char*)(Kg + (size_t)lrow * kvp) + lcb; const char* vgp = (const char*)(Vg + (size_t)lrow * kvp) + lcb;
    const size_t tstep = (size_t)64 * kvp * 2;
    u32x4 ka0, ka1, va0, va1, kb0, kb1, vb0, vb1;
#define LOADA(tt) do { const char* kp_ = kgp + (size_t)(tt) * tstep; const char* vp_ = vgp + (size_t)(tt) * tstep; ka0 = *(const u32x4*)kp_; ka1 = *(const u32x4*)(kp_ + 16); va0 = *(const u32x4*)vp_; va1 = *(const u32x4*)(vp_ + 16); } while (0)
#define LOADB(tt) do { const char* kp_ = kgp + (size_t)(tt) * tstep; const char* vp_ = vgp + (size_t)(tt) * tstep; kb0 = *(const u32x4*)kp_; kb1 = *(const u32x4*)(kp_ + 16); vb0 = *(const u32x4*)vp_; vb1 = *(const u32x4*)(vp_ + 16); } while (0)
#define WRITEA(buf) do { LAS char* kw_ = lds + (buf) * BUFB + lrow * KP + lcb; LAS char* vw_ = lds + (buf) * BUFB + 64 * KP + lrow * VP + lcb; *(LAS u32x4*)kw_ = ka0; *(LAS u32x4*)(kw_ + 16) = ka1; *(LAS u32x4*)vw_ = va0; *(LAS u32x4*)(vw_ + 16) = va1; } while (0)
#define WRITEB(buf) do { LAS char* kw_ = lds + (buf) * BUFB + lrow * KP + lcb; LAS char* vw_ = lds + (buf) * BUFB + 64 * KP + lrow * VP + lcb; *(LAS u32x4*)kw_ = kb0; *(LAS u32x4*)(kw_ + 16) = kb1; *(LAS u32x4*)vw_ = vb0; *(LAS u32x4*)(vw_ + 16) = vb1; } while (0)
    constexpr int BUFB = 64 * KP + 64 * VP;
    const float qd = (float)(qpos - 4 * hi);
    const int td = qw >> 6;
    if (NC == 2) {
    LOADA(0); LOADB(1);
    __syncthreads();
    WRITEA(0);
    __syncthreads();
#pragma unroll 1
    for (int t = 0; t < nt; t += 2) {
        {
            if (t + 2 < nt) LOADA(t + 2);
            int k0v = t * 64; asm volatile("" : "+s"(k0v));
            const LAS char* Kb = lds + cm * 128; const LAS char* Vb = lds + 64 * KP;
            if (t == td) attn_tile<NC, true>(O, l, Q, Kb, Vb, r32, hi, lane, qd, k0v, qw, nslope, negM0);
            else attn_tile<NC, false>(O, l, Q, Kb, Vb, r32, hi, lane, qd, k0v, qw, nslope, negM0);
            WRITEB(1);
            __syncthreads();
        }
        {
            if (t + 3 < nt) LOADB(t + 3);
            int k0v = (t + 1) * 64; asm volatile("" : "+s"(k0v));
            const LAS char* Kb = lds + BUFB + cm * 128; const LAS char* Vb = lds + BUFB + 64 * KP;
            if (t + 1 == td) attn_tile<NC, true>(O, l, Q, Kb, Vb, r32, hi, lane, qd, k0v, qw, nslope, negM0);
            else attn_tile<NC, false>(O, l, Q, Kb, Vb, r32, hi, lane, qd, k0v, qw, nslope, negM0);
            if (t + 2 < nt) WRITEA(0);
            __syncthreads();
        }
    }
    } else {
    LOADA(0);
    __syncthreads();
    WRITEA(0);
    __syncthreads();
#pragma unroll 1
    for (int t = 0; t < nt; ++t) {
        const bool more = (t + 1 < nt);
        if (more) LOADA(t + 1);
        int k0v = t * 64; asm volatile("" : "+s"(k0v));
        const LAS char* Kb = lds + (t & 1) * BUFB; const LAS char* Vb = lds + (t & 1) * BUFB + 64 * KP;
        attn_tile<NC, false>(O, l, Q, Kb, Vb, r32, hi, lane, qd, k0v, qw, nslope, negM0);
        if (more) WRITEA((t + 1) & 1);
        __syncthreads();
    }
    }
#undef LOADA
#undef LOADB
#undef WRITEA
#undef WRITEB
    const int lane2 = pg8::lane_id_fresh(), hi2 = lane2 >> 5;
    bf16* qrow = qbase + (size_t)(lane2 & 31) * LDQ;
    l = pg8::sum_halves(l);
    if (NC == 2) {
        LAS float* XO = (LAS float*)lds + (wv >> 1) * 4096 + lane2;
        if (cm == 1) { const float i2 = *(const LAS float*)(lds + (LDS_BYTES - 64 + 32)) * __builtin_amdgcn_rcpf(l);
#pragma unroll
            for (int db = 0; db < 4; ++db)
#pragma unroll
                for (int r = 0; r < 16; ++r) XO[(db * 16 + r) * 64] = O[db][r] * i2; }
        __syncthreads();
        if (cm == 0) {
            const float i1 = 1.f / l; float ss = 0.f;
#pragma unroll
            for (int db = 0; db < 4; ++db)
#pragma unroll
                for (int r = 0; r < 16; ++r) { const float o = O[db][r] * i1 - XO[(db * 16 + r) * 64]; O[db][r] = o; ss += o * o; }
            ss = pg8::sum_halves(ss);
            const float rstd = (1.f / sqrtf(ss * (1.f / 128.f) + EPS)) * 0.8f;
#pragma unroll
            for (int db = 0; db < 4; ++db)
#pragma unroll
                for (int g4 = 0; g4 < 4; ++g4) { const int d = 32 * db + 8 * g4 + 4 * hi2; const f32x4 gn = *(const f32x4*)(subln + d);
                    u32x2 w; w.x = cvtpk(O[db][4 * g4 + 0] * rstd * gn[0], O[db][4 * g4 + 1] * rstd * gn[1]); w.y = cvtpk(O[db][4 * g4 + 2] * rstd * gn[2], O[db][4 * g4 + 3] * rstd * gn[3]);
                    *(u32x2*)(qrow + d) = w; }
        }
    } else {
        const float i1 = 1.f / l;
#pragma unroll
        for (int db = 0; db < 4; ++db)
#pragma unroll
            for (int g4 = 0; g4 < 4; ++g4) { const int d = 32 * db + 8 * g4 + 4 * hi2;
                u32x2 w; w.x = cvtpk(O[db][4 * g4 + 0] * i1, O[db][4 * g4 + 1] * i1); w.y = cvtpk(O[db][4 * g4 + 2] * i1, O[db][4 * g4 + 3] * i1);
                *(u32x2*)(qrow + d) = w; }
    }
}

__device__ __forceinline__ void attn_b_wave_unit(LAS char* wl, bf16* R, float* LB, int b, int g, int j, int idx, float negM0, int lane_in) {
    int lane = lane_in; asm volatile("" : "+v"(lane));
    const int r32 = lane & 31, hi = lane >> 5;
    const int dil = (g == 0) ? 1 : ((g == 1) ? 4 : 16), nqb = 64 / dil, sub_len = SEQ / dil;
    const int res = idx / nqb, qb = idx % nqb;
    const float slope = __builtin_amdgcn_exp2f(-8.f * (float)(g * 4 + j + 1) / 12.f);
    const float nslope = -slope * (float)dil * L2E;
    const int qsub = 32 * qb + r32;
    const size_t qrow_i = (size_t)b * SEQ + (size_t)qsub * dil + res;
    const int hcol = (g * 4 + j) * 128;
    bf16* qrow = R + qrow_i * LDQ + C_BQ + hcol;
    bf16x8 Q[8];
#pragma unroll
    for (int ks = 0; ks < 8; ++ks) Q[ks] = *(const bf16x8*)(qrow + 16 * ks + 8 * hi);
    f32x16 O[4]; float l = 0.f;
#pragma unroll
    for (int db = 0; db < 4; ++db) zero16(O[db]);
    const int lr = lane >> 4, lc = (lane & 15) * 8;
#pragma unroll 1
    for (int kt = 0; kt < 5; ++kt) {
        const int kb = 32 * qb - 64 + 32 * kt;
        if (kb < 0 || kb >= sub_len) continue;
        u32x4 kr[8], vr[8];
#pragma unroll
        for (int n = 0; n < 8; ++n) { const size_t krow = (size_t)b * SEQ + (size_t)(kb + 4 * n + lr) * dil + res;
            kr[n] = *(const u32x4*)(R + krow * LDQ + C_BK + hcol + lc); vr[n] = *(const u32x4*)(R + krow * LDQ + C_BV + hcol + lc); }
#pragma unroll
        for (int n = 0; n < 8; ++n) { *(LAS u32x4*)(wl + (4 * n + lr) * KP + lc * 2) = kr[n]; *(LAS u32x4*)(wl + 32 * KP + (4 * n + lr) * VP + lc * 2) = vr[n]; }
        asm volatile("s_waitcnt lgkmcnt(0)" ::: "memory");
        f32x16 S;
#pragma unroll
        for (int r = 0; r < 16; ++r) S[r] = negM0;
        qk32<8>(S, wl, Q, 0, r32, hi);
        bf16x8 P[2];
        soft32<2>(S, P, l, (float)(qsub - (kb + 4 * hi)), nslope);
        pv32(O, P, wl + 32 * KP, lane);
        asm volatile("s_waitcnt lgkmcnt(0)" ::: "memory");
    }
    l = pg8::sum_halves(l);
    const float i1 = 1.f / l;
#pragma unroll
    for (int db = 0; db < 4; ++db)
#pragma unroll
        for (int g4 = 0; g4 < 4; ++g4) { const int d = 32 * db + 8 * g4 + 4 * hi;
            u32x2 w; w.x = cvtpk(O[db][4 * g4 + 0] * i1, O[db][4 * g4 + 1] * i1); w.y = cvtpk(O[db][4 * g4 + 2] * i1, O[db][4 * g4 + 3] * i1);
            *(u32x2*)(qrow + d) = w; }
    if (hi == 0) LB[((size_t)g * M + qrow_i) * 4 + j] = l;
}

template <bool SEG2>
__device__ __forceinline__ void attn_b_block_unit(LAS char* lds, bf16* R, float* LB, int b, int g, int j, int res0, int q0, int dil, float nslope, float negM0, int wave_id) {
    const int tid = pg8::tid_fresh(wave_id), lane = tid & 63, r32 = lane & 31, hi = lane >> 5;
    const int sub_len = SEQ / dil, hcol = (g * 4 + j) * 128;
    const int wres = SEG2 ? res0 + (wave_id >> 2) : res0;
    const int qs = SEG2 ? 32 * (wave_id & 3) : q0 + 32 * wave_id;
    const size_t rowb = (size_t)b * SEQ;
    bf16x8 Q[8];
    { const bf16* qr = R + (rowb + (size_t)(qs + r32) * dil + wres) * LDQ + C_BQ + hcol;
#pragma unroll
      for (int ks = 0; ks < 8; ++ks) Q[ks] = *(const bf16x8*)(qr + 16 * ks + 8 * hi); }
    f32x16 O[4]; float l = 0.f;
#pragma unroll
    for (int db = 0; db < 4; ++db) zero16(O[db]);
    constexpr int TK = SEG2 ? 32 : 64;
    const int k_lo = SEG2 ? 0 : ((q0 - 64 > 0) ? q0 - 64 : 0), k_hi = SEG2 ? 128 : ((q0 + 320 < sub_len) ? q0 + 320 : sub_len);
    const int nsteps = (k_hi - k_lo) / TK;
    const int lrow = tid >> 3, lcb = (tid & 7) * 32;
    const int lres = SEG2 ? res0 + (lrow >> 5) : res0, lkey = SEG2 ? (lrow & 31) : lrow;
    const char* kg = (const char*)(R + (rowb + (size_t)(k_lo + lkey) * dil + lres) * LDQ + C_BK + hcol) + lcb;
    const size_t sstep = (size_t)TK * dil * LDQ * 2;
    constexpr int VOFF = (C_BV - C_BK) * 2, BUFB = 64 * KP + 64 * VP;
    u32x4 kr0, kr1, vr0, vr1;
    kr0 = *(const u32x4*)kg; kr1 = *(const u32x4*)(kg + 16); vr0 = *(const u32x4*)(kg + VOFF); vr1 = *(const u32x4*)(kg + VOFF + 16);
    __syncthreads();
    { LAS char* kw = lds + lrow * KP + lcb; LAS char* vw = lds + 64 * KP + lrow * VP + lcb;
      *(LAS u32x4*)kw = kr0; *(LAS u32x4*)(kw + 16) = kr1; *(LAS u32x4*)vw = vr0; *(LAS u32x4*)(vw + 16) = vr1; }
    __syncthreads();
    const float qf = (float)(qs + r32 - 4 * hi);
#pragma unroll 1
    for (int s = 0; s < nsteps; ++s) {
        const bool more = (s + 1 < nsteps);
        if (more) { const char* kp = kg + (size_t)(s + 1) * sstep; kr0 = *(const u32x4*)kp; kr1 = *(const u32x4*)(kp + 16); vr0 = *(const u32x4*)(kp + VOFF); vr1 = *(const u32x4*)(kp + VOFF + 16); }
        const int kb = k_lo + s * TK;
        const LAS char* Kb = lds + (s & 1) * BUFB; const LAS char* Vb = Kb + 64 * KP;
#pragma unroll
        for (int hh = 0; hh < (SEG2 ? 1 : 2); ++hh) {
            const int row0 = SEG2 ? 32 * (wave_id >> 2) : 32 * hh, kbase = SEG2 ? kb : kb + 32 * hh;
            if (kbase + 31 >= qs - 64 && kbase <= qs + 95) {
                f32x16 S;
#pragma unroll
                for (int r = 0; r < 16; ++r) S[r] = negM0;
                qk32<8>(S, Kb + row0 * KP, Q, 0, r32, hi);
                bf16x8 P[2];
                soft32<2>(S, P, l, qf - (float)kbase, nslope);
                pv32(O, P, Vb + row0 * VP, lane);
            }
        }
        if (more) { LAS char* kw = lds + ((s + 1) & 1) * BUFB + lrow * KP + lcb; LAS char* vw = lds + ((s + 1) & 1) * BUFB + 64 * KP + lrow * VP + lcb;
            *(LAS u32x4*)kw = kr0; *(LAS u32x4*)(kw + 16) = kr1; *(LAS u32x4*)vw = vr0; *(LAS u32x4*)(vw + 16) = vr1; }
        __syncthreads();
    }
    const int lane2 = pg8::lane_id_fresh(), hi2 = lane2 >> 5;
    const size_t qrow_i = rowb + (size_t)(qs + (lane2 & 31)) * dil + wres;
    bf16* qrow = R + qrow_i * LDQ + C_BQ + hcol;
    l = pg8::sum_halves(l);
    const float i1 = 1.f / l;
#pragma unroll
    for (int db = 0; db < 4; ++db)
#pragma unroll
        for (int g4 = 0; g4 < 4; ++g4) { const int d = 32 * db + 8 * g4 + 4 * hi2;
            u32x2 w; w.x = cvtpk(O[db][4 * g4 + 0] * i1, O[db][4 * g4 + 1] * i1); w.y = cvtpk(O[db][4 * g4 + 2] * i1, O[db][4 * g4 + 3] * i1);
            *(u32x2*)(qrow + d) = w; }
    if (hi2 == 0) LB[((size_t)g * M + qrow_i) * 4 + j] = l;
}

#define XB_TMO      128
#define XB_XCNT(j)  (256  + 64 * (j))
#define XB_XSUB(j)  (1280 + 64 * (j))
#define XB_XGEN(j)  (2304 + 64 * (j))
#define XB_TOP      3328
#define XB_TOPGEN   3392
#define XCD_BAR_WORDS 3456
#define XB_SPIN_CAP (1u << 18)

__device__ __forceinline__ unsigned xb_ld(unsigned* p)              { return __hip_atomic_load(p, __ATOMIC_RELAXED, __HIP_MEMORY_SCOPE_AGENT); }
__device__ __forceinline__ unsigned xb_add(unsigned* p, unsigned v) { return __hip_atomic_fetch_add(p, v, __ATOMIC_RELAXED, __HIP_MEMORY_SCOPE_AGENT); }
__device__ __forceinline__ unsigned xb_xcc_id() { return (unsigned)__builtin_amdgcn_s_getreg((3 << 11) | 20) & 0xFu; }
#define XB_SPIN(cond, bar) do { unsigned _sp = 0; while (cond) { __builtin_amdgcn_s_sleep(1); \
    if ((++_sp & 255u) == 0u) { if (xb_ld(&(bar)[XB_TMO])) break; if (_sp > XB_SPIN_CAP) { atomicAdd(&(bar)[XB_TMO], 1u); break; } } } } while (0)

struct XcdBarrier {
    unsigned* bar; unsigned x;
    volatile LAS unsigned* st;
};

__device__ __forceinline__ XcdBarrier xcd_barrier_post(unsigned* bar, volatile LAS unsigned* st) {
    XcdBarrier b; b.bar = bar; b.x = xb_xcc_id(); b.st = st;
    if (threadIdx.x == 0) (void)xb_add(&bar[XB_XCNT(b.x)], 1u);
    return b;
}
__device__ __forceinline__ void xcd_barrier_complete(unsigned* bar, unsigned x, unsigned& nloc, unsigned& nx) {
    const unsigned G = gridDim.x * gridDim.y * gridDim.z;
    unsigned sum, cnt, mine, sp = 0u;
    for (;;) {
        sum = 0u; cnt = 0u; mine = 0u;
#pragma unroll
        for (unsigned j = 0; j < 16; ++j) { const unsigned c = xb_ld(&bar[XB_XCNT(j)]); sum += c; cnt += (c > 0u) ? 1u : 0u; mine = (j == x) ? c : mine; }
        if (sum == G) break;
        __builtin_amdgcn_s_sleep(1);
        if ((++sp & 255u) == 0u) { if (xb_ld(&bar[XB_TMO])) break; if (sp > XB_SPIN_CAP) { atomicAdd(&bar[XB_TMO], 1u); break; } }
    }
    nloc = mine > 0u ? mine : 1u; nx = cnt > 0u ? cnt : 1u;
}

__device__ __forceinline__ void xcd_barrier(const XcdBarrier& b, int wave_id) {
    asm volatile("s_waitcnt vmcnt(0)" ::: "memory");
    __syncthreads();
    if (pg8::tid_fresh(wave_id) == 0) {
        unsigned* bar = b.bar;
        __builtin_amdgcn_s_waitcnt(0);
        unsigned nloc = b.st[0], nx = b.st[1];
        if (nloc == 0u) { xcd_barrier_complete(bar, b.x, nloc, nx); b.st[0] = nloc; b.st[1] = nx; }
        const unsigned old = xb_add(&bar[XB_XSUB(b.x)], 1u);
        const unsigned gen = old / nloc;
        if (old + 1u == (gen + 1u) * nloc) {
            __builtin_amdgcn_fence(__ATOMIC_RELEASE, "agent");
            asm volatile("s_waitcnt vmcnt(0)" ::: "memory");
            const unsigned og = xb_add(&bar[XB_TOP], 1u);
            const unsigned tg = og / nx;
            if (og + 1u == (tg + 1u) * nx) xb_add(&bar[XB_TOPGEN], 1u);
            else XB_SPIN(xb_ld(&bar[XB_TOPGEN]) == tg, bar);
            __builtin_amdgcn_fence(__ATOMIC_ACQUIRE, "agent");
            xb_add(&bar[XB_XGEN(b.x)], 1u);
            asm volatile("s_waitcnt vmcnt(0)" ::: "memory");
        } else {
            XB_SPIN(xb_ld(&bar[XB_XGEN(b.x)]) == gen, bar);
            __builtin_amdgcn_fence(__ATOMIC_ACQUIRE, "agent");
            asm volatile("s_waitcnt vmcnt(0)" ::: "memory");
        }
    }
    __syncthreads();
}

struct Args { const float* in[25]; float* out; unsigned char* ws; };

__global__ void __launch_bounds__(512, 2) fwd_megakernel(Args a) {
    extern __shared__ __attribute__((aligned(16))) unsigned char lds_raw[];
    LAS unsigned char* lds = (LAS unsigned char*)lds_raw;
    cg::grid_group grid = cg::this_grid();
    const int wave = __builtin_amdgcn_readfirstlane((int)threadIdx.x >> 6);
#define FRESH_LANE const int lane = pg8::lane_id_fresh();
    const int G = gridDim.x, bid = blockIdx.x;
    const int gw = bid * 8 + wave, NGW = G * 8;
    unsigned char* ws = a.ws;
    const float* x = a.in[0]; const float* mem = a.in[1];
    bf16* W_IN = (bf16*)(ws + WS_WIN); bf16* W_G = (bf16*)(ws + WS_WG); bf16* W_MEM = (bf16*)(ws + WS_WMEM); bf16* W_BR = (bf16*)(ws + WS_WBR);
    bf16* W_OUT = (bf16*)(ws + WS_WOUT3); bf16* W_GU = (bf16*)(ws + WS_WGU); bf16* W_DN = (bf16*)(ws + WS_WDN);
    float* LB = (float*)(ws + WS_LB); bf16* R = (bf16*)(ws + WS_R);
    unsigned char* dob = (unsigned char*)a.out;
    bf16* XN = (bf16*)(dob + DO_XN); bf16* MN = (bf16*)(dob + DO_MN); bf16* CKV = (bf16*)(dob + DO_CKV);

    volatile LAS unsigned* MISC = (volatile LAS unsigned*)(lds + MISC_OFF);
    unsigned* barw = (unsigned*)(ws + WS_BAR);
    if (threadIdx.x < 16) MISC[threadIdx.x] = 0u;
    if (a.ws == nullptr) grid.sync();
    XcdBarrier bar = xcd_barrier_post(barw, MISC);
    __syncthreads();
    {
        FRESH_LANE
        LAS float* scr = (LAS float*)(lds + wave * 8704);
        constexpr int I_IN = 16 * (DIN / 32), I_G = 16 * (3 * D / 32), I_MEM = 16 * (D / 32), I_BR = 8 * (D / 32), I_OUT = 16 * (D / 32), I_FF = 16 * (DFF / 32), I_DN = (DFF / 64) * (D / 32);
        constexpr int NITEMS = I_IN + I_G + I_MEM + 3 * I_BR + I_OUT + 2 * I_FF + I_DN;
        for (int it = gw; it < NITEMS; it += NGW) {
            int r = it;
            if (r < I_IN) { const int nb = DIN / 32; tr_item(a.in[3], DIN, 64 * (r / nb), 32 * (r % nb), W_IN, D, 0, 0, 1, 0, scr, lane); continue; } r -= I_IN;
            if (r < I_G) { const int nb = 3 * D / 32; tr_item(a.in[4], 3 * D, 64 * (r / nb), 32 * (r % nb), W_G, D, 0, 0, 1, 0, scr, lane); continue; } r -= I_G;
            if (r < I_MEM) { const int nb = D / 32; tr_item(a.in[16], D, 64 * (r / nb), 32 * (r % nb), W_MEM, D, 0, 0, 1, 0, scr, lane); continue; } r -= I_MEM;
            if (r < 3 * I_BR) { const int gI = r / I_BR, rr = r % I_BR, nb = D / 32; tr_item(a.in[19] + (size_t)gI * 512 * D, D, 64 * (rr / nb), 32 * (rr % nb), W_BR + (size_t)gI * D * 512, 512, 0, 0, 1, 0, scr, lane); continue; } r -= 3 * I_BR;
            if (r < I_OUT) { const int nb = D / 32; tr_item(a.in[20], D, 64 * (r / nb), 32 * (r % nb), W_OUT, D, 0, 0, 1, 0, scr, lane); continue; } r -= I_OUT;
            if (r < 2 * I_FF) { const int s = r / I_FF, rr = r % I_FF, nb = DFF / 32; const int n0 = 32 * (rr % nb);
                tr_item(a.in[22 + s], DFF, 64 * (rr / nb), n0, W_GU, D, 256 * (n0 / 128) + 128 * s + (n0 % 128) - n0, 0, 1, 0, scr, lane); continue; } r -= 2 * I_FF;
            { const int nb = D / 32; tr_item(a.in[24], D, 64 * (r / nb), 32 * (r % nb), W_DN, DFF, 0, 0, 1, 0, scr, lane); }
        }
        { float* SSQ0 = (float*)(ws + WS_SSQ); for (int i = gw * 64 + lane; i < M; i += NGW * 64) SSQ0[i] = 0.f; }
        for (int m = gw; m < M + MMEM; m += NGW) {
            if (m < M) rms_row_to_bf16(x + (size_t)m * D, a.in[2], XN + (size_t)m * D, lane);
            else rms_row_to_bf16(mem + (size_t)(m - M) * D, a.in[15], MN + (size_t)(m - M) * D, lane);
        }
    }
    xcd_barrier(bar, wave);

    {
        LAS float* GT = (LAS float*)(lds + GT_OFF);
        { const int t2 = pg8::tid_fresh(wave);
          if (t2 < 64) { GT[t2] = a.in[6][t2]; GT[64 + t2] = a.in[7][t2]; }
          if (t2 < 128) { GT[128 + t2] = a.in[13][t2]; GT[256 + t2] = a.in[14][t2]; GT[384 + t2] = a.in[17][t2]; GT[512 + t2] = a.in[18][t2]; } }
        __syncthreads();
        { const pg8::EpiQKV E{R, LDQ, CKV, D, GT, (LAS float*)(lds + XCH_OFF)};
          pg8::Gemm g{XN, W_IN, M, DIN, D, D, MN, W_MEM, nullptr, nullptr}; pg8::DualOrder S; S.init(M, DIN, MMEM, D, G, bid);
          pg8::gemm_phase<pg8::EpiQKV, pg8::DualOrder, true, true>(lds, g, S, E, wave); }
    }
    xcd_barrier(bar, wave);

    {
        FRESH_LANE
#define UNIFORM_F(v) __builtin_bit_cast(float, __builtin_amdgcn_readfirstlane(__builtin_bit_cast(int, (float)(v))))
        const float negM_a = UNIFORM_F(-8.f * absmax_vec(a.in[6], 64, lane) * absmax_vec(a.in[7], 64, lane) * L2E);
        const float lam = UNIFORM_F(expf(wave_sum(a.in[8][lane] * a.in[9][lane])) - expf(wave_sum(a.in[10][lane] * a.in[11][lane])) + 0.2f);
        *(LAS float*)(lds + (LDS_BYTES - 64 + 32)) = lam;
        for (int rr = 0; rr < (512 + G - 1) / G; ++rr) {
            int u;
            if (G == 256) { const int k = rr * 32 + (bid >> 3), bh = (bid & 7) + 8 * (k >> 4); u = bh * 16 + (k & 15); }
            else { u = rr * G + bid; if (u >= 512) break; }
            const int b = u >> 6, h = (u >> 4) & 3, qblk = u & 15;
            const int ta_ = pg8::lane_id_fresh();
            const int qpos = qblk * 128 + (wave >> 1) * 32 + (ta_ & 31);
            bf16* qrow = R + ((size_t)b * SEQ + qblk * 128 + (wave >> 1) * 32) * LDQ + C_AQ + h * 128;
            const bf16* Kg = R + (size_t)b * SEQ * LDQ + C_AK + h * 128; const bf16* Vg = R + (size_t)b * SEQ * LDQ + C_AV + h * 128;
            const float nslope = -__builtin_amdgcn_exp2f(-2.f * (float)(h + 1)) * L2E;
            attn_shared_unit<2>((LAS char*)lds, qrow, Kg, Vg, LDQ, SEQ / 64, qpos, qblk * 128 + (wave >> 1) * 32, nslope, negM_a, lam, a.in[12], wave);
        }
        const int lnc_ = pg8::lane_id_fresh();
        const float negM_c = UNIFORM_F(-11.313708499f * absmax_vec(a.in[17], 128, lnc_) * absmax_vec(a.in[18], 128, lnc_) * L2E);
        for (int u = bid; u < 256; u += G) {
            const int b = u >> 5, h = (u >> 3) & 3, qblk = u & 7;
            const int tc_ = pg8::lane_id_fresh();
            const int qpos = qblk * 256 + wave * 32 + (tc_ & 31);
            bf16* qrow = R + ((size_t)b * SEQ + qblk * 256 + wave * 32) * LDQ + C_CQ + h * 128;
            const bf16* Kg = CKV + (size_t)b * NMEM * D + h * 128; const bf16* Vg = Kg + 512;
            attn_shared_unit<1>((LAS char*)lds, qrow, Kg, Vg, D, NMEM / 64, qpos, 0, 0.f, negM_c, 0.f, a.in[12], wave);
        }
        __syncthreads();
        { const int lnb_ = pg8::lane_id_fresh();
          const float negM_b = UNIFORM_F(-11.313708499f * absmax_vec(a.in[13], 128, lnb_) * absmax_vec(a.in[14], 128, lnb_) * L2E);
          for (int rr = 0; rr < (768 + G - 1) / G; ++rr) {
              int u;
              if (G == 256) { const int k = rr * 32 + (bid >> 3); u = ((bid & 7) + 8 * (k >> 3)) * 8 + (k & 7); }
              else { u = rr * G + bid; if (u >= 768) break; }
              const int sid = u >> 3, loc = u & 7, b = sid / 12, g = (sid % 12) >> 2, j = sid & 3;
              const float slope = __builtin_amdgcn_exp2f(-8.f * (float)(g * 4 + j + 1) / 12.f);
              if (g == 0) attn_b_block_unit<false>((LAS char*)lds, R, LB, b, g, j, 0, loc * 256, 1, -slope * L2E, negM_b, wave);
              else if (g == 1) attn_b_block_unit<false>((LAS char*)lds, R, LB, b, g, j, loc >> 1, (loc & 1) * 256, 4, -slope * 4.f * L2E, negM_b, wave);
              else attn_b_block_unit<true>((LAS char*)lds, R, LB, b, g, j, 2 * loc, 0, 16, -slope * 16.f * L2E, negM_b, wave);
          } }
    }
    xcd_barrier(bar, wave);

    { FRESH_LANE
    for (int m = gw; m < M; m += NGW) {
        const int j = lane >> 4, d8 = (lane & 15) * 8;
        const float l0 = LB[((size_t)0 * M + m) * 4 + j], l1 = LB[((size_t)1 * M + m) * 4 + j], l2 = LB[((size_t)2 * M + m) * 4 + j];
        const float inv = 1.f / (l0 + l1 + l2); const float w0 = l0 * inv, w1 = l1 * inv, w2 = l2 * inv;
        bf16* p0 = R + (size_t)m * LDQ + C_BQ + j * 128 + d8;
        const u32x4 o0 = *(const u32x4*)p0, o1 = *(const u32x4*)(p0 + 512), o2 = *(const u32x4*)(p0 + 1024);
        u32x4 w;
#pragma unroll
        for (int e = 0; e < 4; ++e) {
            const float lo = w0 * pg8::bf_lo(o0[e]) + w1 * pg8::bf_lo(o1[e]) + w2 * pg8::bf_lo(o2[e]);
            const float hi = w0 * pg8::bf_hi(o0[e]) + w1 * pg8::bf_hi(o1[e]) + w2 * pg8::bf_hi(o2[e]);
            w[e] = cvtpk(lo, hi);
        }
        *(u32x4*)p0 = w;
    } }
    {
        pg8::Gemm g{XN, W_G, M, 3 * D, D, D, nullptr, nullptr, nullptr, nullptr}; pg8::StaticOrder S; S.init(M, 3 * D, G, bid);
        pg8::EpiGate E{R + C_GATE, LDQ, a.in[5]};
        pg8::gemm_phase<pg8::EpiGate, pg8::StaticOrder, true, true>(lds, g, S, E, wave);
    }
    xcd_barrier(bar, wave);

    {
        pg8::Gemm g{R + C_AQ, W_BR, M, D, 512, LDQ, R + C_BQ, W_BR + (size_t)D * 512, R + C_CQ, W_BR + (size_t)2 * D * 512};
        pg8::RepeatOrder S; S.init(M, D, 3, G, bid);
        pg8::EpiBranch E{R + C_GATE, R + C_GATE, LDQ, D};
        pg8::gemm_phase<pg8::EpiBranch, pg8::RepeatOrder, true, true>(lds, g, S, E, wave);
    }
    xcd_barrier(bar, wave);

    {
        pg8::Gemm g{R + C_GATE, W_OUT, M, D, D, LDQ, nullptr, nullptr, nullptr, nullptr}; pg8::StaticOrder S; S.init(M, D, G, bid);
        pg8::EpiResidNorm E{x, a.out, D, a.in[21], R + C_H2, LDQ, (float*)(ws + WS_SSQ)};
        pg8::gemm_phase<pg8::EpiResidNorm, pg8::StaticOrder, true, true>(lds, g, S, E, wave);
    }
    xcd_barrier(bar, wave);

    {
        pg8::Gemm g{R + C_H2, W_GU, M, 2 * DFF, D, LDQ, nullptr, nullptr, nullptr, nullptr}; pg8::StaticOrder S; S.init(M, 2 * DFF, G, bid);
        pg8::EpiSwiGLU E{R + C_ACT, LDQ, (const float*)(ws + WS_SSQ)};
        pg8::gemm_phase<pg8::EpiSwiGLU, pg8::StaticOrder, true, true>(lds, g, S, E, wave);
    }
    xcd_barrier(bar, wave);

    {
        pg8::Gemm g{R + C_ACT, W_DN, M, D, DFF, LDQ, nullptr, nullptr, nullptr, nullptr}; pg8::StaticOrder S; S.init(M, D, G, bid);
        pg8::EpiResid E{a.out, a.out, D};
        pg8::gemm_phase<pg8::EpiResid, pg8::StaticOrder, true, true>(lds, g, S, E, wave);
    }
}

extern "C" void kernel_launch(void* const* d_in, const int* in_sizes, int n_in, void* d_out, int out_size, void* d_ws, size_t ws_size, hipStream_t stream) {
    static int grid = 0;
    if (grid == 0) {
        if (n_in != 25 || out_size != M * D || ws_size < WS_END) { fprintf(stderr, "kernel_launch: unexpected problem shape (n_in %d out %d ws %zu)\n", n_in, out_size, ws_size); grid = -1; return; }
        int dev = 0, cus = 0, per_cu = 0;
        hipGetDevice(&dev);
        hipDeviceGetAttribute(&cus, hipDeviceAttributeMultiprocessorCount, dev);
        if (hipFuncSetAttribute((const void*)fwd_megakernel, hipFuncAttributeMaxDynamicSharedMemorySize, LDS_BYTES) != hipSuccess) { fprintf(stderr, "kernel_launch: hipFuncSetAttribute failed\n"); }
        hipOccupancyMaxActiveBlocksPerMultiprocessor(&per_cu, (const void*)fwd_megakernel, 512, LDS_BYTES);
        (void)hipGetLastError();
        if (per_cu < 1) per_cu = 1;
        grid = cus;
        fprintf(stderr, "kernel_launch: cus %d per_cu %d grid %d\n", cus, per_cu, grid);
    }
    if (grid < 0) return;
    if (hipMemsetAsync((char*)d_ws + WS_BAR, 0, 16384, stream) != hipSuccess) { fprintf(stderr, "kernel_launch: memset of the barrier words failed\n"); return; }
    Args a{};
    for (int i = 0; i < 25; ++i) a.in[i] = (const float*)d_in[i];
    a.out = (float*)d_out; a.ws = (unsigned char*)d_ws;
    void* args[] = {&a};
    hipError_t e = hipLaunchCooperativeKernel((const void*)fwd_megakernel, dim3(grid), dim3(512), args, LDS_BYTES, stream);
    if (e != hipSuccess) fprintf(stderr, "cooperative launch failed: %s (grid %d)\n", hipGetErrorString(e), grid);
}
```

```cpp
#include <hip/hip_runtime.h>
#include <hip/hip_cooperative_groups.h>
#include <cstdio>
#include <cstdint>
namespace cg = cooperative_groups;
namespace pg8 {
#define PG8_LAS __attribute__((address_space(3)))
typedef unsigned short bf16_t;
typedef short bf16x8 __attribute__((ext_vector_type(8)));
typedef float f32x4 __attribute__((ext_vector_type(4)));
typedef unsigned u32x4 __attribute__((ext_vector_type(4)));
constexpr int BM = 256, BK = 64, HALF = 128, HTB = HALF * BK * 2  , STAGE_BYTES = 8 * HTB, NXCD = 8, WGM = 8;

__host__ __device__ __forceinline__ int lds_byte(int r, int c) { const int st = (r >> 4) * 2 + (c >> 5), rr = r & 15, cc = c & 31, ob = rr * 64 + cc * 2; return st * 1024 + (ob ^ (((ob >> 9) & 1) << 5)); }
__host__ __device__ __forceinline__ void stage_rc(int b, int& R, int& C) { const int st = b / 1024, sb = b % 1024, swz = sb ^ (((sb >> 9) & 1) << 5); R = (st >> 1) * 16 + swz / 64; C = (st & 1) * 32 + (swz % 64) / 2; }
__host__ __device__ __forceinline__ int perm32(int rho) { const int n = rho >> 4, i = rho & 15; return 8 * (i >> 2) + 4 * n + (i & 3); }

struct Unit { int pm, pn, src; };
struct Gemm { const bf16_t* A; const bf16_t* Bt; int M, N, K, lda; const bf16_t* A2; const bf16_t* Bt2; const bf16_t* A3; const bf16_t* Bt3; };

struct StaticOrder {
    int nM, nN, nwg, G, c;
    __host__ __device__ void init(int M, int N, int G_, int c_) { nM = M / BM; nN = N / BM; nwg = nM * nN; G = G_; c = c_; }
    __host__ __device__ bool next(int i, Unit& u) const {
        const long L = (long)i * G + c; if (L >= nwg) return false;
        int wgid = (int)L; { const int q = nwg / NXCD, r = nwg % NXCD, xcd = wgid % NXCD, off = wgid / NXCD; wgid = (xcd < r ? xcd * (q + 1) : r * (q + 1) + (xcd - r) * q) + off; }
        const int nig = WGM * nN, gid = wgid / nig, fm = gid * WGM, gsz = (nM - fm) < WGM ? (nM - fm) : WGM;
        u.pm = fm + ((wgid % nig) % gsz); u.pn = (wgid % nig) / gsz; u.src = 0; return true;
    }
    __device__ __forceinline__ void a_ready(const Unit&) const {}
    __device__ __forceinline__ void done(const Unit&) const {}
};

struct DualOrder {
    StaticOrder S1; int nM2, nN2;
    __host__ __device__ void init(int M, int N, int M2, int N2, int G_, int c_) { S1.init(M, N, G_, c_); nM2 = M2 / BM; nN2 = N2 / BM; }
    __host__ __device__ bool next(int i, Unit& u) const {
        if (S1.next(i, u)) return true;
        const long L = (long)i * S1.G + S1.c - S1.nwg; if (L < 0 || L >= (long)nM2 * nN2) return false;
        u.pm = (int)L % nM2; u.pn = (int)L / nM2; u.src = 1; return true;
    }
    __device__ __forceinline__ void a_ready(const Unit&) const {}
    __device__ __forceinline__ void done(const Unit&) const {}
};

struct RepeatOrder {
    StaticOrder S1; int nrep;
    __host__ __device__ void init(int M, int N, int nrep_, int G_, int c_) { S1.init(M, N, G_, c_); nrep = nrep_; }
    __host__ __device__ bool next(int i, Unit& u) const { if (i >= nrep) return false; if (!S1.next(0, u)) return false; u.src = i; return true; }
    __device__ __forceinline__ void a_ready(const Unit&) const {}
    __device__ __forceinline__ void done(const Unit&) const {}
};

template <int K> __device__ __forceinline__ float shx(float v) {
    return __builtin_bit_cast(float, __builtin_amdgcn_ds_swizzle(__builtin_bit_cast(int, v), (K << 10) | 0x1f)); }
__device__ __forceinline__ float sum_halves(float v) {
    auto rr = __builtin_amdgcn_permlane32_swap(__builtin_bit_cast(unsigned, v), __builtin_bit_cast(unsigned, v), false, false);
    return __builtin_bit_cast(float, (unsigned)rr[0]) + __builtin_bit_cast(float, (unsigned)rr[1]); }
__device__ __forceinline__ float max_halves(float v) {
    auto rr = __builtin_amdgcn_permlane32_swap(__builtin_bit_cast(unsigned, v), __builtin_bit_cast(unsigned, v), false, false);
    return fmaxf(__builtin_bit_cast(float, (unsigned)rr[0]), __builtin_bit_cast(float, (unsigned)rr[1])); }
__device__ __forceinline__ int lane_id_fresh() { int z = 0; asm volatile("" : "+s"(z)); return __builtin_amdgcn_mbcnt_hi(~0u, __builtin_amdgcn_mbcnt_lo(~0u, z)); }
__device__ __forceinline__ int tid_fresh(int wave) { return wave * 64 + lane_id_fresh(); }
typedef float f32x2v_t __attribute__((ext_vector_type(2))); typedef __bf16 bf16x2v_t __attribute__((ext_vector_type(2)));
__device__ __forceinline__ unsigned cvt_pk_bf16(float lo, float hi) { f32x2v_t v = {lo, hi}; bf16x2v_t b = __builtin_convertvector(v, bf16x2v_t); return __builtin_bit_cast(unsigned, b); }
__device__ __forceinline__ float bf_lo(unsigned w) { return __builtin_bit_cast(float, w << 16); }
__device__ __forceinline__ float bf_hi(unsigned w) { return __builtin_bit_cast(float, w & 0xffff0000u); }
#define PG8_ACC const f32x4 (&acc)[2][2][4][2]

struct EpiQKV {
    static constexpr bool PERM = true, AFTER_DRAIN = false;
    bf16_t* O; int ldc; bf16_t* O2; int ldc2;
    PG8_LAS const float* GT;
    PG8_LAS float* X;
    __device__ __forceinline__ void operator()(PG8_ACC, const Unit& u, int wr, int wc, int fr, int fq) const {
        const int pn = u.pn;
        int kind, gp; float sc = 1.f;
        constexpr float L2E = 1.4426950408889634f;
        const int mode = u.src;
        if (mode == 0) {
            if (pn < 2) { kind = 1; gp = 0; sc = 0.125f * L2E; }
            else if (pn < 4) { kind = 1; gp = 64; }
            else if (pn < 6) { kind = 0; gp = 64; }
            else if (pn < 12) { kind = 2; gp = 128; sc = 0.08838834764831845f * L2E; }
            else if (pn < 18) { kind = 2; gp = 256; }
            else if (pn < 24) { kind = 0; gp = 256; }
            else { kind = 2; gp = 384; sc = 0.08838834764831845f * L2E; }
        } else {
            if (pn < 2) { kind = 2; gp = 512; } else { kind = 0; gp = 512; }
        }
        const int row0 = u.pm * BM + wr * 64 + fr, col0 = pn * BM + wc * 32 + 8 * fq;
        float rs[2][4][2];
        f32x4 gv[2];
        if (kind != 0) {
#pragma unroll
            for (int ai = 0; ai < 2; ++ai)
#pragma unroll
                for (int m = 0; m < 4; ++m)
#pragma unroll
                    for (int bj = 0; bj < 2; ++bj) {
                        const f32x4 a = acc[ai][bj][m][0], b = acc[ai][bj][m][1];
                        float s = (a[0] * a[0] + a[1] * a[1]) + (a[2] * a[2] + a[3] * a[3]) + (b[0] * b[0] + b[1] * b[1]) + (b[2] * b[2] + b[3] * b[3]);
                        s += shx<16>(s); s = sum_halves(s);
                        if (fq == 0) X[((ai * 128 + wr * 64 + m * 16 + fr) * 2 + bj) * 4 + wc] = s;
                    }
            asm volatile("s_waitcnt lgkmcnt(0)" ::: "memory"); __builtin_amdgcn_s_barrier(); asm volatile("" ::: "memory");
            const int hd = (kind == 1) ? 64 : 128;
            const float inv_hd = (kind == 1) ? (1.f / 64.f) : (1.f / 128.f);
#pragma unroll
            for (int ai = 0; ai < 2; ++ai)
#pragma unroll
                for (int m = 0; m < 4; ++m)
#pragma unroll
                    for (int bj = 0; bj < 2; ++bj) {
                        const f32x4 xs = *(const PG8_LAS f32x4*)(X + ((ai * 128 + wr * 64 + m * 16 + fr) * 2 + bj) * 4);
                        float tot;
                        if (kind == 1) tot = (wc < 2) ? (xs[0] + xs[1]) : (xs[2] + xs[3]);
                        else tot = (xs[0] + xs[1]) + (xs[2] + xs[3]);
                        rs[ai][m][bj] = __builtin_amdgcn_rsqf(tot * inv_hd + 1e-6f) * sc;
                    }
            const int gc = ((wc * 32 + 8 * fq) & (hd - 1));
            gv[0] = *(const PG8_LAS f32x4*)(GT + gp + gc); gv[1] = *(const PG8_LAS f32x4*)(GT + gp + gc + 4);
        } else {
#pragma unroll
            for (int ai = 0; ai < 2; ++ai)
#pragma unroll
                for (int m = 0; m < 4; ++m)
#pragma unroll
                    for (int bj = 0; bj < 2; ++bj) rs[ai][m][bj] = 1.f;
            gv[0] = (f32x4){1.f, 1.f, 1.f, 1.f}; gv[1] = gv[0];
        }
#pragma unroll
        for (int ai = 0; ai < 2; ++ai)
#pragma unroll
            for (int m = 0; m < 4; ++m) { bf16_t* rowp = (mode ? O2 : O) + (size_t)(row0 + ai * HALF + m * 16) * (mode ? ldc2 : ldc) + col0;
#pragma unroll
                for (int bj = 0; bj < 2; ++bj) { const float r = rs[ai][m][bj];
                    const f32x4 v0 = acc[ai][bj][m][0] * gv[0] * r, v1 = acc[ai][bj][m][1] * gv[1] * r;
                    u32x4 w; w.x = cvt_pk_bf16(v0[0], v0[1]); w.y = cvt_pk_bf16(v0[2], v0[3]); w.z = cvt_pk_bf16(v1[0], v1[1]); w.w = cvt_pk_bf16(v1[2], v1[3]);
                    *(u32x4*)(rowp + bj * HALF) = w; } }
    }
};

struct EpiGate {
    static constexpr bool PERM = true, AFTER_DRAIN = false;
    bf16_t* O; int ldc; const float* bias;
    __device__ __forceinline__ void operator()(PG8_ACC, const Unit& u, int wr, int wc, int fr, int fq) const {
        const int row0 = u.pm * BM + wr * 64 + fr, col0 = u.pn * BM + wc * 32 + 8 * fq;
        f32x4 bv[2][2];
#pragma unroll
        for (int bj = 0; bj < 2; ++bj)
#pragma unroll
            for (int n = 0; n < 2; ++n) bv[bj][n] = *(const f32x4*)(bias + col0 + bj * HALF + 4 * n);
#pragma unroll
        for (int ai = 0; ai < 2; ++ai)
#pragma unroll
            for (int m = 0; m < 4; ++m) { bf16_t* rowp = O + (size_t)(row0 + ai * HALF + m * 16) * ldc + col0;
#pragma unroll
                for (int bj = 0; bj < 2; ++bj) { f32x4 v0 = acc[ai][bj][m][0] + bv[bj][0], v1 = acc[ai][bj][m][1] + bv[bj][1];
#pragma unroll
                    for (int e = 0; e < 4; ++e) { v0[e] = __builtin_amdgcn_rcpf(1.f + __builtin_amdgcn_exp2f(-1.4426950408889634f * v0[e])); v1[e] = __builtin_amdgcn_rcpf(1.f + __builtin_amdgcn_exp2f(-1.4426950408889634f * v1[e])); }
                    u32x4 w; w.x = cvt_pk_bf16(v0[0], v0[1]); w.y = cvt_pk_bf16(v0[2], v0[3]); w.z = cvt_pk_bf16(v1[0], v1[1]); w.w = cvt_pk_bf16(v1[2], v1[3]);
                    *(u32x4*)(rowp + bj * HALF) = w; } }
    }
};

struct EpiBranch {
    static constexpr bool PERM = true, AFTER_DRAIN = false;
    bf16_t* MIX; const bf16_t* GATE0; int ldc; int gstride;
    __device__ __forceinline__ void operator()(PG8_ACC, const Unit& u, int wr, int wc, int fr, int fq) const {
        const int row0 = u.pm * BM + wr * 64 + fr, col0 = u.pn * BM + wc * 32 + 8 * fq;
        const bf16_t* GATE = GATE0 + (size_t)u.src * gstride; const int accum = u.src;
#pragma unroll
        for (int ai = 0; ai < 2; ++ai)
#pragma unroll
            for (int m = 0; m < 4; ++m) { const size_t off = (size_t)(row0 + ai * HALF + m * 16) * ldc + col0;
#pragma unroll
                for (int bj = 0; bj < 2; ++bj) { const u32x4 gt = *(const u32x4*)(GATE + off + bj * HALF);
                    f32x4 a = acc[ai][bj][m][0], b = acc[ai][bj][m][1];
                    a[0] *= bf_lo(gt.x); a[1] *= bf_hi(gt.x); a[2] *= bf_lo(gt.y); a[3] *= bf_hi(gt.y); b[0] *= bf_lo(gt.z); b[1] *= bf_hi(gt.z); b[2] *= bf_lo(gt.w); b[3] *= bf_hi(gt.w);
                    if (accum) { const u32x4 mx = *(const u32x4*)(MIX + off + bj * HALF);
                        a[0] += bf_lo(mx.x); a[1] += bf_hi(mx.x); a[2] += bf_lo(mx.y); a[3] += bf_hi(mx.y); b[0] += bf_lo(mx.z); b[1] += bf_hi(mx.z); b[2] += bf_lo(mx.w); b[3] += bf_hi(mx.w); }
                    u32x4 w; w.x = cvt_pk_bf16(a[0], a[1]); w.y = cvt_pk_bf16(a[2], a[3]); w.z = cvt_pk_bf16(b[0], b[1]); w.w = cvt_pk_bf16(b[2], b[3]);
                    *(u32x4*)(MIX + off + bj * HALF) = w; } }
    }
};

struct EpiResid {
    static constexpr bool PERM = true, AFTER_DRAIN = false;
    const float* res; float* out; int ld;
    __device__ __forceinline__ void operator()(PG8_ACC, const Unit& u, int wr, int wc, int fr, int fq) const {
        const int row0 = u.pm * BM + wr * 64 + fr, col0 = u.pn * BM + wc * 32 + 8 * fq;
#pragma unroll
        for (int ai = 0; ai < 2; ++ai)
#pragma unroll
            for (int m = 0; m < 4; ++m) { const size_t off = (size_t)(row0 + ai * HALF + m * 16) * ld + col0;
#pragma unroll
                for (int bj = 0; bj < 2; ++bj) {
                    const f32x4 r0 = *(const f32x4*)(res + off + bj * HALF), r1 = *(const f32x4*)(res + off + bj * HALF + 4);
                    const f32x4 v0 = acc[ai][bj][m][0] + r0, v1 = acc[ai][bj][m][1] + r1;
                    *(f32x4*)(out + off + bj * HALF) = v0; *(f32x4*)(out + off + bj * HALF + 4) = v1; } }
    }
};

struct EpiResidNorm {
    static constexpr bool PERM = true, AFTER_DRAIN = false;
    const float* res; float* out; int ld; const float* gain; bf16_t* H; int ldh; float* SSQ;
    __device__ __forceinline__ void operator()(PG8_ACC, const Unit& u, int wr, int wc, int fr, int fq) const {
        const int row0 = u.pm * BM + wr * 64 + fr, col0 = u.pn * BM + wc * 32 + 8 * fq;
        f32x4 gv[2][2];
#pragma unroll
        for (int bj = 0; bj < 2; ++bj)
#pragma unroll
            for (int n = 0; n < 2; ++n) gv[bj][n] = *(const f32x4*)(gain + col0 + bj * HALF + 4 * n);
#pragma unroll
        for (int ai = 0; ai < 2; ++ai)
#pragma unroll
            for (int m = 0; m < 4; ++m) { const int row = row0 + ai * HALF + m * 16; const size_t off = (size_t)row * ld + col0; float s = 0.f;
#pragma unroll
                for (int bj = 0; bj < 2; ++bj) {
                    const f32x4 r0 = *(const f32x4*)(res + off + bj * HALF), r1 = *(const f32x4*)(res + off + bj * HALF + 4);
                    const f32x4 v0 = acc[ai][bj][m][0] + r0, v1 = acc[ai][bj][m][1] + r1;
                    *(f32x4*)(out + off + bj * HALF) = v0; *(f32x4*)(out + off + bj * HALF + 4) = v1;
                    s += (v0[0] * v0[0] + v0[1] * v0[1]) + (v0[2] * v0[2] + v0[3] * v0[3]) + (v1[0] * v1[0] + v1[1] * v1[1]) + (v1[2] * v1[2] + v1[3] * v1[3]);
                    const f32x4 h0 = v0 * gv[bj][0], h1 = v1 * gv[bj][1];
                    u32x4 w; w.x = cvt_pk_bf16(h0[0], h0[1]); w.y = cvt_pk_bf16(h0[2], h0[3]); w.z = cvt_pk_bf16(h1[0], h1[1]); w.w = cvt_pk_bf16(h1[2], h1[3]);
                    *(u32x4*)(H + (size_t)row * ldh + col0 + bj * HALF) = w; }
                s += shx<16>(s); s = sum_halves(s);
                if (fq == 0) atomicAdd(SSQ + row, s); }
    }
};

struct EpiSwiGLU {
    static constexpr bool PERM = true, AFTER_DRAIN = false;
    bf16_t* O; int ldc; const float* SSQ;
    __device__ __forceinline__ void operator()(PG8_ACC, const Unit& u, int wr, int wc, int fr, int fq) const {
        const int row0 = u.pm * BM + wr * 64 + fr, col0 = u.pn * HALF + wc * 32 + 8 * fq;
#pragma unroll
        for (int ai = 0; ai < 2; ++ai)
#pragma unroll
            for (int m = 0; m < 4; ++m) { bf16_t* rowp = O + (size_t)(row0 + ai * HALF + m * 16) * ldc + col0;
                const float rstd = __builtin_amdgcn_rsqf(SSQ[row0 + ai * HALF + m * 16] * (1.f / 1024.f) + 1e-6f);
                f32x4 v[2];
#pragma unroll
                for (int n = 0; n < 2; ++n) { const f32x4 gt = acc[ai][0][m][n] * rstd, up = acc[ai][1][m][n] * rstd;
#pragma unroll
                    for (int e = 0; e < 4; ++e) v[n][e] = gt[e] * __builtin_amdgcn_rcpf(1.f + __builtin_amdgcn_exp2f(-1.4426950408889634f * gt[e])) * up[e]; }
                u32x4 w; w.x = cvt_pk_bf16(v[0][0], v[0][1]); w.y = cvt_pk_bf16(v[0][2], v[0][3]); w.z = cvt_pk_bf16(v[1][0], v[1][1]); w.w = cvt_pk_bf16(v[1][2], v[1][3]);
                *(u32x4*)rowp = w; }
    }
};

template <class Epi, class Sched, bool ALIGN_EPI = false, bool SP2 = false>
__device__ __forceinline__ void gemm_phase(PG8_LAS unsigned char* lds, const Gemm g, const Sched& S, const Epi& E, int wave_id) {
    const int tid = tid_fresh(wave_id);
    const int wid = __builtin_amdgcn_readfirstlane(tid >> 6), lane = tid & 63, wr = wid >> 2, wc = wid & 3, fr = lane & 15, fq = lane >> 4;
    const int K = g.K, nt = K / BK;
    unsigned voffA[2], voffB[2];
#pragma unroll
    for (int i = 0; i < 2; ++i) { int R, C; stage_rc(tid * 16 + i * 8192, R, C); const int Rb = Epi::PERM ? ((R & ~31) + perm32(R & 31)) : R;
        voffA[i] = (unsigned)(R * g.lda + C) * 2u; voffB[i] = (unsigned)(Rb * K + C) * 2u; }
    const size_t kstep = (size_t)(BK * 2);
    const size_t hstepA = (size_t)HALF * g.lda * 2, hstepB = (size_t)HALF * K * 2;
    const size_t tstepA = 2 * hstepA, tstepB = 2 * hstepB;
    const unsigned ldsw = (unsigned)wid * 1024u;
    const int aoff = lds_byte(wr * 64 + fr, fq * 8), boff = lds_byte(wc * 32 + fr, fq * 8);
#define PG8_SA(b, h) (((b) * 2 + (h)) * HTB)
#define PG8_SB(b, h) ((4 + (b) * 2 + (h)) * HTB)
#define PG8_STAGE(bufoff, gbase, voff) do { _Pragma("unroll") for (int _i = 0; _i < 2; ++_i) \
        __builtin_amdgcn_global_load_lds((const unsigned*)((const char*)(gbase) + (voff)[_i]), (PG8_LAS unsigned*)(lds + (bufoff) + ldsw + _i * 8192), 16, 0, 0); } while (0)
#define PG8_LDA(dst, b, h) do { _Pragma("unroll") for (int m = 0; m < 4; ++m) _Pragma("unroll") for (int k = 0; k < 2; ++k) dst[m][k] = *(const PG8_LAS bf16x8*)(lds + PG8_SA(b, h) + aoff + m * 2048 + k * 1024); } while (0)
#define PG8_LDB(dst, b, h) do { _Pragma("unroll") for (int n = 0; n < 2; ++n) _Pragma("unroll") for (int k = 0; k < 2; ++k) dst[n][k] = *(const PG8_LAS bf16x8*)(lds + PG8_SB(b, h) + boff + n * 2048 + k * 1024); } while (0)
#define PG8_MMA(ai, bj, At, Bt) do { __builtin_amdgcn_s_setprio(1); _Pragma("unroll") for (int m = 0; m < 4; ++m) _Pragma("unroll") for (int n = 0; n < 2; ++n) _Pragma("unroll") for (int k = 0; k < 2; ++k) \
        acc[ai][bj][m][n] = __builtin_amdgcn_mfma_f32_16x16x32_bf16(Bt[n][k], At[m][k], acc[ai][bj][m][n], 0, 0, 0); __builtin_amdgcn_s_setprio(0); } while (0)
#define PG8_WAIT_V(n) asm volatile("s_waitcnt vmcnt(" #n ")" ::: "memory")
#define PG8_WAIT_L(n) asm volatile("s_waitcnt lgkmcnt(" #n ")" ::: "memory")
#define PG8_BAR __builtin_amdgcn_s_barrier()
#define PG8_SCHED __builtin_amdgcn_sched_barrier(0)
    Unit cur, nxt; int ui = 0;
    if (!S.next(0, cur)) return;
    f32x4 acc[2][2][4][2];
#pragma unroll
    for (int a = 0; a < 2; ++a)
#pragma unroll
        for (int b = 0; b < 2; ++b)
#pragma unroll
            for (int m = 0; m < 4; ++m)
#pragma unroll
                for (int n = 0; n < 2; ++n) acc[a][b][m][n] = (f32x4){0.f, 0.f, 0.f, 0.f};
    bf16x8 At[4][2], B0[2][2], B1[2][2];
    const char* cA = (const char*)(cur.src == 0 ? g.A : (cur.src == 1 ? g.A2 : g.A3)) + (size_t)cur.pm * tstepA; const char* cB = (const char*)(cur.src == 0 ? g.Bt : (cur.src == 1 ? g.Bt2 : g.Bt3)) + (size_t)cur.pn * tstepB;
    S.a_ready(cur);
    if constexpr (SP2) {
        PG8_STAGE(PG8_SB(0, 0), cB, voffB); PG8_STAGE(PG8_SB(0, 1), cB + hstepB, voffB); PG8_STAGE(PG8_SA(0, 0), cA, voffA); PG8_STAGE(PG8_SA(0, 1), cA + hstepA, voffA);
        if (wr == 1) PG8_BAR;
        PG8_WAIT_V(2); PG8_BAR;
        PG8_STAGE(PG8_SB(1, 0), cB + kstep, voffB); PG8_STAGE(PG8_SA(1, 0), cA + kstep, voffA); PG8_STAGE(PG8_SB(1, 1), cB + hstepB + kstep, voffB);
        PG8_WAIT_V(6); PG8_BAR;
    } else {
        PG8_STAGE(PG8_SB(0, 0), cB, voffB); PG8_STAGE(PG8_SA(0, 0), cA, voffA); PG8_STAGE(PG8_SB(0, 1), cB + hstepB, voffB); PG8_STAGE(PG8_SA(0, 1), cA + hstepA, voffA);
        if (wr == 1) PG8_BAR;
        PG8_WAIT_V(4); PG8_BAR;
        PG8_STAGE(PG8_SB(1, 0), cB + kstep, voffB); PG8_STAGE(PG8_SA(1, 0), cA + kstep, voffA); PG8_STAGE(PG8_SB(1, 1), cB + hstepB + kstep, voffB);
        PG8_WAIT_V(6); PG8_BAR;
    }
    for (;;) {
        const bool has_next = S.next(ui + 1, nxt);
        const char* nA = has_next ? (const char*)(nxt.src == 0 ? g.A : (nxt.src == 1 ? g.A2 : g.A3)) + (size_t)nxt.pm * tstepA : cA; const char* nB = has_next ? (const char*)(nxt.src == 0 ? g.Bt : (nxt.src == 1 ? g.Bt2 : g.Bt3)) + (size_t)nxt.pn * tstepB : cB;
        for (int t = 0; t < nt; t += 2) {
            const bool last = (t == nt - 2);
            const char* a1 = cA + (size_t)(t + 1) * kstep;
            const char* a2 = last ? nA : cA + (size_t)(t + 2) * kstep; const char* b2 = last ? nB : cB + (size_t)(t + 2) * kstep;
            const char* a3 = a2 + kstep; const char* b3 = b2 + kstep;
            if (last && has_next) S.a_ready(nxt);
            if constexpr (SP2) {
            PG8_LDB(B0, 0, 0); PG8_LDB(B1, 0, 1); PG8_SCHED; PG8_LDA(At, 0, 0); PG8_STAGE(PG8_SA(1, 1), a1 + hstepA, voffA);
            PG8_WAIT_V(8); PG8_WAIT_L(0); PG8_BAR; PG8_MMA(0, 0, At, B0); PG8_MMA(0, 1, At, B1); PG8_BAR; PG8_SCHED;
            PG8_LDA(At, 0, 1); PG8_STAGE(PG8_SB(0, 0), b2, voffB); PG8_STAGE(PG8_SB(0, 1), b2 + hstepB, voffB); PG8_STAGE(PG8_SA(0, 0), a2, voffA);
            PG8_WAIT_V(8); PG8_WAIT_L(0); PG8_BAR; PG8_MMA(1, 0, At, B0); PG8_MMA(1, 1, At, B1); PG8_BAR; PG8_SCHED;
            PG8_LDB(B0, 1, 0); PG8_LDB(B1, 1, 1); PG8_SCHED; PG8_LDA(At, 1, 0); PG8_STAGE(PG8_SA(0, 1), a2 + hstepA, voffA);
            PG8_WAIT_V(8); PG8_WAIT_L(0); PG8_BAR; PG8_MMA(0, 0, At, B0); PG8_MMA(0, 1, At, B1); PG8_BAR; PG8_SCHED;
            PG8_LDA(At, 1, 1); PG8_STAGE(PG8_SB(1, 0), b3, voffB); PG8_STAGE(PG8_SB(1, 1), b3 + hstepB, voffB); PG8_STAGE(PG8_SA(1, 0), a3, voffA);
            PG8_WAIT_V(8); PG8_WAIT_L(0); PG8_BAR; PG8_MMA(1, 0, At, B0); PG8_MMA(1, 1, At, B1); PG8_BAR; PG8_SCHED;
            } else {
            PG8_LDB(B0, 0, 0); PG8_SCHED; PG8_LDA(At, 0, 0); PG8_STAGE(PG8_SA(1, 1), a1 + hstepA, voffA);
            PG8_WAIT_L(8); PG8_BAR; PG8_WAIT_L(0); PG8_MMA(0, 0, At, B0); PG8_BAR; PG8_SCHED;
            PG8_LDB(B1, 0, 1); PG8_STAGE(PG8_SB(0, 0), b2, voffB);
            PG8_BAR; PG8_WAIT_L(0); PG8_MMA(0, 1, At, B1); PG8_BAR;
            PG8_LDA(At, 0, 1); PG8_STAGE(PG8_SA(0, 0), a2, voffA);
            PG8_BAR; PG8_WAIT_L(0); PG8_MMA(1, 0, At, B0); PG8_BAR; PG8_SCHED;
            PG8_STAGE(PG8_SB(0, 1), b2 + hstepB, voffB);
            PG8_WAIT_V(6); PG8_BAR; PG8_MMA(1, 1, At, B1); PG8_BAR;
            PG8_LDB(B0, 1, 0); PG8_SCHED; PG8_LDA(At, 1, 0); PG8_STAGE(PG8_SA(0, 1), a2 + hstepA, voffA);
            PG8_WAIT_L(8); PG8_BAR; PG8_WAIT_L(0); PG8_MMA(0, 0, At, B0); PG8_BAR; PG8_SCHED;
            PG8_LDB(B1, 1, 1); PG8_STAGE(PG8_SB(1, 0), b3, voffB);
            PG8_BAR; PG8_WAIT_L(0); PG8_MMA(0, 1, At, B1); PG8_BAR;
            PG8_LDA(At, 1, 1); PG8_STAGE(PG8_SA(1, 0), a3, voffA);
            PG8_BAR; PG8_WAIT_L(0); PG8_MMA(1, 0, At, B0); PG8_BAR; PG8_SCHED;
            PG8_STAGE(PG8_SB(1, 1), b3 + hstepB, voffB);
            PG8_WAIT_V(6); PG8_BAR; PG8_MMA(1, 1, At, B1); PG8_BAR;
            }
        }
        if constexpr (ALIGN_EPI) { if (wr == 0) PG8_BAR; }
        if constexpr (!Epi::AFTER_DRAIN) { E(acc, cur, wr, wc, fr, fq); S.done(cur); }
        if (!has_next) break;
#pragma unroll
        for (int a = 0; a < 2; ++a)
#pragma unroll
            for (int b = 0; b < 2; ++b)
#pragma unroll
                for (int m = 0; m < 4; ++m)
#pragma unroll
                    for (int n = 0; n < 2; ++n) acc[a][b][m][n] = (f32x4){0.f, 0.f, 0.f, 0.f};
        cur = nxt; cA = nA; cB = nB; ++ui;
        if constexpr (ALIGN_EPI) { if (wr == 1) PG8_BAR; }
    }
    PG8_WAIT_V(0);
    if constexpr (!ALIGN_EPI) { if (wr == 0) PG8_BAR; }
    PG8_BAR;
    if constexpr (Epi::AFTER_DRAIN) { E.fused(acc, cur, wr, wc, fr, fq, lds, wid, lane); S.done(cur); }
#undef PG8_SA
#undef PG8_SB
#undef PG8_STAGE
#undef PG8_LDA
#undef PG8_LDB
#undef PG8_MMA
#undef PG8_WAIT_V
#undef PG8_WAIT_L
#undef PG8_BAR
#undef PG8_SCHED
}
}

#define LAS __attribute__((address_space(3)))
typedef unsigned short bf16;
typedef short bf16x8 __attribute__((ext_vector_type(8)));
typedef short s16x4 __attribute__((ext_vector_type(4)));
typedef short v4i16_t __attribute__((ext_vector_type(4)));
typedef float f32x16 __attribute__((ext_vector_type(16)));
typedef float f32x4 __attribute__((ext_vector_type(4)));
typedef float f32x2_t __attribute__((ext_vector_type(2)));
typedef __bf16 bf16x2_t __attribute__((ext_vector_type(2)));
typedef unsigned u32x4 __attribute__((ext_vector_type(4)));
typedef unsigned u32x2 __attribute__((ext_vector_type(2)));

constexpr int D = 1024, SEQ = 2048, NB = 8, M = NB * SEQ, NMEM = 256, MMEM = NB * NMEM, DIN = 6656, DFF = 2816;
constexpr int LDQ = 6656;
constexpr int C_AQ = 0, C_AK = 512, C_AV = 1024, C_BQ = 1536, C_BK = 3072, C_BV = 4608, C_CQ = 6144;
constexpr int C_GATE = 3072;
constexpr int C_H2 = 0, C_ACT = 1024;
constexpr float L2E = 1.4426950408889634f;
constexpr float EPS = 1e-6f;

constexpr size_t WS_WIN = 0;
constexpr size_t WS_WG = WS_WIN + (size_t)DIN * D * 2;
constexpr size_t WS_WMEM = WS_WG + (size_t)3 * D * D * 2;
constexpr size_t WS_WBR = WS_WMEM + (size_t)D * D * 2;
constexpr size_t WS_WOUT3 = WS_WBR + (size_t)3 * D * 512 * 2;
constexpr size_t WS_WGU = WS_WOUT3 + (size_t)D * 3 * D * 2;
constexpr size_t WS_WDN = WS_WGU + (size_t)2 * DFF * D * 2;
constexpr size_t WS_LB = WS_WDN + (size_t)D * DFF * 2;
constexpr size_t WS_R = WS_LB + (size_t)3 * M * 4 * 4;
constexpr size_t WS_BAR = WS_R + (size_t)M * LDQ * 2;
constexpr size_t WS_SSQ = WS_BAR + 16384;
constexpr size_t WS_END = WS_SSQ + (size_t)M * 4;
static_assert(WS_END <= (size_t)256 * 1024 * 1024, "d_ws map");
constexpr size_t DO_XN = 0;
constexpr size_t DO_MN = DO_XN + (size_t)M * D * 2;
constexpr size_t DO_CKV = DO_MN + (size_t)MMEM * D * 2;
static_assert(DO_CKV + (size_t)MMEM * D * 2 <= (size_t)M * D * 4, "d_out scratch map");

constexpr int LDS_BYTES = 155648;
constexpr int XCH_OFF = 131072, GT_OFF = 131072 + 8192;
constexpr int MISC_OFF = LDS_BYTES - 64;
constexpr int KP = 272, VP = 320;

__device__ __forceinline__ unsigned cvtpk(float lo, float hi) { f32x2_t v = {lo, hi}; bf16x2_t b = __builtin_convertvector(v, bf16x2_t); return __builtin_bit_cast(unsigned, b); }
__device__ __forceinline__ float wave_sum(float v) {
    v += pg8::shx<1>(v); v += pg8::shx<2>(v); v += pg8::shx<4>(v); v += pg8::shx<8>(v); v += pg8::shx<16>(v); v = pg8::sum_halves(v);
    return v;
}
__device__ __forceinline__ float wave_max(float v) {
    v = fmaxf(v, pg8::shx<1>(v)); v = fmaxf(v, pg8::shx<2>(v)); v = fmaxf(v, pg8::shx<4>(v)); v = fmaxf(v, pg8::shx<8>(v)); v = fmaxf(v, pg8::shx<16>(v)); v = pg8::max_halves(v);
    return v;
}
__device__ __forceinline__ float absmax_vec(const float* g, int n, int lane) {
    float v = fabsf(g[lane]); if (n > 64) v = fmaxf(v, fabsf(g[lane + 64]));
    return wave_max(v);
}

__device__ __forceinline__ void tr_item(const float* W, int N, int k0, int n0, bf16* WT, int dst_pitch, int dst_row0, int dst_k0, int ncopies, int copy_stride, LAS float* scr, int lane) {
#pragma unroll 8
    for (int i = 0; i < 32; ++i) { const int kk = 2 * i + (lane >> 5); scr[kk * 33 + (lane & 31)] = W[(size_t)(k0 + kk) * N + n0 + (lane & 31)]; }
    asm volatile("s_waitcnt lgkmcnt(0)" ::: "memory");
    const int c = lane & 7;
#pragma unroll
    for (int j = 0; j < 4; ++j) { const int n = (lane >> 3) + 8 * j; const LAS float* s = scr + (8 * c) * 33 + n;
        u32x4 o; o.x = cvtpk(s[0 * 33], s[1 * 33]); o.y = cvtpk(s[2 * 33], s[3 * 33]); o.z = cvtpk(s[4 * 33], s[5 * 33]); o.w = cvtpk(s[6 * 33], s[7 * 33]);
        bf16* dst = WT + (size_t)(dst_row0 + n0 + n) * dst_pitch + dst_k0 + k0 + 8 * c;
        for (int cp = 0; cp < ncopies; ++cp) *(u32x4*)(dst + (size_t)cp * copy_stride) = o; }
    asm volatile("s_waitcnt lgkmcnt(0)" ::: "memory");
}
__device__ __forceinline__ void rms_row_to_bf16(const float* xrow, const float* gain, bf16* orow, int lane) {
    const f32x4* xr = (const f32x4*)xrow + lane; const f32x4* gr = (const f32x4*)gain + lane;
    f32x4 v[4]; float s = 0.f;
#pragma unroll
    for (int j = 0; j < 4; ++j) { v[j] = xr[64 * j]; s += (v[j][0] * v[j][0] + v[j][1] * v[j][1]) + (v[j][2] * v[j][2] + v[j][3] * v[j][3]); }
    const float rstd = 1.f / sqrtf(wave_sum(s) * (1.f / 1024.f) + EPS);
    u32x2* o8 = (u32x2*)orow + lane;
#pragma unroll
    for (int j = 0; j < 4; ++j) { const f32x4 g = gr[64 * j]; u32x2 w; w.x = cvtpk(v[j][0] * rstd * g[0], v[j][1] * rstd * g[1]); w.y = cvtpk(v[j][2] * rstd * g[2], v[j][3] * rstd * g[3]); o8[64 * j] = w; }
}

__device__ __forceinline__ s16x4 vtr(const LAS char* p) { return __builtin_bit_cast(s16x4, __builtin_amdgcn_ds_read_tr16_b64_v4i16((LAS v4i16_t*)p)); }

template <int NK>
__device__ __forceinline__ void qk32(f32x16& S, const LAS char* Kp, const bf16x8* Q, int ks0, int r32, int hi) {
    const LAS char* kb = Kp + r32 * KP + hi * 16 + ks0 * 32;
#pragma unroll
    for (int ks = 0; ks < NK; ++ks) { const bf16x8 kf = *(const LAS bf16x8*)(kb + ks * 32); S = __builtin_amdgcn_mfma_f32_32x32x16_bf16(kf, Q[ks0 + ks], S, 0, 0, 0); }
}
__device__ __forceinline__ void pv32(f32x16 (&O)[4], const bf16x8 (&P)[2], const LAS char* Vp, int lane) {
    const int i = lane & 15, q = i >> 2, p = i & 3, dsel = (lane >> 4) & 1, h = lane >> 5;
    const LAS char* vb = Vp + (4 * h + q) * VP + (16 * dsel + 4 * p) * 2;
#pragma unroll
    for (int s = 0; s < 2; ++s)
#pragma unroll
        for (int db = 0; db < 4; ++db) {
            const s16x4 lo = vtr(vb + (16 * s) * VP + db * 64), hi4 = vtr(vb + (16 * s + 8) * VP + db * 64);
            const bf16x8 a = (bf16x8){lo[0], lo[1], lo[2], lo[3], hi4[0], hi4[1], hi4[2], hi4[3]};
            O[db] = __builtin_amdgcn_mfma_f32_32x32x16_bf16(a, P[s], O[db], 0, 0, 0);
        }
}
struct VFrag { bf16x8 a[2][4]; };
__device__ __forceinline__ void vload32(VFrag& f, const LAS char* Vp, int lane) {
    const int i = lane & 15, q = i >> 2, p = i & 3, dsel = (lane >> 4) & 1, h = lane >> 5;
    const LAS char* vb = Vp + (4 * h + q) * VP + (16 * dsel + 4 * p) * 2;
#pragma unroll
    for (int s = 0; s < 2; ++s)
#pragma unroll
        for (int db = 0; db < 4; ++db) { const s16x4 lo = vtr(vb + (16 * s) * VP + db * 64), hi4 = vtr(vb + (16 * s + 8) * VP + db * 64);
            f.a[s][db] = (bf16x8){lo[0], lo[1], lo[2], lo[3], hi4[0], hi4[1], hi4[2], hi4[3]}; }
}
template <int SS>
__device__ __forceinline__ void vload16(VFrag& f, const LAS char* Vp, int lane) {
    const int i = lane & 15, q = i >> 2, p = i & 3, dsel = (lane >> 4) & 1, h = lane >> 5;
    const LAS char* vb = Vp + (4 * h + q) * VP + (16 * dsel + 4 * p) * 2;
#pragma unroll
    for (int db = 0; db < 4; ++db) { const s16x4 lo = vtr(vb + (16 * SS) * VP + db * 64), hi4 = vtr(vb + (16 * SS + 8) * VP + db * 64);
        f.a[SS][db] = (bf16x8){lo[0], lo[1], lo[2], lo[3], hi4[0], hi4[1], hi4[2], hi4[3]}; }
}
__device__ __forceinline__ void pvmm32(f32x16 (&O)[4], const bf16x8 (&P)[2], const VFrag& f) {
#pragma unroll
    for (int s = 0; s < 2; ++s)
#pragma unroll
        for (int db = 0; db < 4; ++db) O[db] = __builtin_amdgcn_mfma_f32_32x32x16_bf16(f.a[s][db], P[s], O[db], 0, 0, 0);
}
template <int NK>
__device__ __forceinline__ void kload32(bf16x8 (&kf)[NK], const LAS char* Kp, int r32, int hi) {
    const LAS char* kb = Kp + r32 * KP + hi * 16;
#pragma unroll
    for (int ks = 0; ks < NK; ++ks) kf[ks] = *(const LAS bf16x8*)(kb + ks * 32);
}
template <int NK>
__device__ __forceinline__ void qkmm32(f32x16& S, const bf16x8 (&kf)[NK], const bf16x8* Q) {
#pragma unroll
    for (int ks = 0; ks < NK; ++ks) S = __builtin_amdgcn_mfma_f32_32x32x16_bf16(kf[ks], Q[ks], S, 0, 0, 0);
}
#define SCHED_FENCE() __builtin_amdgcn_sched_barrier(0)
template <int MODE>
__device__ __forceinline__ void soft32(const f32x16& S, bf16x8 (&P)[2], float& l, float dbase, float nslope) {
    float p[16];
#pragma unroll
    for (int r = 0; r < 16; ++r) {
        float s = S[r];
        if (MODE >= 1) { const float a = fabsf(dbase - (float)((r & 3) + 8 * (r >> 2))); s = fmaf(nslope, a, s); float e = __builtin_amdgcn_exp2f(s); if (MODE == 2) e = (a <= 64.f) ? e : 0.f; p[r] = e; }
        else p[r] = __builtin_amdgcn_exp2f(s);
        l += p[r];
    }
#pragma unroll
    for (int s = 0; s < 2; ++s) { u32x4 w; w.x = cvtpk(p[8 * s + 0], p[8 * s + 1]); w.y = cvtpk(p[8 * s + 2], p[8 * s + 3]); w.z = cvtpk(p[8 * s + 4], p[8 * s + 5]); w.w = cvtpk(p[8 * s + 6], p[8 * s + 7]); P[s] = __builtin_bit_cast(bf16x8, w); }
}
__device__ __forceinline__ void zero16(f32x16& v) {
#pragma unroll
    for (int r = 0; r < 16; ++r) v[r] = 0.f;
}

__device__ __forceinline__ void stage_put(LAS char* wl, int r32, int hi2, int db, int g4, u32x2 w) { *(LAS u32x2*)(wl + r32 * 272 + (32 * db + 8 * g4 + 4 * hi2) * 2) = w; }
__device__ __forceinline__ void stage_flush(const LAS char* wl, bf16* qbase, size_t row_stride, int lane) {
    asm volatile("s_waitcnt lgkmcnt(0)" ::: "memory");
#pragma unroll
    for (int i = 0; i < 8; ++i) { const int row = 4 * i + (lane >> 4); const u32x4 v = *(const LAS u32x4*)(wl + row * 272 + (lane & 15) * 16);
        *(u32x4*)(qbase + (size_t)row * row_stride + (lane & 15) * 8) = v; }
}
template <int NC, bool DIAG>
__device__ __forceinline__ void attn_tile(f32x16 (&O)[4], float& l, const bf16x8* Q, const LAS char* Kb, const LAS char* Vb, int r32, int hi, int lane, float qd, int k0, int qw, float nslope, float negM0) {
    constexpr int NQ = (NC == 2) ? 4 : 8;
    f32x16 S0, S1; bf16x8 P0[2], P1[2];
    const int k1 = k0 + 32;
    if (NC == 2) {
        const float ns0 = (k0 < qw) ? nslope : ((k0 > qw) ? -nslope : 0.f), ns1 = (k1 < qw) ? nslope : ((k1 > qw) ? -nslope : 0.f);
        const float b0 = fmaf(ns0, qd - (float)k0, negM0), b1 = fmaf(ns1, qd - (float)k1, negM0);
#pragma unroll
        for (int r = 0; r < 16; ++r) { S0[r] = fmaf(-ns0, (float)((r & 3) + 8 * (r >> 2)), b0); S1[r] = fmaf(-ns1, (float)((r & 3) + 8 * (r >> 2)), b1); }
    } else {
#pragma unroll
        for (int r = 0; r < 16; ++r) { S0[r] = negM0; S1[r] = negM0; }
    }
    VFrag vf0, vf1;
    if (NC == 2) {
        bf16x8 kf0[NQ], kf1[NQ];
        kload32<NQ>(kf0, Kb, r32, hi);
        SCHED_FENCE();
        qkmm32<NQ>(S0, kf0, Q);
        kload32<NQ>(kf1, Kb + 32 * KP, r32, hi);
        vload16<0>(vf0, Vb, lane);
        SCHED_FENCE();
        qkmm32<NQ>(S1, kf1, Q);
        if (DIAG) { const float nd = (k0 == qw) ? nslope : 0.f;
#pragma unroll
            for (int r = 0; r < 16; ++r) S0[r] = fmaf(nd, fabsf(qd - (float)k0 - (float)((r & 3) + 8 * (r >> 2))), S0[r]); }
        soft32<0>(S0, P0, l, 0.f, 0.f);
        vload16<1>(vf0, Vb, lane);
        SCHED_FENCE();
    } else {
        bf16x8 kf[NQ];
        kload32<NQ>(kf, Kb, r32, hi);
        SCHED_FENCE();
        qkmm32<NQ>(S0, kf, Q);
        kload32<NQ>(kf, Kb + 32 * KP, r32, hi);
        vload32(vf0, Vb, lane);
        SCHED_FENCE();
        qkmm32<NQ>(S1, kf, Q);
        soft32<0>(S0, P0, l, 0.f, 0.f);
        SCHED_FENCE();
    }
    pvmm32(O, P0, vf0);
    if (NC == 2 && DIAG) { const float nd = (k1 == qw) ? nslope : 0.f;
#pragma unroll
        for (int r = 0; r < 16; ++r) S1[r] = fmaf(nd, fabsf(qd - (float)k1 - (float)((r & 3) + 8 * (r >> 2))), S1[r]); }
    soft32<0>(S1, P1, l, 0.f, 0.f);
    if (NC == 2) {
    vload16<0>(vf1, Vb + 32 * VP, lane);
    SCHED_FENCE();
    vload16<1>(vf1, Vb + 32 * VP, lane);
    } else {
    vload32(vf1, Vb + 32 * VP, lane);
    SCHED_FENCE();
    }
    pvmm32(O, P1, vf1);
}

template <int NC>
__device__ __forceinline__ void attn_shared_unit(LAS char* lds, bf16* qbase, const bf16* Kg, const bf16* Vg, int kvp, int nt, int qpos, int qw, float nslope, float negM0, float lam, const float* subln, int wave_id) {
    const int wv = wave_id, tid = pg8::tid_fresh(wave_id);
    const int lane = tid & 63, r32 = lane & 31, hi = lane >> 5;
    const int cm = (NC == 2) ? (wv & 1) : 0;
    constexpr int NQ = (NC == 2) ? 4 : 8;
    bf16x8 Q[NQ];
    { const bf16* qrow0 = qbase + (size_t)r32 * LDQ;
#pragma unroll
    for (int ks = 0; ks < NQ; ++ks) Q[ks] = *(const bf16x8*)(qrow0 + cm * 64 + 16 * ks + 8 * hi); }
    f32x16 O[4]; float l = 0.f;
#pragma unroll
    for (int db = 0; db < 4; ++db) zero16(O[db]);
    const int lrow = tid >> 3, lcb = (tid & 7) * 32;
    const char* kgp = (const char*)(Kg + (size_t)lrow * kvp) + lcb; const char* vgp = (const char*)(Vg + (size_t)lrow * kvp) + lcb;
    const size_t tstep = (size_t)64 * kvp * 2;
    u32x4 ka0, ka1, va0, va1, kb0, kb1, vb0, vb1;
#define LOADA(tt) do { const char* kp_ = kgp + (size_t)(tt) * tstep; const char* vp_ = vgp + (size_t)(tt) * tstep; ka0 = *(const u32x4*)kp_; ka1 = *(const u32x4*)(kp_ + 16); va0 = *(const u32x4*)vp_; va1 = *(const u32x4*)(vp_ + 16); } while (0)
#define LOADB(tt) do { const char* kp_ = kgp + (size_t)(tt) * tstep; const char* vp_ = vgp + (size_t)(tt) * tstep; kb0 = *(const u32x4*)kp_; kb1 = *(const u32x4*)(kp_ + 16); vb0 = *(const u32x4*)vp_; vb1 = *(const u32x4*)(vp_ + 16); } while (0)
#define WRITEA(buf) do { LAS char* kw_ = lds + (buf) * BUFB + lrow * KP + lcb; LAS char* vw_ = lds + (buf) * BUFB + 64 * KP + lrow * VP + lcb; *(LAS u32x4*)kw_ = ka0; *(LAS u32x4*)(kw_ + 16) = ka1; *(LAS u32x4*)vw_ = va0; *(LAS u32x4*)(vw_ + 16) = va1; } while (0)
#define WRITEB(buf) do { LAS char* kw_ = lds + (buf) * BUFB + lrow * KP + lcb; LAS char* vw_ = lds + (buf) * BUFB + 64 * KP + lrow * VP + lcb; *(LAS u32x4*)kw_ = kb0; *(LAS u32x4*)(kw_ + 16) = kb1; *(LAS u32x4*)vw_ = vb0; *(LAS u32x4*)(vw_ + 16) = vb1; } while (0)
    constexpr int BUFB = 64 * KP + 64 * VP;
    const float qd = (float)(qpos - 4 * hi);
    const int td = qw >> 6;
    if (NC == 2) {
    LOADA(0); LOADB(1);
    __syncthreads();
    WRITEA(0);
    __syncthreads();
#pragma unroll 1
    for (int t = 0; t < nt; t += 2) {
        {
            if (t + 2 < nt) LOADA(t + 2);
            int k0v = t * 64; asm volatile("" : "+s"(k0v));
            const LAS char* Kb = lds + cm * 128; const LAS char* Vb = lds + 64 * KP;
            if (t == td) attn_tile<NC, true>(O, l, Q, Kb, Vb, r32, hi, lane, qd, k0v, qw, nslope, negM0);
            else attn_tile<NC, false>(O, l, Q, Kb, Vb, r32, hi, lane, qd, k0v, qw, nslope, negM0);
            WRITEB(1);
            __syncthreads();
        }
        {
            if (t + 3 < nt) LOADB(t + 3);
            int k0v = (t + 1) * 64; asm volatile("" : "+s"(k0v));
            const LAS char* Kb = lds + BUFB + cm * 128; const LAS char* Vb = lds + BUFB + 64 * KP;
            if (t + 1 == td) attn_tile<NC, true>(O, l, Q, Kb, Vb, r32, hi, lane, qd, k0v, qw, nslope, negM0);
            else attn_tile<NC, false>(O, l, Q, Kb, Vb, r32, hi, lane, qd, k0v, qw, nslope, negM0);
            if (t + 2 < nt) WRITEA(0);
            __syncthreads();
        }
    }
    } else {
    LOADA(0);
    __syncthreads();
    WRITEA(0);
    __syncthreads();
#pragma unroll 1
    for (int t = 0; t < nt; ++t) {
        const bool more = (t + 1 < nt);
        if (more) LOADA(t + 1);
        int k0v = t * 64; asm volatile("" : "+s"(k0v));
        const LAS char* Kb = lds + (t & 1) * BUFB; const LAS char* Vb = lds + (t & 1) * BUFB + 64 * KP;
        attn_tile<NC, false>(O, l, Q, Kb, Vb, r32, hi, lane, qd, k0v, qw, nslope, negM0);
        if (more) WRITEA((t + 1) & 1);
        __syncthreads();
    }
    }
#undef LOADA
#undef LOADB
#undef WRITEA
#undef WRITEB
    const int lane2 = pg8::lane_id_fresh(), hi2 = lane2 >> 5;
    bf16* qrow = qbase + (size_t)(lane2 & 31) * LDQ;
    l = pg8::sum_halves(l);
    if (NC == 2) {
        LAS float* XO = (LAS float*)lds + (wv >> 1) * 4096 + lane2;
        if (cm == 1) { const float i2 = *(const LAS float*)(lds + (LDS_BYTES - 64 + 32)) * __builtin_amdgcn_rcpf(l);
#pragma unroll
            for (int db = 0; db < 4; ++db)
#pragma unroll
                for (int r = 0; r < 16; ++r) XO[(db * 16 + r) * 64] = O[db][r] * i2; }
        __syncthreads();
        if (cm == 0) {
            const float i1 = 1.f / l; float ss = 0.f;
#pragma unroll
            for (int db = 0; db < 4; ++db)
#pragma unroll
                for (int r = 0; r < 16; ++r) { const float o = O[db][r] * i1 - XO[(db * 16 + r) * 64]; O[db][r] = o; ss += o * o; }
            ss = pg8::sum_halves(ss);
            const float rstd = (1.f / sqrtf(ss * (1.f / 128.f) + EPS)) * 0.8f;
#pragma unroll
            for (int db = 0; db < 4; ++db)
#pragma unroll
                for (int g4 = 0; g4 < 4; ++g4) { const int d = 32 * db + 8 * g4 + 4 * hi2; const f32x4 gn = *(const f32x4*)(subln + d);
                    u32x2 w; w.x = cvtpk(O[db][4 * g4 + 0] * rstd * gn[0], O[db][4 * g4 + 1] * rstd * gn[1]); w.y = cvtpk(O[db][4 * g4 + 2] * rstd * gn[2], O[db][4 * g4 + 3] * rstd * gn[3]);
                    stage_put(lds + (wv >> 1) * 16384, lane2 & 31, hi2, db, g4, w); (void)d; }
            stage_flush(lds + (wv >> 1) * 16384, qbase, LDQ, lane2);
        }
    } else {
        const float i1 = 1.f / l;
#pragma unroll
        for (int db = 0; db < 4; ++db)
#pragma unroll
            for (int g4 = 0; g4 < 4; ++g4) { const int d = 32 * db + 8 * g4 + 4 * hi2;
                u32x2 w; w.x = cvtpk(O[db][4 * g4 + 0] * i1, O[db][4 * g4 + 1] * i1); w.y = cvtpk(O[db][4 * g4 + 2] * i1, O[db][4 * g4 + 3] * i1);
                stage_put(lds + wv * 8704, lane2 & 31, hi2, db, g4, w); (void)d; }
        stage_flush(lds + wv * 8704, qbase, LDQ, lane2);
    }
}

template <bool SEG2>
__device__ __forceinline__ void attn_b_block_unit(LAS char* lds, bf16* R, float* LB, int b, int g, int j, int res0, int q0, int dil, float nslope, float negM0, int wave_id) {
    const int tid = pg8::tid_fresh(wave_id), lane = tid & 63, r32 = lane & 31, hi = lane >> 5;
    const int sub_len = SEQ / dil, hcol = (g * 4 + j) * 128;
    const int wres = SEG2 ? res0 + (wave_id >> 2) : res0;
    const int qs = SEG2 ? 32 * (wave_id & 3) : q0 + 32 * wave_id;
    const size_t rowb = (size_t)b * SEQ;
    bf16x8 Q[8];
    { const bf16* qr = R + (rowb + (size_t)(qs + r32) * dil + wres) * LDQ + C_BQ + hcol;
#pragma unroll
      for (int ks = 0; ks < 8; ++ks) Q[ks] = *(const bf16x8*)(qr + 16 * ks + 8 * hi); }
    f32x16 O[4]; float l = 0.f;
#pragma unroll
    for (int db = 0; db < 4; ++db) zero16(O[db]);
    constexpr int TK = SEG2 ? 32 : 64;
    const int k_lo = SEG2 ? 0 : ((q0 - 64 > 0) ? q0 - 64 : 0), k_hi = SEG2 ? 128 : ((q0 + 320 < sub_len) ? q0 + 320 : sub_len);
    const int nsteps = (k_hi - k_lo) / TK;
    const int lrow = tid >> 3, lcb = (tid & 7) * 32;
    const int lres = SEG2 ? res0 + (lrow >> 5) : res0, lkey = SEG2 ? (lrow & 31) : lrow;
    const char* kg = (const char*)(R + (rowb + (size_t)(k_lo + lkey) * dil + lres) * LDQ + C_BK + hcol) + lcb;
    const size_t sstep = (size_t)TK * dil * LDQ * 2;
    constexpr int VOFF = (C_BV - C_BK) * 2, BUFB = 64 * KP + 64 * VP;
    u32x4 kr0, kr1, vr0, vr1;
    kr0 = *(const u32x4*)kg; kr1 = *(const u32x4*)(kg + 16); vr0 = *(const u32x4*)(kg + VOFF); vr1 = *(const u32x4*)(kg + VOFF + 16);
    __syncthreads();
    { LAS char* kw = lds + lrow * KP + lcb; LAS char* vw = lds + 64 * KP + lrow * VP + lcb;
      *(LAS u32x4*)kw = kr0; *(LAS u32x4*)(kw + 16) = kr1; *(LAS u32x4*)vw = vr0; *(LAS u32x4*)(vw + 16) = vr1; }
    __syncthreads();
    const float qf = (float)(qs + r32 - 4 * hi);
#pragma unroll 1
    for (int s = 0; s < nsteps; ++s) {
        const bool more = (s + 1 < nsteps);
        if (more) { const char* kp = kg + (size_t)(s + 1) * sstep; kr0 = *(const u32x4*)kp; kr1 = *(const u32x4*)(kp + 16); vr0 = *(const u32x4*)(kp + VOFF); vr1 = *(const u32x4*)(kp + VOFF + 16); }
        const int kb = k_lo + s * TK;
        const LAS char* Kb = lds + (s & 1) * BUFB; const LAS char* Vb = Kb + 64 * KP;
#pragma unroll
        for (int hh = 0; hh < (SEG2 ? 1 : 2); ++hh) {
            const int row0 = SEG2 ? 32 * (wave_id >> 2) : 32 * hh, kbase = SEG2 ? kb : kb + 32 * hh;
            if (kbase + 31 >= qs - 64 && kbase <= qs + 95) {
                f32x16 S;
#pragma unroll
                for (int r = 0; r < 16; ++r) S[r] = negM0;
                qk32<8>(S, Kb + row0 * KP, Q, 0, r32, hi);
                bf16x8 P[2];
                soft32<2>(S, P, l, qf - (float)kbase, nslope);
                pv32(O, P, Vb + row0 * VP, lane);
            }
        }
        if (more) { LAS char* kw = lds + ((s + 1) & 1) * BUFB + lrow * KP + lcb; LAS char* vw = lds + ((s + 1) & 1) * BUFB + 64 * KP + lrow * VP + lcb;
            *(LAS u32x4*)kw = kr0; *(LAS u32x4*)(kw + 16) = kr1; *(LAS u32x4*)vw = vr0; *(LAS u32x4*)(vw + 16) = vr1; }
        __syncthreads();
    }
    const int lane2 = pg8::lane_id_fresh(), hi2 = lane2 >> 5;
    const size_t qrow_i = rowb + (size_t)(qs + (lane2 & 31)) * dil + wres;
    bf16* qrow = R + qrow_i * LDQ + C_BQ + hcol;
    l = pg8::sum_halves(l);
    const float i1 = 1.f / l;
#pragma unroll
    for (int db = 0; db < 4; ++db)
#pragma unroll
        for (int g4 = 0; g4 < 4; ++g4) { const int d = 32 * db + 8 * g4 + 4 * hi2;
            u32x2 w; w.x = cvtpk(O[db][4 * g4 + 0] * i1, O[db][4 * g4 + 1] * i1); w.y = cvtpk(O[db][4 * g4 + 2] * i1, O[db][4 * g4 + 3] * i1);
            stage_put(lds + wave_id * 8704, lane2 & 31, hi2, db, g4, w); (void)d; }
    stage_flush(lds + wave_id * 8704, R + (rowb + (size_t)qs * dil + wres) * LDQ + C_BQ + hcol, (size_t)dil * LDQ, lane2);
    if (hi2 == 0) LB[((size_t)g * M + qrow_i) * 4 + j] = l;
}

#define XB_TMO      128
#define XB_XCNT(j)  (256  + 64 * (j))
#define XB_XSUB(j)  (1280 + 64 * (j))
#define XB_XGEN(j)  (2304 + 64 * (j))
#define XB_TOP      3328
#define XB_TOPGEN   3392
#define XCD_BAR_WORDS 3456
#define XB_SPIN_CAP (1u << 18)

__device__ __forceinline__ unsigned xb_ld(unsigned* p)              { return __hip_atomic_load(p, __ATOMIC_RELAXED, __HIP_MEMORY_SCOPE_AGENT); }
__device__ __forceinline__ unsigned xb_add(unsigned* p, unsigned v) { return __hip_atomic_fetch_add(p, v, __ATOMIC_RELAXED, __HIP_MEMORY_SCOPE_AGENT); }
__device__ __forceinline__ unsigned xb_xcc_id() { return (unsigned)__builtin_amdgcn_s_getreg((3 << 11) | 20) & 0xFu; }
#define XB_SPIN(cond, bar) do { unsigned _sp = 0; while (cond) { __builtin_amdgcn_s_sleep(1); \
    if ((++_sp & 255u) == 0u) { if (xb_ld(&(bar)[XB_TMO])) break; if (_sp > XB_SPIN_CAP) { atomicAdd(&(bar)[XB_TMO], 1u); break; } } } } while (0)

struct XcdBarrier {
    unsigned* bar; unsigned x;
    volatile LAS unsigned* st;
};

__device__ __forceinline__ XcdBarrier xcd_barrier_post(unsigned* bar, volatile LAS unsigned* st) {
    XcdBarrier b; b.bar = bar; b.x = xb_xcc_id(); b.st = st;
    if (threadIdx.x == 0) (void)xb_add(&bar[XB_XCNT(b.x)], 1u);
    return b;
}
__device__ __forceinline__ void xcd_barrier_complete(unsigned* bar, unsigned x, unsigned& nloc, unsigned& nx) {
    const unsigned G = gridDim.x * gridDim.y * gridDim.z;
    unsigned sum, cnt, mine, sp = 0u;
    for (;;) {
        sum = 0u; cnt = 0u; mine = 0u;
#pragma unroll
        for (unsigned j = 0; j < 16; ++j) { const unsigned c = xb_ld(&bar[XB_XCNT(j)]); sum += c; cnt += (c > 0u) ? 1u : 0u; mine = (j == x) ? c : mine; }
        if (sum == G) break;
        __builtin_amdgcn_s_sleep(1);
        if ((++sp & 255u) == 0u) { if (xb_ld(&bar[XB_TMO])) break; if (sp > XB_SPIN_CAP) { atomicAdd(&bar[XB_TMO], 1u); break; } }
    }
    nloc = mine > 0u ? mine : 1u; nx = cnt > 0u ? cnt : 1u;
}

__device__ __forceinline__ void xcd_barrier(const XcdBarrier& b, int wave_id) {
    asm volatile("s_waitcnt vmcnt(0)" ::: "memory");
    __syncthreads();
    if (pg8::tid_fresh(wave_id) == 0) {
        unsigned* bar = b.bar;
        __builtin_amdgcn_s_waitcnt(0);
        unsigned nloc = b.st[0], nx = b.st[1];
        if (nloc == 0u) { xcd_barrier_complete(bar, b.x, nloc, nx); b.st[0] = nloc; b.st[1] = nx; }
        const unsigned old = xb_add(&bar[XB_XSUB(b.x)], 1u);
        const unsigned gen = old / nloc;
        if (old + 1u == (gen + 1u) * nloc) {
            __builtin_amdgcn_fence(__ATOMIC_RELEASE, "agent");
            asm volatile("s_waitcnt vmcnt(0)" ::: "memory");
            const unsigned og = xb_add(&bar[XB_TOP], 1u);
            const unsigned tg = og / nx;
            if (og + 1u == (tg + 1u) * nx) xb_add(&bar[XB_TOPGEN], 1u);
            else XB_SPIN(xb_ld(&bar[XB_TOPGEN]) == tg, bar);
            __builtin_amdgcn_fence(__ATOMIC_ACQUIRE, "agent");
            xb_add(&bar[XB_XGEN(b.x)], 1u);
            asm volatile("s_waitcnt vmcnt(0)" ::: "memory");
        } else {
            XB_SPIN(xb_ld(&bar[XB_XGEN(b.x)]) == gen, bar);
            __builtin_amdgcn_fence(__ATOMIC_ACQUIRE, "agent");
            asm volatile("s_waitcnt vmcnt(0)" ::: "memory");
        }
    }
    __syncthreads();
}

struct Args { const float* in[25]; float* out; unsigned char* ws; };

__global__ void __launch_bounds__(512, 2) fwd_megakernel(Args a) {
    extern __shared__ __attribute__((aligned(16))) unsigned char lds_raw[];
    LAS unsigned char* lds = (LAS unsigned char*)lds_raw;
    cg::grid_group grid = cg::this_grid();
    const int wave = __builtin_amdgcn_readfirstlane((int)threadIdx.x >> 6);
#define FRESH_LANE const int lane = pg8::lane_id_fresh();
    const int G = gridDim.x, bid = blockIdx.x;
    const int gw = bid * 8 + wave, NGW = G * 8;
    unsigned char* ws = a.ws;
    const float* x = a.in[0]; const float* mem = a.in[1];
    bf16* W_IN = (bf16*)(ws + WS_WIN); bf16* W_G = (bf16*)(ws + WS_WG); bf16* W_MEM = (bf16*)(ws + WS_WMEM); bf16* W_BR = (bf16*)(ws + WS_WBR);
    bf16* W_OUT = (bf16*)(ws + WS_WOUT3); bf16* W_GU = (bf16*)(ws + WS_WGU); bf16* W_DN = (bf16*)(ws + WS_WDN);
    float* LB = (float*)(ws + WS_LB); bf16* R = (bf16*)(ws + WS_R);
    unsigned char* dob = (unsigned char*)a.out;
    bf16* XN = (bf16*)(dob + DO_XN); bf16* MN = (bf16*)(dob + DO_MN); bf16* CKV = (bf16*)(dob + DO_CKV);

    volatile LAS unsigned* MISC = (volatile LAS unsigned*)(lds + MISC_OFF);
    unsigned* barw = (unsigned*)(ws + WS_BAR);
    if (threadIdx.x < 16) MISC[threadIdx.x] = 0u;
    if (a.ws == nullptr) grid.sync();
    XcdBarrier bar = xcd_barrier_post(barw, MISC);
    __syncthreads();
    {
        FRESH_LANE
        LAS float* scr = (LAS float*)(lds + wave * 8704);
        constexpr int I_IN = 16 * (DIN / 32), I_G = 16 * (3 * D / 32), I_MEM = 16 * (D / 32), I_BR = 8 * (D / 32), I_OUT = 16 * (D / 32), I_FF = 16 * (DFF / 32), I_DN = (DFF / 64) * (D / 32);
        constexpr int NITEMS = I_IN + I_G + I_MEM + 3 * I_BR + I_OUT + 2 * I_FF + I_DN;
        for (int it = gw; it < NITEMS; it += NGW) {
            int r = it;
            if (r < I_IN) { const int nb = DIN / 32; tr_item(a.in[3], DIN, 64 * (r / nb), 32 * (r % nb), W_IN, D, 0, 0, 1, 0, scr, lane); continue; } r -= I_IN;
            if (r < I_G) { const int nb = 3 * D / 32; tr_item(a.in[4], 3 * D, 64 * (r / nb), 32 * (r % nb), W_G, D, 0, 0, 1, 0, scr, lane); continue; } r -= I_G;
            if (r < I_MEM) { const int nb = D / 32; tr_item(a.in[16], D, 64 * (r / nb), 32 * (r % nb), W_MEM, D, 0, 0, 1, 0, scr, lane); continue; } r -= I_MEM;
            if (r < 3 * I_BR) { const int gI = r / I_BR, rr = r % I_BR, nb = D / 32; tr_item(a.in[19] + (size_t)gI * 512 * D, D, 64 * (rr / nb), 32 * (rr % nb), W_BR + (size_t)gI * D * 512, 512, 0, 0, 1, 0, scr, lane); continue; } r -= 3 * I_BR;
            if (r < I_OUT) { const int nb = D / 32; tr_item(a.in[20], D, 64 * (r / nb), 32 * (r % nb), W_OUT, D, 0, 0, 1, 0, scr, lane); continue; } r -= I_OUT;
            if (r < 2 * I_FF) { const int s = r / I_FF, rr = r % I_FF, nb = DFF / 32; const int n0 = 32 * (rr % nb);
                tr_item(a.in[22 + s], DFF, 64 * (rr / nb), n0, W_GU, D, 256 * (n0 / 128) + 128 * s + (n0 % 128) - n0, 0, 1, 0, scr, lane); continue; } r -= 2 * I_FF;
            { const int nb = D / 32; tr_item(a.in[24], D, 64 * (r / nb), 32 * (r % nb), W_DN, DFF, 0, 0, 1, 0, scr, lane); }
        }
        { float* SSQ0 = (float*)(ws + WS_SSQ); for (int i = gw * 64 + lane; i < M; i += NGW * 64) SSQ0[i] = 0.f; }
        for (int m = gw; m < M + MMEM; m += NGW) {
            if (m < M) rms_row_to_bf16(x + (size_t)m * D, a.in[2], XN + (size_t)m * D, lane);
            else rms_row_to_bf16(mem + (size_t)(m - M) * D, a.in[15], MN + (size_t)(m - M) * D, lane);
        }
    }
    xcd_barrier(bar, wave);

    {
        LAS float* GT = (LAS float*)(lds + GT_OFF);
        { const int t2 = pg8::tid_fresh(wave);
          if (t2 < 64) { GT[t2] = a.in[6][t2]; GT[64 + t2] = a.in[7][t2]; }
          if (t2 < 128) { GT[128 + t2] = a.in[13][t2]; GT[256 + t2] = a.in[14][t2]; GT[384 + t2] = a.in[17][t2]; GT[512 + t2] = a.in[18][t2]; } }
        __syncthreads();
        { const pg8::EpiQKV E{R, LDQ, CKV, D, GT, (LAS float*)(lds + XCH_OFF)};
          pg8::Gemm g{XN, W_IN, M, DIN, D, D, MN, W_MEM, nullptr, nullptr}; pg8::DualOrder S; S.init(M, DIN, MMEM, D, G, bid);
          pg8::gemm_phase<pg8::EpiQKV, pg8::DualOrder, true, true>(lds, g, S, E, wave); }
    }
    xcd_barrier(bar, wave);

    {
        FRESH_LANE
#define UNIFORM_F(v) __builtin_bit_cast(float, __builtin_amdgcn_readfirstlane(__builtin_bit_cast(int, (float)(v))))
        const float negM_a = UNIFORM_F(-8.f * absmax_vec(a.in[6], 64, lane) * absmax_vec(a.in[7], 64, lane) * L2E);
        const float lam = UNIFORM_F(expf(wave_sum(a.in[8][lane] * a.in[9][lane])) - expf(wave_sum(a.in[10][lane] * a.in[11][lane])) + 0.2f);
        *(LAS float*)(lds + (LDS_BYTES - 64 + 32)) = lam;
        for (int rr = 0; rr < (512 + G - 1) / G; ++rr) {
            int u;
            if (G == 256) { const int k = rr * 32 + (bid >> 3), bh = (bid & 7) + 8 * (k >> 4); u = bh * 16 + (k & 15); }
            else { u = rr * G + bid; if (u >= 512) break; }
            const int b = u >> 6, h = (u >> 4) & 3, qblk = u & 15;
            const int ta_ = pg8::lane_id_fresh();
            const int qpos = qblk * 128 + (wave >> 1) * 32 + (ta_ & 31);
            bf16* qrow = R + ((size_t)b * SEQ + qblk * 128 + (wave >> 1) * 32) * LDQ + C_AQ + h * 128;
            const bf16* Kg = R + (size_t)b * SEQ * LDQ + C_AK + h * 128; const bf16* Vg = R + (size_t)b * SEQ * LDQ + C_AV + h * 128;
            const float nslope = -__builtin_amdgcn_exp2f(-2.f * (float)(h + 1)) * L2E;
            attn_shared_unit<2>((LAS char*)lds, qrow, Kg, Vg, LDQ, SEQ / 64, qpos, qblk * 128 + (wave >> 1) * 32, nslope, negM_a, lam, a.in[12], wave);
        }
        const int lnc_ = pg8::lane_id_fresh();
        const float negM_c = UNIFORM_F(-11.313708499f * absmax_vec(a.in[17], 128, lnc_) * absmax_vec(a.in[18], 128, lnc_) * L2E);
        for (int u = bid; u < 256; u += G) {
            const int b = u >> 5, h = (u >> 3) & 3, qblk = u & 7;
            const int tc_ = pg8::lane_id_fresh();
            const int qpos = qblk * 256 + wave * 32 + (tc_ & 31);
            bf16* qrow = R + ((size_t)b * SEQ + qblk * 256 + wave * 32) * LDQ + C_CQ + h * 128;
            const bf16* Kg = CKV + (size_t)b * NMEM * D + h * 128; const bf16* Vg = Kg + 512;
            attn_shared_unit<1>((LAS char*)lds, qrow, Kg, Vg, D, NMEM / 64, qpos, 0, 0.f, negM_c, 0.f, a.in[12], wave);
        }
        __syncthreads();
        { const int lnb_ = pg8::lane_id_fresh();
          const float negM_b = UNIFORM_F(-11.313708499f * absmax_vec(a.in[13], 128, lnb_) * absmax_vec(a.in[14], 128, lnb_) * L2E);
          for (int rr = 0; rr < (768 + G - 1) / G; ++rr) {
              int u;
              if (G == 256) { const int k = rr * 32 + (bid >> 3); u = ((bid & 7) + 8 * (k >> 3)) * 8 + (k & 7); }
              else { u = rr * G + bid; if (u >= 768) break; }
              const int sid = u >> 3, loc = u & 7, b = sid / 12, g = (sid % 12) >> 2, j = sid & 3;
              const float slope = __builtin_amdgcn_exp2f(-8.f * (float)(g * 4 + j + 1) / 12.f);
              if (g == 0) attn_b_block_unit<false>((LAS char*)lds, R, LB, b, g, j, 0, loc * 256, 1, -slope * L2E, negM_b, wave);
              else if (g == 1) attn_b_block_unit<false>((LAS char*)lds, R, LB, b, g, j, loc >> 1, (loc & 1) * 256, 4, -slope * 4.f * L2E, negM_b, wave);
              else attn_b_block_unit<true>((LAS char*)lds, R, LB, b, g, j, 2 * loc, 0, 16, -slope * 16.f * L2E, negM_b, wave);
          } }
    }
    xcd_barrier(bar, wave);

    { FRESH_LANE
    for (int m = gw; m < M; m += NGW) {
        const int j = lane >> 4, d8 = (lane & 15) * 8;
        const float l0 = LB[((size_t)0 * M + m) * 4 + j], l1 = LB[((size_t)1 * M + m) * 4 + j], l2 = LB[((size_t)2 * M + m) * 4 + j];
        const float inv = 1.f / (l0 + l1 + l2); const float w0 = l0 * inv, w1 = l1 * inv, w2 = l2 * inv;
        bf16* p0 = R + (size_t)m * LDQ + C_BQ + j * 128 + d8;
        const u32x4 o0 = *(const u32x4*)p0, o1 = *(const u32x4*)(p0 + 512), o2 = *(const u32x4*)(p0 + 1024);
        u32x4 w;
#pragma unroll
        for (int e = 0; e < 4; ++e) {
            const float lo = w0 * pg8::bf_lo(o0[e]) + w1 * pg8::bf_lo(o1[e]) + w2 * pg8::bf_lo(o2[e]);
            const float hi = w0 * pg8::bf_hi(o0[e]) + w1 * pg8::bf_hi(o1[e]) + w2 * pg8::bf_hi(o2[e]);
            w[e] = cvtpk(lo, hi);
        }
        *(u32x4*)p0 = w;
    } }
    {
        pg8::Gemm g{XN, W_G, M, 3 * D, D, D, nullptr, nullptr, nullptr, nullptr}; pg8::StaticOrder S; S.init(M, 3 * D, G, bid);
        pg8::EpiGate E{R + C_GATE, LDQ, a.in[5]};
        pg8::gemm_phase<pg8::EpiGate, pg8::StaticOrder, true, true>(lds, g, S, E, wave);
    }
    xcd_barrier(bar, wave);

    {
        pg8::Gemm g{R + C_AQ, W_BR, M, D, 512, LDQ, R + C_BQ, W_BR + (size_t)D * 512, R + C_CQ, W_BR + (size_t)2 * D * 512};
        pg8::RepeatOrder S; S.init(M, D, 3, G, bid);
        pg8::EpiBranch E{R + C_GATE, R + C_GATE, LDQ, D};
        pg8::gemm_phase<pg8::EpiBranch, pg8::RepeatOrder, true, true>(lds, g, S, E, wave);
    }
    xcd_barrier(bar, wave);

    {
        pg8::Gemm g{R + C_GATE, W_OUT, M, D, D, LDQ, nullptr, nullptr, nullptr, nullptr}; pg8::StaticOrder S; S.init(M, D, G, bid);
        pg8::EpiResidNorm E{x, a.out, D, a.in[21], R + C_H2, LDQ, (float*)(ws + WS_SSQ)};
        pg8::gemm_phase<pg8::EpiResidNorm, pg8::StaticOrder, true, true>(lds, g, S, E, wave);
    }
    xcd_barrier(bar, wave);

    {
        pg8::Gemm g{R + C_H2, W_GU, M, 2 * DFF, D, LDQ, nullptr, nullptr, nullptr, nullptr}; pg8::StaticOrder S; S.init(M, 2 * DFF, G, bid);
        pg8::EpiSwiGLU E{R + C_ACT, LDQ, (const float*)(ws + WS_SSQ)};
        pg8::gemm_phase<pg8::EpiSwiGLU, pg8::StaticOrder, true, true>(lds, g, S, E, wave);
    }
    xcd_barrier(bar, wave);

    {
        pg8::Gemm g{R + C_ACT, W_DN, M, D, DFF, LDQ, nullptr, nullptr, nullptr, nullptr}; pg8::StaticOrder S; S.init(M, D, G, bid);
        pg8::EpiResid E{a.out, a.out, D};
        pg8::gemm_phase<pg8::EpiResid, pg8::StaticOrder, true, true>(lds, g, S, E, wave);
    }
}

extern "C" void kernel_launch(void* const* d_in, const int* in_sizes, int n_in, void* d_out, int out_size, void* d_ws, size_t ws_size, hipStream_t stream) {
    static int grid = 0;
    if (grid == 0) {
        if (n_in != 25 || out_size != M * D || ws_size < WS_END) { fprintf(stderr, "kernel_launch: unexpected problem shape (n_in %d out %d ws %zu)\n", n_in, out_size, ws_size); grid = -1; return; }
        int dev = 0, cus = 0, per_cu = 0;
        hipGetDevice(&dev);
        hipDeviceGetAttribute(&cus, hipDeviceAttributeMultiprocessorCount, dev);
        if (hipFuncSetAttribute((const void*)fwd_megakernel, hipFuncAttributeMaxDynamicSharedMemorySize, LDS_BYTES) != hipSuccess) { fprintf(stderr, "kernel_launch: hipFuncSetAttribute failed\n"); }
        hipOccupancyMaxActiveBlocksPerMultiprocessor(&per_cu, (const void*)fwd_megakernel, 512, LDS_BYTES);
        (void)hipGetLastError();
        if (per_cu < 1) per_cu = 1;
        grid = cus;
        fprintf(stderr, "kernel_launch: cus %d per_cu %d grid %d\n", cus, per_cu, grid);
    }
    if (grid < 0) return;
    if (hipMemsetAsync((char*)d_ws + WS_BAR, 0, 16384, stream) != hipSuccess) { fprintf(stderr, "kernel_launch: memset of the barrier words failed\n"); return; }
    Args a{};
    for (int i = 0; i < 25; ++i) a.in[i] = (const float*)d_in[i];
    a.out = (float*)d_out; a.ws = (unsigned char*)d_ws;
    void* args[] = {&a};
    hipError_t e = hipLaunchCooperativeKernel((const void*)fwd_megakernel, dim3(grid), dim3(512), args, LDS_BYTES, stream);
    if (e != hipSuccess) fprintf(stderr, "cooperative launch failed: %s (grid %d)\n", hipGetErrorString(e), grid);
}
```

```cpp
#include <hip/hip_runtime.h>
#include <hip/hip_cooperative_groups.h>
#include <cstdio>
#include <cstdint>
namespace cg = cooperative_groups;
namespace pg8 {
#define PG8_LAS __attribute__((address_space(3)))
typedef unsigned short bf16_t;
typedef short bf16x8 __attribute__((ext_vector_type(8)));
typedef float f32x4 __attribute__((ext_vector_type(4)));
typedef unsigned u32x4 __attribute__((ext_vector_type(4)));
constexpr int BM = 256, BK = 64, HALF = 128, HTB = HALF * BK * 2  , STAGE_BYTES = 8 * HTB, NXCD = 8, WGM = 8;

__host__ __device__ __forceinline__ int lds_byte(int r, int c) { const int st = (r >> 4) * 2 + (c >> 5), rr = r & 15, cc = c & 31, ob = rr * 64 + cc * 2; return st * 1024 + (ob ^ (((ob >> 9) & 1) << 5)); }
__host__ __device__ __forceinline__ void stage_rc(int b, int& R, int& C) { const int st = b / 1024, sb = b % 1024, swz = sb ^ (((sb >> 9) & 1) << 5); R = (st >> 1) * 16 + swz / 64; C = (st & 1) * 32 + (swz % 64) / 2; }
__host__ __device__ __forceinline__ int perm32(int rho) { const int n = rho >> 4, i = rho & 15; return 8 * (i >> 2) + 4 * n + (i & 3); }

struct Unit { int pm, pn, src; };
struct Gemm { const bf16_t* A; const bf16_t* Bt; int M, N, K, lda; const bf16_t* A2; const bf16_t* Bt2; const bf16_t* A3; const bf16_t* Bt3; };

struct StaticOrder {
    int nM, nN, nwg, G, c;
    __host__ __device__ void init(int M, int N, int G_, int c_) { nM = M / BM; nN = N / BM; nwg = nM * nN; G = G_; c = c_; }
    __host__ __device__ bool next(int i, Unit& u) const {
        const long L = (long)i * G + c; if (L >= nwg) return false;
        int wgid = (int)L; { const int q = nwg / NXCD, r = nwg % NXCD, xcd = wgid % NXCD, off = wgid / NXCD; wgid = (xcd < r ? xcd * (q + 1) : r * (q + 1) + (xcd - r) * q) + off; }
        const int nig = WGM * nN, gid = wgid / nig, fm = gid * WGM, gsz = (nM - fm) < WGM ? (nM - fm) : WGM;
        u.pm = fm + ((wgid % nig) % gsz); u.pn = (wgid % nig) / gsz; u.src = 0; return true;
    }
    __device__ __forceinline__ void a_ready(const Unit&) const {}
    __device__ __forceinline__ void done(const Unit&) const {}
};

struct DualOrder {
    StaticOrder S1; int nM2, nN2;
    __host__ __device__ void init(int M, int N, int M2, int N2, int G_, int c_) { S1.init(M, N, G_, c_); nM2 = M2 / BM; nN2 = N2 / BM; }
    __host__ __device__ bool next(int i, Unit& u) const {
        if (S1.next(i, u)) return true;
        const long L = (long)i * S1.G + S1.c - S1.nwg; if (L < 0 || L >= (long)nM2 * nN2) return false;
        u.pm = (int)L % nM2; u.pn = (int)L / nM2; u.src = 1; return true;
    }
    __device__ __forceinline__ void a_ready(const Unit&) const {}
    __device__ __forceinline__ void done(const Unit&) const {}
};

struct RepeatOrder {
    StaticOrder S1; int nrep;
    __host__ __device__ void init(int M, int N, int nrep_, int G_, int c_) { S1.init(M, N, G_, c_); nrep = nrep_; }
    __host__ __device__ bool next(int i, Unit& u) const { if (i >= nrep) return false; if (!S1.next(0, u)) return false; u.src = i; return true; }
    __device__ __forceinline__ void a_ready(const Unit&) const {}
    __device__ __forceinline__ void done(const Unit&) const {}
};

template <int K> __device__ __forceinline__ float shx(float v) {
    return __builtin_bit_cast(float, __builtin_amdgcn_ds_swizzle(__builtin_bit_cast(int, v), (K << 10) | 0x1f)); }
__device__ __forceinline__ float sum_halves(float v) {
    auto rr = __builtin_amdgcn_permlane32_swap(__builtin_bit_cast(unsigned, v), __builtin_bit_cast(unsigned, v), false, false);
    return __builtin_bit_cast(float, (unsigned)rr[0]) + __builtin_bit_cast(float, (unsigned)rr[1]); }
__device__ __forceinline__ float max_halves(float v) {
    auto rr = __builtin_amdgcn_permlane32_swap(__builtin_bit_cast(unsigned, v), __builtin_bit_cast(unsigned, v), false, false);
    return fmaxf(__builtin_bit_cast(float, (unsigned)rr[0]), __builtin_bit_cast(float, (unsigned)rr[1])); }
__device__ __forceinline__ int lane_id_fresh() { int z = 0; asm volatile("" : "+s"(z)); return __builtin_amdgcn_mbcnt_hi(~0u, __builtin_amdgcn_mbcnt_lo(~0u, z)); }
__device__ __forceinline__ int tid_fresh(int wave) { return wave * 64 + lane_id_fresh(); }
typedef float f32x2v_t __attribute__((ext_vector_type(2))); typedef __bf16 bf16x2v_t __attribute__((ext_vector_type(2)));
__device__ __forceinline__ unsigned cvt_pk_bf16(float lo, float hi) { f32x2v_t v = {lo, hi}; bf16x2v_t b = __builtin_convertvector(v, bf16x2v_t); return __builtin_bit_cast(unsigned, b); }
__device__ __forceinline__ float bf_lo(unsigned w) { return __builtin_bit_cast(float, w << 16); }
__device__ __forceinline__ float bf_hi(unsigned w) { return __builtin_bit_cast(float, w & 0xffff0000u); }
#define PG8_ACC const f32x4 (&acc)[2][2][4][2]

struct EpiQKV {
    static constexpr bool PERM = true, AFTER_DRAIN = false;
    bf16_t* O; int ldc; bf16_t* O2; int ldc2;
    PG8_LAS const float* GT;
    PG8_LAS float* X;
    __device__ __forceinline__ void operator()(PG8_ACC, const Unit& u, int wr, int wc, int fr, int fq) const {
        const int pn = u.pn;
        int kind, gp; float sc = 1.f;
        constexpr float L2E = 1.4426950408889634f;
        const int mode = u.src;
        if (mode == 0) {
            if (pn < 2) { kind = 1; gp = 0; sc = 0.125f * L2E; }
            else if (pn < 4) { kind = 1; gp = 64; }
            else if (pn < 6) { kind = 0; gp = 64; }
            else if (pn < 12) { kind = 2; gp = 128; sc = 0.08838834764831845f * L2E; }
            else if (pn < 18) { kind = 2; gp = 256; }
            else if (pn < 24) { kind = 0; gp = 256; }
            else { kind = 2; gp = 384; sc = 0.08838834764831845f * L2E; }
        } else {
            if (pn < 2) { kind = 2; gp = 512; } else { kind = 0; gp = 512; }
        }
        const int row0 = u.pm * BM + wr * 64 + fr, col0 = pn * BM + wc * 32 + 8 * fq;
        float rs[2][4][2];
        f32x4 gv[2];
        if (kind != 0) {
#pragma unroll
            for (int ai = 0; ai < 2; ++ai)
#pragma unroll
                for (int m = 0; m < 4; ++m)
#pragma unroll
                    for (int bj = 0; bj < 2; ++bj) {
                        const f32x4 a = acc[ai][bj][m][0], b = acc[ai][bj][m][1];
                        float s = (a[0] * a[0] + a[1] * a[1]) + (a[2] * a[2] + a[3] * a[3]) + (b[0] * b[0] + b[1] * b[1]) + (b[2] * b[2] + b[3] * b[3]);
                        s += shx<16>(s); s = sum_halves(s);
                        if (fq == 0) X[((ai * 128 + wr * 64 + m * 16 + fr) * 2 + bj) * 4 + wc] = s;
                    }
            asm volatile("s_waitcnt lgkmcnt(0)" ::: "memory"); __builtin_amdgcn_s_barrier(); asm volatile("" ::: "memory");
            const int hd = (kind == 1) ? 64 : 128;
            const float inv_hd = (kind == 1) ? (1.f / 64.f) : (1.f / 128.f);
#pragma unroll
            for (int ai = 0; ai < 2; ++ai)
#pragma unroll
                for (int m = 0; m < 4; ++m)
#pragma unroll
                    for (int bj = 0; bj < 2; ++bj) {
                        const f32x4 xs = *(const PG8_LAS f32x4*)(X + ((ai * 128 + wr * 64 + m * 16 + fr) * 2 + bj) * 4);
                        float tot;
                        if (kind == 1) tot = (wc < 2) ? (xs[0] + xs[1]) : (xs[2] + xs[3]);
                        else tot = (xs[0] + xs[1]) + (xs[2] + xs[3]);
                        rs[ai][m][bj] = __builtin_amdgcn_rsqf(tot * inv_hd + 1e-6f) * sc;
                    }
            const int gc = ((wc * 32 + 8 * fq) & (hd - 1));
            gv[0] = *(const PG8_LAS f32x4*)(GT + gp + gc); gv[1] = *(const PG8_LAS f32x4*)(GT + gp + gc + 4);
        } else {
#pragma unroll
            for (int ai = 0; ai < 2; ++ai)
#pragma unroll
                for (int m = 0; m < 4; ++m)
#pragma unroll
                    for (int bj = 0; bj < 2; ++bj) rs[ai][m][bj] = 1.f;
            gv[0] = (f32x4){1.f, 1.f, 1.f, 1.f}; gv[1] = gv[0];
        }
#pragma unroll
        for (int ai = 0; ai < 2; ++ai)
#pragma unroll
            for (int m = 0; m < 4; ++m) { bf16_t* rowp = (mode ? O2 : O) + (size_t)(row0 + ai * HALF + m * 16) * (mode ? ldc2 : ldc) + col0;
#pragma unroll
                for (int bj = 0; bj < 2; ++bj) { const float r = rs[ai][m][bj];
                    const f32x4 v0 = acc[ai][bj][m][0] * gv[0] * r, v1 = acc[ai][bj][m][1] * gv[1] * r;
                    u32x4 w; w.x = cvt_pk_bf16(v0[0], v0[1]); w.y = cvt_pk_bf16(v0[2], v0[3]); w.z = cvt_pk_bf16(v1[0], v1[1]); w.w = cvt_pk_bf16(v1[2], v1[3]);
                    *(u32x4*)(rowp + bj * HALF) = w; } }
    }
};

struct EpiGate {
    static constexpr bool PERM = true, AFTER_DRAIN = false;
    bf16_t* O; int ldc; const float* bias;
    __device__ __forceinline__ void operator()(PG8_ACC, const Unit& u, int wr, int wc, int fr, int fq) const {
        const int row0 = u.pm * BM + wr * 64 + fr, col0 = u.pn * BM + wc * 32 + 8 * fq;
        f32x4 bv[2][2];
#pragma unroll
        for (int bj = 0; bj < 2; ++bj)
#pragma unroll
            for (int n = 0; n < 2; ++n) bv[bj][n] = *(const f32x4*)(bias + col0 + bj * HALF + 4 * n);
#pragma unroll
        for (int ai = 0; ai < 2; ++ai)
#pragma unroll
            for (int m = 0; m < 4; ++m) { bf16_t* rowp = O + (size_t)(row0 + ai * HALF + m * 16) * ldc + col0;
#pragma unroll
                for (int bj = 0; bj < 2; ++bj) { f32x4 v0 = acc[ai][bj][m][0] + bv[bj][0], v1 = acc[ai][bj][m][1] + bv[bj][1];
#pragma unroll
                    for (int e = 0; e < 4; ++e) { v0[e] = __builtin_amdgcn_rcpf(1.f + __builtin_amdgcn_exp2f(-1.4426950408889634f * v0[e])); v1[e] = __builtin_amdgcn_rcpf(1.f + __builtin_amdgcn_exp2f(-1.4426950408889634f * v1[e])); }
                    u32x4 w; w.x = cvt_pk_bf16(v0[0], v0[1]); w.y = cvt_pk_bf16(v0[2], v0[3]); w.z = cvt_pk_bf16(v1[0], v1[1]); w.w = cvt_pk_bf16(v1[2], v1[3]);
                    *(u32x4*)(rowp + bj * HALF) = w; } }
    }
};

struct EpiBranch {
    static constexpr bool PERM = true, AFTER_DRAIN = false;
    bf16_t* MIX; const bf16_t* GATE0; int ldc; int gstride;
    __device__ __forceinline__ void operator()(PG8_ACC, const Unit& u, int wr, int wc, int fr, int fq) const {
        const int row0 = u.pm * BM + wr * 64 + fr, col0 = u.pn * BM + wc * 32 + 8 * fq;
        const bf16_t* GATE = GATE0 + (size_t)u.src * gstride; const int accum = u.src;
#pragma unroll
        for (int ai = 0; ai < 2; ++ai)
#pragma unroll
            for (int m = 0; m < 4; ++m) { const size_t off = (size_t)(row0 + ai * HALF + m * 16) * ldc + col0;
#pragma unroll
                for (int bj = 0; bj < 2; ++bj) { const u32x4 gt = *(const u32x4*)(GATE + off + bj * HALF);
                    f32x4 a = acc[ai][bj][m][0], b = acc[ai][bj][m][1];
                    a[0] *= bf_lo(gt.x); a[1] *= bf_hi(gt.x); a[2] *= bf_lo(gt.y); a[3] *= bf_hi(gt.y); b[0] *= bf_lo(gt.z); b[1] *= bf_hi(gt.z); b[2] *= bf_lo(gt.w); b[3] *= bf_hi(gt.w);
                    if (accum) { const u32x4 mx = *(const u32x4*)(MIX + off + bj * HALF);
                        a[0] += bf_lo(mx.x); a[1] += bf_hi(mx.x); a[2] += bf_lo(mx.y); a[3] += bf_hi(mx.y); b[0] += bf_lo(mx.z); b[1] += bf_hi(mx.z); b[2] += bf_lo(mx.w); b[3] += bf_hi(mx.w); }
                    u32x4 w; w.x = cvt_pk_bf16(a[0], a[1]); w.y = cvt_pk_bf16(a[2], a[3]); w.z = cvt_pk_bf16(b[0], b[1]); w.w = cvt_pk_bf16(b[2], b[3]);
                    *(u32x4*)(MIX + off + bj * HALF) = w; } }
    }
};

struct EpiResid {
    static constexpr bool PERM = true, AFTER_DRAIN = false;
    const float* res; float* out; int ld;
    __device__ __forceinline__ void operator()(PG8_ACC, const Unit& u, int wr, int wc, int fr, int fq) const {
        const int row0 = u.pm * BM + wr * 64 + fr, col0 = u.pn * BM + wc * 32 + 8 * fq;
#pragma unroll
        for (int ai = 0; ai < 2; ++ai)
#pragma unroll
            for (int m = 0; m < 4; ++m) { const size_t off = (size_t)(row0 + ai * HALF + m * 16) * ld + col0;
#pragma unroll
                for (int bj = 0; bj < 2; ++bj) {
                    const f32x4 r0 = *(const f32x4*)(res + off + bj * HALF), r1 = *(const f32x4*)(res + off + bj * HALF + 4);
                    const f32x4 v0 = acc[ai][bj][m][0] + r0, v1 = acc[ai][bj][m][1] + r1;
                    *(f32x4*)(out + off + bj * HALF) = v0; *(f32x4*)(out + off + bj * HALF + 4) = v1; } }
    }
};

struct EpiResidNorm {
    static constexpr bool PERM = true, AFTER_DRAIN = false;
    const float* res; float* out; int ld; const float* gain; bf16_t* H; int ldh; float* SSQ;
    __device__ __forceinline__ void operator()(PG8_ACC, const Unit& u, int wr, int wc, int fr, int fq) const {
        const int row0 = u.pm * BM + wr * 64 + fr, col0 = u.pn * BM + wc * 32 + 8 * fq;
        f32x4 gv[2][2];
#pragma unroll
        for (int bj = 0; bj < 2; ++bj)
#pragma unroll
            for (int n = 0; n < 2; ++n) gv[bj][n] = *(const f32x4*)(gain + col0 + bj * HALF + 4 * n);
#pragma unroll
        for (int ai = 0; ai < 2; ++ai)
#pragma unroll
            for (int m = 0; m < 4; ++m) { const int row = row0 + ai * HALF + m * 16; const size_t off = (size_t)row * ld + col0; float s = 0.f;
#pragma unroll
                for (int bj = 0; bj < 2; ++bj) {
                    const f32x4 r0 = *(const f32x4*)(res + off + bj * HALF), r1 = *(const f32x4*)(res + off + bj * HALF + 4);
                    const f32x4 v0 = acc[ai][bj][m][0] + r0, v1 = acc[ai][bj][m][1] + r1;
                    *(f32x4*)(out + off + bj * HALF) = v0; *(f32x4*)(out + off + bj * HALF + 4) = v1;
                    s += (v0[0] * v0[0] + v0[1] * v0[1]) + (v0[2] * v0[2] + v0[3] * v0[3]) + (v1[0] * v1[0] + v1[1] * v1[1]) + (v1[2] * v1[2] + v1[3] * v1[3]);
                    const f32x4 h0 = v0 * gv[bj][0], h1 = v1 * gv[bj][1];
                    u32x4 w; w.x = cvt_pk_bf16(h0[0], h0[1]); w.y = cvt_pk_bf16(h0[2], h0[3]); w.z = cvt_pk_bf16(h1[0], h1[1]); w.w = cvt_pk_bf16(h1[2], h1[3]);
                    *(u32x4*)(H + (size_t)row * ldh + col0 + bj * HALF) = w; }
                s += shx<16>(s); s = sum_halves(s);
                if (fq == 0) atomicAdd(SSQ + row, s); }
    }
};

struct EpiSwiGLU {
    static constexpr bool PERM = true, AFTER_DRAIN = false;
    bf16_t* O; int ldc; const float* SSQ;
    __device__ __forceinline__ void operator()(PG8_ACC, const Unit& u, int wr, int wc, int fr, int fq) const {
        const int row0 = u.pm * BM + wr * 64 + fr, col0 = u.pn * HALF + wc * 32 + 8 * fq;
#pragma unroll
        for (int ai = 0; ai < 2; ++ai)
#pragma unroll
            for (int m = 0; m < 4; ++m) { bf16_t* rowp = O + (size_t)(row0 + ai * HALF + m * 16) * ldc + col0;
                const float rstd = __builtin_amdgcn_rsqf(SSQ[row0 + ai * HALF + m * 16] * (1.f / 1024.f) + 1e-6f);
                f32x4 v[2];
#pragma unroll
                for (int n = 0; n < 2; ++n) { const f32x4 gt = acc[ai][0][m][n] * rstd, up = acc[ai][1][m][n] * rstd;
#pragma unroll
                    for (int e = 0; e < 4; ++e) v[n][e] = gt[e] * __builtin_amdgcn_rcpf(1.f + __builtin_amdgcn_exp2f(-1.4426950408889634f * gt[e])) * up[e]; }
                u32x4 w; w.x = cvt_pk_bf16(v[0][0], v[0][1]); w.y = cvt_pk_bf16(v[0][2], v[0][3]); w.z = cvt_pk_bf16(v[1][0], v[1][1]); w.w = cvt_pk_bf16(v[1][2], v[1][3]);
                *(u32x4*)rowp = w; }
    }
};

template <class Epi, class Sched, bool ALIGN_EPI = false, bool SP2 = false>
__device__ __forceinline__ void gemm_phase(PG8_LAS unsigned char* lds, const Gemm g, const Sched& S, const Epi& E, int wave_id) {
    const int tid = tid_fresh(wave_id);
    const int wid = __builtin_amdgcn_readfirstlane(tid >> 6), lane = tid & 63, wr = wid >> 2, wc = wid & 3, fr = lane & 15, fq = lane >> 4;
    const int K = g.K, nt = K / BK;
    unsigned voffA[2], voffB[2];
#pragma unroll
    for (int i = 0; i < 2; ++i) { int R, C; stage_rc(tid * 16 + i * 8192, R, C); const int Rb = Epi::PERM ? ((R & ~31) + perm32(R & 31)) : R;
        voffA[i] = (unsigned)(R * g.lda + C) * 2u; voffB[i] = (unsigned)(Rb * K + C) * 2u; }
    const size_t kstep = (size_t)(BK * 2);
    const size_t hstepA = (size_t)HALF * g.lda * 2, hstepB = (size_t)HALF * K * 2;
    const size_t tstepA = 2 * hstepA, tstepB = 2 * hstepB;
    const unsigned ldsw = (unsigned)wid * 1024u;
    const int aoff = lds_byte(wr * 64 + fr, fq * 8), boff = lds_byte(wc * 32 + fr, fq * 8);
#define PG8_SA(b, h) (((b) * 2 + (h)) * HTB)
#define PG8_SB(b, h) ((4 + (b) * 2 + (h)) * HTB)
#define PG8_STAGE(bufoff, gbase, voff) do { _Pragma("unroll") for (int _i = 0; _i < 2; ++_i) \
        __builtin_amdgcn_global_load_lds((const unsigned*)((const char*)(gbase) + (voff)[_i]), (PG8_LAS unsigned*)(lds + (bufoff) + ldsw + _i * 8192), 16, 0, 0); } while (0)
#define PG8_LDA(dst, b, h) do { _Pragma("unroll") for (int m = 0; m < 4; ++m) _Pragma("unroll") for (int k = 0; k < 2; ++k) dst[m][k] = *(const PG8_LAS bf16x8*)(lds + PG8_SA(b, h) + aoff + m * 2048 + k * 1024); } while (0)
#define PG8_LDB(dst, b, h) do { _Pragma("unroll") for (int n = 0; n < 2; ++n) _Pragma("unroll") for (int k = 0; k < 2; ++k) dst[n][k] = *(const PG8_LAS bf16x8*)(lds + PG8_SB(b, h) + boff + n * 2048 + k * 1024); } while (0)
#define PG8_MMA(ai, bj, At, Bt) do { __builtin_amdgcn_s_setprio(1); _Pragma("unroll") for (int m = 0; m < 4; ++m) _Pragma("unroll") for (int n = 0; n < 2; ++n) _Pragma("unroll") for (int k = 0; k < 2; ++k) \
        acc[ai][bj][m][n] = __builtin_amdgcn_mfma_f32_16x16x32_bf16(Bt[n][k], At[m][k], acc[ai][bj][m][n], 0, 0, 0); __builtin_amdgcn_s_setprio(0); } while (0)
#define PG8_WAIT_V(n) asm volatile("s_waitcnt vmcnt(" #n ")" ::: "memory")
#define PG8_WAIT_L(n) asm volatile("s_waitcnt lgkmcnt(" #n ")" ::: "memory")
#define PG8_BAR __builtin_amdgcn_s_barrier()
#define PG8_SCHED __builtin_amdgcn_sched_barrier(0)
    Unit cur, nxt; int ui = 0;
    if (!S.next(0, cur)) return;
    f32x4 acc[2][2][4][2];
#pragma unroll
    for (int a = 0; a < 2; ++a)
#pragma unroll
        for (int b = 0; b < 2; ++b)
#pragma unroll
            for (int m = 0; m < 4; ++m)
#pragma unroll
                for (int n = 0; n < 2; ++n) acc[a][b][m][n] = (f32x4){0.f, 0.f, 0.f, 0.f};
    bf16x8 At[4][2], B0[2][2], B1[2][2];
    const char* cA = (const char*)(cur.src == 0 ? g.A : (cur.src == 1 ? g.A2 : g.A3)) + (size_t)cur.pm * tstepA; const char* cB = (const char*)(cur.src == 0 ? g.Bt : (cur.src == 1 ? g.Bt2 : g.Bt3)) + (size_t)cur.pn * tstepB;
    S.a_ready(cur);
    if constexpr (SP2) {
        PG8_STAGE(PG8_SB(0, 0), cB, voffB); PG8_STAGE(PG8_SB(0, 1), cB + hstepB, voffB); PG8_STAGE(PG8_SA(0, 0), cA, voffA); PG8_STAGE(PG8_SA(0, 1), cA + hstepA, voffA);
        if (wr == 1) PG8_BAR;
        PG8_WAIT_V(2); PG8_BAR;
        PG8_STAGE(PG8_SB(1, 0), cB + kstep, voffB); PG8_STAGE(PG8_SA(1, 0), cA + kstep, voffA); PG8_STAGE(PG8_SB(1, 1), cB + hstepB + kstep, voffB);
        PG8_WAIT_V(6); PG8_BAR;
    } else {
        PG8_STAGE(PG8_SB(0, 0), cB, voffB); PG8_STAGE(PG8_SA(0, 0), cA, voffA); PG8_STAGE(PG8_SB(0, 1), cB + hstepB, voffB); PG8_STAGE(PG8_SA(0, 1), cA + hstepA, voffA);
        if (wr == 1) PG8_BAR;
        PG8_WAIT_V(4); PG8_BAR;
        PG8_STAGE(PG8_SB(1, 0), cB + kstep, voffB); PG8_STAGE(PG8_SA(1, 0), cA + kstep, voffA); PG8_STAGE(PG8_SB(1, 1), cB + hstepB + kstep, voffB);
        PG8_WAIT_V(6); PG8_BAR;
    }
    for (;;) {
        const bool has_next = S.next(ui + 1, nxt);
        const char* nA = has_next ? (const char*)(nxt.src == 0 ? g.A : (nxt.src == 1 ? g.A2 : g.A3)) + (size_t)nxt.pm * tstepA : cA; const char* nB = has_next ? (const char*)(nxt.src == 0 ? g.Bt : (nxt.src == 1 ? g.Bt2 : g.Bt3)) + (size_t)nxt.pn * tstepB : cB;
        for (int t = 0; t < nt; t += 2) {
            const bool last = (t == nt - 2);
            const char* a1 = cA + (size_t)(t + 1) * kstep;
            const char* a2 = last ? nA : cA + (size_t)(t + 2) * kstep; const char* b2 = last ? nB : cB + (size_t)(t + 2) * kstep;
            const char* a3 = a2 + kstep; const char* b3 = b2 + kstep;
            if (last && has_next) S.a_ready(nxt);
            if constexpr (SP2) {
            PG8_LDB(B0, 0, 0); PG8_LDB(B1, 0, 1); PG8_SCHED; PG8_LDA(At, 0, 0); PG8_STAGE(PG8_SA(1, 1), a1 + hstepA, voffA);
            PG8_WAIT_V(8); PG8_WAIT_L(0); PG8_BAR; PG8_MMA(0, 0, At, B0); PG8_MMA(0, 1, At, B1); PG8_BAR; PG8_SCHED;
            PG8_LDA(At, 0, 1); PG8_STAGE(PG8_SB(0, 0), b2, voffB); PG8_STAGE(PG8_SB(0, 1), b2 + hstepB, voffB); PG8_STAGE(PG8_SA(0, 0), a2, voffA);
            PG8_WAIT_V(8); PG8_WAIT_L(0); PG8_BAR; PG8_MMA(1, 0, At, B0); PG8_MMA(1, 1, At, B1); PG8_BAR; PG8_SCHED;
            PG8_LDB(B0, 1, 0); PG8_LDB(B1, 1, 1); PG8_SCHED; PG8_LDA(At, 1, 0); PG8_STAGE(PG8_SA(0, 1), a2 + hstepA, voffA);
            PG8_WAIT_V(8); PG8_WAIT_L(0); PG8_BAR; PG8_MMA(0, 0, At, B0); PG8_MMA(0, 1, At, B1); PG8_BAR; PG8_SCHED;
            PG8_LDA(At, 1, 1); PG8_STAGE(PG8_SB(1, 0), b3, voffB); PG8_STAGE(PG8_SB(1, 1), b3 + hstepB, voffB); PG8_STAGE(PG8_SA(1, 0), a3, voffA);
            PG8_WAIT_V(8); PG8_WAIT_L(0); PG8_BAR; PG8_MMA(1, 0, At, B0); PG8_MMA(1, 1, At, B1); PG8_BAR; PG8_SCHED;
            } else {
            PG8_LDB(B0, 0, 0); PG8_SCHED; PG8_LDA(At, 0, 0); PG8_STAGE(PG8_SA(1, 1), a1 + hstepA, voffA);
            PG8_WAIT_L(8); PG8_BAR; PG8_WAIT_L(0); PG8_MMA(0, 0, At, B0); PG8_BAR; PG8_SCHED;
            PG8_LDB(B1, 0, 1); PG8_STAGE(PG8_SB(0, 0), b2, voffB);
            PG8_BAR; PG8_WAIT_L(0); PG8_MMA(0, 1, At, B1); PG8_BAR;
            PG8_LDA(At, 0, 1); PG8_STAGE(PG8_SA(0, 0), a2, voffA);
            PG8_BAR; PG8_WAIT_L(0); PG8_MMA(1, 0, At, B0); PG8_BAR; PG8_SCHED;
            PG8_STAGE(PG8_SB(0, 1), b2 + hstepB, voffB);
            PG8_WAIT_V(6); PG8_BAR; PG8_MMA(1, 1, At, B1); PG8_BAR;
            PG8_LDB(B0, 1, 0); PG8_SCHED; PG8_LDA(At, 1, 0); PG8_STAGE(PG8_SA(0, 1), a2 + hstepA, voffA);
            PG8_WAIT_L(8); PG8_BAR; PG8_WAIT_L(0); PG8_MMA(0, 0, At, B0); PG8_BAR; PG8_SCHED;
            PG8_LDB(B1, 1, 1); PG8_STAGE(PG8_SB(1, 0), b3, voffB);
            PG8_BAR; PG8_WAIT_L(0); PG8_MMA(0, 1, At, B1); PG8_BAR;
            PG8_LDA(At, 1, 1); PG8_STAGE(PG8_SA(1, 0), a3, voffA);
            PG8_BAR; PG8_WAIT_L(0); PG8_MMA(1, 0, At, B0); PG8_BAR; PG8_SCHED;
            PG8_STAGE(PG8_SB(1, 1), b3 + hstepB, voffB);
            PG8_WAIT_V(6); PG8_BAR; PG8_MMA(1, 1, At, B1); PG8_BAR;
            }
        }
        if constexpr (ALIGN_EPI) { if (wr == 0) PG8_BAR; }
        if constexpr (!Epi::AFTER_DRAIN) { E(acc, cur, wr, wc, fr, fq); S.done(cur); }
        if (!has_next) break;
#pragma unroll
        for (int a = 0; a < 2; ++a)
#pragma unroll
            for (int b = 0; b < 2; ++b)
#pragma unroll
                for (int m = 0; m < 4; ++m)
#pragma unroll
                    for (int n = 0; n < 2; ++n) acc[a][b][m][n] = (f32x4){0.f, 0.f, 0.f, 0.f};
        cur = nxt; cA = nA; cB = nB; ++ui;
        if constexpr (ALIGN_EPI) { if (wr == 1) PG8_BAR; }
    }
    PG8_WAIT_V(0);
    if constexpr (!ALIGN_EPI) { if (wr == 0) PG8_BAR; }
    PG8_BAR;
    if constexpr (Epi::AFTER_DRAIN) { E.fused(acc, cur, wr, wc, fr, fq, lds, wid, lane); S.done(cur); }
#undef PG8_SA
#undef PG8_SB
#undef PG8_STAGE
#undef PG8_LDA
#undef PG8_LDB
#undef PG8_MMA
#undef PG8_WAIT_V
#undef PG8_WAIT_L
#undef PG8_BAR
#undef PG8_SCHED
}
}

#define LAS __attribute__((address_space(3)))
typedef unsigned short bf16;
typedef short bf16x8 __attribute__((ext_vector_type(8)));
typedef short s16x4 __attribute__((ext_vector_type(4)));
typedef short v4i16_t __attribute__((ext_vector_type(4)));
typedef float f32x16 __attribute__((ext_vector_type(16)));
typedef float f32x4 __attribute__((ext_vector_type(4)));
typedef float f32x2_t __attribute__((ext_vector_type(2)));
typedef __bf16 bf16x2_t __attribute__((ext_vector_type(2)));
typedef unsigned u32x4 __attribute__((ext_vector_type(4)));
typedef unsigned u32x2 __attribute__((ext_vector_type(2)));

constexpr int D = 1024, SEQ = 2048, NB = 8, M = NB * SEQ, NMEM = 256, MMEM = NB * NMEM, DIN = 6656, DFF = 2816;
constexpr int LDQ = 6656;
constexpr int C_AQ = 0, C_AK = 512, C_AV = 1024, C_BQ = 1536, C_BK = 3072, C_BV = 4608, C_CQ = 6144;
constexpr int C_GATE = 3072;
constexpr int C_H2 = 0, C_ACT = 1024;
constexpr float L2E = 1.4426950408889634f;
constexpr float EPS = 1e-6f;

constexpr size_t WS_WIN = 0;
constexpr size_t WS_WG = WS_WIN + (size_t)DIN * D * 2;
constexpr size_t WS_WMEM = WS_WG + (size_t)3 * D * D * 2;
constexpr size_t WS_WBR = WS_WMEM + (size_t)D * D * 2;
constexpr size_t WS_WOUT3 = WS_WBR + (size_t)3 * D * 512 * 2;
constexpr size_t WS_WGU = WS_WOUT3 + (size_t)D * 3 * D * 2;
constexpr size_t WS_WDN = WS_WGU + (size_t)2 * DFF * D * 2;
constexpr size_t WS_LB = WS_WDN + (size_t)D * DFF * 2;
constexpr size_t WS_R = WS_LB + (size_t)3 * M * 4 * 4;
constexpr size_t WS_BAR = WS_R + (size_t)M * LDQ * 2;
constexpr size_t WS_SSQ = WS_BAR + 16384;
constexpr size_t WS_END = WS_SSQ + (size_t)M * 4;
static_assert(WS_END <= (size_t)256 * 1024 * 1024, "d_ws map");
constexpr size_t DO_XN = 0;
constexpr size_t DO_MN = DO_XN + (size_t)M * D * 2;
constexpr size_t DO_CKV = DO_MN + (size_t)MMEM * D * 2;
static_assert(DO_CKV + (size_t)MMEM * D * 2 <= (size_t)M * D * 4, "d_out scratch map");

constexpr int LDS_BYTES = 155648;
constexpr int XCH_OFF = 131072, GT_OFF = 131072 + 8192;
constexpr int MISC_OFF = LDS_BYTES - 64;
constexpr int KP = 272, VP = 320;

__device__ __forceinline__ unsigned cvtpk(float lo, float hi) { f32x2_t v = {lo, hi}; bf16x2_t b = __builtin_convertvector(v, bf16x2_t); return __builtin_bit_cast(unsigned, b); }
__device__ __forceinline__ float wave_sum(float v) {
    v += pg8::shx<1>(v); v += pg8::shx<2>(v); v += pg8::shx<4>(v); v += pg8::shx<8>(v); v += pg8::shx<16>(v); v = pg8::sum_halves(v);
    return v;
}
__device__ __forceinline__ float wave_max(float v) {
    v = fmaxf(v, pg8::shx<1>(v)); v = fmaxf(v, pg8::shx<2>(v)); v = fmaxf(v, pg8::shx<4>(v)); v = fmaxf(v, pg8::shx<8>(v)); v = fmaxf(v, pg8::shx<16>(v)); v = pg8::max_halves(v);
    return v;
}
__device__ __forceinline__ float absmax_vec(const float* g, int n, int lane) {
    float v = fabsf(g[lane]); if (n > 64) v = fmaxf(v, fabsf(g[lane + 64]));
    return wave_max(v);
}

__device__ __forceinline__ void tr_item(const float* W, int N, int k0, int n0, bf16* WT, int dst_pitch, int dst_row0, int dst_k0, int ncopies, int copy_stride, LAS float* scr, int lane) {
#pragma unroll 8
    for (int i = 0; i < 32; ++i) { const int kk = 2 * i + (lane >> 5); scr[kk * 33 + (lane & 31)] = W[(size_t)(k0 + kk) * N + n0 + (lane & 31)]; }
    asm volatile("s_waitcnt lgkmcnt(0)" ::: "memory");
    const int c = lane & 7;
#pragma unroll
    for (int j = 0; j < 4; ++j) { const int n = (lane >> 3) + 8 * j; const LAS float* s = scr + (8 * c) * 33 + n;
        u32x4 o; o.x = cvtpk(s[0 * 33], s[1 * 33]); o.y = cvtpk(s[2 * 33], s[3 * 33]); o.z = cvtpk(s[4 * 33], s[5 * 33]); o.w = cvtpk(s[6 * 33], s[7 * 33]);
        bf16* dst = WT + (size_t)(dst_row0 + n0 + n) * dst_pitch + dst_k0 + k0 + 8 * c;
        for (int cp = 0; cp < ncopies; ++cp) *(u32x4*)(dst + (size_t)cp * copy_stride) = o; }
    asm volatile("s_waitcnt lgkmcnt(0)" ::: "memory");
}
__device__ __forceinline__ void rms_row_to_bf16(const float* xrow, const float* gain, bf16* orow, int lane) {
    const f32x4* xr = (const f32x4*)xrow + lane; const f32x4* gr = (const f32x4*)gain + lane;
    f32x4 v[4]; float s = 0.f;
#pragma unroll
    for (int j = 0; j < 4; ++j) { v[j] = xr[64 * j]; s += (v[j][0] * v[j][0] + v[j][1] * v[j][1]) + (v[j][2] * v[j][2] + v[j][3] * v[j][3]); }
    const float rstd = 1.f / sqrtf(wave_sum(s) * (1.f / 1024.f) + EPS);
    u32x2* o8 = (u32x2*)orow + lane;
#pragma unroll
    for (int j = 0; j < 4; ++j) { const f32x4 g = gr[64 * j]; u32x2 w; w.x = cvtpk(v[j][0] * rstd * g[0], v[j][1] * rstd * g[1]); w.y = cvtpk(v[j][2] * rstd * g[2], v[j][3] * rstd * g[3]); o8[64 * j] = w; }
}

__device__ __forceinline__ s16x4 vtr(const LAS char* p) { return __builtin_bit_cast(s16x4, __builtin_amdgcn_ds_read_tr16_b64_v4i16((LAS v4i16_t*)p)); }

template <int NK>
__device__ __forceinline__ void qk32(f32x16& S, const LAS char* Kp, const bf16x8* Q, int ks0, int r32, int hi) {
    const LAS char* kb = Kp + r32 * KP + hi * 16 + ks0 * 32;
#pragma unroll
    for (int ks = 0; ks < NK; ++ks) { const bf16x8 kf = *(const LAS bf16x8*)(kb + ks * 32); S = __builtin_amdgcn_mfma_f32_32x32x16_bf16(kf, Q[ks0 + ks], S, 0, 0, 0); }
}
__device__ __forceinline__ void pv32(f32x16 (&O)[4], const bf16x8 (&P)[2], const LAS char* Vp, int lane) {
    const int i = lane & 15, q = i >> 2, p = i & 3, dsel = (lane >> 4) & 1, h = lane >> 5;
    const LAS char* vb = Vp + (4 * h + q) * VP + (16 * dsel + 4 * p) * 2;
#pragma unroll
    for (int s = 0; s < 2; ++s)
#pragma unroll
        for (int db = 0; db < 4; ++db) {
            const s16x4 lo = vtr(vb + (16 * s) * VP + db * 64), hi4 = vtr(vb + (16 * s + 8) * VP + db * 64);
            const bf16x8 a = (bf16x8){lo[0], lo[1], lo[2], lo[3], hi4[0], hi4[1], hi4[2], hi4[3]};
            O[db] = __builtin_amdgcn_mfma_f32_32x32x16_bf16(a, P[s], O[db], 0, 0, 0);
        }
}
struct VFrag { bf16x8 a[2][4]; };
__device__ __forceinline__ void vload32(VFrag& f, const LAS char* Vp, int lane) {
    const int i = lane & 15, q = i >> 2, p = i & 3, dsel = (lane >> 4) & 1, h = lane >> 5;
    const LAS char* vb = Vp + (4 * h + q) * VP + (16 * dsel + 4 * p) * 2;
#pragma unroll
    for (int s = 0; s < 2; ++s)
#pragma unroll
        for (int db = 0; db < 4; ++db) { const s16x4 lo = vtr(vb + (16 * s) * VP + db * 64), hi4 = vtr(vb + (16 * s + 8) * VP + db * 64);
            f.a[s][db] = (bf16x8){lo[0], lo[1], lo[2], lo[3], hi4[0], hi4[1], hi4[2], hi4[3]}; }
}
template <int SS>
__device__ __forceinline__ void vload16(VFrag& f, const LAS char* Vp, int lane) {
    const int i = lane & 15, q = i >> 2, p = i & 3, dsel = (lane >> 4) & 1, h = lane >> 5;
    const LAS char* vb = Vp + (4 * h + q) * VP + (16 * dsel + 4 * p) * 2;
#pragma unroll
    for (int db = 0; db < 4; ++db) { const s16x4 lo = vtr(vb + (16 * SS) * VP + db * 64), hi4 = vtr(vb + (16 * SS + 8) * VP + db * 64);
        f.a[SS][db] = (bf16x8){lo[0], lo[1], lo[2], lo[3], hi4[0], hi4[1], hi4[2], hi4[3]}; }
}
__device__ __forceinline__ void pvmm32(f32x16 (&O)[4], const bf16x8 (&P)[2], const VFrag& f) {
#pragma unroll
    for (int s = 0; s < 2; ++s)
#pragma unroll
        for (int db = 0; db < 4; ++db) O[db] = __builtin_amdgcn_mfma_f32_32x32x16_bf16(f.a[s][db], P[s], O[db], 0, 0, 0);
}
template <int NK>
__device__ __forceinline__ void kload32(bf16x8 (&kf)[NK], const LAS char* Kp, int r32, int hi) {
    const LAS char* kb = Kp + r32 * KP + hi * 16;
#pragma unroll
    for (int ks = 0; ks < NK; ++ks) kf[ks] = *(const LAS bf16x8*)(kb + ks * 32);
}
template <int NK>
__device__ __forceinline__ void qkmm32(f32x16& S, const bf16x8 (&kf)[NK], const bf16x8* Q) {
#pragma unroll
    for (int ks = 0; ks < NK; ++ks) S = __builtin_amdgcn_mfma_f32_32x32x16_bf16(kf[ks], Q[ks], S, 0, 0, 0);
}
#define SCHED_FENCE() __builtin_amdgcn_sched_barrier(0)
template <int MODE>
__device__ __forceinline__ void soft32(const f32x16& S, bf16x8 (&P)[2], float& l, float dbase, float nslope) {
    float p[16];
#pragma unroll
    for (int r = 0; r < 16; ++r) {
        float s = S[r];
        if (MODE >= 1) { const float a = fabsf(dbase - (float)((r & 3) + 8 * (r >> 2))); s = fmaf(nslope, a, s); float e = __builtin_amdgcn_exp2f(s); if (MODE == 2) e = (a <= 64.f) ? e : 0.f; p[r] = e; }
        else p[r] = __builtin_amdgcn_exp2f(s);
        l += p[r];
    }
#pragma unroll
    for (int s = 0; s < 2; ++s) { u32x4 w; w.x = cvtpk(p[8 * s + 0], p[8 * s + 1]); w.y = cvtpk(p[8 * s + 2], p[8 * s + 3]); w.z = cvtpk(p[8 * s + 4], p[8 * s + 5]); w.w = cvtpk(p[8 * s + 6], p[8 * s + 7]); P[s] = __builtin_bit_cast(bf16x8, w); }
}
__device__ __forceinline__ void zero16(f32x16& v) {
#pragma unroll
    for (int r = 0; r < 16; ++r) v[r] = 0.f;
}

__device__ __forceinline__ void stage_put(LAS char* wl, int r32, int hi2, int db, int g4, u32x2 w) { *(LAS u32x2*)(wl + r32 * 272 + (32 * db + 8 * g4 + 4 * hi2) * 2) = w; }
__device__ __forceinline__ void stage_flush(const LAS char* wl, bf16* qbase, size_t row_stride, int lane) {
    asm volatile("s_waitcnt lgkmcnt(0)" ::: "memory");
#pragma unroll
    for (int i = 0; i < 8; ++i) { const int row = 4 * i + (lane >> 4); const u32x4 v = *(const LAS u32x4*)(wl + row * 272 + (lane & 15) * 16);
        *(u32x4*)(qbase + (size_t)row * row_stride + (lane & 15) * 8) = v; }
}
template <int NC, bool DIAG>
__device__ __forceinline__ void attn_tile(f32x16 (&O)[4], float& l, const bf16x8* Q, const LAS char* Kb, const LAS char* Vb, int r32, int hi, int lane, float qd, int k0, int qw, float nslope, float negM0) {
    constexpr int NQ = (NC == 2) ? 4 : 8;
    f32x16 S0, S1; bf16x8 P0[2], P1[2];
    const int k1 = k0 + 32;
    if (NC == 2) {
        const float ns0 = (k0 < qw) ? nslope : ((k0 > qw) ? -nslope : 0.f), ns1 = (k1 < qw) ? nslope : ((k1 > qw) ? -nslope : 0.f);
        const float b0 = fmaf(ns0, qd - (float)k0, negM0), b1 = fmaf(ns1, qd - (float)k1, negM0);
#pragma unroll
        for (int r = 0; r < 16; ++r) { S0[r] = fmaf(-ns0, (float)((r & 3) + 8 * (r >> 2)), b0); S1[r] = fmaf(-ns1, (float)((r & 3) + 8 * (r >> 2)), b1); }
    } else {
#pragma unroll
        for (int r = 0; r < 16; ++r) { S0[r] = negM0; S1[r] = negM0; }
    }
    VFrag vf0, vf1;
    if (NC == 2) {
        bf16x8 kf0[NQ], kf1[NQ];
        kload32<NQ>(kf0, Kb, r32, hi);
        SCHED_FENCE();
        qkmm32<NQ>(S0, kf0, Q);
        kload32<NQ>(kf1, Kb + 32 * KP, r32, hi);
        vload16<0>(vf0, Vb, lane);
        SCHED_FENCE();
        qkmm32<NQ>(S1, kf1, Q);
        if (DIAG) { const float nd = (k0 == qw) ? nslope : 0.f;
#pragma unroll
            for (int r = 0; r < 16; ++r) S0[r] = fmaf(nd, fabsf(qd - (float)k0 - (float)((r & 3) + 8 * (r >> 2))), S0[r]); }
        soft32<0>(S0, P0, l, 0.f, 0.f);
        vload16<1>(vf0, Vb, lane);
        SCHED_FENCE();
    } else {
        bf16x8 kf[NQ];
        kload32<NQ>(kf, Kb, r32, hi);
        SCHED_FENCE();
        qkmm32<NQ>(S0, kf, Q);
        kload32<NQ>(kf, Kb + 32 * KP, r32, hi);
        vload32(vf0, Vb, lane);
        SCHED_FENCE();
        qkmm32<NQ>(S1, kf, Q);
        soft32<0>(S0, P0, l, 0.f, 0.f);
        SCHED_FENCE();
    }
    pvmm32(O, P0, vf0);
    if (NC == 2 && DIAG) { const float nd = (k1 == qw) ? nslope : 0.f;
#pragma unroll
        for (int r = 0; r < 16; ++r) S1[r] = fmaf(nd, fabsf(qd - (float)k1 - (float)((r & 3) + 8 * (r >> 2))), S1[r]); }
    soft32<0>(S1, P1, l, 0.f, 0.f);
    if (NC == 2) {
    vload16<0>(vf1, Vb + 32 * VP, lane);
    SCHED_FENCE();
    vload16<1>(vf1, Vb + 32 * VP, lane);
    } else {
    vload32(vf1, Vb + 32 * VP, lane);
    SCHED_FENCE();
    }
    pvmm32(O, P1, vf1);
}

template <int NC>
__device__ __forceinline__ void attn_shared_unit(LAS char* lds, bf16* qbase, const bf16* Kg, const bf16* Vg, int kvp, int nt, int qpos, int qw, float nslope, float negM0, float lam, const float* subln, int wave_id) {
    const int wv = wave_id, tid = pg8::tid_fresh(wave_id);
    const int lane = tid & 63, r32 = lane & 31, hi = lane >> 5;
    const int cm = (NC == 2) ? (wv & 1) : 0;
    constexpr int NQ = (NC == 2) ? 4 : 8;
    bf16x8 Q[NQ];
    { const bf16* qrow0 = qbase + (size_t)r32 * LDQ;
#pragma unroll
    for (int ks = 0; ks < NQ; ++ks) Q[ks] = *(const bf16x8*)(qrow0 + cm * 64 + 16 * ks + 8 * hi); }
    f32x16 O[4]; float l = 0.f;
#pragma unroll
    for (int db = 0; db < 4; ++db) zero16(O[db]);
    const int lrow = tid >> 3, lcb = (tid & 7) * 32;
    const char* kgp = (const char*)(Kg + (size_t)lrow * kvp) + lcb; const char* vgp = (const char*)(Vg + (size_t)lrow * kvp) + lcb;
    const size_t tstep = (size_t)64 * kvp * 2;
    u32x4 ka0, ka1, va0, va1, kb0, kb1, vb0, vb1;
#define LOADA(tt) do { const char* kp_ = kgp + (size_t)(tt) * tstep; const char* vp_ = vgp + (size_t)(tt) * tstep; ka0 = *(const u32x4*)kp_; ka1 = *(const u32x4*)(kp_ + 16); va0 = *(const u32x4*)vp_; va1 = *(const u32x4*)(vp_ + 16); } while (0)
#define LOADB(tt) do { const char* kp_ = kgp + (size_t)(tt) * tstep; const char* vp_ = vgp + (size_t)(tt) * tstep; kb0 = *(const u32x4*)kp_; kb1 = *(const u32x4*)(kp_ + 16); vb0 = *(const u32x4*)vp_; vb1 = *(const u32x4*)(vp_ + 16); } while (0)
#define WRITEA(buf) do { LAS char* kw_ = lds + (buf) * BUFB + lrow * KP + lcb; LAS char* vw_ = lds + (buf) * BUFB + 64 * KP + lrow * VP + lcb; *(LAS u32x4*)kw_ = ka0; *(LAS u32x4*)(kw_ + 16) = ka1; *(LAS u32x4*)vw_ = va0; *(LAS u32x4*)(vw_ + 16) = va1; } while (0)
#define WRITEB(buf) do { LAS char* kw_ = lds + (buf) * BUFB + lrow * KP + lcb; LAS char* vw_ = lds + (buf) * BUFB + 64 * KP + lrow * VP + lcb; *(LAS u32x4*)kw_ = kb0; *(LAS u32x4*)(kw_ + 16) = kb1; *(LAS u32x4*)vw_ = vb0; *(LAS u32x4*)(vw_ + 16) = vb1; } while (0)
    constexpr int BUFB = 64 * KP + 64 * VP;
    const float qd = (float)(qpos - 4 * hi);
    const int td = qw >> 6;
    if (NC == 2) {
    LOADA(0); LOADB(1);
    __syncthreads();
    WRITEA(0);
    __syncthreads();
#pragma unroll 1
    for (int t = 0; t < nt; t += 2) {
        {
            if (t + 2 < nt) LOADA(t + 2);
            int k0v = t * 64; asm volatile("" : "+s"(k0v));
            const LAS char* Kb = lds + cm * 128; const LAS char* Vb = lds + 64 * KP;
            if (t == td) attn_tile<NC, true>(O, l, Q, Kb, Vb, r32, hi, lane, qd, k0v, qw, nslope, negM0);
            else attn_tile<NC, false>(O, l, Q, Kb, Vb, r32, hi, lane, qd, k0v, qw, nslope, negM0);
            WRITEB(1);
            __syncthreads();
        }
        {
            if (t + 3 < nt) LOADB(t + 3);
            int k0v = (t + 1) * 64; asm volatile("" : "+s"(k0v));
            const LAS char* Kb = lds + BUFB + cm * 128; const LAS char* Vb = lds + BUFB + 64 * KP;
            if (t + 1 == td) attn_tile<NC, true>(O, l, Q, Kb, Vb, r32, hi, lane, qd, k0v, qw, nslope, negM0);
            else attn_tile<NC, false>(O, l, Q, Kb, Vb, r32, hi, lane, qd, k0v, qw, nslope, negM0);
            if (t + 2 < nt) WRITEA(0);
            __syncthreads();
        }
    }
    } else {
    LOADA(0);
    __syncthreads();
    WRITEA(0);
    __syncthreads();
#pragma unroll 1
    for (int t = 0; t < nt; ++t) {
        const bool more = (t + 1 < nt);
        if (more) LOADA(t + 1);
        int k0v = t * 64; asm volatile("" : "+s"(k0v));
        const LAS char* Kb = lds + (t & 1) * BUFB; const LAS char* Vb = lds + (t & 1) * BUFB + 64 * KP;
        attn_tile<NC, false>(O, l, Q, Kb, Vb, r32, hi, lane, qd, k0v, qw, nslope, negM0);
        if (more) WRITEA((t + 1) & 1);
        __syncthreads();
    }
    }
#undef LOADA
#undef LOADB
#undef WRITEA
#undef WRITEB
    const int lane2 = pg8::lane_id_fresh(), hi2 = lane2 >> 5;
    bf16* qrow = qbase + (size_t)(lane2 & 31) * LDQ;
    l = pg8::sum_halves(l);
    if (NC == 2) {
        LAS float* XO = (LAS float*)lds + (wv >> 1) * 4096 + lane2;
        if (cm == 1) { const float i2 = *(const LAS float*)(lds + (LDS_BYTES - 64 + 32)) * __builtin_amdgcn_rcpf(l);
#pragma unroll
            for (int db = 0; db < 4; ++db)
#pragma unroll
                for (int r = 0; r < 16; ++r) XO[(db * 16 + r) * 64] = O[db][r] * i2; }
        __syncthreads();
        if (cm == 0) {
            const float i1 = 1.f / l; float ss = 0.f;
#pragma unroll
            for (int db = 0; db < 4; ++db)
#pragma unroll
                for (int r = 0; r < 16; ++r) { const float o = O[db][r] * i1 - XO[(db * 16 + r) * 64]; O[db][r] = o; ss += o * o; }
            ss = pg8::sum_halves(ss);
            const float rstd = (1.f / sqrtf(ss * (1.f / 128.f) + EPS)) * 0.8f;
#pragma unroll
            for (int db = 0; db < 4; ++db)
#pragma unroll
                for (int g4 = 0; g4 < 4; ++g4) { const int d = 32 * db + 8 * g4 + 4 * hi2; const f32x4 gn = *(const f32x4*)(subln + d);
                    u32x2 w; w.x = cvtpk(O[db][4 * g4 + 0] * rstd * gn[0], O[db][4 * g4 + 1] * rstd * gn[1]); w.y = cvtpk(O[db][4 * g4 + 2] * rstd * gn[2], O[db][4 * g4 + 3] * rstd * gn[3]);
                    stage_put(lds + (wv >> 1) * 16384, lane2 & 31, hi2, db, g4, w); (void)d; }
            stage_flush(lds + (wv >> 1) * 16384, qbase, LDQ, lane2);
        }
    } else {
        const float i1 = 1.f / l;
#pragma unroll
        for (int db = 0; db < 4; ++db)
#pragma unroll
            for (int g4 = 0; g4 < 4; ++g4) { const int d = 32 * db + 8 * g4 + 4 * hi2;
                u32x2 w; w.x = cvtpk(O[db][4 * g4 + 0] * i1, O[db][4 * g4 + 1] * i1); w.y = cvtpk(O[db][4 * g4 + 2] * i1, O[db][4 * g4 + 3] * i1);
                stage_put(lds + wv * 8704, lane2 & 31, hi2, db, g4, w); (void)d; }
        stage_flush(lds + wv * 8704, qbase, LDQ, lane2);
    }
}

template <bool SEG2>
__device__ __forceinline__ void attn_b_block_unit(LAS char* lds, bf16* R, float* LB, int b, int g, int j, int res0, int q0, int dil, float nslope, float negM0, int wave_id) {
    const int tid = pg8::tid_fresh(wave_id), lane = tid & 63, r32 = lane & 31, hi = lane >> 5;
    const int sub_len = SEQ / dil, hcol = (g * 4 + j) * 128;
    const int wres = SEG2 ? res0 + (wave_id >> 2) : res0;
    const int qs = SEG2 ? 32 * (wave_id & 3) : q0 + 32 * wave_id;
    const size_t rowb = (size_t)b * SEQ;
    bf16x8 Q[8];
    { const bf16* qr = R + (rowb + (size_t)(qs + r32) * dil + wres) * LDQ + C_BQ + hcol;
#pragma unroll
      for (int ks = 0; ks < 8; ++ks) Q[ks] = *(const bf16x8*)(qr + 16 * ks + 8 * hi); }
    f32x16 O[4]; float l = 0.f;
#pragma unroll
    for (int db = 0; db < 4; ++db) zero16(O[db]);
    constexpr int TK = SEG2 ? 32 : 64;
    const int k_lo = SEG2 ? 0 : ((q0 - 64 > 0) ? q0 - 64 : 0), k_hi = SEG2 ? 128 : ((q0 + 320 < sub_len) ? q0 + 320 : sub_len);
    const int nsteps = (k_hi - k_lo) / TK;
    const int lrow = tid >> 3, lcb = (tid & 7) * 32;
    const int lres = SEG2 ? res0 + (lrow >> 5) : res0, lkey = SEG2 ? (lrow & 31) : lrow;
    const char* kg = (const char*)(R + (rowb + (size_t)(k_lo + lkey) * dil + lres) * LDQ + C_BK + hcol) + lcb;
    const size_t sstep = (size_t)TK * dil * LDQ * 2;
    constexpr int VOFF = (C_BV - C_BK) * 2, BUFB = 64 * KP + 64 * VP;
    u32x4 kr0, kr1, vr0, vr1;
    kr0 = *(const u32x4*)kg; kr1 = *(const u32x4*)(kg + 16); vr0 = *(const u32x4*)(kg + VOFF); vr1 = *(const u32x4*)(kg + VOFF + 16);
    __syncthreads();
    { LAS char* kw = lds + lrow * KP + lcb; LAS char* vw = lds + 64 * KP + lrow * VP + lcb;
      *(LAS u32x4*)kw = kr0; *(LAS u32x4*)(kw + 16) = kr1; *(LAS u32x4*)vw = vr0; *(LAS u32x4*)(vw + 16) = vr1; }
    __syncthreads();
    const float qf = (float)(qs + r32 - 4 * hi);
#pragma unroll 1
    for (int s = 0; s < nsteps; ++s) {
        const bool more = (s + 1 < nsteps);
        if (more) { const char* kp = kg + (size_t)(s + 1) * sstep; kr0 = *(const u32x4*)kp; kr1 = *(const u32x4*)(kp + 16); vr0 = *(const u32x4*)(kp + VOFF); vr1 = *(const u32x4*)(kp + VOFF + 16); }
        const int kb = k_lo + s * TK;
        const LAS char* Kb = lds + (s & 1) * BUFB; const LAS char* Vb = Kb + 64 * KP;
#pragma unroll
        for (int hh = 0; hh < (SEG2 ? 1 : 2); ++hh) {
            const int row0 = SEG2 ? 32 * (wave_id >> 2) : 32 * hh, kbase = SEG2 ? kb : kb + 32 * hh;
            if (kbase + 31 >= qs - 64 && kbase <= qs + 95) {
                f32x16 S;
#pragma unroll
                for (int r = 0; r < 16; ++r) S[r] = negM0;
                qk32<8>(S, Kb + row0 * KP, Q, 0, r32, hi);
                bf16x8 P[2];
                soft32<2>(S, P, l, qf - (float)kbase, nslope);
                pv32(O, P, Vb + row0 * VP, lane);
            }
        }
        if (more) { LAS char* kw = lds + ((s + 1) & 1) * BUFB + lrow * KP + lcb; LAS char* vw = lds + ((s + 1) & 1) * BUFB + 64 * KP + lrow * VP + lcb;
            *(LAS u32x4*)kw = kr0; *(LAS u32x4*)(kw + 16) = kr1; *(LAS u32x4*)vw = vr0; *(LAS u32x4*)(vw + 16) = vr1; }
        __syncthreads();
    }
    const int lane2 = pg8::lane_id_fresh(), hi2 = lane2 >> 5;
    const size_t qrow_i = rowb + (size_t)(qs + (lane2 & 31)) * dil + wres;
    bf16* qrow = R + qrow_i * LDQ + C_BQ + hcol;
    l = pg8::sum_halves(l);
    const float i1 = 1.f / l;
#pragma unroll
    for (int db = 0; db < 4; ++db)
#pragma unroll
        for (int g4 = 0; g4 < 4; ++g4) { const int d = 32 * db + 8 * g4 + 4 * hi2;
            u32x2 w; w.x = cvtpk(O[db][4 * g4 + 0] * i1, O[db][4 * g4 + 1] * i1); w.y = cvtpk(O[db][4 * g4 + 2] * i1, O[db][4 * g4 + 3] * i1);
            stage_put(lds + wave_id * 8704, lane2 & 31, hi2, db, g4, w); (void)d; }
    stage_flush(lds + wave_id * 8704, R + (rowb + (size_t)qs * dil + wres) * LDQ + C_BQ + hcol, (size_t)dil * LDQ, lane2);
    if (hi2 == 0) LB[((size_t)g * M + qrow_i) * 4 + j] = l;
}

#define XB_TMO      128
#define XB_XCNT(j)  (256  + 64 * (j))
#define XB_XSUB(j)  (1280 + 64 * (j))
#define XB_XGEN(j)  (2304 + 64 * (j))
#define XB_TOP      3328
#define XB_TOPGEN   3392
#define XCD_BAR_WORDS 3456
#define XB_SPIN_CAP (1u << 18)

__device__ __forceinline__ unsigned xb_ld(unsigned* p)              { return __hip_atomic_load(p, __ATOMIC_RELAXED, __HIP_MEMORY_SCOPE_AGENT); }
__device__ __forceinline__ unsigned xb_add(unsigned* p, unsigned v) { return __hip_atomic_fetch_add(p, v, __ATOMIC_RELAXED, __HIP_MEMORY_SCOPE_AGENT); }
__device__ __forceinline__ unsigned xb_xcc_id() { return (unsigned)__builtin_amdgcn_s_getreg((3 << 11) | 20) & 0xFu; }
#define XB_SPIN(cond, bar) do { unsigned _sp = 0; while (cond) { __builtin_amdgcn_s_sleep(1); \
    if ((++_sp & 255u) == 0u) { if (xb_ld(&(bar)[XB_TMO])) break; if (_sp > XB_SPIN_CAP) { atomicAdd(&(bar)[XB_TMO], 1u); break; } } } } while (0)

struct XcdBarrier {
    unsigned* bar; unsigned x;
    volatile LAS unsigned* st;
};

__device__ __forceinline__ XcdBarrier xcd_barrier_post(unsigned* bar, volatile LAS unsigned* st) {
    XcdBarrier b; b.bar = bar; b.x = xb_xcc_id(); b.st = st;
    if (threadIdx.x == 0) (void)xb_add(&bar[XB_XCNT(b.x)], 1u);
    return b;
}
__device__ __forceinline__ void xcd_barrier_complete(unsigned* bar, unsigned x, unsigned& nloc, unsigned& nx) {
    const unsigned G = gridDim.x * gridDim.y * gridDim.z;
    unsigned sum, cnt, mine, sp = 0u;
    for (;;) {
        sum = 0u; cnt = 0u; mine = 0u;
#pragma unroll
        for (unsigned j = 0; j < 16; ++j) { const unsigned c = xb_ld(&bar[XB_XCNT(j)]); sum += c; cnt += (c > 0u) ? 1u : 0u; mine = (j == x) ? c : mine; }
        if (sum == G) break;
        __builtin_amdgcn_s_sleep(1);
        if ((++sp & 255u) == 0u) { if (xb_ld(&bar[XB_TMO])) break; if (sp > XB_SPIN_CAP) { atomicAdd(&bar[XB_TMO], 1u); break; } }
    }
    nloc = mine > 0u ? mine : 1u; nx = cnt > 0u ? cnt : 1u;
}

__device__ __forceinline__ void xcd_barrier(const XcdBarrier& b, int wave_id) {
    asm volatile("s_waitcnt vmcnt(0)" ::: "memory");
    __syncthreads();
    if (pg8::tid_fresh(wave_id) == 0) {
        unsigned* bar = b.bar;
        __builtin_amdgcn_s_waitcnt(0);
        unsigned nloc = b.st[0], nx = b.st[1];
        if (nloc == 0u) { xcd_barrier_complete(bar, b.x, nloc, nx); b.st[0] = nloc; b.st[1] = nx; }
        const unsigned old = xb_add(&bar[XB_XSUB(b.x)], 1u);
        const unsigned gen = old / nloc;
        if (old + 1u == (gen + 1u) * nloc) {
            __builtin_amdgcn_fence(__ATOMIC_RELEASE, "agent");
            asm volatile("s_waitcnt vmcnt(0)" ::: "memory");
            const unsigned og = xb_add(&bar[XB_TOP], 1u);
            const unsigned tg = og / nx;
            if (og + 1u == (tg + 1u) * nx) xb_add(&bar[XB_TOPGEN], 1u);
            else XB_SPIN(xb_ld(&bar[XB_TOPGEN]) == tg, bar);
            __builtin_amdgcn_fence(__ATOMIC_ACQUIRE, "agent");
            xb_add(&bar[XB_XGEN(b.x)], 1u);
            asm volatile("s_waitcnt vmcnt(0)" ::: "memory");
        } else {
            XB_SPIN(xb_ld(&bar[XB_XGEN(b.x)]) == gen, bar);
            __builtin_amdgcn_fence(__ATOMIC_ACQUIRE, "agent");
            asm volatile("s_waitcnt vmcnt(0)" ::: "memory");
        }
    }
    __syncthreads();
}

struct Args { const float* in[25]; float* out; unsigned char* ws; };

__global__ void __launch_bounds__(512, 2) fwd_megakernel(Args a) {
    extern __shared__ __attribute__((aligned(16))) unsigned char lds_raw[];
    LAS unsigned char* lds = (LAS unsigned char*)lds_raw;
    cg::grid_group grid = cg::this_grid();
    const int wave = __builtin_amdgcn_readfirstlane((int)threadIdx.x >> 6);
#define FRESH_LANE const int lane = pg8::lane_id_fresh();
    const int G = gridDim.x, bid = blockIdx.x;
    const int gw = bid * 8 + wave, NGW = G * 8;
    unsigned char* ws = a.ws;
    const float* x = a.in[0]; const float* mem = a.in[1];
    bf16* W_IN = (bf16*)(ws + WS_WIN); bf16* W_G = (bf16*)(ws + WS_WG); bf16* W_MEM = (bf16*)(ws + WS_WMEM); bf16* W_BR = (bf16*)(ws + WS_WBR);
    bf16* W_OUT = (bf16*)(ws + WS_WOUT3); bf16* W_GU = (bf16*)(ws + WS_WGU); bf16* W_DN = (bf16*)(ws + WS_WDN);
    float* LB = (float*)(ws + WS_LB); bf16* R = (bf16*)(ws + WS_R);
    unsigned char* dob = (unsigned char*)a.out;
    bf16* XN = (bf16*)(dob + DO_XN); bf16* MN = (bf16*)(dob + DO_MN); bf16* CKV = (bf16*)(dob + DO_CKV);

    volatile LAS unsigned* MISC = (volatile LAS unsigned*)(lds + MISC_OFF);
    unsigned* barw = (unsigned*)(ws + WS_BAR);
    if (threadIdx.x < 16) MISC[threadIdx.x] = 0u;
    if (a.ws == nullptr) grid.sync();
    XcdBarrier bar = xcd_barrier_post(barw, MISC);
    __syncthreads();
    {
        FRESH_LANE
        LAS float* scr = (LAS float*)(lds + wave * 8704);
        constexpr int I_IN = 16 * (DIN / 32), I_MEM = 16 * (D / 32);
        for (int it = gw; it < I_IN + I_MEM; it += NGW) {
            int r = it;
            if (r < I_IN) { const int nb = DIN / 32; tr_item(a.in[3], DIN, 64 * (r / nb), 32 * (r % nb), W_IN, D, 0, 0, 1, 0, scr, lane); continue; } r -= I_IN;
            { const int nb = D / 32; tr_item(a.in[16], D, 64 * (r / nb), 32 * (r % nb), W_MEM, D, 0, 0, 1, 0, scr, lane); }
        }
        { float* SSQ0 = (float*)(ws + WS_SSQ); for (int i = gw * 64 + lane; i < M; i += NGW * 64) SSQ0[i] = 0.f; }
        for (int m0 = gw; m0 < M + MMEM; m0 += 3 * NGW) {
            f32x4 v[3][4]; float ssq[3];
#pragma unroll
            for (int q = 0; q < 3; ++q) { const int m = m0 + q * NGW; ssq[q] = 0.f;
                if (m < M + MMEM) { const f32x4* xr = (const f32x4*)((m < M) ? x + (size_t)m * D : mem + (size_t)(m - M) * D) + lane;
#pragma unroll
                    for (int j = 0; j < 4; ++j) v[q][j] = xr[64 * j]; } }
#pragma unroll
            for (int q = 0; q < 3; ++q) { const int m = m0 + q * NGW;
                if (m < M + MMEM) {
                    float s = 0.f;
#pragma unroll
                    for (int j = 0; j < 4; ++j) s += (v[q][j][0] * v[q][j][0] + v[q][j][1] * v[q][j][1]) + (v[q][j][2] * v[q][j][2] + v[q][j][3] * v[q][j][3]);
                    const float rstd = 1.f / sqrtf(wave_sum(s) * (1.f / 1024.f) + EPS);
                    const f32x4* gr = (const f32x4*)((m < M) ? a.in[2] : a.in[15]) + lane;
                    u32x2* o8 = (u32x2*)((m < M) ? XN + (size_t)m * D : MN + (size_t)(m - M) * D) + lane;
#pragma unroll
                    for (int j = 0; j < 4; ++j) { const f32x4 gn = gr[64 * j]; u32x2 w; w.x = cvtpk(v[q][j][0] * rstd * gn[0], v[q][j][1] * rstd * gn[1]); w.y = cvtpk(v[q][j][2] * rstd * gn[2], v[q][j][3] * rstd * gn[3]); o8[64 * j] = w; }
                } }
        }
    }
    xcd_barrier(bar, wave);

    {
        LAS float* GT = (LAS float*)(lds + GT_OFF);
        { const int t2 = pg8::tid_fresh(wave);
          if (t2 < 64) { GT[t2] = a.in[6][t2]; GT[64 + t2] = a.in[7][t2]; }
          if (t2 < 128) { GT[128 + t2] = a.in[13][t2]; GT[256 + t2] = a.in[14][t2]; GT[384 + t2] = a.in[17][t2]; GT[512 + t2] = a.in[18][t2]; } }
        __syncthreads();
        { const pg8::EpiQKV E{R, LDQ, CKV, D, GT, (LAS float*)(lds + XCH_OFF)};
          pg8::Gemm g{XN, W_IN, M, DIN, D, D, MN, W_MEM, nullptr, nullptr}; pg8::DualOrder S; S.init(M, DIN, MMEM, D, G, bid);
          pg8::gemm_phase<pg8::EpiQKV, pg8::DualOrder, true, true>(lds, g, S, E, wave); }
        {
            constexpr int I_G = 16 * (3 * D / 32), I_BR = 8 * (D / 32), I_OUT = 16 * (D / 32), I_FF = 16 * (DFF / 32), I_DN = (DFF / 64) * (D / 32);
            constexpr int NREST = I_G + 3 * I_BR + I_OUT + 2 * I_FF + I_DN;
            const int first = (G == 256) ? 160 : 0, nsl = G - first;
            if (bid >= first) {
                const int lane = pg8::lane_id_fresh();
                LAS float* scr = (LAS float*)(lds + wave * 8704);
                for (int it = (bid - first) * 8 + wave; it < NREST; it += nsl * 8) {
                    int r = it;
                    if (r < I_G) { const int nb = 3 * D / 32; tr_item(a.in[4], 3 * D, 64 * (r / nb), 32 * (r % nb), W_G, D, 0, 0, 1, 0, scr, lane); continue; } r -= I_G;
                    if (r < 3 * I_BR) { const int gI = r / I_BR, rr = r % I_BR, nb = D / 32; tr_item(a.in[19] + (size_t)gI * 512 * D, D, 64 * (rr / nb), 32 * (rr % nb), W_BR + (size_t)gI * D * 512, 512, 0, 0, 1, 0, scr, lane); continue; } r -= 3 * I_BR;
                    if (r < I_OUT) { const int nb = D / 32; tr_item(a.in[20], D, 64 * (r / nb), 32 * (r % nb), W_OUT, D, 0, 0, 1, 0, scr, lane); continue; } r -= I_OUT;
                    if (r < 2 * I_FF) { const int s = r / I_FF, rr = r % I_FF, nb = DFF / 32; const int n0 = 32 * (rr % nb);
                        tr_item(a.in[22 + s], DFF, 64 * (rr / nb), n0, W_GU, D, 256 * (n0 / 128) + 128 * s + (n0 % 128) - n0, 0, 1, 0, scr, lane); continue; } r -= 2 * I_FF;
                    { const int nb = D / 32; tr_item(a.in[24], D, 64 * (r / nb), 32 * (r % nb), W_DN, DFF, 0, 0, 1, 0, scr, lane); }
                }
            }
        }
    }
    xcd_barrier(bar, wave);

    {
        FRESH_LANE
#define UNIFORM_F(v) __builtin_bit_cast(float, __builtin_amdgcn_readfirstlane(__builtin_bit_cast(int, (float)(v))))
        const float negM_a = UNIFORM_F(-8.f * absmax_vec(a.in[6], 64, lane) * absmax_vec(a.in[7], 64, lane) * L2E);
        const float lam = UNIFORM_F(expf(wave_sum(a.in[8][lane] * a.in[9][lane])) - expf(wave_sum(a.in[10][lane] * a.in[11][lane])) + 0.2f);
        *(LAS float*)(lds + (LDS_BYTES - 64 + 32)) = lam;
        for (int rr = 0; rr < (512 + G - 1) / G; ++rr) {
            int u;
            if (G == 256) { const int k = rr * 32 + (bid >> 3), bh = (bid & 7) + 8 * (k >> 4); u = bh * 16 + (k & 15); }
            else { u = rr * G + bid; if (u >= 512) break; }
            const int b = u >> 6, h = (u >> 4) & 3, qblk = u & 15;
            const int ta_ = pg8::lane_id_fresh();
            const int qpos = qblk * 128 + (wave >> 1) * 32 + (ta_ & 31);
            bf16* qrow = R + ((size_t)b * SEQ + qblk * 128 + (wave >> 1) * 32) * LDQ + C_AQ + h * 128;
            const bf16* Kg = R + (size_t)b * SEQ * LDQ + C_AK + h * 128; const bf16* Vg = R + (size_t)b * SEQ * LDQ + C_AV + h * 128;
            const float nslope = -__builtin_amdgcn_exp2f(-2.f * (float)(h + 1)) * L2E;
            attn_shared_unit<2>((LAS char*)lds, qrow, Kg, Vg, LDQ, SEQ / 64, qpos, qblk * 128 + (wave >> 1) * 32, nslope, negM_a, lam, a.in[12], wave);
        }
        const int lnc_ = pg8::lane_id_fresh();
        const float negM_c = UNIFORM_F(-11.313708499f * absmax_vec(a.in[17], 128, lnc_) * absmax_vec(a.in[18], 128, lnc_) * L2E);
        for (int u = bid; u < 256; u += G) {
            const int b = u >> 5, h = (u >> 3) & 3, qblk = u & 7;
            const int tc_ = pg8::lane_id_fresh();
            const int qpos = qblk * 256 + wave * 32 + (tc_ & 31);
            bf16* qrow = R + ((size_t)b * SEQ + qblk * 256 + wave * 32) * LDQ + C_CQ + h * 128;
            const bf16* Kg = CKV + (size_t)b * NMEM * D + h * 128; const bf16* Vg = Kg + 512;
            attn_shared_unit<1>((LAS char*)lds, qrow, Kg, Vg, D, NMEM / 64, qpos, 0, 0.f, negM_c, 0.f, a.in[12], wave);
        }
        __syncthreads();
        { const int lnb_ = pg8::lane_id_fresh();
          const float negM_b = UNIFORM_F(-11.313708499f * absmax_vec(a.in[13], 128, lnb_) * absmax_vec(a.in[14], 128, lnb_) * L2E);
          for (int rr = 0; rr < (768 + G - 1) / G; ++rr) {
              int u;
              if (G == 256) { const int k = rr * 32 + (bid >> 3); u = ((bid & 7) + 8 * (k >> 3)) * 8 + (k & 7); }
              else { u = rr * G + bid; if (u >= 768) break; }
              const int sid = u >> 3, loc = u & 7, b = sid / 12, g = (sid % 12) >> 2, j = sid & 3;
              const float slope = __builtin_amdgcn_exp2f(-8.f * (float)(g * 4 + j + 1) / 12.f);
              if (g == 0) attn_b_block_unit<false>((LAS char*)lds, R, LB, b, g, j, 0, loc * 256, 1, -slope * L2E, negM_b, wave);
              else if (g == 1) attn_b_block_unit<false>((LAS char*)lds, R, LB, b, g, j, loc >> 1, (loc & 1) * 256, 4, -slope * 4.f * L2E, negM_b, wave);
              else attn_b_block_unit<true>((LAS char*)lds, R, LB, b, g, j, 2 * loc, 0, 16, -slope * 16.f * L2E, negM_b, wave);
          } }
    }
    xcd_barrier(bar, wave);

    { FRESH_LANE
    const int j = lane >> 4, d8 = (lane & 15) * 8;
    for (int m0 = gw; m0 < M; m0 += 4 * NGW) {
        u32x4 o0[4], o1[4], o2[4]; float l0[4], l1[4], l2[4];
#pragma unroll
        for (int q = 0; q < 4; ++q) { const int m = m0 + q * NGW;
            if (m < M) { const bf16* p0 = R + (size_t)m * LDQ + C_BQ + j * 128 + d8;
                o0[q] = *(const u32x4*)p0; o1[q] = *(const u32x4*)(p0 + 512); o2[q] = *(const u32x4*)(p0 + 1024);
                l0[q] = LB[((size_t)0 * M + m) * 4 + j]; l1[q] = LB[((size_t)1 * M + m) * 4 + j]; l2[q] = LB[((size_t)2 * M + m) * 4 + j]; } }
#pragma unroll
        for (int q = 0; q < 4; ++q) { const int m = m0 + q * NGW;
            if (m < M) {
                const float inv = 1.f / (l0[q] + l1[q] + l2[q]); const float w0 = l0[q] * inv, w1 = l1[q] * inv, w2 = l2[q] * inv;
                u32x4 w;
#pragma unroll
                for (int e = 0; e < 4; ++e) {
                    const float lo = w0 * pg8::bf_lo(o0[q][e]) + w1 * pg8::bf_lo(o1[q][e]) + w2 * pg8::bf_lo(o2[q][e]);
                    const float hi = w0 * pg8::bf_hi(o0[q][e]) + w1 * pg8::bf_hi(o1[q][e]) + w2 * pg8::bf_hi(o2[q][e]);
                    w[e] = cvtpk(lo, hi);
                }
                *(u32x4*)(R + (size_t)m * LDQ + C_BQ + j * 128 + d8) = w; } }
    } }
    {
        pg8::Gemm g{XN, W_G, M, 3 * D, D, D, nullptr, nullptr, nullptr, nullptr}; pg8::StaticOrder S; S.init(M, 3 * D, G, bid);
        pg8::EpiGate E{R + C_GATE, LDQ, a.in[5]};
        pg8::gemm_phase<pg8::EpiGate, pg8::StaticOrder, true, true>(lds, g, S, E, wave);
    }
    xcd_barrier(bar, wave);

    {
        pg8::Gemm g{R + C_AQ, W_BR, M, D, 512, LDQ, R + C_BQ, W_BR + (size_t)D * 512, R + C_CQ, W_BR + (size_t)2 * D * 512};
        pg8::RepeatOrder S; S.init(M, D, 3, G, bid);
        pg8::EpiBranch E{R + C_GATE, R + C_GATE, LDQ, D};
        pg8::gemm_phase<pg8::EpiBranch, pg8::RepeatOrder, true, true>(lds, g, S, E, wave);
    }
    xcd_barrier(bar, wave);

    {
        pg8::Gemm g{R + C_GATE, W_OUT, M, D, D, LDQ, nullptr, nullptr, nullptr, nullptr}; pg8::StaticOrder S; S.init(M, D, G, bid);
        pg8::EpiResidNorm E{x, a.out, D, a.in[21], R + C_H2, LDQ, (float*)(ws + WS_SSQ)};
        pg8::gemm_phase<pg8::EpiResidNorm, pg8::StaticOrder, true, true>(lds, g, S, E, wave);
    }
    xcd_barrier(bar, wave);

    {
        pg8::Gemm g{R + C_H2, W_GU, M, 2 * DFF, D, LDQ, nullptr, nullptr, nullptr, nullptr}; pg8::StaticOrder S; S.init(M, 2 * DFF, G, bid);
        pg8::EpiSwiGLU E{R + C_ACT, LDQ, (const float*)(ws + WS_SSQ)};
        pg8::gemm_phase<pg8::EpiSwiGLU, pg8::StaticOrder, true, true>(lds, g, S, E, wave);
    }
    xcd_barrier(bar, wave);

    {
        pg8::Gemm g{R + C_ACT, W_DN, M, D, DFF, LDQ, nullptr, nullptr, nullptr, nullptr}; pg8::StaticOrder S; S.init(M, D, G, bid);
        pg8::EpiResid E{a.out, a.out, D};
        pg8::gemm_phase<pg8::EpiResid, pg8::StaticOrder, true, true>(lds, g, S, E, wave);
    }
}

extern "C" void kernel_launch(void* const* d_in, const int* in_sizes, int n_in, void* d_out, int out_size, void* d_ws, size_t ws_size, hipStream_t stream) {
    static int grid = 0;
    if (grid == 0) {
        if (n_in != 25 || out_size != M * D || ws_size < WS_END) { fprintf(stderr, "kernel_launch: unexpected problem shape (n_in %d out %d ws %zu)\n", n_in, out_size, ws_size); grid = -1; return; }
        int dev = 0, cus = 0, per_cu = 0;
        hipGetDevice(&dev);
        hipDeviceGetAttribute(&cus, hipDeviceAttributeMultiprocessorCount, dev);
        if (hipFuncSetAttribute((const void*)fwd_megakernel, hipFuncAttributeMaxDynamicSharedMemorySize, LDS_BYTES) != hipSuccess) { fprintf(stderr, "kernel_launch: hipFuncSetAttribute failed\n"); }
        hipOccupancyMaxActiveBlocksPerMultiprocessor(&per_cu, (const void*)fwd_megakernel, 512, LDS_BYTES);
        (void)hipGetLastError();
        if (per_cu < 1) per_cu = 1;
        grid = cus;
        fprintf(stderr, "kernel_launch: cus %d per_cu %d grid %d\n", cus, per_cu, grid);
    }
    if (grid < 0) return;
    if (hipMemsetAsync((char*)d_ws + WS_BAR, 0, 16384, stream) != hipSuccess) { fprintf(stderr, "kernel_launch: memset of the barrier words failed\n"); return; }
    Args a{};
    for (int i = 0; i < 25; ++i) a.in[i] = (const float*)d_in[i];
    a.out = (float*)d_out; a.ws = (unsigned char*)d_ws;
    void* args[] = {&a};
    hipError_t e = hipLaunchCooperativeKernel((const void*)fwd_megakernel, dim3(grid), dim3(512), args, LDS_BYTES, stream);
    if (e != hipSuccess) fprintf(stderr, "cooperative launch failed: %s (grid %d)\n", hipGetErrorString(e), grid);
}
```

```cpp
#include <hip/hip_runtime.h>
#include <hip/hip_cooperative_groups.h>
#include <cstdio>
#include <cstdint>
namespace cg = cooperative_groups;
namespace pg8 {
#define PG8_LAS __attribute__((address_space(3)))
typedef unsigned short bf16_t;
typedef short bf16x8 __attribute__((ext_vector_type(8)));
typedef float f32x4 __attribute__((ext_vector_type(4)));
typedef unsigned u32x4 __attribute__((ext_vector_type(4)));
constexpr int BM = 256, BK = 64, HALF = 128, HTB = HALF * BK * 2  , STAGE_BYTES = 8 * HTB, NXCD = 8, WGM = 8;

__host__ __device__ __forceinline__ int lds_byte(int r, int c) { const int st = (r >> 4) * 2 + (c >> 5), rr = r & 15, cc = c & 31, ob = rr * 64 + cc * 2; return st * 1024 + (ob ^ (((ob >> 9) & 1) << 5)); }
__host__ __device__ __forceinline__ void stage_rc(int b, int& R, int& C) { const int st = b / 1024, sb = b % 1024, swz = sb ^ (((sb >> 9) & 1) << 5); R = (st >> 1) * 16 + swz / 64; C = (st & 1) * 32 + (swz % 64) / 2; }
__host__ __device__ __forceinline__ int perm32(int rho) { const int n = rho >> 4, i = rho & 15; return 8 * (i >> 2) + 4 * n + (i & 3); }

struct Unit { int pm, pn, src; };
struct Gemm { const bf16_t* A; const bf16_t* Bt; int M, N, K, lda; const bf16_t* A2; const bf16_t* Bt2; const bf16_t* A3; const bf16_t* Bt3; };

struct StaticOrder {
    int nM, nN, nwg, G, c;
    __host__ __device__ void init(int M, int N, int G_, int c_) { nM = M / BM; nN = N / BM; nwg = nM * nN; G = G_; c = c_; }
    __host__ __device__ bool next(int i, Unit& u) const {
        const long L = (long)i * G + c; if (L >= nwg) return false;
        int wgid = (int)L; { const int q = nwg / NXCD, r = nwg % NXCD, xcd = wgid % NXCD, off = wgid / NXCD; wgid = (xcd < r ? xcd * (q + 1) : r * (q + 1) + (xcd - r) * q) + off; }
        const int nig = WGM * nN, gid = wgid / nig, fm = gid * WGM, gsz = (nM - fm) < WGM ? (nM - fm) : WGM;
        u.pm = fm + ((wgid % nig) % gsz); u.pn = (wgid % nig) / gsz; u.src = 0; return true;
    }
    __device__ __forceinline__ void a_ready(const Unit&) const {}
    __device__ __forceinline__ void done(const Unit&) const {}
};

struct DualOrder {
    StaticOrder S1; int nM2, nN2;
    __host__ __device__ void init(int M, int N, int M2, int N2, int G_, int c_) { S1.init(M, N, G_, c_); nM2 = M2 / BM; nN2 = N2 / BM; }
    __host__ __device__ bool next(int i, Unit& u) const {
        if (S1.next(i, u)) return true;
        const long L = (long)i * S1.G + S1.c - S1.nwg; if (L < 0 || L >= (long)nM2 * nN2) return false;
        u.pm = (int)L % nM2; u.pn = (int)L / nM2; u.src = 1; return true;
    }
    __device__ __forceinline__ void a_ready(const Unit&) const {}
    __device__ __forceinline__ void done(const Unit&) const {}
};

struct RepeatOrder {
    StaticOrder S1; int nrep;
    __host__ __device__ void init(int M, int N, int nrep_, int G_, int c_) { S1.init(M, N, G_, c_); nrep = nrep_; }
    __host__ __device__ bool next(int i, Unit& u) const { if (i >= nrep) return false; if (!S1.next(0, u)) return false; u.src = i; return true; }
    __device__ __forceinline__ void a_ready(const Unit&) const {}
    __device__ __forceinline__ void done(const Unit&) const {}
};

template <int K> __device__ __forceinline__ float shx(float v) {
    return __builtin_bit_cast(float, __builtin_amdgcn_ds_swizzle(__builtin_bit_cast(int, v), (K << 10) | 0x1f)); }
__device__ __forceinline__ float sum_halves(float v) {
    auto rr = __builtin_amdgcn_permlane32_swap(__builtin_bit_cast(unsigned, v), __builtin_bit_cast(unsigned, v), false, false);
    return __builtin_bit_cast(float, (unsigned)rr[0]) + __builtin_bit_cast(float, (unsigned)rr[1]); }
__device__ __forceinline__ float max_halves(float v) {
    auto rr = __builtin_amdgcn_permlane32_swap(__builtin_bit_cast(unsigned, v), __builtin_bit_cast(unsigned, v), false, false);
    return fmaxf(__builtin_bit_cast(float, (unsigned)rr[0]), __builtin_bit_cast(float, (unsigned)rr[1])); }
__device__ __forceinline__ int lane_id_fresh() { int z = 0; asm volatile("" : "+s"(z)); return __builtin_amdgcn_mbcnt_hi(~0u, __builtin_amdgcn_mbcnt_lo(~0u, z)); }
__device__ __forceinline__ int tid_fresh(int wave) { return wave * 64 + lane_id_fresh(); }
typedef float f32x2v_t __attribute__((ext_vector_type(2))); typedef __bf16 bf16x2v_t __attribute__((ext_vector_type(2)));
__device__ __forceinline__ unsigned cvt_pk_bf16(float lo, float hi) { f32x2v_t v = {lo, hi}; bf16x2v_t b = __builtin_convertvector(v, bf16x2v_t); return __builtin_bit_cast(unsigned, b); }
__device__ __forceinline__ float bf_lo(unsigned w) { return __builtin_bit_cast(float, w << 16); }
__device__ __forceinline__ float bf_hi(unsigned w) { return __builtin_bit_cast(float, w & 0xffff0000u); }
#define PG8_ACC const f32x4 (&acc)[2][2][4][2]

struct EpiQKV {
    static constexpr bool PERM = true, AFTER_DRAIN = false;
    bf16_t* O; int ldc; bf16_t* O2; int ldc2;
    PG8_LAS const float* GT;
    PG8_LAS float* X;
    __device__ __forceinline__ void operator()(PG8_ACC, const Unit& u, int wr, int wc, int fr, int fq) const {
        const int pn = u.pn;
        int kind, gp; float sc = 1.f;
        constexpr float L2E = 1.4426950408889634f;
        const int mode = u.src;
        if (mode == 0) {
            if (pn < 2) { kind = 1; gp = 0; sc = 0.125f * L2E; }
            else if (pn < 4) { kind = 1; gp = 64; }
            else if (pn < 6) { kind = 0; gp = 64; }
            else if (pn < 12) { kind = 2; gp = 128; sc = 0.08838834764831845f * L2E; }
            else if (pn < 18) { kind = 2; gp = 256; }
            else if (pn < 24) { kind = 0; gp = 256; }
            else { kind = 2; gp = 384; sc = 0.08838834764831845f * L2E; }
        } else {
            if (pn < 2) { kind = 2; gp = 512; } else { kind = 0; gp = 512; }
        }
        const int row0 = u.pm * BM + wr * 64 + fr, col0 = pn * BM + wc * 32 + 8 * fq;
        float rs[2][4][2];
        f32x4 gv[2];
        if (kind != 0) {
#pragma unroll
            for (int ai = 0; ai < 2; ++ai)
#pragma unroll
                for (int m = 0; m < 4; ++m)
#pragma unroll
                    for (int bj = 0; bj < 2; ++bj) {
                        const f32x4 a = acc[ai][bj][m][0], b = acc[ai][bj][m][1];
                        float s = (a[0] * a[0] + a[1] * a[1]) + (a[2] * a[2] + a[3] * a[3]) + (b[0] * b[0] + b[1] * b[1]) + (b[2] * b[2] + b[3] * b[3]);
                        s += shx<16>(s); s = sum_halves(s);
                        if (fq == 0) X[((ai * 128 + wr * 64 + m * 16 + fr) * 2 + bj) * 4 + wc] = s;
                    }
            asm volatile("s_waitcnt lgkmcnt(0)" ::: "memory"); __builtin_amdgcn_s_barrier(); asm volatile("" ::: "memory");
            const int hd = (kind == 1) ? 64 : 128;
            const float inv_hd = (kind == 1) ? (1.f / 64.f) : (1.f / 128.f);
#pragma unroll
            for (int ai = 0; ai < 2; ++ai)
#pragma unroll
                for (int m = 0; m < 4; ++m)
#pragma unroll
                    for (int bj = 0; bj < 2; ++bj) {
                        const f32x4 xs = *(const PG8_LAS f32x4*)(X + ((ai * 128 + wr * 64 + m * 16 + fr) * 2 + bj) * 4);
                        float tot;
                        if (kind == 1) tot = (wc < 2) ? (xs[0] + xs[1]) : (xs[2] + xs[3]);
                        else tot = (xs[0] + xs[1]) + (xs[2] + xs[3]);
                        rs[ai][m][bj] = __builtin_amdgcn_rsqf(tot * inv_hd + 1e-6f) * sc;
                    }
            const int gc = ((wc * 32 + 8 * fq) & (hd - 1));
            gv[0] = *(const PG8_LAS f32x4*)(GT + gp + gc); gv[1] = *(const PG8_LAS f32x4*)(GT + gp + gc + 4);
        } else {
#pragma unroll
            for (int ai = 0; ai < 2; ++ai)
#pragma unroll
                for (int m = 0; m < 4; ++m)
#pragma unroll
                    for (int bj = 0; bj < 2; ++bj) rs[ai][m][bj] = 1.f;
            gv[0] = (f32x4){1.f, 1.f, 1.f, 1.f}; gv[1] = gv[0];
        }
#pragma unroll
        for (int ai = 0; ai < 2; ++ai)
#pragma unroll
            for (int m = 0; m < 4; ++m) { bf16_t* rowp = (mode ? O2 : O) + (size_t)(row0 + ai * HALF + m * 16) * (mode ? ldc2 : ldc) + col0;
#pragma unroll
                for (int bj = 0; bj < 2; ++bj) { const float r = rs[ai][m][bj];
                    const f32x4 v0 = acc[ai][bj][m][0] * gv[0] * r, v1 = acc[ai][bj][m][1] * gv[1] * r;
                    u32x4 w; w.x = cvt_pk_bf16(v0[0], v0[1]); w.y = cvt_pk_bf16(v0[2], v0[3]); w.z = cvt_pk_bf16(v1[0], v1[1]); w.w = cvt_pk_bf16(v1[2], v1[3]);
                    *(u32x4*)(rowp + bj * HALF) = w; } }
    }
};

struct EpiGate {
    static constexpr bool PERM = true, AFTER_DRAIN = false;
    bf16_t* O; int ldc; const float* bias;
    __device__ __forceinline__ void operator()(PG8_ACC, const Unit& u, int wr, int wc, int fr, int fq) const {
        const int row0 = u.pm * BM + wr * 64 + fr, col0 = u.pn * BM + wc * 32 + 8 * fq;
        f32x4 bv[2][2];
#pragma unroll
        for (int bj = 0; bj < 2; ++bj)
#pragma unroll
            for (int n = 0; n < 2; ++n) bv[bj][n] = *(const f32x4*)(bias + col0 + bj * HALF + 4 * n);
#pragma unroll
        for (int ai = 0; ai < 2; ++ai)
#pragma unroll
            for (int m = 0; m < 4; ++m) { bf16_t* rowp = O + (size_t)(row0 + ai * HALF + m * 16) * ldc + col0;
#pragma unroll
                for (int bj = 0; bj < 2; ++bj) { f32x4 v0 = acc[ai][bj][m][0] + bv[bj][0], v1 = acc[ai][bj][m][1] + bv[bj][1];
#pragma unroll
                    for (int e = 0; e < 4; ++e) { v0[e] = __builtin_amdgcn_rcpf(1.f + __builtin_amdgcn_exp2f(-1.4426950408889634f * v0[e])); v1[e] = __builtin_amdgcn_rcpf(1.f + __builtin_amdgcn_exp2f(-1.4426950408889634f * v1[e])); }
                    u32x4 w; w.x = cvt_pk_bf16(v0[0], v0[1]); w.y = cvt_pk_bf16(v0[2], v0[3]); w.z = cvt_pk_bf16(v1[0], v1[1]); w.w = cvt_pk_bf16(v1[2], v1[3]);
                    *(u32x4*)(rowp + bj * HALF) = w; } }
    }
};

struct EpiBranch {
    static constexpr bool PERM = true, AFTER_DRAIN = false;
    bf16_t* MIX; const bf16_t* GATE0; int ldc; int gstride;
    __device__ __forceinline__ void operator()(PG8_ACC, const Unit& u, int wr, int wc, int fr, int fq) const {
        const int row0 = u.pm * BM + wr * 64 + fr, col0 = u.pn * BM + wc * 32 + 8 * fq;
        const bf16_t* GATE = GATE0 + (size_t)u.src * gstride; const int accum = u.src;
#pragma unroll
        for (int ai = 0; ai < 2; ++ai)
#pragma unroll
            for (int m = 0; m < 4; ++m) { const size_t off = (size_t)(row0 + ai * HALF + m * 16) * ldc + col0;
#pragma unroll
                for (int bj = 0; bj < 2; ++bj) { const u32x4 gt = *(const u32x4*)(GATE + off + bj * HALF);
                    f32x4 a = acc[ai][bj][m][0], b = acc[ai][bj][m][1];
                    a[0] *= bf_lo(gt.x); a[1] *= bf_hi(gt.x); a[2] *= bf_lo(gt.y); a[3] *= bf_hi(gt.y); b[0] *= bf_lo(gt.z); b[1] *= bf_hi(gt.z); b[2] *= bf_lo(gt.w); b[3] *= bf_hi(gt.w);
                    if (accum) { const u32x4 mx = *(const u32x4*)(MIX + off + bj * HALF);
                        a[0] += bf_lo(mx.x); a[1] += bf_hi(mx.x); a[2] += bf_lo(mx.y); a[3] += bf_hi(mx.y); b[0] += bf_lo(mx.z); b[1] += bf_hi(mx.z); b[2] += bf_lo(mx.w); b[3] += bf_hi(mx.w); }
                    u32x4 w; w.x = cvt_pk_bf16(a[0], a[1]); w.y = cvt_pk_bf16(a[2], a[3]); w.z = cvt_pk_bf16(b[0], b[1]); w.w = cvt_pk_bf16(b[2], b[3]);
                    *(u32x4*)(MIX + off + bj * HALF) = w; } }
    }
};

struct EpiResid {
    static constexpr bool PERM = true, AFTER_DRAIN = false;
    const float* res; float* out; int ld;
    __device__ __forceinline__ void operator()(PG8_ACC, const Unit& u, int wr, int wc, int fr, int fq) const {
        const int row0 = u.pm * BM + wr * 64 + fr, col0 = u.pn * BM + wc * 32 + 8 * fq;
#pragma unroll
        for (int ai = 0; ai < 2; ++ai)
#pragma unroll
            for (int m = 0; m < 4; ++m) { const size_t off = (size_t)(row0 + ai * HALF + m * 16) * ld + col0;
#pragma unroll
                for (int bj = 0; bj < 2; ++bj) {
                    const f32x4 r0 = *(const f32x4*)(res + off + bj * HALF), r1 = *(const f32x4*)(res + off + bj * HALF + 4);
                    const f32x4 v0 = acc[ai][bj][m][0] + r0, v1 = acc[ai][bj][m][1] + r1;
                    *(f32x4*)(out + off + bj * HALF) = v0; *(f32x4*)(out + off + bj * HALF + 4) = v1; } }
    }
};

struct EpiResidNorm {
    static constexpr bool PERM = true, AFTER_DRAIN = false;
    const float* res; float* out; int ld; const float* gain; bf16_t* H; int ldh; float* SSQ;
    __device__ __forceinline__ void operator()(PG8_ACC, const Unit& u, int wr, int wc, int fr, int fq) const {
        const int row0 = u.pm * BM + wr * 64 + fr, col0 = u.pn * BM + wc * 32 + 8 * fq;
        f32x4 gv[2][2];
#pragma unroll
        for (int bj = 0; bj < 2; ++bj)
#pragma unroll
            for (int n = 0; n < 2; ++n) gv[bj][n] = *(const f32x4*)(gain + col0 + bj * HALF + 4 * n);
#pragma unroll
        for (int ai = 0; ai < 2; ++ai)
#pragma unroll
            for (int m = 0; m < 4; ++m) { const int row = row0 + ai * HALF + m * 16; const size_t off = (size_t)row * ld + col0; float s = 0.f;
#pragma unroll
                for (int bj = 0; bj < 2; ++bj) {
                    const f32x4 r0 = *(const f32x4*)(res + off + bj * HALF), r1 = *(const f32x4*)(res + off + bj * HALF + 4);
                    const f32x4 v0 = acc[ai][bj][m][0] + r0, v1 = acc[ai][bj][m][1] + r1;
                    *(f32x4*)(out + off + bj * HALF) = v0; *(f32x4*)(out + off + bj * HALF + 4) = v1;
                    s += (v0[0] * v0[0] + v0[1] * v0[1]) + (v0[2] * v0[2] + v0[3] * v0[3]) + (v1[0] * v1[0] + v1[1] * v1[1]) + (v1[2] * v1[2] + v1[3] * v1[3]);
                    const f32x4 h0 = v0 * gv[bj][0], h1 = v1 * gv[bj][1];
                    u32x4 w; w.x = cvt_pk_bf16(h0[0], h0[1]); w.y = cvt_pk_bf16(h0[2], h0[3]); w.z = cvt_pk_bf16(h1[0], h1[1]); w.w = cvt_pk_bf16(h1[2], h1[3]);
                    *(u32x4*)(H + (size_t)row * ldh + col0 + bj * HALF) = w; }
                s += shx<16>(s); s = sum_halves(s);
                if (fq == 0) atomicAdd(SSQ + row, s); }
    }
};

struct EpiSwiGLU {
    static constexpr bool PERM = true, AFTER_DRAIN = false;
    bf16_t* O; int ldc; const float* SSQ;
    __device__ __forceinline__ void operator()(PG8_ACC, const Unit& u, int wr, int wc, int fr, int fq) const {
        const int row0 = u.pm * BM + wr * 64 + fr, col0 = u.pn * HALF + wc * 32 + 8 * fq;
#pragma unroll
        for (int ai = 0; ai < 2; ++ai)
#pragma unroll
            for (int m = 0; m < 4; ++m) { bf16_t* rowp = O + (size_t)(row0 + ai * HALF + m * 16) * ldc + col0;
                const float rstd = __builtin_amdgcn_rsqf(SSQ[row0 + ai * HALF + m * 16] * (1.f / 1024.f) + 1e-6f);
                f32x4 v[2];
#pragma unroll
                for (int n = 0; n < 2; ++n) { const f32x4 gt = acc[ai][0][m][n] * rstd, up = acc[ai][1][m][n] * rstd;
#pragma unroll
                    for (int e = 0; e < 4; ++e) v[n][e] = gt[e] * __builtin_amdgcn_rcpf(1.f + __builtin_amdgcn_exp2f(-1.4426950408889634f * gt[e])) * up[e]; }
                u32x4 w; w.x = cvt_pk_bf16(v[0][0], v[0][1]); w.y = cvt_pk_bf16(v[0][2], v[0][3]); w.z = cvt_pk_bf16(v[1][0], v[1][1]); w.w = cvt_pk_bf16(v[1][2], v[1][3]);
                *(u32x4*)rowp = w; }
    }
};

template <class Epi, class Sched, bool ALIGN_EPI = false, bool SP2 = false>
__device__ __forceinline__ void gemm_phase(PG8_LAS unsigned char* lds, const Gemm g, const Sched& S, const Epi& E, int wave_id) {
    const int tid = tid_fresh(wave_id);
    const int wid = __builtin_amdgcn_readfirstlane(tid >> 6), lane = tid & 63, wr = wid >> 2, wc = wid & 3, fr = lane & 15, fq = lane >> 4;
    const int K = g.K, nt = K / BK;
    unsigned voffA[2], voffB[2];
#pragma unroll
    for (int i = 0; i < 2; ++i) { int R, C; stage_rc(tid * 16 + i * 8192, R, C); const int Rb = Epi::PERM ? ((R & ~31) + perm32(R & 31)) : R;
        voffA[i] = (unsigned)(R * g.lda + C) * 2u; voffB[i] = (unsigned)(Rb * K + C) * 2u; }
    const size_t kstep = (size_t)(BK * 2);
    const size_t hstepA = (size_t)HALF * g.lda * 2, hstepB = (size_t)HALF * K * 2;
    const size_t tstepA = 2 * hstepA, tstepB = 2 * hstepB;
    const unsigned ldsw = (unsigned)wid * 1024u;
    const int aoff = lds_byte(wr * 64 + fr, fq * 8), boff = lds_byte(wc * 32 + fr, fq * 8);
#define PG8_SA(b, h) (((b) * 2 + (h)) * HTB)
#define PG8_SB(b, h) ((4 + (b) * 2 + (h)) * HTB)
#define PG8_STAGE(bufoff, gbase, voff) do { _Pragma("unroll") for (int _i = 0; _i < 2; ++_i) \
        __builtin_amdgcn_global_load_lds((const unsigned*)((const char*)(gbase) + (voff)[_i]), (PG8_LAS unsigned*)(lds + (bufoff) + ldsw + _i * 8192), 16, 0, 0); } while (0)
#define PG8_LDA(dst, b, h) do { _Pragma("unroll") for (int m = 0; m < 4; ++m) _Pragma("unroll") for (int k = 0; k < 2; ++k) dst[m][k] = *(const PG8_LAS bf16x8*)(lds + PG8_SA(b, h) + aoff + m * 2048 + k * 1024); } while (0)
#define PG8_LDB(dst, b, h) do { _Pragma("unroll") for (int n = 0; n < 2; ++n) _Pragma("unroll") for (int k = 0; k < 2; ++k) dst[n][k] = *(const PG8_LAS bf16x8*)(lds + PG8_SB(b, h) + boff + n * 2048 + k * 1024); } while (0)
#define PG8_MMA(ai, bj, At, Bt) do { __builtin_amdgcn_s_setprio(1); _Pragma("unroll") for (int m = 0; m < 4; ++m) _Pragma("unroll") for (int n = 0; n < 2; ++n) _Pragma("unroll") for (int k = 0; k < 2; ++k) \
        acc[ai][bj][m][n] = __builtin_amdgcn_mfma_f32_16x16x32_bf16(Bt[n][k], At[m][k], acc[ai][bj][m][n], 0, 0, 0); __builtin_amdgcn_s_setprio(0); } while (0)
#define PG8_WAIT_V(n) asm volatile("s_waitcnt vmcnt(" #n ")" ::: "memory")
#define PG8_WAIT_L(n) asm volatile("s_waitcnt lgkmcnt(" #n ")" ::: "memory")
#define PG8_BAR __builtin_amdgcn_s_barrier()
#define PG8_SCHED __builtin_amdgcn_sched_barrier(0)
    Unit cur, nxt; int ui = 0;
    if (!S.next(0, cur)) return;
    f32x4 acc[2][2][4][2];
#pragma unroll
    for (int a = 0; a < 2; ++a)
#pragma unroll
        for (int b = 0; b < 2; ++b)
#pragma unroll
            for (int m = 0; m < 4; ++m)
#pragma unroll
                for (int n = 0; n < 2; ++n) acc[a][b][m][n] = (f32x4){0.f, 0.f, 0.f, 0.f};
    bf16x8 At[4][2], B0[2][2], B1[2][2];
    const char* cA = (const char*)(cur.src == 0 ? g.A : (cur.src == 1 ? g.A2 : g.A3)) + (size_t)cur.pm * tstepA; const char* cB = (const char*)(cur.src == 0 ? g.Bt : (cur.src == 1 ? g.Bt2 : g.Bt3)) + (size_t)cur.pn * tstepB;
    S.a_ready(cur);
    if constexpr (SP2) {
        PG8_STAGE(PG8_SB(0, 0), cB, voffB); PG8_STAGE(PG8_SB(0, 1), cB + hstepB, voffB); PG8_STAGE(PG8_SA(0, 0), cA, voffA); PG8_STAGE(PG8_SA(0, 1), cA + hstepA, voffA);
        if (wr == 1) PG8_BAR;
        PG8_WAIT_V(2); PG8_BAR;
        PG8_STAGE(PG8_SB(1, 0), cB + kstep, voffB); PG8_STAGE(PG8_SA(1, 0), cA + kstep, voffA); PG8_STAGE(PG8_SB(1, 1), cB + hstepB + kstep, voffB);
        PG8_WAIT_V(6); PG8_BAR;
    } else {
        PG8_STAGE(PG8_SB(0, 0), cB, voffB); PG8_STAGE(PG8_SA(0, 0), cA, voffA); PG8_STAGE(PG8_SB(0, 1), cB + hstepB, voffB); PG8_STAGE(PG8_SA(0, 1), cA + hstepA, voffA);
        if (wr == 1) PG8_BAR;
        PG8_WAIT_V(4); PG8_BAR;
        PG8_STAGE(PG8_SB(1, 0), cB + kstep, voffB); PG8_STAGE(PG8_SA(1, 0), cA + kstep, voffA); PG8_STAGE(PG8_SB(1, 1), cB + hstepB + kstep, voffB);
        PG8_WAIT_V(6); PG8_BAR;
    }
    for (;;) {
        const bool has_next = S.next(ui + 1, nxt);
        const char* nA = has_next ? (const char*)(nxt.src == 0 ? g.A : (nxt.src == 1 ? g.A2 : g.A3)) + (size_t)nxt.pm * tstepA : cA; const char* nB = has_next ? (const char*)(nxt.src == 0 ? g.Bt : (nxt.src == 1 ? g.Bt2 : g.Bt3)) + (size_t)nxt.pn * tstepB : cB;
        for (int t = 0; t < nt; t += 2) {
            const bool last = (t == nt - 2);
            const char* a1 = cA + (size_t)(t + 1) * kstep;
            const char* a2 = last ? nA : cA + (size_t)(t + 2) * kstep; const char* b2 = last ? nB : cB + (size_t)(t + 2) * kstep;
            const char* a3 = a2 + kstep; const char* b3 = b2 + kstep;
            if (last && has_next) S.a_ready(nxt);
            if constexpr (SP2) {
            PG8_LDB(B0, 0, 0); PG8_LDB(B1, 0, 1); PG8_SCHED; PG8_LDA(At, 0, 0); PG8_STAGE(PG8_SA(1, 1), a1 + hstepA, voffA);
            PG8_WAIT_V(8); PG8_WAIT_L(0); PG8_BAR; PG8_MMA(0, 0, At, B0); PG8_MMA(0, 1, At, B1); PG8_BAR; PG8_SCHED;
            PG8_LDA(At, 0, 1); PG8_STAGE(PG8_SB(0, 0), b2, voffB); PG8_STAGE(PG8_SB(0, 1), b2 + hstepB, voffB); PG8_STAGE(PG8_SA(0, 0), a2, voffA);
            PG8_WAIT_V(8); PG8_WAIT_L(0); PG8_BAR; PG8_MMA(1, 0, At, B0); PG8_MMA(1, 1, At, B1); PG8_BAR; PG8_SCHED;
            PG8_LDB(B0, 1, 0); PG8_LDB(B1, 1, 1); PG8_SCHED; PG8_LDA(At, 1, 0); PG8_STAGE(PG8_SA(0, 1), a2 + hstepA, voffA);
            PG8_WAIT_V(8); PG8_WAIT_L(0); PG8_BAR; PG8_MMA(0, 0, At, B0); PG8_MMA(0, 1, At, B1); PG8_BAR; PG8_SCHED;
            PG8_LDA(At, 1, 1); PG8_STAGE(PG8_SB(1, 0), b3, voffB); PG8_STAGE(PG8_SB(1, 1), b3 + hstepB, voffB); PG8_STAGE(PG8_SA(1, 0), a3, voffA);
            PG8_WAIT_V(8); PG8_WAIT_L(0); PG8_BAR; PG8_MMA(1, 0, At, B0); PG8_MMA(1, 1, At, B1); PG8_BAR; PG8_SCHED;
            } else {
            PG8_LDB(B0, 0, 0); PG8_SCHED; PG8_LDA(At, 0, 0); PG8_STAGE(PG8_SA(1, 1), a1 + hstepA, voffA);
            PG8_WAIT_L(8); PG8_BAR; PG8_WAIT_L(0); PG8_MMA(0, 0, At, B0); PG8_BAR; PG8_SCHED;
            PG8_LDB(B1, 0, 1); PG8_STAGE(PG8_SB(0, 0), b2, voffB);
            PG8_BAR; PG8_WAIT_L(0); PG8_MMA(0, 1, At, B1); PG8_BAR;
            PG8_LDA(At, 0, 1); PG8_STAGE(PG8_SA(0, 0), a2, voffA);
            PG8_BAR; PG8_WAIT_L(0); PG8_MMA(1, 0, At, B0); PG8_BAR; PG8_SCHED;
            PG8_STAGE(PG8_SB(0, 1), b2 + hstepB, voffB);
            PG8_WAIT_V(6); PG8_BAR; PG8_MMA(1, 1, At, B1); PG8_BAR;
            PG8_LDB(B0, 1, 0); PG8_SCHED; PG8_LDA(At, 1, 0); PG8_STAGE(PG8_SA(0, 1), a2 + hstepA, voffA);
            PG8_WAIT_L(8); PG8_BAR; PG8_WAIT_L(0); PG8_MMA(0, 0, At, B0); PG8_BAR; PG8_SCHED;
            PG8_LDB(B1, 1, 1); PG8_STAGE(PG8_SB(1, 0), b3, voffB);
            PG8_BAR; PG8_WAIT_L(0); PG8_MMA(0, 1, At, B1); PG8_BAR;
            PG8_LDA(At, 1, 1); PG8_STAGE(PG8_SA(1, 0), a3, voffA);
            PG8_BAR; PG8_WAIT_L(0); PG8_MMA(1, 0, At, B0); PG8_BAR; PG8_SCHED;
            PG8_STAGE(PG8_SB(1, 1), b3 + hstepB, voffB);
            PG8_WAIT_V(6); PG8_BAR; PG8_MMA(1, 1, At, B1); PG8_BAR;
            }
        }
        if constexpr (ALIGN_EPI) { if (wr == 0) PG8_BAR; }
        if constexpr (!Epi::AFTER_DRAIN) { E(acc, cur, wr, wc, fr, fq); S.done(cur); }
        if (!has_next) break;
#pragma unroll
        for (int a = 0; a < 2; ++a)
#pragma unroll
            for (int b = 0; b < 2; ++b)
#pragma unroll
                for (int m = 0; m < 4; ++m)
#pragma unroll
                    for (int n = 0; n < 2; ++n) acc[a][b][m][n] = (f32x4){0.f, 0.f, 0.f, 0.f};
        cur = nxt; cA = nA; cB = nB; ++ui;
        if constexpr (ALIGN_EPI) { if (wr == 1) PG8_BAR; }
    }
    PG8_WAIT_V(0);
    if constexpr (!ALIGN_EPI) { if (wr == 0) PG8_BAR; }
    PG8_BAR;
    if constexpr (Epi::AFTER_DRAIN) { E.fused(acc, cur, wr, wc, fr, fq, lds, wid, lane); S.done(cur); }
#undef PG8_SA
#undef PG8_SB
#undef PG8_STAGE
#undef PG8_LDA
#undef PG8_LDB
#undef PG8_MMA
#undef PG8_WAIT_V
#undef PG8_WAIT_L
#undef PG8_BAR
#undef PG8_SCHED
}
}

#define LAS __attribute__((address_space(3)))
typedef unsigned short bf16;
typedef short bf16x8 __attribute__((ext_vector_type(8)));
typedef short s16x4 __attribute__((ext_vector_type(4)));
typedef short v4i16_t __attribute__((ext_vector_type(4)));
typedef float f32x16 __attribute__((ext_vector_type(16)));
typedef float f32x4 __attribute__((ext_vector_type(4)));
typedef float f32x2_t __attribute__((ext_vector_type(2)));
typedef __bf16 bf16x2_t __attribute__((ext_vector_type(2)));
typedef unsigned u32x4 __attribute__((ext_vector_type(4)));
typedef unsigned u32x2 __attribute__((ext_vector_type(2)));

constexpr int D = 1024, SEQ = 2048, NB = 8, M = NB * SEQ, NMEM = 256, MMEM = NB * NMEM, DIN = 6656, DFF = 2816;
constexpr int LDQ = 6656;
constexpr int C_AQ = 0, C_AK = 512, C_AV = 1024, C_BQ = 1536, C_BK = 3072, C_BV = 4608, C_CQ = 6144;
constexpr int C_GATE = 3072;
constexpr int C_H2 = 0, C_ACT = 1024;
constexpr float L2E = 1.4426950408889634f;
constexpr float EPS = 1e-6f;

constexpr size_t WS_WIN = 0;
constexpr size_t WS_WG = WS_WIN + (size_t)DIN * D * 2;
constexpr size_t WS_WMEM = WS_WG + (size_t)3 * D * D * 2;
constexpr size_t WS_WBR = WS_WMEM + (size_t)D * D * 2;
constexpr size_t WS_WOUT3 = WS_WBR + (size_t)3 * D * 512 * 2;
constexpr size_t WS_WGU = WS_WOUT3 + (size_t)D * 3 * D * 2;
constexpr size_t WS_WDN = WS_WGU + (size_t)2 * DFF * D * 2;
constexpr size_t WS_LB = WS_WDN + (size_t)D * DFF * 2;
constexpr size_t WS_R = WS_LB + (size_t)3 * M * 4 * 4;
constexpr size_t WS_BAR = WS_R + (size_t)M * LDQ * 2;
constexpr size_t WS_SSQ = WS_BAR + 16384;
constexpr size_t WS_END = WS_SSQ + (size_t)M * 4;
static_assert(WS_END <= (size_t)256 * 1024 * 1024, "d_ws map");
constexpr size_t DO_XN = 0;
constexpr size_t DO_MN = DO_XN + (size_t)M * D * 2;
constexpr size_t DO_CKV = DO_MN + (size_t)MMEM * D * 2;
static_assert(DO_CKV + (size_t)MMEM * D * 2 <= (size_t)M * D * 4, "d_out scratch map");

constexpr int LDS_BYTES = 155648;
constexpr int XCH_OFF = 131072, GT_OFF = 131072 + 8192;
constexpr int MISC_OFF = LDS_BYTES - 64;
constexpr int KP = 272, VP = 320;

__device__ __forceinline__ unsigned cvtpk(float lo, float hi) { f32x2_t v = {lo, hi}; bf16x2_t b = __builtin_convertvector(v, bf16x2_t); return __builtin_bit_cast(unsigned, b); }
__device__ __forceinline__ float wave_sum(float v) {
    v += pg8::shx<1>(v); v += pg8::shx<2>(v); v += pg8::shx<4>(v); v += pg8::shx<8>(v); v += pg8::shx<16>(v); v = pg8::sum_halves(v);
    return v;
}
__device__ __forceinline__ float wave_max(float v) {
    v = fmaxf(v, pg8::shx<1>(v)); v = fmaxf(v, pg8::shx<2>(v)); v = fmaxf(v, pg8::shx<4>(v)); v = fmaxf(v, pg8::shx<8>(v)); v = fmaxf(v, pg8::shx<16>(v)); v = pg8::max_halves(v);
    return v;
}
__device__ __forceinline__ float absmax_vec(const float* g, int n, int lane) {
    float v = fabsf(g[lane]); if (n > 64) v = fmaxf(v, fabsf(g[lane + 64]));
    return wave_max(v);
}

__device__ __forceinline__ void tr_item(const float* W, int N, int k0, int n0, bf16* WT, int dst_pitch, int dst_row0, int dst_k0, int ncopies, int copy_stride, LAS float* scr, int lane) {
#pragma unroll 8
    for (int i = 0; i < 32; ++i) { const int kk = 2 * i + (lane >> 5); scr[kk * 33 + (lane & 31)] = W[(size_t)(k0 + kk) * N + n0 + (lane & 31)]; }
    asm volatile("s_waitcnt lgkmcnt(0)" ::: "memory");
    const int c = lane & 7;
#pragma unroll
    for (int j = 0; j < 4; ++j) { const int n = (lane >> 3) + 8 * j; const LAS float* s = scr + (8 * c) * 33 + n;
        u32x4 o; o.x = cvtpk(s[0 * 33], s[1 * 33]); o.y = cvtpk(s[2 * 33], s[3 * 33]); o.z = cvtpk(s[4 * 33], s[5 * 33]); o.w = cvtpk(s[6 * 33], s[7 * 33]);
        bf16* dst = WT + (size_t)(dst_row0 + n0 + n) * dst_pitch + dst_k0 + k0 + 8 * c;
        for (int cp = 0; cp < ncopies; ++cp) *(u32x4*)(dst + (size_t)cp * copy_stride) = o; }
    asm volatile("s_waitcnt lgkmcnt(0)" ::: "memory");
}
__device__ __forceinline__ void rms_row_to_bf16(const float* xrow, const float* gain, bf16* orow, int lane) {
    const f32x4* xr = (const f32x4*)xrow + lane; const f32x4* gr = (const f32x4*)gain + lane;
    f32x4 v[4]; float s = 0.f;
#pragma unroll
    for (int j = 0; j < 4; ++j) { v[j] = xr[64 * j]; s += (v[j][0] * v[j][0] + v[j][1] * v[j][1]) + (v[j][2] * v[j][2] + v[j][3] * v[j][3]); }
    const float rstd = 1.f / sqrtf(wave_sum(s) * (1.f / 1024.f) + EPS);
    u32x2* o8 = (u32x2*)orow + lane;
#pragma unroll
    for (int j = 0; j < 4; ++j) { const f32x4 g = gr[64 * j]; u32x2 w; w.x = cvtpk(v[j][0] * rstd * g[0], v[j][1] * rstd * g[1]); w.y = cvtpk(v[j][2] * rstd * g[2], v[j][3] * rstd * g[3]); o8[64 * j] = w; }
}

__device__ __forceinline__ s16x4 vtr(const LAS char* p) { return __builtin_bit_cast(s16x4, __builtin_amdgcn_ds_read_tr16_b64_v4i16((LAS v4i16_t*)p)); }

template <int NK>
__device__ __forceinline__ void qk32(f32x16& S, const LAS char* Kp, const bf16x8* Q, int ks0, int r32, int hi) {
    const LAS char* kb = Kp + r32 * KP + hi * 16 + ks0 * 32;
#pragma unroll
    for (int ks = 0; ks < NK; ++ks) { const bf16x8 kf = *(const LAS bf16x8*)(kb + ks * 32); S = __builtin_amdgcn_mfma_f32_32x32x16_bf16(kf, Q[ks0 + ks], S, 0, 0, 0); }
}
__device__ __forceinline__ void pv32(f32x16 (&O)[4], const bf16x8 (&P)[2], const LAS char* Vp, int lane) {
    const int i = lane & 15, q = i >> 2, p = i & 3, dsel = (lane >> 4) & 1, h = lane >> 5;
    const LAS char* vb = Vp + (4 * h + q) * VP + (16 * dsel + 4 * p) * 2;
#pragma unroll
    for (int s = 0; s < 2; ++s)
#pragma unroll
        for (int db = 0; db < 4; ++db) {
            const s16x4 lo = vtr(vb + (16 * s) * VP + db * 64), hi4 = vtr(vb + (16 * s + 8) * VP + db * 64);
            const bf16x8 a = (bf16x8){lo[0], lo[1], lo[2], lo[3], hi4[0], hi4[1], hi4[2], hi4[3]};
            O[db] = __builtin_amdgcn_mfma_f32_32x32x16_bf16(a, P[s], O[db], 0, 0, 0);
        }
}
struct VFrag { bf16x8 a[2][4]; };
__device__ __forceinline__ void vload32(VFrag& f, const LAS char* Vp, int lane) {
    const int i = lane & 15, q = i >> 2, p = i & 3, dsel = (lane >> 4) & 1, h = lane >> 5;
    const LAS char* vb = Vp + (4 * h + q) * VP + (16 * dsel + 4 * p) * 2;
#pragma unroll
    for (int s = 0; s < 2; ++s)
#pragma unroll
        for (int db = 0; db < 4; ++db) { const s16x4 lo = vtr(vb + (16 * s) * VP + db * 64), hi4 = vtr(vb + (16 * s + 8) * VP + db * 64);
            f.a[s][db] = (bf16x8){lo[0], lo[1], lo[2], lo[3], hi4[0], hi4[1], hi4[2], hi4[3]}; }
}
template <int SS>
__device__ __forceinline__ void vload16(VFrag& f, const LAS char* Vp, int lane) {
    const int i = lane & 15, q = i >> 2, p = i & 3, dsel = (lane >> 4) & 1, h = lane >> 5;
    const LAS char* vb = Vp + (4 * h + q) * VP + (16 * dsel + 4 * p) * 2;
#pragma unroll
    for (int db = 0; db < 4; ++db) { const s16x4 lo = vtr(vb + (16 * SS) * VP + db * 64), hi4 = vtr(vb + (16 * SS + 8) * VP + db * 64);
        f.a[SS][db] = (bf16x8){lo[0], lo[1], lo[2], lo[3], hi4[0], hi4[1], hi4[2], hi4[3]}; }
}
__device__ __forceinline__ void pvmm32(f32x16 (&O)[4], const bf16x8 (&P)[2], const VFrag& f) {
#pragma unroll
    for (int s = 0; s < 2; ++s)
#pragma unroll
        for (int db = 0; db < 4; ++db) O[db] = __builtin_amdgcn_mfma_f32_32x32x16_bf16(f.a[s][db], P[s], O[db], 0, 0, 0);
}
template <int NK>
__device__ __forceinline__ void kload32(bf16x8 (&kf)[NK], const LAS char* Kp, int r32, int hi) {
    const LAS char* kb = Kp + r32 * KP + hi * 16;
#pragma unroll
    for (int ks = 0; ks < NK; ++ks) kf[ks] = *(const LAS bf16x8*)(kb + ks * 32);
}
template <int NK>
__device__ __forceinline__ void qkmm32(f32x16& S, const bf16x8 (&kf)[NK], const bf16x8* Q) {
#pragma unroll
    for (int ks = 0; ks < NK; ++ks) S = __builtin_amdgcn_mfma_f32_32x32x16_bf16(kf[ks], Q[ks], S, 0, 0, 0);
}
#define SCHED_FENCE() __builtin_amdgcn_sched_barrier(0)
template <int MODE>
__device__ __forceinline__ void soft32(const f32x16& S, bf16x8 (&P)[2], float& l, float dbase, float nslope) {
    float p[16];
#pragma unroll
    for (int r = 0; r < 16; ++r) {
        float s = S[r];
        if (MODE >= 1) { const float a = fabsf(dbase - (float)((r & 3) + 8 * (r >> 2))); s = fmaf(nslope, a, s); float e = __builtin_amdgcn_exp2f(s); if (MODE == 2) e = (a <= 64.f) ? e : 0.f; p[r] = e; }
        else p[r] = __builtin_amdgcn_exp2f(s);
        l += p[r];
    }
#pragma unroll
    for (int s = 0; s < 2; ++s) { u32x4 w; w.x = cvtpk(p[8 * s + 0], p[8 * s + 1]); w.y = cvtpk(p[8 * s + 2], p[8 * s + 3]); w.z = cvtpk(p[8 * s + 4], p[8 * s + 5]); w.w = cvtpk(p[8 * s + 6], p[8 * s + 7]); P[s] = __builtin_bit_cast(bf16x8, w); }
}
__device__ __forceinline__ void zero16(f32x16& v) {
#pragma unroll
    for (int r = 0; r < 16; ++r) v[r] = 0.f;
}

__device__ __forceinline__ void stage_put(LAS char* wl, int r32, int hi2, int db, int g4, u32x2 w) { *(LAS u32x2*)(wl + r32 * 272 + (32 * db + 8 * g4 + 4 * hi2) * 2) = w; }
__device__ __forceinline__ void stage_flush(const LAS char* wl, bf16* qbase, size_t row_stride, int lane) {
    asm volatile("s_waitcnt lgkmcnt(0)" ::: "memory");
#pragma unroll
    for (int i = 0; i < 8; ++i) { const int row = 4 * i + (lane >> 4); const u32x4 v = *(const LAS u32x4*)(wl + row * 272 + (lane & 15) * 16);
        *(u32x4*)(qbase + (size_t)row * row_stride + (lane & 15) * 8) = v; }
}
template <int NC, bool DIAG>
__device__ __forceinline__ void attn_tile(f32x16 (&O)[4], float& l, const bf16x8* Q, const LAS char* Kb, const LAS char* Vb, int r32, int hi, int lane, float qd, int k0, int qw, float nslope, float negM0) {
    constexpr int NQ = (NC == 2) ? 4 : 8;
    f32x16 S0, S1; bf16x8 P0[2], P1[2];
    const int k1 = k0 + 32;
    if (NC == 2) {
        const float ns0 = (k0 < qw) ? nslope : ((k0 > qw) ? -nslope : 0.f), ns1 = (k1 < qw) ? nslope : ((k1 > qw) ? -nslope : 0.f);
        const float b0 = fmaf(ns0, qd - (float)k0, negM0), b1 = fmaf(ns1, qd - (float)k1, negM0);
#pragma unroll
        for (int r = 0; r < 16; ++r) { S0[r] = fmaf(-ns0, (float)((r & 3) + 8 * (r >> 2)), b0); S1[r] = fmaf(-ns1, (float)((r & 3) + 8 * (r >> 2)), b1); }
    } else {
#pragma unroll
        for (int r = 0; r < 16; ++r) { S0[r] = negM0; S1[r] = negM0; }
    }
    VFrag vf0, vf1;
    if (NC == 2) {
        bf16x8 kf0[NQ], kf1[NQ];
        kload32<NQ>(kf0, Kb, r32, hi);
        SCHED_FENCE();
        qkmm32<NQ>(S0, kf0, Q);
        kload32<NQ>(kf1, Kb + 32 * KP, r32, hi);
        vload16<0>(vf0, Vb, lane);
        SCHED_FENCE();
        qkmm32<NQ>(S1, kf1, Q);
        if (DIAG) { const float nd = (k0 == qw) ? nslope : 0.f;
#pragma unroll
            for (int r = 0; r < 16; ++r) S0[r] = fmaf(nd, fabsf(qd - (float)k0 - (float)((r & 3) + 8 * (r >> 2))), S0[r]); }
        soft32<0>(S0, P0, l, 0.f, 0.f);
        vload16<1>(vf0, Vb, lane);
        SCHED_FENCE();
    } else {
        bf16x8 kf[NQ];
        kload32<NQ>(kf, Kb, r32, hi);
        SCHED_FENCE();
        qkmm32<NQ>(S0, kf, Q);
        kload32<NQ>(kf, Kb + 32 * KP, r32, hi);
        vload32(vf0, Vb, lane);
        SCHED_FENCE();
        qkmm32<NQ>(S1, kf, Q);
        soft32<0>(S0, P0, l, 0.f, 0.f);
        SCHED_FENCE();
    }
    pvmm32(O, P0, vf0);
    if (NC == 2 && DIAG) { const float nd = (k1 == qw) ? nslope : 0.f;
#pragma unroll
        for (int r = 0; r < 16; ++r) S1[r] = fmaf(nd, fabsf(qd - (float)k1 - (float)((r & 3) + 8 * (r >> 2))), S1[r]); }
    soft32<0>(S1, P1, l, 0.f, 0.f);
    if (NC == 2) {
    vload16<0>(vf1, Vb + 32 * VP, lane);
    SCHED_FENCE();
    vload16<1>(vf1, Vb + 32 * VP, lane);
    } else {
    vload32(vf1, Vb + 32 * VP, lane);
    SCHED_FENCE();
    }
    pvmm32(O, P1, vf1);
}

template <int NC>
__device__ __forceinline__ void attn_shared_unit(LAS char* lds, bf16* qbase, const bf16* Kg, const bf16* Vg, int kvp, int nt, int qpos, int qw, float nslope, float negM0, float lam, const float* subln, int wave_id) {
    const int wv = wave_id, tid = pg8::tid_fresh(wave_id);
    const int lane = tid & 63, r32 = lane & 31, hi = lane >> 5;
    const int cm = (NC == 2) ? (wv & 1) : 0;
    constexpr int NQ = (NC == 2) ? 4 : 8;
    bf16x8 Q[NQ];
    { const bf16* qrow0 = qbase + (size_t)r32 * LDQ;
#pragma unroll
    for (int ks = 0; ks < NQ; ++ks) Q[ks] = *(const bf16x8*)(qrow0 + cm * 64 + 16 * ks + 8 * hi); }
    f32x16 O[4]; float l = 0.f;
#pragma unroll
    for (int db = 0; db < 4; ++db) zero16(O[db]);
    const int lrow = tid >> 3, lcb = (tid & 7) * 32;
    const char* kgp = (const char*)(Kg + (size_t)lrow * kvp) + lcb; const char* vgp = (const char*)(Vg + (size_t)lrow * kvp) + lcb;
    const size_t tstep = (size_t)64 * kvp * 2;
    u32x4 ka0, ka1, va0, va1, kb0, kb1, vb0, vb1;
#define LOADA(tt) do { const char* kp_ = kgp + (size_t)(tt) * tstep; const char* vp_ = vgp + (size_t)(tt) * tstep; ka0 = *(const u32x4*)kp_; ka1 = *(const u32x4*)(kp_ + 16); va0 = *(const u32x4*)vp_; va1 = *(const u32x4*)(vp_ + 16); } while (0)
#define LOADB(tt) do { const char* kp_ = kgp + (size_t)(tt) * tstep; const char* vp_ = vgp + (size_t)(tt) * tstep; kb0 = *(const u32x4*)kp_; kb1 = *(const u32x4*)(kp_ + 16); vb0 = *(const u32x4*)vp_; vb1 = *(const u32x4*)(vp_ + 16); } while (0)
#define WRITEA(buf) do { LAS char* kw_ = lds + (buf) * BUFB + lrow * KP + lcb; LAS char* vw_ = lds + (buf) * BUFB + 64 * KP + lrow * VP + lcb; *(LAS u32x4*)kw_ = ka0; *(LAS u32x4*)(kw_ + 16) = ka1; *(LAS u32x4*)vw_ = va0; *(LAS u32x4*)(vw_ + 16) = va1; } while (0)
#define WRITEB(buf) do { LAS char* kw_ = lds + (buf) * BUFB + lrow * KP + lcb; LAS char* vw_ = lds + (buf) * BUFB + 64 * KP + lrow * VP + lcb; *(LAS u32x4*)kw_ = kb0; *(LAS u32x4*)(kw_ + 16) = kb1; *(LAS u32x4*)vw_ = vb0; *(LAS u32x4*)(vw_ + 16) = vb1; } while (0)
    constexpr int BUFB = 64 * KP + 64 * VP;
    const float qd = (float)(qpos - 4 * hi);
    const int td = qw >> 6;
    if (NC == 2) {
    LOADA(0); LOADB(1);
    __syncthreads();
    WRITEA(0);
    __syncthreads();
#pragma unroll 1
    for (int t = 0; t < nt; t += 2) {
        {
            if (t + 2 < nt) LOADA(t + 2);
            int k0v = t * 64; asm volatile("" : "+s"(k0v));
            const LAS char* Kb = lds + cm * 128; const LAS char* Vb = lds + 64 * KP;
            if (t == td) attn_tile<NC, true>(O, l, Q, Kb, Vb, r32, hi, lane, qd, k0v, qw, nslope, negM0);
            else attn_tile<NC, false>(O, l, Q, Kb, Vb, r32, hi, lane, qd, k0v, qw, nslope, negM0);
            WRITEB(1);
            __syncthreads();
        }
        {
            if (t + 3 < nt) LOADB(t + 3);
            int k0v = (t + 1) * 64; asm volatile("" : "+s"(k0v));
            const LAS char* Kb = lds + BUFB + cm * 128; const LAS char* Vb = lds + BUFB + 64 * KP;
            if (t + 1 == td) attn_tile<NC, true>(O, l, Q, Kb, Vb, r32, hi, lane, qd, k0v, qw, nslope, negM0);
            else attn_tile<NC, false>(O, l, Q, Kb, Vb, r32, hi, lane, qd, k0v, qw, nslope, negM0);
            if (t + 2 < nt) WRITEA(0);
            __syncthreads();
        }
    }
    } else {
    LOADA(0);
    __syncthreads();
    WRITEA(0);
    __syncthreads();
#pragma unroll 1
    for (int t = 0; t < nt; ++t) {
        const bool more = (t + 1 < nt);
        if (more) LOADA(t + 1);
        int k0v = t * 64; asm volatile("" : "+s"(k0v));
        const LAS char* Kb = lds + (t & 1) * BUFB; const LAS char* Vb = lds + (t & 1) * BUFB + 64 * KP;
        attn_tile<NC, false>(O, l, Q, Kb, Vb, r32, hi, lane, qd, k0v, qw, nslope, negM0);
        if (more) WRITEA((t + 1) & 1);
        __syncthreads();
    }
    }
#undef LOADA
#undef LOADB
#undef WRITEA
#undef WRITEB
    const int lane2 = pg8::lane_id_fresh(), hi2 = lane2 >> 5;
    bf16* qrow = qbase + (size_t)(lane2 & 31) * LDQ;
    l = pg8::sum_halves(l);
    if (NC == 2) {
        LAS float* XO = (LAS float*)lds + (wv >> 1) * 4096 + lane2;
        if (cm == 1) { const float i2 = *(const LAS float*)(lds + (LDS_BYTES - 64 + 32)) * __builtin_amdgcn_rcpf(l);
#pragma unroll
            for (int db = 0; db < 4; ++db)
#pragma unroll
                for (int r = 0; r < 16; ++r) XO[(db * 16 + r) * 64] = O[db][r] * i2; }
        __syncthreads();
        if (cm == 0) {
            const float i1 = 1.f / l; float ss = 0.f;
#pragma unroll
            for (int db = 0; db < 4; ++db)
#pragma unroll
                for (int r = 0; r < 16; ++r) { const float o = O[db][r] * i1 - XO[(db * 16 + r) * 64]; O[db][r] = o; ss += o * o; }
            ss = pg8::sum_halves(ss);
            const float rstd = (1.f / sqrtf(ss * (1.f / 128.f) + EPS)) * 0.8f;
#pragma unroll
            for (int db = 0; db < 4; ++db)
#pragma unroll
                for (int g4 = 0; g4 < 4; ++g4) { const int d = 32 * db + 8 * g4 + 4 * hi2; const f32x4 gn = *(const f32x4*)(subln + d);
                    u32x2 w; w.x = cvtpk(O[db][4 * g4 + 0] * rstd * gn[0], O[db][4 * g4 + 1] * rstd * gn[1]); w.y = cvtpk(O[db][4 * g4 + 2] * rstd * gn[2], O[db][4 * g4 + 3] * rstd * gn[3]);
                    stage_put(lds + (wv >> 1) * 16384, lane2 & 31, hi2, db, g4, w); (void)d; }
            stage_flush(lds + (wv >> 1) * 16384, qbase, LDQ, lane2);
        }
    } else {
        const float i1 = 1.f / l;
#pragma unroll
        for (int db = 0; db < 4; ++db)
#pragma unroll
            for (int g4 = 0; g4 < 4; ++g4) { const int d = 32 * db + 8 * g4 + 4 * hi2;
                u32x2 w; w.x = cvtpk(O[db][4 * g4 + 0] * i1, O[db][4 * g4 + 1] * i1); w.y = cvtpk(O[db][4 * g4 + 2] * i1, O[db][4 * g4 + 3] * i1);
                stage_put(lds + wv * 8704, lane2 & 31, hi2, db, g4, w); (void)d; }
        stage_flush(lds + wv * 8704, qbase, LDQ, lane2);
    }
}

template <bool SEG2>
__device__ __forceinline__ void attn_b_block_unit(LAS char* lds, bf16* R, float* LB, int b, int g, int j, int res0, int q0, int dil, float nslope, float negM0, int wave_id) {
    const int tid = pg8::tid_fresh(wave_id), lane = tid & 63, r32 = lane & 31, hi = lane >> 5;
    const int sub_len = SEQ / dil, hcol = (g * 4 + j) * 128;
    const int wres = SEG2 ? res0 + (wave_id >> 2) : res0;
    const int qs = SEG2 ? 32 * (wave_id & 3) : q0 + 32 * wave_id;
    const size_t rowb = (size_t)b * SEQ;
    bf16x8 Q[8];
    { const bf16* qr = R + (rowb + (size_t)(qs + r32) * dil + wres) * LDQ + C_BQ + hcol;
#pragma unroll
      for (int ks = 0; ks < 8; ++ks) Q[ks] = *(const bf16x8*)(qr + 16 * ks + 8 * hi); }
    f32x16 O[4]; float l = 0.f;
#pragma unroll
    for (int db = 0; db < 4; ++db) zero16(O[db]);
    constexpr int TK = SEG2 ? 32 : 64;
    const int k_lo = SEG2 ? 0 : ((q0 - 64 > 0) ? q0 - 64 : 0), k_hi = SEG2 ? 128 : ((q0 + 320 < sub_len) ? q0 + 320 : sub_len);
    const int nsteps = (k_hi - k_lo) / TK;
    const int lrow = tid >> 3, lcb = (tid & 7) * 32;
    const int lres = SEG2 ? res0 + (lrow >> 5) : res0, lkey = SEG2 ? (lrow & 31) : lrow;
    const char* kg = (const char*)(R + (rowb + (size_t)(k_lo + lkey) * dil + lres) * LDQ + C_BK + hcol) + lcb;
    const size_t sstep = (size_t)TK * dil * LDQ * 2;
    constexpr int VOFF = (C_BV - C_BK) * 2, BUFB = 64 * KP + 64 * VP;
    u32x4 kr0, kr1, vr0, vr1;
    kr0 = *(const u32x4*)kg; kr1 = *(const u32x4*)(kg + 16); vr0 = *(const u32x4*)(kg + VOFF); vr1 = *(const u32x4*)(kg + VOFF + 16);
    __syncthreads();
    { LAS char* kw = lds + lrow * KP + lcb; LAS char* vw = lds + 64 * KP + lrow * VP + lcb;
      *(LAS u32x4*)kw = kr0; *(LAS u32x4*)(kw + 16) = kr1; *(LAS u32x4*)vw = vr0; *(LAS u32x4*)(vw + 16) = vr1; }
    __syncthreads();
    const float qf = (float)(qs + r32 - 4 * hi);
#pragma unroll 1
    for (int s = 0; s < nsteps; ++s) {
        const bool more = (s + 1 < nsteps);
        if (more) { const char* kp = kg + (size_t)(s + 1) * sstep; kr0 = *(const u32x4*)kp; kr1 = *(const u32x4*)(kp + 16); vr0 = *(const u32x4*)(kp + VOFF); vr1 = *(const u32x4*)(kp + VOFF + 16); }
        const int kb = k_lo + s * TK;
        const LAS char* Kb = lds + (s & 1) * BUFB; const LAS char* Vb = Kb + 64 * KP;
#pragma unroll
        for (int hh = 0; hh < (SEG2 ? 1 : 2); ++hh) {
            const int row0 = SEG2 ? 32 * (wave_id >> 2) : 32 * hh, kbase = SEG2 ? kb : kb + 32 * hh;
            if (kbase + 31 >= qs - 64 && kbase <= qs + 95) {
                f32x16 S;
#pragma unroll
                for (int r = 0; r < 16; ++r) S[r] = negM0;
                qk32<8>(S, Kb + row0 * KP, Q, 0, r32, hi);
                bf16x8 P[2];
                soft32<2>(S, P, l, qf - (float)kbase, nslope);
                pv32(O, P, Vb + row0 * VP, lane);
            }
        }
        if (more) { LAS char* kw = lds + ((s + 1) & 1) * BUFB + lrow * KP + lcb; LAS char* vw = lds + ((s + 1) & 1) * BUFB + 64 * KP + lrow * VP + lcb;
            *(LAS u32x4*)kw = kr0; *(LAS u32x4*)(kw + 16) = kr1; *(LAS u32x4*)vw = vr0; *(LAS u32x4*)(vw + 16) = vr1; }
        __syncthreads();
    }
    const int lane2 = pg8::lane_id_fresh(), hi2 = lane2 >> 5;
    const size_t qrow_i = rowb + (size_t)(qs + (lane2 & 31)) * dil + wres;
    bf16* qrow = R + qrow_i * LDQ + C_BQ + hcol;
    l = pg8::sum_halves(l);
    const float i1 = 1.f / l;
#pragma unroll
    for (int db = 0; db < 4; ++db)
#pragma unroll
        for (int g4 = 0; g4 < 4; ++g4) { const int d = 32 * db + 8 * g4 + 4 * hi2;
            u32x2 w; w.x = cvtpk(O[db][4 * g4 + 0] * i1, O[db][4 * g4 + 1] * i1); w.y = cvtpk(O[db][4 * g4 + 2] * i1, O[db][4 * g4 + 3] * i1);
            stage_put(lds + wave_id * 8704, lane2 & 31, hi2, db, g4, w); (void)d; }
    stage_flush(lds + wave_id * 8704, R + (rowb + (size_t)qs * dil + wres) * LDQ + C_BQ + hcol, (size_t)dil * LDQ, lane2);
    if (hi2 == 0) LB[((size_t)g * M + qrow_i) * 4 + j] = l;
}

#define XB_TMO      128
#define XB_XCNT(j)  (256  + 64 * (j))
#define XB_XSUB(j)  (1280 + 64 * (j))
#define XB_XGEN(j)  (2304 + 64 * (j))
#define XB_TOP      3328
#define XB_TOPGEN   3392
#define XCD_BAR_WORDS 3456
#define XB_SPIN_CAP (1u << 18)

__device__ __forceinline__ unsigned xb_ld(unsigned* p)              { return __hip_atomic_load(p, __ATOMIC_RELAXED, __HIP_MEMORY_SCOPE_AGENT); }
__device__ __forceinline__ unsigned xb_add(unsigned* p, unsigned v) { return __hip_atomic_fetch_add(p, v, __ATOMIC_RELAXED, __HIP_MEMORY_SCOPE_AGENT); }
__device__ __forceinline__ unsigned xb_xcc_id() { return (unsigned)__builtin_amdgcn_s_getreg((3 << 11) | 20) & 0xFu; }
#define XB_SPIN(cond, bar) do { unsigned _sp = 0; while (cond) { __builtin_amdgcn_s_sleep(1); \
    if ((++_sp & 255u) == 0u) { if (xb_ld(&(bar)[XB_TMO])) break; if (_sp > XB_SPIN_CAP) { atomicAdd(&(bar)[XB_TMO], 1u); break; } } } } while (0)

struct XcdBarrier {
    unsigned* bar; unsigned x;
    volatile LAS unsigned* st;
};

__device__ __forceinline__ XcdBarrier xcd_barrier_post(unsigned* bar, volatile LAS unsigned* st) {
    XcdBarrier b; b.bar = bar; b.x = xb_xcc_id(); b.st = st;
    if (threadIdx.x == 0) (void)xb_add(&bar[XB_XCNT(b.x)], 1u);
    return b;
}
__device__ __forceinline__ void xcd_barrier_complete(unsigned* bar, unsigned x, unsigned& nloc, unsigned& nx) {
    const unsigned G = gridDim.x * gridDim.y * gridDim.z;
    unsigned sum, cnt, mine, sp = 0u;
    for (;;) {
        sum = 0u; cnt = 0u; mine = 0u;
#pragma unroll
        for (unsigned j = 0; j < 16; ++j) { const unsigned c = xb_ld(&bar[XB_XCNT(j)]); sum += c; cnt += (c > 0u) ? 1u : 0u; mine = (j == x) ? c : mine; }
        if (sum == G) break;
        __builtin_amdgcn_s_sleep(1);
        if ((++sp & 255u) == 0u) { if (xb_ld(&bar[XB_TMO])) break; if (sp > XB_SPIN_CAP) { atomicAdd(&bar[XB_TMO], 1u); break; } }
    }
    nloc = mine > 0u ? mine : 1u; nx = cnt > 0u ? cnt : 1u;
}

__device__ __forceinline__ void xcd_barrier(const XcdBarrier& b, int wave_id) {
    asm volatile("s_waitcnt vmcnt(0)" ::: "memory");
    __syncthreads();
    if (pg8::tid_fresh(wave_id) == 0) {
        unsigned* bar = b.bar;
        __builtin_amdgcn_s_waitcnt(0);
        unsigned nloc = b.st[0], nx = b.st[1];
        if (nloc == 0u) { xcd_barrier_complete(bar, b.x, nloc, nx); b.st[0] = nloc; b.st[1] = nx; }
        const unsigned old = xb_add(&bar[XB_XSUB(b.x)], 1u);
        const unsigned gen = old / nloc;
        if (old + 1u == (gen + 1u) * nloc) {
            __builtin_amdgcn_fence(__ATOMIC_RELEASE, "agent");
            asm volatile("s_waitcnt vmcnt(0)" ::: "memory");
            const unsigned og = xb_add(&bar[XB_TOP], 1u);
            const unsigned tg = og / nx;
            if (og + 1u == (tg + 1u) * nx) xb_add(&bar[XB_TOPGEN], 1u);
            else XB_SPIN(xb_ld(&bar[XB_TOPGEN]) == tg, bar);
            __builtin_amdgcn_fence(__ATOMIC_ACQUIRE, "agent");
            xb_add(&bar[XB_XGEN(b.x)], 1u);
            asm volatile("s_waitcnt vmcnt(0)" ::: "memory");
        } else {
            XB_SPIN(xb_ld(&bar[XB_XGEN(b.x)]) == gen, bar);
            __builtin_amdgcn_fence(__ATOMIC_ACQUIRE, "agent");
            asm volatile("s_waitcnt vmcnt(0)" ::: "memory");
        }
    }
    __syncthreads();
}

struct Args { const float* in[25]; float* out; unsigned char* ws; };

__global__ void __launch_bounds__(512, 2) fwd_megakernel(Args a) {
    extern __shared__ __attribute__((aligned(16))) unsigned char lds_raw[];
    LAS unsigned char* lds = (LAS unsigned char*)lds_raw;
    cg::grid_group grid = cg::this_grid();
    const int wave = __builtin_amdgcn_readfirstlane((int)threadIdx.x >> 6);
#define FRESH_LANE const int lane = pg8::lane_id_fresh();
    const int G = gridDim.x, bid = blockIdx.x;
    const int gw = bid * 8 + wave, NGW = G * 8;
    unsigned char* ws = a.ws;
    const float* x = a.in[0]; const float* mem = a.in[1];
    bf16* W_IN = (bf16*)(ws + WS_WIN); bf16* W_G = (bf16*)(ws + WS_WG); bf16* W_MEM = (bf16*)(ws + WS_WMEM); bf16* W_BR = (bf16*)(ws + WS_WBR);
    bf16* W_OUT = (bf16*)(ws + WS_WOUT3); bf16* W_GU = (bf16*)(ws + WS_WGU); bf16* W_DN = (bf16*)(ws + WS_WDN);
    float* LB = (float*)(ws + WS_LB); bf16* R = (bf16*)(ws + WS_R);
    unsigned char* dob = (unsigned char*)a.out;
    bf16* XN = (bf16*)(dob + DO_XN); bf16* MN = (bf16*)(dob + DO_MN); bf16* CKV = (bf16*)(dob + DO_CKV);

    volatile LAS unsigned* MISC = (volatile LAS unsigned*)(lds + MISC_OFF);
    unsigned* barw = (unsigned*)(ws + WS_BAR);
    if (threadIdx.x < 16) MISC[threadIdx.x] = 0u;
    if (a.ws == nullptr) grid.sync();
    XcdBarrier bar = xcd_barrier_post(barw, MISC);
    __syncthreads();
    {
        FRESH_LANE
        LAS float* scr = (LAS float*)(lds + wave * 8704);
        constexpr int I_IN = 16 * (DIN / 32), I_MEM = 16 * (D / 32);
        for (int it = gw; it < I_IN + I_MEM; it += NGW) {
            int r = it;
            if (r < I_IN) { const int nb = DIN / 32; tr_item(a.in[3], DIN, 64 * (r / nb), 32 * (r % nb), W_IN, D, 0, 0, 1, 0, scr, lane); continue; } r -= I_IN;
            { const int nb = D / 32; tr_item(a.in[16], D, 64 * (r / nb), 32 * (r % nb), W_MEM, D, 0, 0, 1, 0, scr, lane); }
        }
        { float* SSQ0 = (float*)(ws + WS_SSQ); for (int i = gw * 64 + lane; i < M; i += NGW * 64) SSQ0[i] = 0.f; }
        for (int m0 = gw; m0 < M + MMEM; m0 += 3 * NGW) {
            f32x4 v[3][4]; float ssq[3];
#pragma unroll
            for (int q = 0; q < 3; ++q) { const int m = m0 + q * NGW; ssq[q] = 0.f;
                if (m < M + MMEM) { const f32x4* xr = (const f32x4*)((m < M) ? x + (size_t)m * D : mem + (size_t)(m - M) * D) + lane;
#pragma unroll
                    for (int j = 0; j < 4; ++j) v[q][j] = xr[64 * j]; } }
#pragma unroll
            for (int q = 0; q < 3; ++q) { const int m = m0 + q * NGW;
                if (m < M + MMEM) {
                    float s = 0.f;
#pragma unroll
                    for (int j = 0; j < 4; ++j) s += (v[q][j][0] * v[q][j][0] + v[q][j][1] * v[q][j][1]) + (v[q][j][2] * v[q][j][2] + v[q][j][3] * v[q][j][3]);
                    const float rstd = 1.f / sqrtf(wave_sum(s) * (1.f / 1024.f) + EPS);
                    const f32x4* gr = (const f32x4*)((m < M) ? a.in[2] : a.in[15]) + lane;
                    u32x2* o8 = (u32x2*)((m < M) ? XN + (size_t)m * D : MN + (size_t)(m - M) * D) + lane;
#pragma unroll
                    for (int j = 0; j < 4; ++j) { const f32x4 gn = gr[64 * j]; u32x2 w; w.x = cvtpk(v[q][j][0] * rstd * gn[0], v[q][j][1] * rstd * gn[1]); w.y = cvtpk(v[q][j][2] * rstd * gn[2], v[q][j][3] * rstd * gn[3]); o8[64 * j] = w; }
                } }
        }
    }
    xcd_barrier(bar, wave);

    {
        LAS float* GT = (LAS float*)(lds + GT_OFF);
        { const int t2 = pg8::tid_fresh(wave);
          if (t2 < 64) { GT[t2] = a.in[6][t2]; GT[64 + t2] = a.in[7][t2]; }
          if (t2 < 128) { GT[128 + t2] = a.in[13][t2]; GT[256 + t2] = a.in[14][t2]; GT[384 + t2] = a.in[17][t2]; GT[512 + t2] = a.in[18][t2]; } }
        __syncthreads();
        { const pg8::EpiQKV E{R, LDQ, CKV, D, GT, (LAS float*)(lds + XCH_OFF)};
          pg8::Gemm g{XN, W_IN, M, DIN, D, D, MN, W_MEM, nullptr, nullptr}; pg8::DualOrder S; S.init(M, DIN, MMEM, D, G, bid);
          pg8::gemm_phase<pg8::EpiQKV, pg8::DualOrder, true, true>(lds, g, S, E, wave); }
        {
            constexpr int I_G = 16 * (3 * D / 32), I_BR = 8 * (D / 32), I_OUT = 16 * (D / 32), I_FF = 16 * (DFF / 32);
            constexpr int NREST = I_G + 3 * I_BR + I_OUT + 2 * I_FF;
            const int first = (G == 256) ? 160 : 0, nsl = G - first;
            if (bid >= first) {
                const int lane = pg8::lane_id_fresh();
                LAS float* scr = (LAS float*)(lds + wave * 8704);
                for (int it = (bid - first) * 8 + wave; it < NREST; it += nsl * 8) {
                    int r = it;
                    if (r < I_G) { const int nb = 3 * D / 32; tr_item(a.in[4], 3 * D, 64 * (r / nb), 32 * (r % nb), W_G, D, 0, 0, 1, 0, scr, lane); continue; } r -= I_G;
                    if (r < 3 * I_BR) { const int gI = r / I_BR, rr = r % I_BR, nb = D / 32; tr_item(a.in[19] + (size_t)gI * 512 * D, D, 64 * (rr / nb), 32 * (rr % nb), W_BR + (size_t)gI * D * 512, 512, 0, 0, 1, 0, scr, lane); continue; } r -= 3 * I_BR;
                    if (r < I_OUT) { const int nb = D / 32; tr_item(a.in[20], D, 64 * (r / nb), 32 * (r % nb), W_OUT, D, 0, 0, 1, 0, scr, lane); continue; } r -= I_OUT;
                    { const int s = r / I_FF, rr = r % I_FF, nb = DFF / 32; const int n0 = 32 * (rr % nb);
                      tr_item(a.in[22 + s], DFF, 64 * (rr / nb), n0, W_GU, D, 256 * (n0 / 128) + 128 * s + (n0 % 128) - n0, 0, 1, 0, scr, lane); }
                }
            }
        }
    }
    xcd_barrier(bar, wave);

    {
        FRESH_LANE
#define UNIFORM_F(v) __builtin_bit_cast(float, __builtin_amdgcn_readfirstlane(__builtin_bit_cast(int, (float)(v))))
        const float negM_a = UNIFORM_F(-8.f * absmax_vec(a.in[6], 64, lane) * absmax_vec(a.in[7], 64, lane) * L2E);
        const float lam = UNIFORM_F(expf(wave_sum(a.in[8][lane] * a.in[9][lane])) - expf(wave_sum(a.in[10][lane] * a.in[11][lane])) + 0.2f);
        *(LAS float*)(lds + (LDS_BYTES - 64 + 32)) = lam;
        for (int rr = 0; rr < (512 + G - 1) / G; ++rr) {
            int u;
            if (G == 256) { const int k = rr * 32 + (bid >> 3), bh = (bid & 7) + 8 * (k >> 4); u = bh * 16 + (k & 15); }
            else { u = rr * G + bid; if (u >= 512) break; }
            const int b = u >> 6, h = (u >> 4) & 3, qblk = u & 15;
            const int ta_ = pg8::lane_id_fresh();
            const int qpos = qblk * 128 + (wave >> 1) * 32 + (ta_ & 31);
            bf16* qrow = R + ((size_t)b * SEQ + qblk * 128 + (wave >> 1) * 32) * LDQ + C_AQ + h * 128;
            const bf16* Kg = R + (size_t)b * SEQ * LDQ + C_AK + h * 128; const bf16* Vg = R + (size_t)b * SEQ * LDQ + C_AV + h * 128;
            const float nslope = -__builtin_amdgcn_exp2f(-2.f * (float)(h + 1)) * L2E;
            attn_shared_unit<2>((LAS char*)lds, qrow, Kg, Vg, LDQ, SEQ / 64, qpos, qblk * 128 + (wave >> 1) * 32, nslope, negM_a, lam, a.in[12], wave);
        }
        const int lnc_ = pg8::lane_id_fresh();
        const float negM_c = UNIFORM_F(-11.313708499f * absmax_vec(a.in[17], 128, lnc_) * absmax_vec(a.in[18], 128, lnc_) * L2E);
        for (int u = bid; u < 256; u += G) {
            const int b = u >> 5, h = (u >> 3) & 3, qblk = u & 7;
            const int tc_ = pg8::lane_id_fresh();
            const int qpos = qblk * 256 + wave * 32 + (tc_ & 31);
            bf16* qrow = R + ((size_t)b * SEQ + qblk * 256 + wave * 32) * LDQ + C_CQ + h * 128;
            const bf16* Kg = CKV + (size_t)b * NMEM * D + h * 128; const bf16* Vg = Kg + 512;
            attn_shared_unit<1>((LAS char*)lds, qrow, Kg, Vg, D, NMEM / 64, qpos, 0, 0.f, negM_c, 0.f, a.in[12], wave);
        }
        __syncthreads();
        { const int lnb_ = pg8::lane_id_fresh();
          const float negM_b = UNIFORM_F(-11.313708499f * absmax_vec(a.in[13], 128, lnb_) * absmax_vec(a.in[14], 128, lnb_) * L2E);
          for (int rr = 0; rr < (768 + G - 1) / G; ++rr) {
              int u;
              if (G == 256) { const int k = rr * 32 + (bid >> 3); u = ((bid & 7) + 8 * (k >> 3)) * 8 + (k & 7); }
              else { u = rr * G + bid; if (u >= 768) break; }
              const int sid = u >> 3, loc = u & 7, b = sid / 12, g = (sid % 12) >> 2, j = sid & 3;
              const float slope = __builtin_amdgcn_exp2f(-8.f * (float)(g * 4 + j + 1) / 12.f);
              if (g == 0) attn_b_block_unit<false>((LAS char*)lds, R, LB, b, g, j, 0, loc * 256, 1, -slope * L2E, negM_b, wave);
              else if (g == 1) attn_b_block_unit<false>((LAS char*)lds, R, LB, b, g, j, loc >> 1, (loc & 1) * 256, 4, -slope * 4.f * L2E, negM_b, wave);
              else attn_b_block_unit<true>((LAS char*)lds, R, LB, b, g, j, 2 * loc, 0, 16, -slope * 16.f * L2E, negM_b, wave);
          } }
    }
    xcd_barrier(bar, wave);

    { FRESH_LANE
    const int j = lane >> 4, d8 = (lane & 15) * 8;
    for (int m0 = gw; m0 < M; m0 += 4 * NGW) {
        u32x4 o0[4], o1[4], o2[4]; float l0[4], l1[4], l2[4];
#pragma unroll
        for (int q = 0; q < 4; ++q) { const int m = m0 + q * NGW;
            if (m < M) { const bf16* p0 = R + (size_t)m * LDQ + C_BQ + j * 128 + d8;
                o0[q] = *(const u32x4*)p0; o1[q] = *(const u32x4*)(p0 + 512); o2[q] = *(const u32x4*)(p0 + 1024);
                l0[q] = LB[((size_t)0 * M + m) * 4 + j]; l1[q] = LB[((size_t)1 * M + m) * 4 + j]; l2[q] = LB[((size_t)2 * M + m) * 4 + j]; } }
#pragma unroll
        for (int q = 0; q < 4; ++q) { const int m = m0 + q * NGW;
            if (m < M) {
                const float inv = 1.f / (l0[q] + l1[q] + l2[q]); const float w0 = l0[q] * inv, w1 = l1[q] * inv, w2 = l2[q] * inv;
                u32x4 w;
#pragma unroll
                for (int e = 0; e < 4; ++e) {
                    const float lo = w0 * pg8::bf_lo(o0[q][e]) + w1 * pg8::bf_lo(o1[q][e]) + w2 * pg8::bf_lo(o2[q][e]);
                    const float hi = w0 * pg8::bf_hi(o0[q][e]) + w1 * pg8::bf_hi(o1[q][e]) + w2 * pg8::bf_hi(o2[q][e]);
                    w[e] = cvtpk(lo, hi);
                }
                *(u32x4*)(R + (size_t)m * LDQ + C_BQ + j * 128 + d8) = w; } }
    } }
    {
        pg8::Gemm g{XN, W_G, M, 3 * D, D, D, nullptr, nullptr, nullptr, nullptr}; pg8::StaticOrder S; S.init(M, 3 * D, G, bid);
        pg8::EpiGate E{R + C_GATE, LDQ, a.in[5]};
        pg8::gemm_phase<pg8::EpiGate, pg8::StaticOrder, true, true>(lds, g, S, E, wave);
    }
    xcd_barrier(bar, wave);

    {
        pg8::Gemm g{R + C_AQ, W_BR, M, D, 512, LDQ, R + C_BQ, W_BR + (size_t)D * 512, R + C_CQ, W_BR + (size_t)2 * D * 512};
        pg8::RepeatOrder S; S.init(M, D, 3, G, bid);
        pg8::EpiBranch E{R + C_GATE, R + C_GATE, LDQ, D};
        pg8::gemm_phase<pg8::EpiBranch, pg8::RepeatOrder, true, true>(lds, g, S, E, wave);
    }
    xcd_barrier(bar, wave);

    {
        pg8::Gemm g{R + C_GATE, W_OUT, M, D, D, LDQ, nullptr, nullptr, nullptr, nullptr}; pg8::StaticOrder S; S.init(M, D, G, bid);
        pg8::EpiResidNorm E{x, a.out, D, a.in[21], R + C_H2, LDQ, (float*)(ws + WS_SSQ)};
        pg8::gemm_phase<pg8::EpiResidNorm, pg8::StaticOrder, true, true>(lds, g, S, E, wave);
    }
    xcd_barrier(bar, wave);

    {
        pg8::Gemm g{R + C_H2, W_GU, M, 2 * DFF, D, LDQ, nullptr, nullptr, nullptr, nullptr}; pg8::StaticOrder S; S.init(M, 2 * DFF, G, bid);
        pg8::EpiSwiGLU E{R + C_ACT, LDQ, (const float*)(ws + WS_SSQ)};
        pg8::gemm_phase<pg8::EpiSwiGLU, pg8::StaticOrder, true, true>(lds, g, S, E, wave);
        { constexpr int I_DN = (DFF / 64) * (D / 32);
          const int first = (G == 256) ? 128 : 0, nsl = G - first;
          if (bid >= first) { const int lane = pg8::lane_id_fresh(); LAS float* scr = (LAS float*)(lds + wave * 8704);
              for (int r = (bid - first) * 8 + wave; r < I_DN; r += nsl * 8) { const int nb = D / 32; tr_item(a.in[24], D, 64 * (r / nb), 32 * (r % nb), W_DN, DFF, 0, 0, 1, 0, scr, lane); } } }
    }
    xcd_barrier(bar, wave);

    {
        pg8::Gemm g{R + C_ACT, W_DN, M, D, DFF, LDQ, nullptr, nullptr, nullptr, nullptr}; pg8::StaticOrder S; S.init(M, D, G, bid);
        pg8::EpiResid E{a.out, a.out, D};
        pg8::gemm_phase<pg8::EpiResid, pg8::StaticOrder, true, true>(lds, g, S, E, wave);
    }
}

extern "C" void kernel_launch(void* const* d_in, const int* in_sizes, int n_in, void* d_out, int out_size, void* d_ws, size_t ws_size, hipStream_t stream) {
    static int grid = 0;
    if (grid == 0) {
        if (n_in != 25 || out_size != M * D || ws_size < WS_END) { fprintf(stderr, "kernel_launch: unexpected problem shape (n_in %d out %d ws %zu)\n", n_in, out_size, ws_size); grid = -1; return; }
        int dev = 0, cus = 0, per_cu = 0;
        hipGetDevice(&dev);
        hipDeviceGetAttribute(&cus, hipDeviceAttributeMultiprocessorCount, dev);
        if (hipFuncSetAttribute((const void*)fwd_megakernel, hipFuncAttributeMaxDynamicSharedMemorySize, LDS_BYTES) != hipSuccess) { fprintf(stderr, "kernel_launch: hipFuncSetAttribute failed\n"); }
        hipOccupancyMaxActiveBlocksPerMultiprocessor(&per_cu, (const void*)fwd_megakernel, 512, LDS_BYTES);
        (void)hipGetLastError();
        if (per_cu < 1) per_cu = 1;
        grid = cus;
        fprintf(stderr, "kernel_launch: cus %d per_cu %d grid %d\n", cus, per_cu, grid);
    }
    if (grid < 0) return;
    if (hipMemsetAsync((char*)d_ws + WS_BAR, 0, 16384, stream) != hipSuccess) { fprintf(stderr, "kernel_launch: memset of the barrier words failed\n"); return; }
    Args a{};
    for (int i = 0; i < 25; ++i) a.in[i] = (const float*)d_in[i];
    a.out = (float*)d_out; a.ws = (unsigned char*)d_ws;
    void* args[] = {&a};
    hipError_t e = hipLaunchCooperativeKernel((const void*)fwd_megakernel, dim3(grid), dim3(512), args, LDS_BYTES, stream);
    if (e != hipSuccess) fprintf(stderr, "cooperative launch failed: %s (grid %d)\n", hipGetErrorString(e), grid);
}
```

```cpp
#include <hip/hip_runtime.h>
#include <hip/hip_cooperative_groups.h>
#include <cstdio>
#include <cstdint>
namespace cg = cooperative_groups;
namespace pg8 {
#define PG8_LAS __attribute__((address_space(3)))
typedef unsigned short bf16_t;
typedef short bf16x8 __attribute__((ext_vector_type(8)));
typedef float f32x4 __attribute__((ext_vector_type(4)));
typedef unsigned u32x4 __attribute__((ext_vector_type(4)));
constexpr int BM = 256, BK = 64, HALF = 128, HTB = HALF * BK * 2  , STAGE_BYTES = 8 * HTB, NXCD = 8, WGM = 8;

__host__ __device__ __forceinline__ int lds_byte(int r, int c) { const int st = (r >> 4) * 2 + (c >> 5), rr = r & 15, cc = c & 31, ob = rr * 64 + cc * 2; return st * 1024 + (ob ^ (((ob >> 9) & 1) << 5)); }
__host__ __device__ __forceinline__ void stage_rc(int b, int& R, int& C) { const int st = b / 1024, sb = b % 1024, swz = sb ^ (((sb >> 9) & 1) << 5); R = (st >> 1) * 16 + swz / 64; C = (st & 1) * 32 + (swz % 64) / 2; }
__host__ __device__ __forceinline__ int perm32(int rho) { const int n = rho >> 4, i = rho & 15; return 8 * (i >> 2) + 4 * n + (i & 3); }

struct Unit { int pm, pn, src; };
struct Gemm { const bf16_t* A; const bf16_t* Bt; int M, N, K, lda; const bf16_t* A2; const bf16_t* Bt2; const bf16_t* A3; const bf16_t* Bt3; };

struct StaticOrder {
    int nM, nN, nwg, G, c;
    __host__ __device__ void init(int M, int N, int G_, int c_) { nM = M / BM; nN = N / BM; nwg = nM * nN; G = G_; c = c_; }
    __host__ __device__ bool next(int i, Unit& u) const {
        const long L = (long)i * G + c; if (L >= nwg) return false;
        int wgid = (int)L; { const int q = nwg / NXCD, r = nwg % NXCD, xcd = wgid % NXCD, off = wgid / NXCD; wgid = (xcd < r ? xcd * (q + 1) : r * (q + 1) + (xcd - r) * q) + off; }
        const int nig = WGM * nN, gid = wgid / nig, fm = gid * WGM, gsz = (nM - fm) < WGM ? (nM - fm) : WGM;
        u.pm = fm + ((wgid % nig) % gsz); u.pn = (wgid % nig) / gsz; u.src = 0; return true;
    }
    __device__ __forceinline__ void a_ready(const Unit&) const {}
    __device__ __forceinline__ void done(const Unit&) const {}
};

struct DualOrder {
    StaticOrder S1; int nM2, nN2;
    __host__ __device__ void init(int M, int N, int M2, int N2, int G_, int c_) { S1.init(M, N, G_, c_); nM2 = M2 / BM; nN2 = N2 / BM; }
    __host__ __device__ bool next(int i, Unit& u) const {
        if (S1.next(i, u)) return true;
        const long L = (long)i * S1.G + S1.c - S1.nwg; if (L < 0 || L >= (long)nM2 * nN2) return false;
        u.pm = (int)L % nM2; u.pn = (int)L / nM2; u.src = 1; return true;
    }
    __device__ __forceinline__ void a_ready(const Unit&) const {}
    __device__ __forceinline__ void done(const Unit&) const {}
};

struct RepeatOrder {
    StaticOrder S1; int nrep;
    __host__ __device__ void init(int M, int N, int nrep_, int G_, int c_) { S1.init(M, N, G_, c_); nrep = nrep_; }
    __host__ __device__ bool next(int i, Unit& u) const { if (i >= nrep) return false; if (!S1.next(0, u)) return false; u.src = i; return true; }
    __device__ __forceinline__ void a_ready(const Unit&) const {}
    __device__ __forceinline__ void done(const Unit&) const {}
};

template <int K> __device__ __forceinline__ float shx(float v) {
    return __builtin_bit_cast(float, __builtin_amdgcn_ds_swizzle(__builtin_bit_cast(int, v), (K << 10) | 0x1f)); }
__device__ __forceinline__ float sum_halves(float v) {
    auto rr = __builtin_amdgcn_permlane32_swap(__builtin_bit_cast(unsigned, v), __builtin_bit_cast(unsigned, v), false, false);
    return __builtin_bit_cast(float, (unsigned)rr[0]) + __builtin_bit_cast(float, (unsigned)rr[1]); }
__device__ __forceinline__ float max_halves(float v) {
    auto rr = __builtin_amdgcn_permlane32_swap(__builtin_bit_cast(unsigned, v), __builtin_bit_cast(unsigned, v), false, false);
    return fmaxf(__builtin_bit_cast(float, (unsigned)rr[0]), __builtin_bit_cast(float, (unsigned)rr[1])); }
__device__ __forceinline__ int lane_id_fresh() { int z = 0; asm volatile("" : "+s"(z)); return __builtin_amdgcn_mbcnt_hi(~0u, __builtin_amdgcn_mbcnt_lo(~0u, z)); }
__device__ __forceinline__ int tid_fresh(int wave) { return wave * 64 + lane_id_fresh(); }
typedef float f32x2v_t __attribute__((ext_vector_type(2))); typedef __bf16 bf16x2v_t __attribute__((ext_vector_type(2)));
__device__ __forceinline__ unsigned cvt_pk_bf16(float lo, float hi) { f32x2v_t v = {lo, hi}; bf16x2v_t b = __builtin_convertvector(v, bf16x2v_t); return __builtin_bit_cast(unsigned, b); }
__device__ __forceinline__ float bf_lo(unsigned w) { return __builtin_bit_cast(float, w << 16); }
__device__ __forceinline__ float bf_hi(unsigned w) { return __builtin_bit_cast(float, w & 0xffff0000u); }
#define PG8_ACC const f32x4 (&acc)[2][2][4][2]

struct EpiQKV {
    static constexpr bool PERM = true, AFTER_DRAIN = false;
    bf16_t* O; int ldc; bf16_t* O2; int ldc2;
    PG8_LAS const float* GT;
    PG8_LAS float* X;
    __device__ __forceinline__ void operator()(PG8_ACC, const Unit& u, int wr, int wc, int fr, int fq) const {
        const int pn = u.pn;
        int kind, gp; float sc = 1.f;
        constexpr float L2E = 1.4426950408889634f;
        const int mode = u.src;
        if (mode == 0) {
            if (pn < 2) { kind = 1; gp = 0; sc = 0.125f * L2E; }
            else if (pn < 4) { kind = 1; gp = 64; }
            else if (pn < 6) { kind = 0; gp = 64; }
            else if (pn < 12) { kind = 2; gp = 128; sc = 0.08838834764831845f * L2E; }
            else if (pn < 18) { kind = 2; gp = 256; }
            else if (pn < 24) { kind = 0; gp = 256; }
            else { kind = 2; gp = 384; sc = 0.08838834764831845f * L2E; }
        } else {
            if (pn < 2) { kind = 2; gp = 512; } else { kind = 0; gp = 512; }
        }
        const int row0 = u.pm * BM + wr * 64 + fr, col0 = pn * BM + wc * 32 + 8 * fq;
        float rs[2][4][2];
        f32x4 gv[2];
        if (kind != 0) {
#pragma unroll
            for (int ai = 0; ai < 2; ++ai)
#pragma unroll
                for (int m = 0; m < 4; ++m)
#pragma unroll
                    for (int bj = 0; bj < 2; ++bj) {
                        const f32x4 a = acc[ai][bj][m][0], b = acc[ai][bj][m][1];
                        float s = (a[0] * a[0] + a[1] * a[1]) + (a[2] * a[2] + a[3] * a[3]) + (b[0] * b[0] + b[1] * b[1]) + (b[2] * b[2] + b[3] * b[3]);
                        s += shx<16>(s); s = sum_halves(s);
                        if (fq == 0) X[((ai * 128 + wr * 64 + m * 16 + fr) * 2 + bj) * 4 + wc] = s;
                    }
            asm volatile("s_waitcnt lgkmcnt(0)" ::: "memory"); __builtin_amdgcn_s_barrier(); asm volatile("" ::: "memory");
            const int hd = (kind == 1) ? 64 : 128;
            const float inv_hd = (kind == 1) ? (1.f / 64.f) : (1.f / 128.f);
#pragma unroll
            for (int ai = 0; ai < 2; ++ai)
#pragma unroll
                for (int m = 0; m < 4; ++m)
#pragma unroll
                    for (int bj = 0; bj < 2; ++bj) {
                        const f32x4 xs = *(const PG8_LAS f32x4*)(X + ((ai * 128 + wr * 64 + m * 16 + fr) * 2 + bj) * 4);
                        float tot;
                        if (kind == 1) tot = (wc < 2) ? (xs[0] + xs[1]) : (xs[2] + xs[3]);
                        else tot = (xs[0] + xs[1]) + (xs[2] + xs[3]);
                        rs[ai][m][bj] = __builtin_amdgcn_rsqf(tot * inv_hd + 1e-6f) * sc;
                    }
            const int gc = ((wc * 32 + 8 * fq) & (hd - 1));
            gv[0] = *(const PG8_LAS f32x4*)(GT + gp + gc); gv[1] = *(const PG8_LAS f32x4*)(GT + gp + gc + 4);
        } else {
#pragma unroll
            for (int ai = 0; ai < 2; ++ai)
#pragma unroll
                for (int m = 0; m < 4; ++m)
#pragma unroll
                    for (int bj = 0; bj < 2; ++bj) rs[ai][m][bj] = 1.f;
            gv[0] = (f32x4){1.f, 1.f, 1.f, 1.f}; gv[1] = gv[0];
        }
#pragma unroll
        for (int ai = 0; ai < 2; ++ai)
#pragma unroll
            for (int m = 0; m < 4; ++m) { bf16_t* rowp = (mode ? O2 : O) + (size_t)(row0 + ai * HALF + m * 16) * (mode ? ldc2 : ldc) + col0;
#pragma unroll
                for (int bj = 0; bj < 2; ++bj) { const float r = rs[ai][m][bj];
                    const f32x4 v0 = acc[ai][bj][m][0] * gv[0] * r, v1 = acc[ai][bj][m][1] * gv[1] * r;
                    u32x4 w; w.x = cvt_pk_bf16(v0[0], v0[1]); w.y = cvt_pk_bf16(v0[2], v0[3]); w.z = cvt_pk_bf16(v1[0], v1[1]); w.w = cvt_pk_bf16(v1[2], v1[3]);
                    *(u32x4*)(rowp + bj * HALF) = w; } }
    }
};

struct EpiGate {
    static constexpr bool PERM = true, AFTER_DRAIN = false;
    bf16_t* O; int ldc; const float* bias;
    __device__ __forceinline__ void operator()(PG8_ACC, const Unit& u, int wr, int wc, int fr, int fq) const {
        const int row0 = u.pm * BM + wr * 64 + fr, col0 = u.pn * BM + wc * 32 + 8 * fq;
        f32x4 bv[2][2];
#pragma unroll
        for (int bj = 0; bj < 2; ++bj)
#pragma unroll
            for (int n = 0; n < 2; ++n) bv[bj][n] = *(const f32x4*)(bias + col0 + bj * HALF + 4 * n);
#pragma unroll
        for (int ai = 0; ai < 2; ++ai)
#pragma unroll
            for (int m = 0; m < 4; ++m) { bf16_t* rowp = O + (size_t)(row0 + ai * HALF + m * 16) * ldc + col0;
#pragma unroll
                for (int bj = 0; bj < 2; ++bj) { f32x4 v0 = acc[ai][bj][m][0] + bv[bj][0], v1 = acc[ai][bj][m][1] + bv[bj][1];
#pragma unroll
                    for (int e = 0; e < 4; ++e) { v0[e] = __builtin_amdgcn_rcpf(1.f + __builtin_amdgcn_exp2f(-1.4426950408889634f * v0[e])); v1[e] = __builtin_amdgcn_rcpf(1.f + __builtin_amdgcn_exp2f(-1.4426950408889634f * v1[e])); }
                    u32x4 w; w.x = cvt_pk_bf16(v0[0], v0[1]); w.y = cvt_pk_bf16(v0[2], v0[3]); w.z = cvt_pk_bf16(v1[0], v1[1]); w.w = cvt_pk_bf16(v1[2], v1[3]);
                    *(u32x4*)(rowp + bj * HALF) = w; } }
    }
};

struct EpiBranch {
    static constexpr bool PERM = true, AFTER_DRAIN = false;
    bf16_t* MIX; const bf16_t* GATE0; int ldc; int gstride;
    __device__ __forceinline__ void operator()(PG8_ACC, const Unit& u, int wr, int wc, int fr, int fq) const {
        const int row0 = u.pm * BM + wr * 64 + fr, col0 = u.pn * BM + wc * 32 + 8 * fq;
        const bf16_t* GATE = GATE0 + (size_t)u.src * gstride; const int accum = u.src;
#pragma unroll
        for (int ai = 0; ai < 2; ++ai)
#pragma unroll
            for (int m = 0; m < 4; ++m) { const size_t off = (size_t)(row0 + ai * HALF + m * 16) * ldc + col0;
#pragma unroll
                for (int bj = 0; bj < 2; ++bj) { const u32x4 gt = *(const u32x4*)(GATE + off + bj * HALF);
                    f32x4 a = acc[ai][bj][m][0], b = acc[ai][bj][m][1];
                    a[0] *= bf_lo(gt.x); a[1] *= bf_hi(gt.x); a[2] *= bf_lo(gt.y); a[3] *= bf_hi(gt.y); b[0] *= bf_lo(gt.z); b[1] *= bf_hi(gt.z); b[2] *= bf_lo(gt.w); b[3] *= bf_hi(gt.w);
                    if (accum) { const u32x4 mx = *(const u32x4*)(MIX + off + bj * HALF);
                        a[0] += bf_lo(mx.x); a[1] += bf_hi(mx.x); a[2] += bf_lo(mx.y); a[3] += bf_hi(mx.y); b[0] += bf_lo(mx.z); b[1] += bf_hi(mx.z); b[2] += bf_lo(mx.w); b[3] += bf_hi(mx.w); }
                    u32x4 w; w.x = cvt_pk_bf16(a[0], a[1]); w.y = cvt_pk_bf16(a[2], a[3]); w.z = cvt_pk_bf16(b[0], b[1]); w.w = cvt_pk_bf16(b[2], b[3]);
                    *(u32x4*)(MIX + off + bj * HALF) = w; } }
    }
};

struct EpiResid {
    static constexpr bool PERM = true, AFTER_DRAIN = false;
    const float* res; float* out; int ld;
    __device__ __forceinline__ void operator()(PG8_ACC, const Unit& u, int wr, int wc, int fr, int fq) const {
        const int row0 = u.pm * BM + wr * 64 + fr, col0 = u.pn * BM + wc * 32 + 8 * fq;
#pragma unroll
        for (int ai = 0; ai < 2; ++ai)
#pragma unroll
            for (int m = 0; m < 4; ++m) { const size_t off = (size_t)(row0 + ai * HALF + m * 16) * ld + col0;
#pragma unroll
                for (int bj = 0; bj < 2; ++bj) {
                    const f32x4 r0 = *(const f32x4*)(res + off + bj * HALF), r1 = *(const f32x4*)(res + off + bj * HALF + 4);
                    const f32x4 v0 = acc[ai][bj][m][0] + r0, v1 = acc[ai][bj][m][1] + r1;
                    *(f32x4*)(out + off + bj * HALF) = v0; *(f32x4*)(out + off + bj * HALF + 4) = v1; } }
    }
};

struct EpiResidNorm {
    static constexpr bool PERM = true, AFTER_DRAIN = false;
    const float* res; float* out; int ld; const float* gain; bf16_t* H; int ldh; float* SSQ;
    __device__ __forceinline__ void operator()(PG8_ACC, const Unit& u, int wr, int wc, int fr, int fq) const {
        const int row0 = u.pm * BM + wr * 64 + fr, col0 = u.pn * BM + wc * 32 + 8 * fq;
        f32x4 gv[2][2];
#pragma unroll
        for (int bj = 0; bj < 2; ++bj)
#pragma unroll
            for (int n = 0; n < 2; ++n) gv[bj][n] = *(const f32x4*)(gain + col0 + bj * HALF + 4 * n);
#pragma unroll
        for (int ai = 0; ai < 2; ++ai)
#pragma unroll
            for (int m = 0; m < 4; ++m) { const int row = row0 + ai * HALF + m * 16; const size_t off = (size_t)row * ld + col0; float s = 0.f;
#pragma unroll
                for (int bj = 0; bj < 2; ++bj) {
                    const f32x4 r0 = *(const f32x4*)(res + off + bj * HALF), r1 = *(const f32x4*)(res + off + bj * HALF + 4);
                    const f32x4 v0 = acc[ai][bj][m][0] + r0, v1 = acc[ai][bj][m][1] + r1;
                    *(f32x4*)(out + off + bj * HALF) = v0; *(f32x4*)(out + off + bj * HALF + 4) = v1;
                    s += (v0[0] * v0[0] + v0[1] * v0[1]) + (v0[2] * v0[2] + v0[3] * v0[3]) + (v1[0] * v1[0] + v1[1] * v1[1]) + (v1[2] * v1[2] + v1[3] * v1[3]);
                    const f32x4 h0 = v0 * gv[bj][0], h1 = v1 * gv[bj][1];
                    u32x4 w; w.x = cvt_pk_bf16(h0[0], h0[1]); w.y = cvt_pk_bf16(h0[2], h0[3]); w.z = cvt_pk_bf16(h1[0], h1[1]); w.w = cvt_pk_bf16(h1[2], h1[3]);
                    *(u32x4*)(H + (size_t)row * ldh + col0 + bj * HALF) = w; }
                s += shx<16>(s); s = sum_halves(s);
                if (fq == 0) atomicAdd(SSQ + row, s); }
    }
};

struct EpiSwiGLU {
    static constexpr bool PERM = true, AFTER_DRAIN = false;
    bf16_t* O; int ldc; const float* SSQ;
    __device__ __forceinline__ void operator()(PG8_ACC, const Unit& u, int wr, int wc, int fr, int fq) const {
        const int row0 = u.pm * BM + wr * 64 + fr, col0 = u.pn * HALF + wc * 32 + 8 * fq;
#pragma unroll
        for (int ai = 0; ai < 2; ++ai)
#pragma unroll
            for (int m = 0; m < 4; ++m) { bf16_t* rowp = O + (size_t)(row0 + ai * HALF + m * 16) * ldc + col0;
                const float rstd = __builtin_amdgcn_rsqf(SSQ[row0 + ai * HALF + m * 16] * (1.f / 1024.f) + 1e-6f);
                f32x4 v[2];
#pragma unroll
                for (int n = 0; n < 2; ++n) { const f32x4 gt = acc[ai][0][m][n] * rstd, up = acc[ai][1][m][n] * rstd;
#pragma unroll
                    for (int e = 0; e < 4; ++e) v[n][e] = gt[e] * __builtin_amdgcn_rcpf(1.f + __builtin_amdgcn_exp2f(-1.4426950408889634f * gt[e])) * up[e]; }
                u32x4 w; w.x = cvt_pk_bf16(v[0][0], v[0][1]); w.y = cvt_pk_bf16(v[0][2], v[0][3]); w.z = cvt_pk_bf16(v[1][0], v[1][1]); w.w = cvt_pk_bf16(v[1][2], v[1][3]);
                *(u32x4*)rowp = w; }
    }
};

template <class Epi, class Sched, bool ALIGN_EPI = false, bool SP2 = false>
__device__ __forceinline__ void gemm_phase(PG8_LAS unsigned char* lds, const Gemm g, const Sched& S, const Epi& E, int wave_id) {
    const int tid = tid_fresh(wave_id);
    const int wid = __builtin_amdgcn_readfirstlane(tid >> 6), lane = tid & 63, wr = wid >> 2, wc = wid & 3, fr = lane & 15, fq = lane >> 4;
    const int K = g.K, nt = K / BK;
    unsigned voffA[2], voffB[2];
#pragma unroll
    for (int i = 0; i < 2; ++i) { int R, C; stage_rc(tid * 16 + i * 8192, R, C); const int Rb = Epi::PERM ? ((R & ~31) + perm32(R & 31)) : R;
        voffA[i] = (unsigned)(R * g.lda + C) * 2u; voffB[i] = (unsigned)(Rb * K + C) * 2u; }
    const size_t kstep = (size_t)(BK * 2);
    const size_t hstepA = (size_t)HALF * g.lda * 2, hstepB = (size_t)HALF * K * 2;
    const size_t tstepA = 2 * hstepA, tstepB = 2 * hstepB;
    const unsigned ldsw = (unsigned)wid * 1024u;
    const int aoff = lds_byte(wr * 64 + fr, fq * 8), boff = lds_byte(wc * 32 + fr, fq * 8);
#define PG8_SA(b, h) (((b) * 2 + (h)) * HTB)
#define PG8_SB(b, h) ((4 + (b) * 2 + (h)) * HTB)
#define PG8_STAGE(bufoff, gbase, voff) do { _Pragma("unroll") for (int _i = 0; _i < 2; ++_i) \
        __builtin_amdgcn_global_load_lds((const unsigned*)((const char*)(gbase) + (voff)[_i]), (PG8_LAS unsigned*)(lds + (bufoff) + ldsw + _i * 8192), 16, 0, 0); } while (0)
#define PG8_LDA(dst, b, h) do { _Pragma("unroll") for (int m = 0; m < 4; ++m) _Pragma("unroll") for (int k = 0; k < 2; ++k) dst[m][k] = *(const PG8_LAS bf16x8*)(lds + PG8_SA(b, h) + aoff + m * 2048 + k * 1024); } while (0)
#define PG8_LDB(dst, b, h) do { _Pragma("unroll") for (int n = 0; n < 2; ++n) _Pragma("unroll") for (int k = 0; k < 2; ++k) dst[n][k] = *(const PG8_LAS bf16x8*)(lds + PG8_SB(b, h) + boff + n * 2048 + k * 1024); } while (0)
#define PG8_MMA(ai, bj, At, Bt) do { __builtin_amdgcn_s_setprio(1); _Pragma("unroll") for (int m = 0; m < 4; ++m) _Pragma("unroll") for (int n = 0; n < 2; ++n) _Pragma("unroll") for (int k = 0; k < 2; ++k) \
        acc[ai][bj][m][n] = __builtin_amdgcn_mfma_f32_16x16x32_bf16(Bt[n][k], At[m][k], acc[ai][bj][m][n], 0, 0, 0); __builtin_amdgcn_s_setprio(0); } while (0)
#define PG8_WAIT_V(n) asm volatile("s_waitcnt vmcnt(" #n ")" ::: "memory")
#define PG8_WAIT_L(n) asm volatile("s_waitcnt lgkmcnt(" #n ")" ::: "memory")
#define PG8_BAR __builtin_amdgcn_s_barrier()
#define PG8_SCHED __builtin_amdgcn_sched_barrier(0)
    Unit cur, nxt; int ui = 0;
    if (!S.next(0, cur)) return;
    f32x4 acc[2][2][4][2];
#pragma unroll
    for (int a = 0; a < 2; ++a)
#pragma unroll
        for (int b = 0; b < 2; ++b)
#pragma unroll
            for (int m = 0; m < 4; ++m)
#pragma unroll
                for (int n = 0; n < 2; ++n) acc[a][b][m][n] = (f32x4){0.f, 0.f, 0.f, 0.f};
    bf16x8 At[4][2], B0[2][2], B1[2][2];
    const char* cA = (const char*)(cur.src == 0 ? g.A : (cur.src == 1 ? g.A2 : g.A3)) + (size_t)cur.pm * tstepA; const char* cB = (const char*)(cur.src == 0 ? g.Bt : (cur.src == 1 ? g.Bt2 : g.Bt3)) + (size_t)cur.pn * tstepB;
    S.a_ready(cur);
    if constexpr (SP2) {
        PG8_STAGE(PG8_SB(0, 0), cB, voffB); PG8_STAGE(PG8_SB(0, 1), cB + hstepB, voffB); PG8_STAGE(PG8_SA(0, 0), cA, voffA); PG8_STAGE(PG8_SA(0, 1), cA + hstepA, voffA);
        if (wr == 1) PG8_BAR;
        PG8_WAIT_V(2); PG8_BAR;
        PG8_STAGE(PG8_SB(1, 0), cB + kstep, voffB); PG8_STAGE(PG8_SA(1, 0), cA + kstep, voffA); PG8_STAGE(PG8_SB(1, 1), cB + hstepB + kstep, voffB);
        PG8_WAIT_V(6); PG8_BAR;
    } else {
        PG8_STAGE(PG8_SB(0, 0), cB, voffB); PG8_STAGE(PG8_SA(0, 0), cA, voffA); PG8_STAGE(PG8_SB(0, 1), cB + hstepB, voffB); PG8_STAGE(PG8_SA(0, 1), cA + hstepA, voffA);
        if (wr == 1) PG8_BAR;
        PG8_WAIT_V(4); PG8_BAR;
        PG8_STAGE(PG8_SB(1, 0), cB + kstep, voffB); PG8_STAGE(PG8_SA(1, 0), cA + kstep, voffA); PG8_STAGE(PG8_SB(1, 1), cB + hstepB + kstep, voffB);
        PG8_WAIT_V(6); PG8_BAR;
    }
    for (;;) {
        const bool has_next = S.next(ui + 1, nxt);
        const char* nA = has_next ? (const char*)(nxt.src == 0 ? g.A : (nxt.src == 1 ? g.A2 : g.A3)) + (size_t)nxt.pm * tstepA : cA; const char* nB = has_next ? (const char*)(nxt.src == 0 ? g.Bt : (nxt.src == 1 ? g.Bt2 : g.Bt3)) + (size_t)nxt.pn * tstepB : cB;
        for (int t = 0; t < nt; t += 2) {
            const bool last = (t == nt - 2);
            const char* a1 = cA + (size_t)(t + 1) * kstep;
            const char* a2 = last ? nA : cA + (size_t)(t + 2) * kstep; const char* b2 = last ? nB : cB + (size_t)(t + 2) * kstep;
            const char* a3 = a2 + kstep; const char* b3 = b2 + kstep;
            if (last && has_next) S.a_ready(nxt);
            if constexpr (SP2) {
            PG8_LDB(B0, 0, 0); PG8_LDB(B1, 0, 1); PG8_SCHED; PG8_LDA(At, 0, 0); PG8_STAGE(PG8_SA(1, 1), a1 + hstepA, voffA);
            PG8_WAIT_V(8); PG8_WAIT_L(0); PG8_BAR; PG8_MMA(0, 0, At, B0); PG8_MMA(0, 1, At, B1); PG8_BAR; PG8_SCHED;
            PG8_LDA(At, 0, 1); PG8_STAGE(PG8_SB(0, 0), b2, voffB); PG8_STAGE(PG8_SB(0, 1), b2 + hstepB, voffB); PG8_STAGE(PG8_SA(0, 0), a2, voffA);
            PG8_WAIT_V(8); PG8_WAIT_L(0); PG8_BAR; PG8_MMA(1, 0, At, B0); PG8_MMA(1, 1, At, B1); PG8_BAR; PG8_SCHED;
            PG8_LDB(B0, 1, 0); PG8_LDB(B1, 1, 1); PG8_SCHED; PG8_LDA(At, 1, 0); PG8_STAGE(PG8_SA(0, 1), a2 + hstepA, voffA);
            PG8_WAIT_V(8); PG8_WAIT_L(0); PG8_BAR; PG8_MMA(0, 0, At, B0); PG8_MMA(0, 1, At, B1); PG8_BAR; PG8_SCHED;
            PG8_LDA(At, 1, 1); PG8_STAGE(PG8_SB(1, 0), b3, voffB); PG8_STAGE(PG8_SB(1, 1), b3 + hstepB, voffB); PG8_STAGE(PG8_SA(1, 0), a3, voffA);
            PG8_WAIT_V(8); PG8_WAIT_L(0); PG8_BAR; PG8_MMA(1, 0, At, B0); PG8_MMA(1, 1, At, B1); PG8_BAR; PG8_SCHED;
            } else {
            PG8_LDB(B0, 0, 0); PG8_SCHED; PG8_LDA(At, 0, 0); PG8_STAGE(PG8_SA(1, 1), a1 + hstepA, voffA);
            PG8_WAIT_L(8); PG8_BAR; PG8_WAIT_L(0); PG8_MMA(0, 0, At, B0); PG8_BAR; PG8_SCHED;
            PG8_LDB(B1, 0, 1); PG8_STAGE(PG8_SB(0, 0), b2, voffB);
            PG8_BAR; PG8_WAIT_L(0); PG8_MMA(0, 1, At, B1); PG8_BAR;
            PG8_LDA(At, 0, 1); PG8_STAGE(PG8_SA(0, 0), a2, voffA);
            PG8_BAR; PG8_WAIT_L(0); PG8_MMA(1, 0, At, B0); PG8_BAR; PG8_SCHED;
            PG8_STAGE(PG8_SB(0, 1), b2 + hstepB, voffB);
            PG8_WAIT_V(6); PG8_BAR; PG8_MMA(1, 1, At, B1); PG8_BAR;
            PG8_LDB(B0, 1, 0); PG8_SCHED; PG8_LDA(At, 1, 0); PG8_STAGE(PG8_SA(0, 1), a2 + hstepA, voffA);
            PG8_WAIT_L(8); PG8_BAR; PG8_WAIT_L(0); PG8_MMA(0, 0, At, B0); PG8_BAR; PG8_SCHED;
            PG8_LDB(B1, 1, 1); PG8_STAGE(PG8_SB(1, 0), b3, voffB);
            PG8_BAR; PG8_WAIT_L(0); PG8_MMA(0, 1, At, B1); PG8_BAR;
            PG8_LDA(At, 1, 1); PG8_STAGE(PG8_SA(1, 0), a3, voffA);
            PG8_BAR; PG8_WAIT_L(0); PG8_MMA(1, 0, At, B0); PG8_BAR; PG8_SCHED;
            PG8_STAGE(PG8_SB(1, 1), b3 + hstepB, voffB);
            PG8_WAIT_V(6); PG8_BAR; PG8_MMA(1, 1, At, B1); PG8_BAR;
            }
        }
        if constexpr (ALIGN_EPI) { if (wr == 0) PG8_BAR; }
        if constexpr (!Epi::AFTER_DRAIN) { E(acc, cur, wr, wc, fr, fq); S.done(cur); }
        if (!has_next) break;
#pragma unroll
        for (int a = 0; a < 2; ++a)
#pragma unroll
            for (int b = 0; b < 2; ++b)
#pragma unroll
                for (int m = 0; m < 4; ++m)
#pragma unroll
                    for (int n = 0; n < 2; ++n) acc[a][b][m][n] = (f32x4){0.f, 0.f, 0.f, 0.f};
        cur = nxt; cA = nA; cB = nB; ++ui;
        if constexpr (ALIGN_EPI) { if (wr == 1) PG8_BAR; }
    }
    PG8_WAIT_V(0);
    if constexpr (!ALIGN_EPI) { if (wr == 0) PG8_BAR; }
    PG8_BAR;
    if constexpr (Epi::AFTER_DRAIN) { E.fused(acc, cur, wr, wc, fr, fq, lds, wid, lane); S.done(cur); }
#undef PG8_SA
#undef PG8_SB
#undef PG8_STAGE
#undef PG8_LDA
#undef PG8_LDB
#undef PG8_MMA
#undef PG8_WAIT_V
#undef PG8_WAIT_L
#undef PG8_BAR
#undef PG8_SCHED
}
}

#define LAS __attribute__((address_space(3)))
typedef unsigned short bf16;
typedef short bf16x8 __attribute__((ext_vector_type(8)));
typedef short s16x4 __attribute__((ext_vector_type(4)));
typedef short v4i16_t __attribute__((ext_vector_type(4)));
typedef float f32x16 __attribute__((ext_vector_type(16)));
typedef float f32x4 __attribute__((ext_vector_type(4)));
typedef float f32x2_t __attribute__((ext_vector_type(2)));
typedef __bf16 bf16x2_t __attribute__((ext_vector_type(2)));
typedef unsigned u32x4 __attribute__((ext_vector_type(4)));
typedef unsigned u32x2 __attribute__((ext_vector_type(2)));

constexpr int D = 1024, SEQ = 2048, NB = 8, M = NB * SEQ, NMEM = 256, MMEM = NB * NMEM, DIN = 6656, DFF = 2816;
constexpr int LDQ = 6656;
constexpr int C_AQ = 0, C_AK = 512, C_AV = 1024, C_BQ = 1536, C_BK = 3072, C_BV = 4608, C_CQ = 6144;
constexpr int C_GATE = 3072;
constexpr int C_H2 = 0, C_ACT = 1024;
constexpr float L2E = 1.4426950408889634f;
constexpr float EPS = 1e-6f;

constexpr size_t WS_WIN = 0;
constexpr size_t WS_WG = WS_WIN + (size_t)DIN * D * 2;
constexpr size_t WS_WMEM = WS_WG + (size_t)3 * D * D * 2;
constexpr size_t WS_WBR = WS_WMEM + (size_t)D * D * 2;
constexpr size_t WS_WOUT3 = WS_WBR + (size_t)3 * D * 512 * 2;
constexpr size_t WS_WGU = WS_WOUT3 + (size_t)D * 3 * D * 2;
constexpr size_t WS_WDN = WS_WGU + (size_t)2 * DFF * D * 2;
constexpr size_t WS_LB = WS_WDN + (size_t)D * DFF * 2;
constexpr size_t WS_R = WS_LB + (size_t)3 * M * 4 * 4;
constexpr size_t WS_BAR = WS_R + (size_t)M * LDQ * 2;
constexpr size_t WS_SSQ = WS_BAR + 16384;
constexpr size_t WS_END = WS_SSQ + (size_t)M * 4;
static_assert(WS_END <= (size_t)256 * 1024 * 1024, "d_ws map");
constexpr size_t DO_XN = 0;
constexpr size_t DO_MN = DO_XN + (size_t)M * D * 2;
constexpr size_t DO_CKV = DO_MN + (size_t)MMEM * D * 2;
static_assert(DO_CKV + (size_t)MMEM * D * 2 <= (size_t)M * D * 4, "d_out scratch map");

constexpr int LDS_BYTES = 155648;
constexpr int XCH_OFF = 131072, GT_OFF = 131072 + 8192;
constexpr int MISC_OFF = LDS_BYTES - 64;
constexpr int KP = 272, VP = 320;

__device__ __forceinline__ unsigned cvtpk(float lo, float hi) { f32x2_t v = {lo, hi}; bf16x2_t b = __builtin_convertvector(v, bf16x2_t); return __builtin_bit_cast(unsigned, b); }
__device__ __forceinline__ float wave_sum(float v) {
    v += pg8::shx<1>(v); v += pg8::shx<2>(v); v += pg8::shx<4>(v); v += pg8::shx<8>(v); v += pg8::shx<16>(v); v = pg8::sum_halves(v);
    return v;
}
__device__ __forceinline__ float wave_max(float v) {
    v = fmaxf(v, pg8::shx<1>(v)); v = fmaxf(v, pg8::shx<2>(v)); v = fmaxf(v, pg8::shx<4>(v)); v = fmaxf(v, pg8::shx<8>(v)); v = fmaxf(v, pg8::shx<16>(v)); v = pg8::max_halves(v);
    return v;
}
__device__ __forceinline__ float absmax_vec(const float* g, int n, int lane) {
    float v = fabsf(g[lane]); if (n > 64) v = fmaxf(v, fabsf(g[lane + 64]));
    return wave_max(v);
}

__device__ __forceinline__ void tr_item(const float* W, int N, int k0, int n0, bf16* WT, int dst_pitch, int dst_row0, int dst_k0, int ncopies, int copy_stride, LAS float* scr, int lane) {
#pragma unroll 8
    for (int i = 0; i < 32; ++i) { const int kk = 2 * i + (lane >> 5); scr[kk * 33 + (lane & 31)] = W[(size_t)(k0 + kk) * N + n0 + (lane & 31)]; }
    asm volatile("s_waitcnt lgkmcnt(0)" ::: "memory");
    const int c = lane & 7;
#pragma unroll
    for (int j = 0; j < 4; ++j) { const int n = (lane >> 3) + 8 * j; const LAS float* s = scr + (8 * c) * 33 + n;
        u32x4 o; o.x = cvtpk(s[0 * 33], s[1 * 33]); o.y = cvtpk(s[2 * 33], s[3 * 33]); o.z = cvtpk(s[4 * 33], s[5 * 33]); o.w = cvtpk(s[6 * 33], s[7 * 33]);
        bf16* dst = WT + (size_t)(dst_row0 + n0 + n) * dst_pitch + dst_k0 + k0 + 8 * c;
        for (int cp = 0; cp < ncopies; ++cp) *(u32x4*)(dst + (size_t)cp * copy_stride) = o; }
    asm volatile("s_waitcnt lgkmcnt(0)" ::: "memory");
}
__device__ __forceinline__ void rms_row_to_bf16(const float* xrow, const float* gain, bf16* orow, int lane) {
    const f32x4* xr = (const f32x4*)xrow + lane; const f32x4* gr = (const f32x4*)gain + lane;
    f32x4 v[4]; float s = 0.f;
#pragma unroll
    for (int j = 0; j < 4; ++j) { v[j] = xr[64 * j]; s += (v[j][0] * v[j][0] + v[j][1] * v[j][1]) + (v[j][2] * v[j][2] + v[j][3] * v[j][3]); }
    const float rstd = 1.f / sqrtf(wave_sum(s) * (1.f / 1024.f) + EPS);
    u32x2* o8 = (u32x2*)orow + lane;
#pragma unroll
    for (int j = 0; j < 4; ++j) { const f32x4 g = gr[64 * j]; u32x2 w; w.x = cvtpk(v[j][0] * rstd * g[0], v[j][1] * rstd * g[1]); w.y = cvtpk(v[j][2] * rstd * g[2], v[j][3] * rstd * g[3]); o8[64 * j] = w; }
}

__device__ __forceinline__ s16x4 vtr(const LAS char* p) { return __builtin_bit_cast(s16x4, __builtin_amdgcn_ds_read_tr16_b64_v4i16((LAS v4i16_t*)p)); }

template <int NK>
__device__ __forceinline__ void qk32(f32x16& S, const LAS char* Kp, const bf16x8* Q, int ks0, int r32, int hi) {
    const LAS char* kb = Kp + r32 * KP + hi * 16 + ks0 * 32;
#pragma unroll
    for (int ks = 0; ks < NK; ++ks) { const bf16x8 kf = *(const LAS bf16x8*)(kb + ks * 32); S = __builtin_amdgcn_mfma_f32_32x32x16_bf16(kf, Q[ks0 + ks], S, 0, 0, 0); }
}
__device__ __forceinline__ void pv32(f32x16 (&O)[4], const bf16x8 (&P)[2], const LAS char* Vp, int lane) {
    const int i = lane & 15, q = i >> 2, p = i & 3, dsel = (lane >> 4) & 1, h = lane >> 5;
    const LAS char* vb = Vp + (4 * h + q) * VP + (16 * dsel + 4 * p) * 2;
#pragma unroll
    for (int s = 0; s < 2; ++s)
#pragma unroll
        for (int db = 0; db < 4; ++db) {
            const s16x4 lo = vtr(vb + (16 * s) * VP + db * 64), hi4 = vtr(vb + (16 * s + 8) * VP + db * 64);
            const bf16x8 a = (bf16x8){lo[0], lo[1], lo[2], lo[3], hi4[0], hi4[1], hi4[2], hi4[3]};
            O[db] = __builtin_amdgcn_mfma_f32_32x32x16_bf16(a, P[s], O[db], 0, 0, 0);
        }
}
struct VFrag { bf16x8 a[2][4]; };
__device__ __forceinline__ void vload32(VFrag& f, const LAS char* Vp, int lane) {
    const int i = lane & 15, q = i >> 2, p = i & 3, dsel = (lane >> 4) & 1, h = lane >> 5;
    const LAS char* vb = Vp + (4 * h + q) * VP + (16 * dsel + 4 * p) * 2;
#pragma unroll
    for (int s = 0; s < 2; ++s)
#pragma unroll
        for (int db = 0; db < 4; ++db) { const s16x4 lo = vtr(vb + (16 * s) * VP + db * 64), hi4 = vtr(vb + (16 * s + 8) * VP + db * 64);
            f.a[s][db] = (bf16x8){lo[0], lo[1], lo[2], lo[3], hi4[0], hi4[1], hi4[2], hi4[3]}; }
}
template <int SS>
__device__ __forceinline__ void vload16(VFrag& f, const LAS char* Vp, int lane) {
    const int i = lane & 15, q = i >> 2, p = i & 3, dsel = (lane >> 4) & 1, h = lane >> 5;
    const LAS char* vb = Vp + (4 * h + q) * VP + (16 * dsel + 4 * p) * 2;
#pragma unroll
    for (int db = 0; db < 4; ++db) { const s16x4 lo = vtr(vb + (16 * SS) * VP + db * 64), hi4 = vtr(vb + (16 * SS + 8) * VP + db * 64);
        f.a[SS][db] = (bf16x8){lo[0], lo[1], lo[2], lo[3], hi4[0], hi4[1], hi4[2], hi4[3]}; }
}
__device__ __forceinline__ void pvmm32(f32x16 (&O)[4], const bf16x8 (&P)[2], const VFrag& f) {
#pragma unroll
    for (int s = 0; s < 2; ++s)
#pragma unroll
        for (int db = 0; db < 4; ++db) O[db] = __builtin_amdgcn_mfma_f32_32x32x16_bf16(f.a[s][db], P[s], O[db], 0, 0, 0);
}
template <int NK>
__device__ __forceinline__ void kload32(bf16x8 (&kf)[NK], const LAS char* Kp, int r32, int hi) {
    const LAS char* kb = Kp + r32 * KP + hi * 16;
#pragma unroll
    for (int ks = 0; ks < NK; ++ks) kf[ks] = *(const LAS bf16x8*)(kb + ks * 32);
}
template <int NK>
__device__ __forceinline__ void qkmm32(f32x16& S, const bf16x8 (&kf)[NK], const bf16x8* Q) {
#pragma unroll
    for (int ks = 0; ks < NK; ++ks) S = __builtin_amdgcn_mfma_f32_32x32x16_bf16(kf[ks], Q[ks], S, 0, 0, 0);
}
#define SCHED_FENCE() __builtin_amdgcn_sched_barrier(0)
template <int MODE>
__device__ __forceinline__ void soft32(const f32x16& S, bf16x8 (&P)[2], float& l, float dbase, float nslope) {
    float p[16];
#pragma unroll
    for (int r = 0; r < 16; ++r) {
        float s = S[r];
        if (MODE >= 1) { const float a = fabsf(dbase - (float)((r & 3) + 8 * (r >> 2))); s = fmaf(nslope, a, s); float e = __builtin_amdgcn_exp2f(s); if (MODE == 2) e = (a <= 64.f) ? e : 0.f; p[r] = e; }
        else p[r] = __builtin_amdgcn_exp2f(s);
        l += p[r];
    }
#pragma unroll
    for (int s = 0; s < 2; ++s) { u32x4 w; w.x = cvtpk(p[8 * s + 0], p[8 * s + 1]); w.y = cvtpk(p[8 * s + 2], p[8 * s + 3]); w.z = cvtpk(p[8 * s + 4], p[8 * s + 5]); w.w = cvtpk(p[8 * s + 6], p[8 * s + 7]); P[s] = __builtin_bit_cast(bf16x8, w); }
}
__device__ __forceinline__ void zero16(f32x16& v) {
#pragma unroll
    for (int r = 0; r < 16; ++r) v[r] = 0.f;
}

__device__ __forceinline__ void stage_put(LAS char* wl, int r32, int hi2, int db, int g4, u32x2 w) { *(LAS u32x2*)(wl + r32 * 272 + (32 * db + 8 * g4 + 4 * hi2) * 2) = w; }
__device__ __forceinline__ void stage_flush(const LAS char* wl, bf16* qbase, size_t row_stride, int lane) {
    asm volatile("s_waitcnt lgkmcnt(0)" ::: "memory");
#pragma unroll
    for (int i = 0; i < 8; ++i) { const int row = 4 * i + (lane >> 4); const u32x4 v = *(const LAS u32x4*)(wl + row * 272 + (lane & 15) * 16);
        *(u32x4*)(qbase + (size_t)row * row_stride + (lane & 15) * 8) = v; }
}
template <int NC, bool DIAG>
__device__ __forceinline__ void attn_tile(f32x16 (&O)[4], float& l, const bf16x8* Q, const LAS char* Kb, const LAS char* Vb, int r32, int hi, int lane, float qd, int k0, int qw, float nslope, float negM0) {
    constexpr int NQ = (NC == 2) ? 4 : 8;
    f32x16 S0, S1; bf16x8 P0[2], P1[2];
    const int k1 = k0 + 32;
    if (NC == 2) {
        const float ns0 = (k0 < qw) ? nslope : ((k0 > qw) ? -nslope : 0.f), ns1 = (k1 < qw) ? nslope : ((k1 > qw) ? -nslope : 0.f);
        const float b0 = fmaf(ns0, qd - (float)k0, negM0), b1 = fmaf(ns1, qd - (float)k1, negM0);
#pragma unroll
        for (int r = 0; r < 16; ++r) { S0[r] = fmaf(-ns0, (float)((r & 3) + 8 * (r >> 2)), b0); S1[r] = fmaf(-ns1, (float)((r & 3) + 8 * (r >> 2)), b1); }
    } else {
#pragma unroll
        for (int r = 0; r < 16; ++r) { S0[r] = negM0; S1[r] = negM0; }
    }
    VFrag vf0, vf1;
    if (NC == 2) {
        bf16x8 kf0[NQ], kf1[NQ];
        kload32<NQ>(kf0, Kb, r32, hi);
        SCHED_FENCE();
        qkmm32<NQ>(S0, kf0, Q);
        kload32<NQ>(kf1, Kb + 32 * KP, r32, hi);
        vload16<0>(vf0, Vb, lane);
        SCHED_FENCE();
        qkmm32<NQ>(S1, kf1, Q);
        if (DIAG) { const float nd = (k0 == qw) ? nslope : 0.f;
#pragma unroll
            for (int r = 0; r < 16; ++r) S0[r] = fmaf(nd, fabsf(qd - (float)k0 - (float)((r & 3) + 8 * (r >> 2))), S0[r]); }
        soft32<0>(S0, P0, l, 0.f, 0.f);
        vload16<1>(vf0, Vb, lane);
        SCHED_FENCE();
    } else {
        bf16x8 kf[NQ];
        kload32<NQ>(kf, Kb, r32, hi);
        SCHED_FENCE();
        qkmm32<NQ>(S0, kf, Q);
        kload32<NQ>(kf, Kb + 32 * KP, r32, hi);
        vload32(vf0, Vb, lane);
        SCHED_FENCE();
        qkmm32<NQ>(S1, kf, Q);
        soft32<0>(S0, P0, l, 0.f, 0.f);
        SCHED_FENCE();
    }
    pvmm32(O, P0, vf0);
    if (NC == 2 && DIAG) { const float nd = (k1 == qw) ? nslope : 0.f;
#pragma unroll
        for (int r = 0; r < 16; ++r) S1[r] = fmaf(nd, fabsf(qd - (float)k1 - (float)((r & 3) + 8 * (r >> 2))), S1[r]); }
    soft32<0>(S1, P1, l, 0.f, 0.f);
    if (NC == 2) {
    vload16<0>(vf1, Vb + 32 * VP, lane);
    SCHED_FENCE();
    vload16<1>(vf1, Vb + 32 * VP, lane);
    } else {
    vload32(vf1, Vb + 32 * VP, lane);
    SCHED_FENCE();
    }
    pvmm32(O, P1, vf1);
}

template <int NC>
__device__ __forceinline__ void attn_shared_unit(LAS char* lds, bf16* qbase, const bf16* Kg, const bf16* Vg, int kvp, int nt, int qpos, int qw, float nslope, float negM0, float lam, const float* subln, int wave_id) {
    const int wv = wave_id, tid = pg8::tid_fresh(wave_id);
    const int lane = tid & 63, r32 = lane & 31, hi = lane >> 5;
    const int cm = (NC == 2) ? (wv & 1) : 0;
    constexpr int NQ = (NC == 2) ? 4 : 8;
    bf16x8 Q[NQ];
    { const bf16* qrow0 = qbase + (size_t)r32 * LDQ;
#pragma unroll
    for (int ks = 0; ks < NQ; ++ks) Q[ks] = *(const bf16x8*)(qrow0 + cm * 64 + 16 * ks + 8 * hi); }
    f32x16 O[4]; float l = 0.f;
#pragma unroll
    for (int db = 0; db < 4; ++db) zero16(O[db]);
    const int lrow = tid >> 3, lcb = (tid & 7) * 32;
    const char* kgp = (const char*)(Kg + (size_t)lrow * kvp) + lcb; const char* vgp = (const char*)(Vg + (size_t)lrow * kvp) + lcb;
    const size_t tstep = (size_t)64 * kvp * 2;
    u32x4 ka0, ka1, va0, va1, kb0, kb1, vb0, vb1;
#define LOADA(tt) do { const char* kp_ = kgp + (size_t)(tt) * tstep; const char* vp_ = vgp + (size_t)(tt) * tstep; ka0 = *(const u32x4*)kp_; ka1 = *(const u32x4*)(kp_ + 16); va0 = *(const u32x4*)vp_; va1 = *(const u32x4*)(vp_ + 16); } while (0)
#define LOADB(tt) do { const char* kp_ = kgp + (size_t)(tt) * tstep; const char* vp_ = vgp + (size_t)(tt) * tstep; kb0 = *(const u32x4*)kp_; kb1 = *(const u32x4*)(kp_ + 16); vb0 = *(const u32x4*)vp_; vb1 = *(const u32x4*)(vp_ + 16); } while (0)
#define WRITEA(buf) do { LAS char* kw_ = lds + (buf) * BUFB + lrow * KP + lcb; LAS char* vw_ = lds + (buf) * BUFB + 64 * KP + lrow * VP + lcb; *(LAS u32x4*)kw_ = ka0; *(LAS u32x4*)(kw_ + 16) = ka1; *(LAS u32x4*)vw_ = va0; *(LAS u32x4*)(vw_ + 16) = va1; } while (0)
#define WRITEB(buf) do { LAS char* kw_ = lds + (buf) * BUFB + lrow * KP + lcb; LAS char* vw_ = lds + (buf) * BUFB + 64 * KP + lrow * VP + lcb; *(LAS u32x4*)kw_ = kb0; *(LAS u32x4*)(kw_ + 16) = kb1; *(LAS u32x4*)vw_ = vb0; *(LAS u32x4*)(vw_ + 16) = vb1; } while (0)
    constexpr int BUFB = 64 * KP + 64 * VP;
    const float qd = (float)(qpos - 4 * hi);
    const int td = qw >> 6;
    if (NC == 2) {
    const int qb0 = qw & ~127;
    const float dkf = 152.f / fmaxf(-nslope, 1e-6f);
    const int Dk = (dkf < 4096.f) ? (int)dkf + 1 : 4096;
    int t_lo = ((qb0 - Dk > 0) ? (qb0 - Dk) : 0) >> 6, t_hi = ((qb0 + 127 + Dk) >> 6) + 1;
    t_lo &= ~1; t_hi = (t_hi + 1) & ~1; if (t_hi > nt) t_hi = nt;
    LOADA(t_lo); LOADB(t_lo + 1);
    __syncthreads();
    WRITEA(0);
    __syncthreads();
#pragma unroll 1
    for (int t = t_lo; t < t_hi; t += 2) {
        {
            if (t + 2 < t_hi) LOADA(t + 2);
            int k0v = t * 64; asm volatile("" : "+s"(k0v));
            const LAS char* Kb = lds + cm * 128; const LAS char* Vb = lds + 64 * KP;
            if (t == td) attn_tile<NC, true>(O, l, Q, Kb, Vb, r32, hi, lane, qd, k0v, qw, nslope, negM0);
            else attn_tile<NC, false>(O, l, Q, Kb, Vb, r32, hi, lane, qd, k0v, qw, nslope, negM0);
            WRITEB(1);
            __syncthreads();
        }
        {
            if (t + 3 < t_hi) LOADB(t + 3);
            int k0v = (t + 1) * 64; asm volatile("" : "+s"(k0v));
            const LAS char* Kb = lds + BUFB + cm * 128; const LAS char* Vb = lds + BUFB + 64 * KP;
            if (t + 1 == td) attn_tile<NC, true>(O, l, Q, Kb, Vb, r32, hi, lane, qd, k0v, qw, nslope, negM0);
            else attn_tile<NC, false>(O, l, Q, Kb, Vb, r32, hi, lane, qd, k0v, qw, nslope, negM0);
            if (t + 2 < t_hi) WRITEA(0);
            __syncthreads();
        }
    }
    } else {
    LOADA(0);
    __syncthreads();
    WRITEA(0);
    __syncthreads();
#pragma unroll 1
    for (int t = 0; t < nt; ++t) {
        const bool more = (t + 1 < nt);
        if (more) LOADA(t + 1);
        int k0v = t * 64; asm volatile("" : "+s"(k0v));
        const LAS char* Kb = lds + (t & 1) * BUFB; const LAS char* Vb = lds + (t & 1) * BUFB + 64 * KP;
        attn_tile<NC, false>(O, l, Q, Kb, Vb, r32, hi, lane, qd, k0v, qw, nslope, negM0);
        if (more) WRITEA((t + 1) & 1);
        __syncthreads();
    }
    }
#undef LOADA
#undef LOADB
#undef WRITEA
#undef WRITEB
    const int lane2 = pg8::lane_id_fresh(), hi2 = lane2 >> 5;
    bf16* qrow = qbase + (size_t)(lane2 & 31) * LDQ;
    l = pg8::sum_halves(l);
    if (NC == 2) {
        LAS float* XO = (LAS float*)lds + (wv >> 1) * 4096 + lane2;
        if (cm == 1) { const float i2 = *(const LAS float*)(lds + (LDS_BYTES - 64 + 32)) * __builtin_amdgcn_rcpf(l);
#pragma unroll
            for (int db = 0; db < 4; ++db)
#pragma unroll
                for (int r = 0; r < 16; ++r) XO[(db * 16 + r) * 64] = O[db][r] * i2; }
        __syncthreads();
        if (cm == 0) {
            const float i1 = 1.f / l; float ss = 0.f;
#pragma unroll
            for (int db = 0; db < 4; ++db)
#pragma unroll
                for (int r = 0; r < 16; ++r) { const float o = O[db][r] * i1 - XO[(db * 16 + r) * 64]; O[db][r] = o; ss += o * o; }
            ss = pg8::sum_halves(ss);
            const float rstd = (1.f / sqrtf(ss * (1.f / 128.f) + EPS)) * 0.8f;
#pragma unroll
            for (int db = 0; db < 4; ++db)
#pragma unroll
                for (int g4 = 0; g4 < 4; ++g4) { const int d = 32 * db + 8 * g4 + 4 * hi2; const f32x4 gn = *(const f32x4*)(subln + d);
                    u32x2 w; w.x = cvtpk(O[db][4 * g4 + 0] * rstd * gn[0], O[db][4 * g4 + 1] * rstd * gn[1]); w.y = cvtpk(O[db][4 * g4 + 2] * rstd * gn[2], O[db][4 * g4 + 3] * rstd * gn[3]);
                    stage_put(lds + (wv >> 1) * 16384, lane2 & 31, hi2, db, g4, w); (void)d; }
            stage_flush(lds + (wv >> 1) * 16384, qbase, LDQ, lane2);
        }
    } else {
        const float i1 = 1.f / l;
#pragma unroll
        for (int db = 0; db < 4; ++db)
#pragma unroll
            for (int g4 = 0; g4 < 4; ++g4) { const int d = 32 * db + 8 * g4 + 4 * hi2;
                u32x2 w; w.x = cvtpk(O[db][4 * g4 + 0] * i1, O[db][4 * g4 + 1] * i1); w.y = cvtpk(O[db][4 * g4 + 2] * i1, O[db][4 * g4 + 3] * i1);
                stage_put(lds + wv * 8704, lane2 & 31, hi2, db, g4, w); (void)d; }
        stage_flush(lds + wv * 8704, qbase, LDQ, lane2);
    }
}

template <bool SEG2>
__device__ __forceinline__ void attn_b_block_unit(LAS char* lds, bf16* R, float* LB, int b, int g, int j, int res0, int q0, int dil, float nslope, float negM0, int wave_id) {
    const int tid = pg8::tid_fresh(wave_id), lane = tid & 63, r32 = lane & 31, hi = lane >> 5;
    const int sub_len = SEQ / dil, hcol = (g * 4 + j) * 128;
    const int wres = SEG2 ? res0 + (wave_id >> 2) : res0;
    const int qs = SEG2 ? 32 * (wave_id & 3) : q0 + 32 * wave_id;
    const size_t rowb = (size_t)b * SEQ;
    bf16x8 Q[8];
    { const bf16* qr = R + (rowb + (size_t)(qs + r32) * dil + wres) * LDQ + C_BQ + hcol;
#pragma unroll
      for (int ks = 0; ks < 8; ++ks) Q[ks] = *(const bf16x8*)(qr + 16 * ks + 8 * hi); }
    f32x16 O[4]; float l = 0.f;
#pragma unroll
    for (int db = 0; db < 4; ++db) zero16(O[db]);
    constexpr int TK = SEG2 ? 32 : 64;
    const int k_lo = SEG2 ? 0 : ((q0 - 64 > 0) ? q0 - 64 : 0), k_hi = SEG2 ? 128 : ((q0 + 320 < sub_len) ? q0 + 320 : sub_len);
    const int nsteps = (k_hi - k_lo) / TK;
    const int lrow = tid >> 3, lcb = (tid & 7) * 32;
    const int lres = SEG2 ? res0 + (lrow >> 5) : res0, lkey = SEG2 ? (lrow & 31) : lrow;
    const char* kg = (const char*)(R + (rowb + (size_t)(k_lo + lkey) * dil + lres) * LDQ + C_BK + hcol) + lcb;
    const size_t sstep = (size_t)TK * dil * LDQ * 2;
    constexpr int VOFF = (C_BV - C_BK) * 2, BUFB = 64 * KP + 64 * VP;
    u32x4 kr0, kr1, vr0, vr1;
    kr0 = *(const u32x4*)kg; kr1 = *(const u32x4*)(kg + 16); vr0 = *(const u32x4*)(kg + VOFF); vr1 = *(const u32x4*)(kg + VOFF + 16);
    __syncthreads();
    { LAS char* kw = lds + lrow * KP + lcb; LAS char* vw = lds + 64 * KP + lrow * VP + lcb;
      *(LAS u32x4*)kw = kr0; *(LAS u32x4*)(kw + 16) = kr1; *(LAS u32x4*)vw = vr0; *(LAS u32x4*)(vw + 16) = vr1; }
    __syncthreads();
    const float qf = (float)(qs + r32 - 4 * hi);
#pragma unroll 1
    for (int s = 0; s < nsteps; ++s) {
        const bool more = (s + 1 < nsteps);
        if (more) { const char* kp = kg + (size_t)(s + 1) * sstep; kr0 = *(const u32x4*)kp; kr1 = *(const u32x4*)(kp + 16); vr0 = *(const u32x4*)(kp + VOFF); vr1 = *(const u32x4*)(kp + VOFF + 16); }
        const int kb = k_lo + s * TK;
        const LAS char* Kb = lds + (s & 1) * BUFB; const LAS char* Vb = Kb + 64 * KP;
#pragma unroll
        for (int hh = 0; hh < (SEG2 ? 1 : 2); ++hh) {
            const int row0 = SEG2 ? 32 * (wave_id >> 2) : 32 * hh, kbase = SEG2 ? kb : kb + 32 * hh;
            if (kbase + 31 >= qs - 64 && kbase <= qs + 95) {
                f32x16 S;
#pragma unroll
                for (int r = 0; r < 16; ++r) S[r] = negM0;
                qk32<8>(S, Kb + row0 * KP, Q, 0, r32, hi);
                bf16x8 P[2];
                soft32<2>(S, P, l, qf - (float)kbase, nslope);
                pv32(O, P, Vb + row0 * VP, lane);
            }
        }
        if (more) { LAS char* kw = lds + ((s + 1) & 1) * BUFB + lrow * KP + lcb; LAS char* vw = lds + ((s + 1) & 1) * BUFB + 64 * KP + lrow * VP + lcb;
            *(LAS u32x4*)kw = kr0; *(LAS u32x4*)(kw + 16) = kr1; *(LAS u32x4*)vw = vr0; *(LAS u32x4*)(vw + 16) = vr1; }
        __syncthreads();
    }
    const int lane2 = pg8::lane_id_fresh(), hi2 = lane2 >> 5;
    const size_t qrow_i = rowb + (size_t)(qs + (lane2 & 31)) * dil + wres;
    bf16* qrow = R + qrow_i * LDQ + C_BQ + hcol;
    l = pg8::sum_halves(l);
    const float i1 = 1.f / l;
#pragma unroll
    for (int db = 0; db < 4; ++db)
#pragma unroll
        for (int g4 = 0; g4 < 4; ++g4) { const int d = 32 * db + 8 * g4 + 4 * hi2;
            u32x2 w; w.x = cvtpk(O[db][4 * g4 + 0] * i1, O[db][4 * g4 + 1] * i1); w.y = cvtpk(O[db][4 * g4 + 2] * i1, O[db][4 * g4 + 3] * i1);
            stage_put(lds + wave_id * 8704, lane2 & 31, hi2, db, g4, w); (void)d; }
    stage_flush(lds + wave_id * 8704, R + (rowb + (size_t)qs * dil + wres) * LDQ + C_BQ + hcol, (size_t)dil * LDQ, lane2);
    if (hi2 == 0) LB[((size_t)g * M + qrow_i) * 4 + j] = l;
}

#define XB_TMO      128
#define XB_XCNT(j)  (256  + 64 * (j))
#define XB_XSUB(j)  (1280 + 64 * (j))
#define XB_XGEN(j)  (2304 + 64 * (j))
#define XB_TOP      3328
#define XB_TOPGEN   3392
#define XCD_BAR_WORDS 3456
#define XB_SPIN_CAP (1u << 18)

__device__ __forceinline__ unsigned xb_ld(unsigned* p)              { return __hip_atomic_load(p, __ATOMIC_RELAXED, __HIP_MEMORY_SCOPE_AGENT); }
__device__ __forceinline__ unsigned xb_add(unsigned* p, unsigned v) { return __hip_atomic_fetch_add(p, v, __ATOMIC_RELAXED, __HIP_MEMORY_SCOPE_AGENT); }
__device__ __forceinline__ unsigned xb_xcc_id() { return (unsigned)__builtin_amdgcn_s_getreg((3 << 11) | 20) & 0xFu; }
#define XB_SPIN(cond, bar) do { unsigned _sp = 0; while (cond) { __builtin_amdgcn_s_sleep(1); \
    if ((++_sp & 255u) == 0u) { if (xb_ld(&(bar)[XB_TMO])) break; if (_sp > XB_SPIN_CAP) { atomicAdd(&(bar)[XB_TMO], 1u); break; } } } } while (0)

struct XcdBarrier {
    unsigned* bar; unsigned x;
    volatile LAS unsigned* st;
};

__device__ __forceinline__ XcdBarrier xcd_barrier_post(unsigned* bar, volatile LAS unsigned* st) {
    XcdBarrier b; b.bar = bar; b.x = xb_xcc_id(); b.st = st;
    if (threadIdx.x == 0) (void)xb_add(&bar[XB_XCNT(b.x)], 1u);
    return b;
}
__device__ __forceinline__ void xcd_barrier_complete(unsigned* bar, unsigned x, unsigned& nloc, unsigned& nx) {
    const unsigned G = gridDim.x * gridDim.y * gridDim.z;
    unsigned sum, cnt, mine, sp = 0u;
    for (;;) {
        sum = 0u; cnt = 0u; mine = 0u;
#pragma unroll
        for (unsigned j = 0; j < 16; ++j) { const unsigned c = xb_ld(&bar[XB_XCNT(j)]); sum += c; cnt += (c > 0u) ? 1u : 0u; mine = (j == x) ? c : mine; }
        if (sum == G) break;
        __builtin_amdgcn_s_sleep(1);
        if ((++sp & 255u) == 0u) { if (xb_ld(&bar[XB_TMO])) break; if (sp > XB_SPIN_CAP) { atomicAdd(&bar[XB_TMO], 1u); break; } }
    }
    nloc = mine > 0u ? mine : 1u; nx = cnt > 0u ? cnt : 1u;
}

__device__ __forceinline__ void xcd_barrier(const XcdBarrier& b, int wave_id) {
    asm volatile("s_waitcnt vmcnt(0)" ::: "memory");
    __syncthreads();
    if (pg8::tid_fresh(wave_id) == 0) {
        unsigned* bar = b.bar;
        __builtin_amdgcn_s_waitcnt(0);
        unsigned nloc = b.st[0], nx = b.st[1];
        if (nloc == 0u) { xcd_barrier_complete(bar, b.x, nloc, nx); b.st[0] = nloc; b.st[1] = nx; }
        const unsigned old = xb_add(&bar[XB_XSUB(b.x)], 1u);
        const unsigned gen = old / nloc;
        if (old + 1u == (gen + 1u) * nloc) {
            __builtin_amdgcn_fence(__ATOMIC_RELEASE, "agent");
            asm volatile("s_waitcnt vmcnt(0)" ::: "memory");
            const unsigned og = xb_add(&bar[XB_TOP], 1u);
            const unsigned tg = og / nx;
            if (og + 1u == (tg + 1u) * nx) xb_add(&bar[XB_TOPGEN], 1u);
            else XB_SPIN(xb_ld(&bar[XB_TOPGEN]) == tg, bar);
            __builtin_amdgcn_fence(__ATOMIC_ACQUIRE, "agent");
            xb_add(&bar[XB_XGEN(b.x)], 1u);
            asm volatile("s_waitcnt vmcnt(0)" ::: "memory");
        } else {
            XB_SPIN(xb_ld(&bar[XB_XGEN(b.x)]) == gen, bar);
            __builtin_amdgcn_fence(__ATOMIC_ACQUIRE, "agent");
            asm volatile("s_waitcnt vmcnt(0)" ::: "memory");
        }
    }
    __syncthreads();
}

struct Args { const float* in[25]; float* out; unsigned char* ws; };

__global__ void __launch_bounds__(512, 2) fwd_megakernel(Args a) {
    extern __shared__ __attribute__((aligned(16))) unsigned char lds_raw[];
    LAS unsigned char* lds = (LAS unsigned char*)lds_raw;
    cg::grid_group grid = cg::this_grid();
    const int wave = __builtin_amdgcn_readfirstlane((int)threadIdx.x >> 6);
#define FRESH_LANE const int lane = pg8::lane_id_fresh();
    const int G = gridDim.x, bid = blockIdx.x;
    const int gw = bid * 8 + wave, NGW = G * 8;
    unsigned char* ws = a.ws;
    const float* x = a.in[0]; const float* mem = a.in[1];
    bf16* W_IN = (bf16*)(ws + WS_WIN); bf16* W_G = (bf16*)(ws + WS_WG); bf16* W_MEM = (bf16*)(ws + WS_WMEM); bf16* W_BR = (bf16*)(ws + WS_WBR);
    bf16* W_OUT = (bf16*)(ws + WS_WOUT3); bf16* W_GU = (bf16*)(ws + WS_WGU); bf16* W_DN = (bf16*)(ws + WS_WDN);
    float* LB = (float*)(ws + WS_LB); bf16* R = (bf16*)(ws + WS_R);
    unsigned char* dob = (unsigned char*)a.out;
    bf16* XN = (bf16*)(dob + DO_XN); bf16* MN = (bf16*)(dob + DO_MN); bf16* CKV = (bf16*)(dob + DO_CKV);

    volatile LAS unsigned* MISC = (volatile LAS unsigned*)(lds + MISC_OFF);
    unsigned* barw = (unsigned*)(ws + WS_BAR);
    if (threadIdx.x < 16) MISC[threadIdx.x] = 0u;
    if (a.ws == nullptr) grid.sync();
    XcdBarrier bar = xcd_barrier_post(barw, MISC);
    __syncthreads();
    {
        FRESH_LANE
        LAS float* scr = (LAS float*)(lds + wave * 8704);
        constexpr int I_IN = 16 * (DIN / 32), I_MEM = 16 * (D / 32);
        for (int it = gw; it < I_IN + I_MEM; it += NGW) {
            int r = it;
            if (r < I_IN) { const int nb = DIN / 32; tr_item(a.in[3], DIN, 64 * (r / nb), 32 * (r % nb), W_IN, D, 0, 0, 1, 0, scr, lane); continue; } r -= I_IN;
            { const int nb = D / 32; tr_item(a.in[16], D, 64 * (r / nb), 32 * (r % nb), W_MEM, D, 0, 0, 1, 0, scr, lane); }
        }
        { float* SSQ0 = (float*)(ws + WS_SSQ); for (int i = gw * 64 + lane; i < M; i += NGW * 64) SSQ0[i] = 0.f; }
        for (int m0 = gw; m0 < M + MMEM; m0 += 3 * NGW) {
            f32x4 v[3][4]; float ssq[3];
#pragma unroll
            for (int q = 0; q < 3; ++q) { const int m = m0 + q * NGW; ssq[q] = 0.f;
                if (m < M + MMEM) { const f32x4* xr = (const f32x4*)((m < M) ? x + (size_t)m * D : mem + (size_t)(m - M) * D) + lane;
#pragma unroll
                    for (int j = 0; j < 4; ++j) v[q][j] = xr[64 * j]; } }
#pragma unroll
            for (int q = 0; q < 3; ++q) { const int m = m0 + q * NGW;
                if (m < M + MMEM) {
                    float s = 0.f;
#pragma unroll
                    for (int j = 0; j < 4; ++j) s += (v[q][j][0] * v[q][j][0] + v[q][j][1] * v[q][j][1]) + (v[q][j][2] * v[q][j][2] + v[q][j][3] * v[q][j][3]);
                    const float rstd = 1.f / sqrtf(wave_sum(s) * (1.f / 1024.f) + EPS);
                    const f32x4* gr = (const f32x4*)((m < M) ? a.in[2] : a.in[15]) + lane;
                    u32x2* o8 = (u32x2*)((m < M) ? XN + (size_t)m * D : MN + (size_t)(m - M) * D) + lane;
#pragma unroll
                    for (int j = 0; j < 4; ++j) { const f32x4 gn = gr[64 * j]; u32x2 w; w.x = cvtpk(v[q][j][0] * rstd * gn[0], v[q][j][1] * rstd * gn[1]); w.y = cvtpk(v[q][j][2] * rstd * gn[2], v[q][j][3] * rstd * gn[3]); o8[64 * j] = w; }
                } }
        }
    }
    xcd_barrier(bar, wave);

    {
        LAS float* GT = (LAS float*)(lds + GT_OFF);
        { const int t2 = pg8::tid_fresh(wave);
          if (t2 < 64) { GT[t2] = a.in[6][t2]; GT[64 + t2] = a.in[7][t2]; }
          if (t2 < 128) { GT[128 + t2] = a.in[13][t2]; GT[256 + t2] = a.in[14][t2]; GT[384 + t2] = a.in[17][t2]; GT[512 + t2] = a.in[18][t2]; } }
        __syncthreads();
        { const pg8::EpiQKV E{R, LDQ, CKV, D, GT, (LAS float*)(lds + XCH_OFF)};
          pg8::Gemm g{XN, W_IN, M, DIN, D, D, MN, W_MEM, nullptr, nullptr}; pg8::DualOrder S; S.init(M, DIN, MMEM, D, G, bid);
          pg8::gemm_phase<pg8::EpiQKV, pg8::DualOrder, true, true>(lds, g, S, E, wave); }
        {
            constexpr int I_G = 16 * (3 * D / 32), I_BR = 8 * (D / 32), I_OUT = 16 * (D / 32), I_FF = 16 * (DFF / 32);
            constexpr int NREST = I_G + 3 * I_BR + I_OUT + 2 * I_FF;
            const int first = (G == 256) ? 160 : 0, nsl = G - first;
            if (bid >= first) {
                const int lane = pg8::lane_id_fresh();
                LAS float* scr = (LAS float*)(lds + wave * 8704);
                for (int it = (bid - first) * 8 + wave; it < NREST; it += nsl * 8) {
                    int r = it;
                    if (r < I_G) { const int nb = 3 * D / 32; tr_item(a.in[4], 3 * D, 64 * (r / nb), 32 * (r % nb), W_G, D, 0, 0, 1, 0, scr, lane); continue; } r -= I_G;
                    if (r < 3 * I_BR) { const int gI = r / I_BR, rr = r % I_BR, nb = D / 32; tr_item(a.in[19] + (size_t)gI * 512 * D, D, 64 * (rr / nb), 32 * (rr % nb), W_BR + (size_t)gI * D * 512, 512, 0, 0, 1, 0, scr, lane); continue; } r -= 3 * I_BR;
                    if (r < I_OUT) { const int nb = D / 32; tr_item(a.in[20], D, 64 * (r / nb), 32 * (r % nb), W_OUT, D, 0, 0, 1, 0, scr, lane); continue; } r -= I_OUT;
                    { const int s = r / I_FF, rr = r % I_FF, nb = DFF / 32; const int n0 = 32 * (rr % nb);
                      tr_item(a.in[22 + s], DFF, 64 * (rr / nb), n0, W_GU, D, 256 * (n0 / 128) + 128 * s + (n0 % 128) - n0, 0, 1, 0, scr, lane); }
                }
            }
        }
    }
    xcd_barrier(bar, wave);

    {
        FRESH_LANE
#define UNIFORM_F(v) __builtin_bit_cast(float, __builtin_amdgcn_readfirstlane(__builtin_bit_cast(int, (float)(v))))
        const float negM_a = UNIFORM_F(-8.f * absmax_vec(a.in[6], 64, lane) * absmax_vec(a.in[7], 64, lane) * L2E);
        const float lam = UNIFORM_F(expf(wave_sum(a.in[8][lane] * a.in[9][lane])) - expf(wave_sum(a.in[10][lane] * a.in[11][lane])) + 0.2f);
        *(LAS float*)(lds + (LDS_BYTES - 64 + 32)) = lam;
        for (int rr = 0; rr < (512 + G - 1) / G; ++rr) {
            int b, h, qblk;
            if (G == 256) {
                const int j = bid >> 3, i = j >> 1; b = bid & 7;
                if ((j & 1) == 0) { h = (rr == 0) ? 1 : 0; qblk = i; }
                else { const int n = 16 + 2 * i + rr; h = 1 + (n >> 4); qblk = n & 15; }
            } else { const int u = rr * G + bid; if (u >= 512) break; b = u >> 6; h = (u >> 4) & 3; qblk = u & 15; }
            const int ta_ = pg8::lane_id_fresh();
            const int qpos = qblk * 128 + (wave >> 1) * 32 + (ta_ & 31);
            bf16* qrow = R + ((size_t)b * SEQ + qblk * 128 + (wave >> 1) * 32) * LDQ + C_AQ + h * 128;
            const bf16* Kg = R + (size_t)b * SEQ * LDQ + C_AK + h * 128; const bf16* Vg = R + (size_t)b * SEQ * LDQ + C_AV + h * 128;
            const float nslope = -__builtin_amdgcn_exp2f(-2.f * (float)(h + 1)) * L2E;
            attn_shared_unit<2>((LAS char*)lds, qrow, Kg, Vg, LDQ, SEQ / 64, qpos, qblk * 128 + (wave >> 1) * 32, nslope, negM_a, lam, a.in[12], wave);
        }
        const int lnc_ = pg8::lane_id_fresh();
        const float negM_c = UNIFORM_F(-11.313708499f * absmax_vec(a.in[17], 128, lnc_) * absmax_vec(a.in[18], 128, lnc_) * L2E);
        for (int u = bid; u < 256; u += G) {
            const int b = u >> 5, h = (u >> 3) & 3, qblk = u & 7;
            const int tc_ = pg8::lane_id_fresh();
            const int qpos = qblk * 256 + wave * 32 + (tc_ & 31);
            bf16* qrow = R + ((size_t)b * SEQ + qblk * 256 + wave * 32) * LDQ + C_CQ + h * 128;
            const bf16* Kg = CKV + (size_t)b * NMEM * D + h * 128; const bf16* Vg = Kg + 512;
            attn_shared_unit<1>((LAS char*)lds, qrow, Kg, Vg, D, NMEM / 64, qpos, 0, 0.f, negM_c, 0.f, a.in[12], wave);
        }
        __syncthreads();
        { const int lnb_ = pg8::lane_id_fresh();
          const float negM_b = UNIFORM_F(-11.313708499f * absmax_vec(a.in[13], 128, lnb_) * absmax_vec(a.in[14], 128, lnb_) * L2E);
          const int jb = bid >> 3, heavy = jb & 1, xq = bid & 7, ib = jb >> 1;
          const int nbu = (G == 256) ? (heavy ? 2 : 4) : (768 + G - 1) / G;
          for (int rr = 0; rr < nbu; ++rr) {
              int u;
              if (G == 256) {
                  int s, loc;
                  if (rr < 2) { const int kb = (heavy ? 32 : 0) + 2 * ib + rr, st = kb >> 3; s = 3 * (st >> 1) + ((st & 1) ? ((xq < 4) ? 2 : 1) : 0); loc = kb & 7; }
                  else { const int ks = 2 * ib + (rr - 2); s = 3 * (ks >> 3) + ((xq < 4) ? 1 : 2); loc = ks & 7; }
                  u = (xq + 8 * s) * 8 + loc;
              }
              else { u = rr * G + bid; if (u >= 768) break; }
              const int sid = u >> 3, loc = u & 7, b = sid / 12, g = (sid % 12) >> 2, j = sid & 3;
              const float slope = __builtin_amdgcn_exp2f(-8.f * (float)(g * 4 + j + 1) / 12.f);
              if (g == 0) attn_b_block_unit<false>((LAS char*)lds, R, LB, b, g, j, 0, loc * 256, 1, -slope * L2E, negM_b, wave);
              else if (g == 1) attn_b_block_unit<false>((LAS char*)lds, R, LB, b, g, j, loc >> 1, (loc & 1) * 256, 4, -slope * 4.f * L2E, negM_b, wave);
              else attn_b_block_unit<true>((LAS char*)lds, R, LB, b, g, j, 2 * loc, 0, 16, -slope * 16.f * L2E, negM_b, wave);
          } }
    }
    xcd_barrier(bar, wave);

    { FRESH_LANE
    const int j = lane >> 4, d8 = (lane & 15) * 8;
    for (int m0 = gw; m0 < M; m0 += 4 * NGW) {
        u32x4 o0[4], o1[4], o2[4]; float l0[4], l1[4], l2[4];
#pragma unroll
        for (int q = 0; q < 4; ++q) { const int m = m0 + q * NGW;
            if (m < M) { const bf16* p0 = R + (size_t)m * LDQ + C_BQ + j * 128 + d8;
                o0[q] = *(const u32x4*)p0; o1[q] = *(const u32x4*)(p0 + 512); o2[q] = *(const u32x4*)(p0 + 1024);
                l0[q] = LB[((size_t)0 * M + m) * 4 + j]; l1[q] = LB[((size_t)1 * M + m) * 4 + j]; l2[q] = LB[((size_t)2 * M + m) * 4 + j]; } }
#pragma unroll
        for (int q = 0; q < 4; ++q) { const int m = m0 + q * NGW;
            if (m < M) {
                const float inv = 1.f / (l0[q] + l1[q] + l2[q]); const float w0 = l0[q] * inv, w1 = l1[q] * inv, w2 = l2[q] * inv;
                u32x4 w;
#pragma unroll
                for (int e = 0; e < 4; ++e) {
                    const float lo = w0 * pg8::bf_lo(o0[q][e]) + w1 * pg8::bf_lo(o1[q][e]) + w2 * pg8::bf_lo(o2[q][e]);
                    const float hi = w0 * pg8::bf_hi(o0[q][e]) + w1 * pg8::bf_hi(o1[q][e]) + w2 * pg8::bf_hi(o2[q][e]);
                    w[e] = cvtpk(lo, hi);
                }
                *(u32x4*)(R + (size_t)m * LDQ + C_BQ + j * 128 + d8) = w; } }
    } }
    {
        pg8::Gemm g{XN, W_G, M, 3 * D, D, D, nullptr, nullptr, nullptr, nullptr}; pg8::StaticOrder S; S.init(M, 3 * D, G, bid);
        pg8::EpiGate E{R + C_GATE, LDQ, a.in[5]};
        pg8::gemm_phase<pg8::EpiGate, pg8::StaticOrder, true, true>(lds, g, S, E, wave);
    }
    xcd_barrier(bar, wave);

    {
        pg8::Gemm g{R + C_AQ, W_BR, M, D, 512, LDQ, R + C_BQ, W_BR + (size_t)D * 512, R + C_CQ, W_BR + (size_t)2 * D * 512};
        pg8::RepeatOrder S; S.init(M, D, 3, G, bid);
        pg8::EpiBranch E{R + C_GATE, R + C_GATE, LDQ, D};
        pg8::gemm_phase<pg8::EpiBranch, pg8::RepeatOrder, true, true>(lds, g, S, E, wave);
    }
    xcd_barrier(bar, wave);

    {
        pg8::Gemm g{R + C_GATE, W_OUT, M, D, D, LDQ, nullptr, nullptr, nullptr, nullptr}; pg8::StaticOrder S; S.init(M, D, G, bid);
        pg8::EpiResidNorm E{x, a.out, D, a.in[21], R + C_H2, LDQ, (float*)(ws + WS_SSQ)};
        pg8::gemm_phase<pg8::EpiResidNorm, pg8::StaticOrder, true, true>(lds, g, S, E, wave);
    }
    xcd_barrier(bar, wave);

    {
        pg8::Gemm g{R + C_H2, W_GU, M, 2 * DFF, D, LDQ, nullptr, nullptr, nullptr, nullptr}; pg8::StaticOrder S; S.init(M, 2 * DFF, G, bid);
        pg8::EpiSwiGLU E{R + C_ACT, LDQ, (const float*)(ws + WS_SSQ)};
        pg8::gemm_phase<pg8::EpiSwiGLU, pg8::StaticOrder, true, true>(lds, g, S, E, wave);
        { constexpr int I_DN = (DFF / 64) * (D / 32);
          const int first = (G == 256) ? 128 : 0, nsl = G - first;
          if (bid >= first) { const int lane = pg8::lane_id_fresh(); LAS float* scr = (LAS float*)(lds + wave * 8704);
              for (int r = (bid - first) * 8 + wave; r < I_DN; r += nsl * 8) { const int nb = D / 32; tr_item(a.in[24], D, 64 * (r / nb), 32 * (r % nb), W_DN, DFF, 0, 0, 1, 0, scr, lane); } } }
    }
    xcd_barrier(bar, wave);

    {
        pg8::Gemm g{R + C_ACT, W_DN, M, D, DFF, LDQ, nullptr, nullptr, nullptr, nullptr}; pg8::StaticOrder S; S.init(M, D, G, bid);
        pg8::EpiResid E{a.out, a.out, D};
        pg8::gemm_phase<pg8::EpiResid, pg8::StaticOrder, true, true>(lds, g, S, E, wave);
    }
}

extern "C" void kernel_launch(void* const* d_in, const int* in_sizes, int n_in, void* d_out, int out_size, void* d_ws, size_t ws_size, hipStream_t stream) {
    static int grid = 0;
    if (grid == 0) {
        if (n_in != 25 || out_size != M * D || ws_size < WS_END) { fprintf(stderr, "kernel_launch: unexpected problem shape (n_in %d out %d ws %zu)\n", n_in, out_size, ws_size); grid = -1; return; }
        int dev = 0, cus = 0, per_cu = 0;
        hipGetDevice(&dev);
        hipDeviceGetAttribute(&cus, hipDeviceAttributeMultiprocessorCount, dev);
        if (hipFuncSetAttribute((const void*)fwd_megakernel, hipFuncAttributeMaxDynamicSharedMemorySize, LDS_BYTES) != hipSuccess) { fprintf(stderr, "kernel_launch: hipFuncSetAttribute failed\n"); }
        hipOccupancyMaxActiveBlocksPerMultiprocessor(&per_cu, (const void*)fwd_megakernel, 512, LDS_BYTES);
        (void)hipGetLastError();
        if (per_cu < 1) per_cu = 1;
        grid = cus;
        fprintf(stderr, "kernel_launch: cus %d per_cu %d grid %d\n", cus, per_cu, grid);
    }
    if (grid < 0) return;
    if (hipMemsetAsync((char*)d_ws + WS_BAR, 0, 16384, stream) != hipSuccess) { fprintf(stderr, "kernel_launch: memset of the barrier words failed\n"); return; }
    Args a{};
    for (int i = 0; i < 25; ++i) a.in[i] = (const float*)d_in[i];
    a.out = (float*)d_out; a.ws = (unsigned char*)d_ws;
    void* args[] = {&a};
    hipError_t e = hipLaunchCooperativeKernel((const void*)fwd_megakernel, dim3(grid), dim3(512), args, LDS_BYTES, stream);
    if (e != hipSuccess) fprintf(stderr, "cooperative launch failed: %s (grid %d)\n", hipGetErrorString(e), grid);
}
```

```cpp
#include <hip/hip_runtime.h>
#include <hip/hip_cooperative_groups.h>
#include <cstdio>
#include <cstdint>
namespace cg = cooperative_groups;
namespace pg8 {
#define PG8_LAS __attribute__((address_space(3)))
typedef unsigned short bf16_t;
typedef short bf16x8 __attribute__((ext_vector_type(8)));
typedef float f32x4 __attribute__((ext_vector_type(4)));
typedef unsigned u32x4 __attribute__((ext_vector_type(4)));
constexpr int BM = 256, BK = 64, HALF = 128, HTB = HALF * BK * 2  , STAGE_BYTES = 8 * HTB, NXCD = 8, WGM = 8;

__host__ __device__ __forceinline__ int lds_byte(int r, int c) { const int st = (r >> 4) * 2 + (c >> 5), rr = r & 15, cc = c & 31, ob = rr * 64 + cc * 2; return st * 1024 + (ob ^ (((ob >> 9) & 1) << 5)); }
__host__ __device__ __forceinline__ void stage_rc(int b, int& R, int& C) { const int st = b / 1024, sb = b % 1024, swz = sb ^ (((sb >> 9) & 1) << 5); R = (st >> 1) * 16 + swz / 64; C = (st & 1) * 32 + (swz % 64) / 2; }
__host__ __device__ __forceinline__ int perm32(int rho) { const int n = rho >> 4, i = rho & 15; return 8 * (i >> 2) + 4 * n + (i & 3); }

struct Unit { int pm, pn, src; };
struct Gemm { const bf16_t* A; const bf16_t* Bt; int M, N, K, lda; const bf16_t* A2; const bf16_t* Bt2; const bf16_t* A3; const bf16_t* Bt3; };

struct StaticOrder {
    int nM, nN, nwg, G, c;
    __host__ __device__ void init(int M, int N, int G_, int c_) { nM = M / BM; nN = N / BM; nwg = nM * nN; G = G_; c = c_; }
    __host__ __device__ bool next(int i, Unit& u) const {
        const long L = (long)i * G + c; if (L >= nwg) return false;
        int wgid = (int)L; { const int q = nwg / NXCD, r = nwg % NXCD, xcd = wgid % NXCD, off = wgid / NXCD; wgid = (xcd < r ? xcd * (q + 1) : r * (q + 1) + (xcd - r) * q) + off; }
        const int nig = WGM * nN, gid = wgid / nig, fm = gid * WGM, gsz = (nM - fm) < WGM ? (nM - fm) : WGM;
        u.pm = fm + ((wgid % nig) % gsz); u.pn = (wgid % nig) / gsz; u.src = 0; return true;
    }
    __device__ __forceinline__ void a_ready(const Unit&) const {}
    __device__ __forceinline__ void done(const Unit&) const {}
};

struct DualOrder {
    StaticOrder S1; int nM2, nN2;
    __host__ __device__ void init(int M, int N, int M2, int N2, int G_, int c_) { S1.init(M, N, G_, c_); nM2 = M2 / BM; nN2 = N2 / BM; }
    __host__ __device__ bool next(int i, Unit& u) const {
        if (S1.next(i, u)) return true;
        const long L = (long)i * S1.G + S1.c - S1.nwg; if (L < 0 || L >= (long)nM2 * nN2) return false;
        u.pm = (int)L % nM2; u.pn = (int)L / nM2; u.src = 1; return true;
    }
    __device__ __forceinline__ void a_ready(const Unit&) const {}
    __device__ __forceinline__ void done(const Unit&) const {}
};

struct RepeatOrder {
    StaticOrder S1; int nrep;
    __host__ __device__ void init(int M, int N, int nrep_, int G_, int c_) { S1.init(M, N, G_, c_); nrep = nrep_; }
    __host__ __device__ bool next(int i, Unit& u) const { if (i >= nrep) return false; if (!S1.next(0, u)) return false; u.src = i; return true; }
    __device__ __forceinline__ void a_ready(const Unit&) const {}
    __device__ __forceinline__ void done(const Unit&) const {}
};

template <int K> __device__ __forceinline__ float shx(float v) {
    return __builtin_bit_cast(float, __builtin_amdgcn_ds_swizzle(__builtin_bit_cast(int, v), (K << 10) | 0x1f)); }
__device__ __forceinline__ float sum_halves(float v) {
    auto rr = __builtin_amdgcn_permlane32_swap(__builtin_bit_cast(unsigned, v), __builtin_bit_cast(unsigned, v), false, false);
    return __builtin_bit_cast(float, (unsigned)rr[0]) + __builtin_bit_cast(float, (unsigned)rr[1]); }
__device__ __forceinline__ float max_halves(float v) {
    auto rr = __builtin_amdgcn_permlane32_swap(__builtin_bit_cast(unsigned, v), __builtin_bit_cast(unsigned, v), false, false);
    return fmaxf(__builtin_bit_cast(float, (unsigned)rr[0]), __builtin_bit_cast(float, (unsigned)rr[1])); }
__device__ __forceinline__ int lane_id_fresh() { int z = 0; asm volatile("" : "+s"(z)); return __builtin_amdgcn_mbcnt_hi(~0u, __builtin_amdgcn_mbcnt_lo(~0u, z)); }
__device__ __forceinline__ int tid_fresh(int wave) { return wave * 64 + lane_id_fresh(); }
typedef float f32x2v_t __attribute__((ext_vector_type(2))); typedef __bf16 bf16x2v_t __attribute__((ext_vector_type(2)));
__device__ __forceinline__ unsigned cvt_pk_bf16(float lo, float hi) { f32x2v_t v = {lo, hi}; bf16x2v_t b = __builtin_convertvector(v, bf16x2v_t); return __builtin_bit_cast(unsigned, b); }
__device__ __forceinline__ float bf_lo(unsigned w) { return __builtin_bit_cast(float, w << 16); }
__device__ __forceinline__ float bf_hi(unsigned w) { return __builtin_bit_cast(float, w & 0xffff0000u); }
#define PG8_ACC const f32x4 (&acc)[2][2][4][2]

struct EpiQKV {
    static constexpr bool PERM = true, AFTER_DRAIN = false;
    bf16_t* O; int ldc; bf16_t* O2; int ldc2;
    PG8_LAS const float* GT;
    PG8_LAS float* X;
    __device__ __forceinline__ void operator()(PG8_ACC, const Unit& u, int wr, int wc, int fr, int fq) const {
        const int pn = u.pn;
        int kind, gp; float sc = 1.f;
        constexpr float L2E = 1.4426950408889634f;
        const int mode = u.src;
        if (mode == 0) {
            if (pn < 2) { kind = 1; gp = 0; sc = 0.125f * L2E; }
            else if (pn < 4) { kind = 1; gp = 64; }
            else if (pn < 6) { kind = 0; gp = 64; }
            else if (pn < 12) { kind = 2; gp = 128; sc = 0.08838834764831845f * L2E; }
            else if (pn < 18) { kind = 2; gp = 256; }
            else if (pn < 24) { kind = 0; gp = 256; }
            else { kind = 2; gp = 384; sc = 0.08838834764831845f * L2E; }
        } else {
            if (pn < 2) { kind = 2; gp = 512; } else { kind = 0; gp = 512; }
        }
        const int row0 = u.pm * BM + wr * 64 + fr, col0 = pn * BM + wc * 32 + 8 * fq;
        float rs[2][4][2];
        f32x4 gv[2];
        if (kind != 0) {
#pragma unroll
            for (int ai = 0; ai < 2; ++ai)
#pragma unroll
                for (int m = 0; m < 4; ++m)
#pragma unroll
                    for (int bj = 0; bj < 2; ++bj) {
                        const f32x4 a = acc[ai][bj][m][0], b = acc[ai][bj][m][1];
                        float s = (a[0] * a[0] + a[1] * a[1]) + (a[2] * a[2] + a[3] * a[3]) + (b[0] * b[0] + b[1] * b[1]) + (b[2] * b[2] + b[3] * b[3]);
                        s += shx<16>(s); s = sum_halves(s);
                        if (fq == 0) X[((ai * 128 + wr * 64 + m * 16 + fr) * 2 + bj) * 4 + wc] = s;
                    }
            asm volatile("s_waitcnt lgkmcnt(0)" ::: "memory"); __builtin_amdgcn_s_barrier(); asm volatile("" ::: "memory");
            const int hd = (kind == 1) ? 64 : 128;
            const float inv_hd = (kind == 1) ? (1.f / 64.f) : (1.f / 128.f);
#pragma unroll
            for (int ai = 0; ai < 2; ++ai)
#pragma unroll
                for (int m = 0; m < 4; ++m)
#pragma unroll
                    for (int bj = 0; bj < 2; ++bj) {
                        const f32x4 xs = *(const PG8_LAS f32x4*)(X + ((ai * 128 + wr * 64 + m * 16 + fr) * 2 + bj) * 4);
                        float tot;
                        if (kind == 1) tot = (wc < 2) ? (xs[0] + xs[1]) : (xs[2] + xs[3]);
                        else tot = (xs[0] + xs[1]) + (xs[2] + xs[3]);
                        rs[ai][m][bj] = __builtin_amdgcn_rsqf(tot * inv_hd + 1e-6f) * sc;
                    }
            const int gc = ((wc * 32 + 8 * fq) & (hd - 1));
            gv[0] = *(const PG8_LAS f32x4*)(GT + gp + gc); gv[1] = *(const PG8_LAS f32x4*)(GT + gp + gc + 4);
        } else {
#pragma unroll
            for (int ai = 0; ai < 2; ++ai)
#pragma unroll
                for (int m = 0; m < 4; ++m)
#pragma unroll
                    for (int bj = 0; bj < 2; ++bj) rs[ai][m][bj] = 1.f;
            gv[0] = (f32x4){1.f, 1.f, 1.f, 1.f}; gv[1] = gv[0];
        }
#pragma unroll
        for (int ai = 0; ai < 2; ++ai)
#pragma unroll
            for (int m = 0; m < 4; ++m) { bf16_t* rowp = (mode ? O2 : O) + (size_t)(row0 + ai * HALF + m * 16) * (mode ? ldc2 : ldc) + col0;
#pragma unroll
                for (int bj = 0; bj < 2; ++bj) { const float r = rs[ai][m][bj];
                    const f32x4 v0 = acc[ai][bj][m][0] * gv[0] * r, v1 = acc[ai][bj][m][1] * gv[1] * r;
                    u32x4 w; w.x = cvt_pk_bf16(v0[0], v0[1]); w.y = cvt_pk_bf16(v0[2], v0[3]); w.z = cvt_pk_bf16(v1[0], v1[1]); w.w = cvt_pk_bf16(v1[2], v1[3]);
                    *(u32x4*)(rowp + bj * HALF) = w; } }
    }
};

struct EpiGate {
    static constexpr bool PERM = true, AFTER_DRAIN = false;
    bf16_t* O; int ldc; const float* bias;
    __device__ __forceinline__ void operator()(PG8_ACC, const Unit& u, int wr, int wc, int fr, int fq) const {
        const int row0 = u.pm * BM + wr * 64 + fr, col0 = u.pn * BM + wc * 32 + 8 * fq;
        f32x4 bv[2][2];
#pragma unroll
        for (int bj = 0; bj < 2; ++bj)
#pragma unroll
            for (int n = 0; n < 2; ++n) bv[bj][n] = *(const f32x4*)(bias + col0 + bj * HALF + 4 * n);
#pragma unroll
        for (int ai = 0; ai < 2; ++ai)
#pragma unroll
            for (int m = 0; m < 4; ++m) { bf16_t* rowp = O + (size_t)(row0 + ai * HALF + m * 16) * ldc + col0;
#pragma unroll
                for (int bj = 0; bj < 2; ++bj) { f32x4 v0 = acc[ai][bj][m][0] + bv[bj][0], v1 = acc[ai][bj][m][1] + bv[bj][1];
#pragma unroll
                    for (int e = 0; e < 4; ++e) { v0[e] = __builtin_amdgcn_rcpf(1.f + __builtin_amdgcn_exp2f(-1.4426950408889634f * v0[e])); v1[e] = __builtin_amdgcn_rcpf(1.f + __builtin_amdgcn_exp2f(-1.4426950408889634f * v1[e])); }
                    u32x4 w; w.x = cvt_pk_bf16(v0[0], v0[1]); w.y = cvt_pk_bf16(v0[2], v0[3]); w.z = cvt_pk_bf16(v1[0], v1[1]); w.w = cvt_pk_bf16(v1[2], v1[3]);
                    *(u32x4*)(rowp + bj * HALF) = w; } }
    }
};

struct EpiBranch {
    static constexpr bool PERM = true, AFTER_DRAIN = false;
    bf16_t* MIX; const bf16_t* GATE0; int ldc; int gstride;
    __device__ __forceinline__ void operator()(PG8_ACC, const Unit& u, int wr, int wc, int fr, int fq) const {
        const int row0 = u.pm * BM + wr * 64 + fr, col0 = u.pn * BM + wc * 32 + 8 * fq;
        const bf16_t* GATE = GATE0 + (size_t)u.src * gstride; const int accum = u.src;
#pragma unroll
        for (int ai = 0; ai < 2; ++ai)
#pragma unroll
            for (int m = 0; m < 4; ++m) { const size_t off = (size_t)(row0 + ai * HALF + m * 16) * ldc + col0;
#pragma unroll
                for (int bj = 0; bj < 2; ++bj) { const u32x4 gt = *(const u32x4*)(GATE + off + bj * HALF);
                    f32x4 a = acc[ai][bj][m][0], b = acc[ai][bj][m][1];
                    a[0] *= bf_lo(gt.x); a[1] *= bf_hi(gt.x); a[2] *= bf_lo(gt.y); a[3] *= bf_hi(gt.y); b[0] *= bf_lo(gt.z); b[1] *= bf_hi(gt.z); b[2] *= bf_lo(gt.w); b[3] *= bf_hi(gt.w);
                    if (accum) { const u32x4 mx = *(const u32x4*)(MIX + off + bj * HALF);
                        a[0] += bf_lo(mx.x); a[1] += bf_hi(mx.x); a[2] += bf_lo(mx.y); a[3] += bf_hi(mx.y); b[0] += bf_lo(mx.z); b[1] += bf_hi(mx.z); b[2] += bf_lo(mx.w); b[3] += bf_hi(mx.w); }
                    u32x4 w; w.x = cvt_pk_bf16(a[0], a[1]); w.y = cvt_pk_bf16(a[2], a[3]); w.z = cvt_pk_bf16(b[0], b[1]); w.w = cvt_pk_bf16(b[2], b[3]);
                    *(u32x4*)(MIX + off + bj * HALF) = w; } }
    }
};

struct EpiResid {
    static constexpr bool PERM = true, AFTER_DRAIN = false;
    const float* res; float* out; int ld;
    __device__ __forceinline__ void operator()(PG8_ACC, const Unit& u, int wr, int wc, int fr, int fq) const {
        const int row0 = u.pm * BM + wr * 64 + fr, col0 = u.pn * BM + wc * 32 + 8 * fq;
#pragma unroll
        for (int ai = 0; ai < 2; ++ai)
#pragma unroll
            for (int m = 0; m < 4; ++m) { const size_t off = (size_t)(row0 + ai * HALF + m * 16) * ld + col0;
#pragma unroll
                for (int bj = 0; bj < 2; ++bj) {
                    const f32x4 r0 = *(const f32x4*)(res + off + bj * HALF), r1 = *(const f32x4*)(res + off + bj * HALF + 4);
                    const f32x4 v0 = acc[ai][bj][m][0] + r0, v1 = acc[ai][bj][m][1] + r1;
                    *(f32x4*)(out + off + bj * HALF) = v0; *(f32x4*)(out + off + bj * HALF + 4) = v1; } }
    }
};

struct EpiResidNorm {
    static constexpr bool PERM = true, AFTER_DRAIN = false;
    const float* res; float* out; int ld; const float* gain; bf16_t* H; int ldh; float* SSQ;
    __device__ __forceinline__ void operator()(PG8_ACC, const Unit& u, int wr, int wc, int fr, int fq) const {
        const int row0 = u.pm * BM + wr * 64 + fr, col0 = u.pn * BM + wc * 32 + 8 * fq;
        f32x4 gv[2][2];
#pragma unroll
        for (int bj = 0; bj < 2; ++bj)
#pragma unroll
            for (int n = 0; n < 2; ++n) gv[bj][n] = *(const f32x4*)(gain + col0 + bj * HALF + 4 * n);
#pragma unroll
        for (int ai = 0; ai < 2; ++ai)
#pragma unroll
            for (int m = 0; m < 4; ++m) { const int row = row0 + ai * HALF + m * 16; const size_t off = (size_t)row * ld + col0; float s = 0.f;
#pragma unroll
                for (int bj = 0; bj < 2; ++bj) {
                    const f32x4 r0 = *(const f32x4*)(res + off + bj * HALF), r1 = *(const f32x4*)(res + off + bj * HALF + 4);
                    const f32x4 v0 = acc[ai][bj][m][0] + r0, v1 = acc[ai][bj][m][1] + r1;
                    *(f32x4*)(out + off + bj * HALF) = v0; *(f32x4*)(out + off + bj * HALF + 4) = v1;
                    s += (v0[0] * v0[0] + v0[1] * v0[1]) + (v0[2] * v0[2] + v0[3] * v0[3]) + (v1[0] * v1[0] + v1[1] * v1[1]) + (v1[2] * v1[2] + v1[3] * v1[3]);
                    const f32x4 h0 = v0 * gv[bj][0], h1 = v1 * gv[bj][1];
                    u32x4 w; w.x = cvt_pk_bf16(h0[0], h0[1]); w.y = cvt_pk_bf16(h0[2], h0[3]); w.z = cvt_pk_bf16(h1[0], h1[1]); w.w = cvt_pk_bf16(h1[2], h1[3]);
                    *(u32x4*)(H + (size_t)row * ldh + col0 + bj * HALF) = w; }
                s += shx<16>(s); s = sum_halves(s);
                if (fq == 0) atomicAdd(SSQ + row, s); }
    }
};

struct EpiSwiGLU {
    static constexpr bool PERM = true, AFTER_DRAIN = false;
    bf16_t* O; int ldc; const float* SSQ;
    __device__ __forceinline__ void operator()(PG8_ACC, const Unit& u, int wr, int wc, int fr, int fq) const {
        const int row0 = u.pm * BM + wr * 64 + fr, col0 = u.pn * HALF + wc * 32 + 8 * fq;
#pragma unroll
        for (int ai = 0; ai < 2; ++ai)
#pragma unroll
            for (int m = 0; m < 4; ++m) { bf16_t* rowp = O + (size_t)(row0 + ai * HALF + m * 16) * ldc + col0;
                const float rstd = __builtin_amdgcn_rsqf(SSQ[row0 + ai * HALF + m * 16] * (1.f / 1024.f) + 1e-6f);
                f32x4 v[2];
#pragma unroll
                for (int n = 0; n < 2; ++n) { const f32x4 gt = acc[ai][0][m][n] * rstd, up = acc[ai][1][m][n] * rstd;
#pragma unroll
                    for (int e = 0; e < 4; ++e) v[n][e] = gt[e] * __builtin_amdgcn_rcpf(1.f + __builtin_amdgcn_exp2f(-1.4426950408889634f * gt[e])) * up[e]; }
                u32x4 w; w.x = cvt_pk_bf16(v[0][0], v[0][1]); w.y = cvt_pk_bf16(v[0][2], v[0][3]); w.z = cvt_pk_bf16(v[1][0], v[1][1]); w.w = cvt_pk_bf16(v[1][2], v[1][3]);
                *(u32x4*)rowp = w; }
    }
};

template <class Epi, class Sched, bool ALIGN_EPI = false, bool SP2 = false>
__device__ __forceinline__ void gemm_phase(PG8_LAS unsigned char* lds, const Gemm g, const Sched& S, const Epi& E, int wave_id) {
    const int tid = tid_fresh(wave_id);
    const int wid = __builtin_amdgcn_readfirstlane(tid >> 6), lane = tid & 63, wr = wid >> 2, wc = wid & 3, fr = lane & 15, fq = lane >> 4;
    const int K = g.K, nt = K / BK;
    unsigned voffA[2], voffB[2];
#pragma unroll
    for (int i = 0; i < 2; ++i) { int R, C; stage_rc(tid * 16 + i * 8192, R, C); const int Rb = Epi::PERM ? ((R & ~31) + perm32(R & 31)) : R;
        voffA[i] = (unsigned)(R * g.lda + C) * 2u; voffB[i] = (unsigned)(Rb * K + C) * 2u; }
    const size_t kstep = (size_t)(BK * 2);
    const size_t hstepA = (size_t)HALF * g.lda * 2, hstepB = (size_t)HALF * K * 2;
    const size_t tstepA = 2 * hstepA, tstepB = 2 * hstepB;
    const unsigned ldsw = (unsigned)wid * 1024u;
    const int aoff = lds_byte(wr * 64 + fr, fq * 8), boff = lds_byte(wc * 32 + fr, fq * 8);
#define PG8_SA(b, h) (((b) * 2 + (h)) * HTB)
#define PG8_SB(b, h) ((4 + (b) * 2 + (h)) * HTB)
#define PG8_STAGE(bufoff, gbase, voff) do { _Pragma("unroll") for (int _i = 0; _i < 2; ++_i) \
        __builtin_amdgcn_global_load_lds((const unsigned*)((const char*)(gbase) + (voff)[_i]), (PG8_LAS unsigned*)(lds + (bufoff) + ldsw + _i * 8192), 16, 0, 0); } while (0)
#define PG8_LDA(dst, b, h) do { _Pragma("unroll") for (int m = 0; m < 4; ++m) _Pragma("unroll") for (int k = 0; k < 2; ++k) dst[m][k] = *(const PG8_LAS bf16x8*)(lds + PG8_SA(b, h) + aoff + m * 2048 + k * 1024); } while (0)
#define PG8_LDB(dst, b, h) do { _Pragma("unroll") for (int n = 0; n < 2; ++n) _Pragma("unroll") for (int k = 0; k < 2; ++k) dst[n][k] = *(const PG8_LAS bf16x8*)(lds + PG8_SB(b, h) + boff + n * 2048 + k * 1024); } while (0)
#define PG8_MMA(ai, bj, At, Bt) do { __builtin_amdgcn_s_setprio(1); _Pragma("unroll") for (int m = 0; m < 4; ++m) _Pragma("unroll") for (int n = 0; n < 2; ++n) _Pragma("unroll") for (int k = 0; k < 2; ++k) \
        acc[ai][bj][m][n] = __builtin_amdgcn_mfma_f32_16x16x32_bf16(Bt[n][k], At[m][k], acc[ai][bj][m][n], 0, 0, 0); __builtin_amdgcn_s_setprio(0); } while (0)
#define PG8_WAIT_V(n) asm volatile("s_waitcnt vmcnt(" #n ")" ::: "memory")
#define PG8_WAIT_L(n) asm volatile("s_waitcnt lgkmcnt(" #n ")" ::: "memory")
#define PG8_BAR __builtin_amdgcn_s_barrier()
#define PG8_SCHED __builtin_amdgcn_sched_barrier(0)
    Unit cur, nxt; int ui = 0;
    if (!S.next(0, cur)) return;
    f32x4 acc[2][2][4][2];
#pragma unroll
    for (int a = 0; a < 2; ++a)
#pragma unroll
        for (int b = 0; b < 2; ++b)
#pragma unroll
            for (int m = 0; m < 4; ++m)
#pragma unroll
                for (int n = 0; n < 2; ++n) acc[a][b][m][n] = (f32x4){0.f, 0.f, 0.f, 0.f};
    bf16x8 At[4][2], B0[2][2], B1[2][2];
    const char* cA = (const char*)(cur.src == 0 ? g.A : (cur.src == 1 ? g.A2 : g.A3)) + (size_t)cur.pm * tstepA; const char* cB = (const char*)(cur.src == 0 ? g.Bt : (cur.src == 1 ? g.Bt2 : g.Bt3)) + (size_t)cur.pn * tstepB;
    S.a_ready(cur);
    if constexpr (SP2) {
        PG8_STAGE(PG8_SB(0, 0), cB, voffB); PG8_STAGE(PG8_SB(0, 1), cB + hstepB, voffB); PG8_STAGE(PG8_SA(0, 0), cA, voffA); PG8_STAGE(PG8_SA(0, 1), cA + hstepA, voffA);
        if (wr == 1) PG8_BAR;
        PG8_WAIT_V(2); PG8_BAR;
        PG8_STAGE(PG8_SB(1, 0), cB + kstep, voffB); PG8_STAGE(PG8_SA(1, 0), cA + kstep, voffA); PG8_STAGE(PG8_SB(1, 1), cB + hstepB + kstep, voffB);
        PG8_WAIT_V(6); PG8_BAR;
    } else {
        PG8_STAGE(PG8_SB(0, 0), cB, voffB); PG8_STAGE(PG8_SA(0, 0), cA, voffA); PG8_STAGE(PG8_SB(0, 1), cB + hstepB, voffB); PG8_STAGE(PG8_SA(0, 1), cA + hstepA, voffA);
        if (wr == 1) PG8_BAR;
        PG8_WAIT_V(4); PG8_BAR;
        PG8_STAGE(PG8_SB(1, 0), cB + kstep, voffB); PG8_STAGE(PG8_SA(1, 0), cA + kstep, voffA); PG8_STAGE(PG8_SB(1, 1), cB + hstepB + kstep, voffB);
        PG8_WAIT_V(6); PG8_BAR;
    }
    for (;;) {
        const bool has_next = S.next(ui + 1, nxt);
        const char* nA = has_next ? (const char*)(nxt.src == 0 ? g.A : (nxt.src == 1 ? g.A2 : g.A3)) + (size_t)nxt.pm * tstepA : cA; const char* nB = has_next ? (const char*)(nxt.src == 0 ? g.Bt : (nxt.src == 1 ? g.Bt2 : g.Bt3)) + (size_t)nxt.pn * tstepB : cB;
        for (int t = 0; t < nt; t += 2) {
            const bool last = (t == nt - 2);
            const char* a1 = cA + (size_t)(t + 1) * kstep;
            const char* a2 = last ? nA : cA + (size_t)(t + 2) * kstep; const char* b2 = last ? nB : cB + (size_t)(t + 2) * kstep;
            const char* a3 = a2 + kstep; const char* b3 = b2 + kstep;
            if (last && has_next) S.a_ready(nxt);
            if constexpr (SP2) {
            PG8_LDB(B0, 0, 0); PG8_LDB(B1, 0, 1); PG8_SCHED; PG8_LDA(At, 0, 0); PG8_STAGE(PG8_SA(1, 1), a1 + hstepA, voffA);
            PG8_WAIT_V(8); PG8_WAIT_L(0); PG8_BAR; PG8_MMA(0, 0, At, B0); PG8_MMA(0, 1, At, B1); PG8_BAR; PG8_SCHED;
            PG8_LDA(At, 0, 1); PG8_STAGE(PG8_SB(0, 0), b2, voffB); PG8_STAGE(PG8_SB(0, 1), b2 + hstepB, voffB); PG8_STAGE(PG8_SA(0, 0), a2, voffA);
            PG8_WAIT_V(8); PG8_WAIT_L(0); PG8_BAR; PG8_MMA(1, 0, At, B0); PG8_MMA(1, 1, At, B1); PG8_BAR; PG8_SCHED;
            PG8_LDB(B0, 1, 0); PG8_LDB(B1, 1, 1); PG8_SCHED; PG8_LDA(At, 1, 0); PG8_STAGE(PG8_SA(0, 1), a2 + hstepA, voffA);
            PG8_WAIT_V(8); PG8_WAIT_L(0); PG8_BAR; PG8_MMA(0, 0, At, B0); PG8_MMA(0, 1, At, B1); PG8_BAR; PG8_SCHED;
            PG8_LDA(At, 1, 1); PG8_STAGE(PG8_SB(1, 0), b3, voffB); PG8_STAGE(PG8_SB(1, 1), b3 + hstepB, voffB); PG8_STAGE(PG8_SA(1, 0), a3, voffA);
            PG8_WAIT_V(8); PG8_WAIT_L(0); PG8_BAR; PG8_MMA(1, 0, At, B0); PG8_MMA(1, 1, At, B1); PG8_BAR; PG8_SCHED;
            } else {
            PG8_LDB(B0, 0, 0); PG8_SCHED; PG8_LDA(At, 0, 0); PG8_STAGE(PG8_SA(1, 1), a1 + hstepA, voffA);
            PG8_WAIT_L(8); PG8_BAR; PG8_WAIT_L(0); PG8_MMA(0, 0, At, B0); PG8_BAR; PG8_SCHED;
            PG8_LDB(B1, 0, 1); PG8_STAGE(PG8_SB(0, 0), b2, voffB);
            PG8_BAR; PG8_WAIT_L(0); PG8_MMA(0, 1, At, B1); PG8_BAR;
            PG8_LDA(At, 0, 1); PG8_STAGE(PG8_SA(0, 0), a2, voffA);
            PG8_BAR; PG8_WAIT_L(0); PG8_MMA(1, 0, At, B0); PG8_BAR; PG8_SCHED;
            PG8_STAGE(PG8_SB(0, 1), b2 + hstepB, voffB);
            PG8_WAIT_V(6); PG8_BAR; PG8_MMA(1, 1, At, B1); PG8_BAR;
            PG8_LDB(B0, 1, 0); PG8_SCHED; PG8_LDA(At, 1, 0); PG8_STAGE(PG8_SA(0, 1), a2 + hstepA, voffA);
            PG8_WAIT_L(8); PG8_BAR; PG8_WAIT_L(0); PG8_MMA(0, 0, At, B0); PG8_BAR; PG8_SCHED;
            PG8_LDB(B1, 1, 1); PG8_STAGE(PG8_SB(1, 0), b3, voffB);
            PG8_BAR; PG8_WAIT_L(0); PG8_MMA(0, 1, At, B1); PG8_BAR;
            PG8_LDA(At, 1, 1); PG8_STAGE(PG8_SA(1, 0), a3, voffA);
            PG8_BAR; PG8_WAIT_L(0); PG8_MMA(1, 0, At, B0); PG8_BAR; PG8_SCHED;
            PG8_STAGE(PG8_SB(1, 1), b3 + hstepB, voffB);
            PG8_WAIT_V(6); PG8_BAR; PG8_MMA(1, 1, At, B1); PG8_BAR;
            }
        }
        if constexpr (ALIGN_EPI) { if (wr == 0) PG8_BAR; }
        if constexpr (!Epi::AFTER_DRAIN) { E(acc, cur, wr, wc, fr, fq); S.done(cur); }
        if (!has_next) break;
#pragma unroll
        for (int a = 0; a < 2; ++a)
#pragma unroll
            for (int b = 0; b < 2; ++b)
#pragma unroll
                for (int m = 0; m < 4; ++m)
#pragma unroll
                    for (int n = 0; n < 2; ++n) acc[a][b][m][n] = (f32x4){0.f, 0.f, 0.f, 0.f};
        cur = nxt; cA = nA; cB = nB; ++ui;
        if constexpr (ALIGN_EPI) { if (wr == 1) PG8_BAR; }
    }
    PG8_WAIT_V(0);
    if constexpr (!ALIGN_EPI) { if (wr == 0) PG8_BAR; }
    PG8_BAR;
    if constexpr (Epi::AFTER_DRAIN) { E.fused(acc, cur, wr, wc, fr, fq, lds, wid, lane); S.done(cur); }
#undef PG8_SA
#undef PG8_SB
#undef PG8_STAGE
#undef PG8_LDA
#undef PG8_LDB
#undef PG8_MMA
#undef PG8_WAIT_V
#undef PG8_WAIT_L
#undef PG8_BAR
#undef PG8_SCHED
}
}

#define LAS __attribute__((address_space(3)))
typedef unsigned short bf16;
typedef short bf16x8 __attribute__((ext_vector_type(8)));
typedef short s16x4 __attribute__((ext_vector_type(4)));
typedef short v4i16_t __attribute__((ext_vector_type(4)));
typedef float f32x16 __attribute__((ext_vector_type(16)));
typedef float f32x4 __attribute__((ext_vector_type(4)));
typedef float f32x2_t __attribute__((ext_vector_type(2)));
typedef __bf16 bf16x2_t __attribute__((ext_vector_type(2)));
typedef unsigned u32x4 __attribute__((ext_vector_type(4)));
typedef unsigned u32x2 __attribute__((ext_vector_type(2)));

constexpr int D = 1024, SEQ = 2048, NB = 8, M = NB * SEQ, NMEM = 256, MMEM = NB * NMEM, DIN = 6656, DFF = 2816;
constexpr int LDQ = 6656;
constexpr int C_AQ = 0, C_AK = 512, C_AV = 1024, C_BQ = 1536, C_BK = 3072, C_BV = 4608, C_CQ = 6144;
constexpr int C_GATE = 3072;
constexpr int C_H2 = 0, C_ACT = 1024;
constexpr float L2E = 1.4426950408889634f;
constexpr float EPS = 1e-6f;

constexpr size_t WS_WIN = 0;
constexpr size_t WS_WG = WS_WIN + (size_t)DIN * D * 2;
constexpr size_t WS_WMEM = WS_WG + (size_t)3 * D * D * 2;
constexpr size_t WS_WBR = WS_WMEM + (size_t)D * D * 2;
constexpr size_t WS_WOUT3 = WS_WBR + (size_t)3 * D * 512 * 2;
constexpr size_t WS_WGU = WS_WOUT3 + (size_t)D * 3 * D * 2;
constexpr size_t WS_WDN = WS_WGU + (size_t)2 * DFF * D * 2;
constexpr size_t WS_LB = WS_WDN + (size_t)D * DFF * 2;
constexpr size_t WS_R = WS_LB + (size_t)3 * M * 4 * 4;
constexpr size_t WS_BAR = WS_R + (size_t)M * LDQ * 2;
constexpr size_t WS_SSQ = WS_BAR + 16384;
constexpr size_t WS_END = WS_SSQ + (size_t)M * 4;
static_assert(WS_END <= (size_t)256 * 1024 * 1024, "d_ws map");
constexpr size_t DO_XN = 0;
constexpr size_t DO_MN = DO_XN + (size_t)M * D * 2;
constexpr size_t DO_CKV = DO_MN + (size_t)MMEM * D * 2;
static_assert(DO_CKV + (size_t)MMEM * D * 2 <= (size_t)M * D * 4, "d_out scratch map");

constexpr int LDS_BYTES = 155648;
constexpr int XCH_OFF = 131072, GT_OFF = 131072 + 8192;
constexpr int MISC_OFF = LDS_BYTES - 64;
constexpr int KP = 272, VP = 320;

__device__ __forceinline__ unsigned cvtpk(float lo, float hi) { f32x2_t v = {lo, hi}; bf16x2_t b = __builtin_convertvector(v, bf16x2_t); return __builtin_bit_cast(unsigned, b); }
__device__ __forceinline__ float wave_sum(float v) {
    v += pg8::shx<1>(v); v += pg8::shx<2>(v); v += pg8::shx<4>(v); v += pg8::shx<8>(v); v += pg8::shx<16>(v); v = pg8::sum_halves(v);
    return v;
}
__device__ __forceinline__ float wave_max(float v) {
    v = fmaxf(v, pg8::shx<1>(v)); v = fmaxf(v, pg8::shx<2>(v)); v = fmaxf(v, pg8::shx<4>(v)); v = fmaxf(v, pg8::shx<8>(v)); v = fmaxf(v, pg8::shx<16>(v)); v = pg8::max_halves(v);
    return v;
}
__device__ __forceinline__ float absmax_vec(const float* g, int n, int lane) {
    float v = fabsf(g[lane]); if (n > 64) v = fmaxf(v, fabsf(g[lane + 64]));
    return wave_max(v);
}

__device__ __forceinline__ void tr_item(const float* W, int N, int k0, int n0, bf16* WT, int dst_pitch, int dst_row0, int dst_k0, int ncopies, int copy_stride, LAS float* scr, int lane) {
#pragma unroll 8
    for (int i = 0; i < 32; ++i) { const int kk = 2 * i + (lane >> 5); scr[kk * 33 + (lane & 31)] = __builtin_nontemporal_load(W + (size_t)(k0 + kk) * N + n0 + (lane & 31)); }
    asm volatile("s_waitcnt lgkmcnt(0)" ::: "memory");
    const int c = lane & 7;
#pragma unroll
    for (int j = 0; j < 4; ++j) { const int n = (lane >> 3) + 8 * j; const LAS float* s = scr + (8 * c) * 33 + n;
        u32x4 o; o.x = cvtpk(s[0 * 33], s[1 * 33]); o.y = cvtpk(s[2 * 33], s[3 * 33]); o.z = cvtpk(s[4 * 33], s[5 * 33]); o.w = cvtpk(s[6 * 33], s[7 * 33]);
        bf16* dst = WT + (size_t)(dst_row0 + n0 + n) * dst_pitch + dst_k0 + k0 + 8 * c;
        for (int cp = 0; cp < ncopies; ++cp) *(u32x4*)(dst + (size_t)cp * copy_stride) = o; }
    asm volatile("s_waitcnt lgkmcnt(0)" ::: "memory");
}
__device__ __forceinline__ void rms_row_to_bf16(const float* xrow, const float* gain, bf16* orow, int lane) {
    const f32x4* xr = (const f32x4*)xrow + lane; const f32x4* gr = (const f32x4*)gain + lane;
    f32x4 v[4]; float s = 0.f;
#pragma unroll
    for (int j = 0; j < 4; ++j) { v[j] = xr[64 * j]; s += (v[j][0] * v[j][0] + v[j][1] * v[j][1]) + (v[j][2] * v[j][2] + v[j][3] * v[j][3]); }
    const float rstd = 1.f / sqrtf(wave_sum(s) * (1.f / 1024.f) + EPS);
    u32x2* o8 = (u32x2*)orow + lane;
#pragma unroll
    for (int j = 0; j < 4; ++j) { const f32x4 g = gr[64 * j]; u32x2 w; w.x = cvtpk(v[j][0] * rstd * g[0], v[j][1] * rstd * g[1]); w.y = cvtpk(v[j][2] * rstd * g[2], v[j][3] * rstd * g[3]); o8[64 * j] = w; }
}

__device__ __forceinline__ s16x4 vtr(const LAS char* p) { return __builtin_bit_cast(s16x4, __builtin_amdgcn_ds_read_tr16_b64_v4i16((LAS v4i16_t*)p)); }

template <int NK>
__device__ __forceinline__ void qk32(f32x16& S, const LAS char* Kp, const bf16x8* Q, int ks0, int r32, int hi) {
    const LAS char* kb = Kp + r32 * KP + hi * 16 + ks0 * 32;
#pragma unroll
    for (int ks = 0; ks < NK; ++ks) { const bf16x8 kf = *(const LAS bf16x8*)(kb + ks * 32); S = __builtin_amdgcn_mfma_f32_32x32x16_bf16(kf, Q[ks0 + ks], S, 0, 0, 0); }
}
__device__ __forceinline__ void pv32(f32x16 (&O)[4], const bf16x8 (&P)[2], const LAS char* Vp, int lane) {
    const int i = lane & 15, q = i >> 2, p = i & 3, dsel = (lane >> 4) & 1, h = lane >> 5;
    const LAS char* vb = Vp + (4 * h + q) * VP + (16 * dsel + 4 * p) * 2;
#pragma unroll
    for (int s = 0; s < 2; ++s)
#pragma unroll
        for (int db = 0; db < 4; ++db) {
            const s16x4 lo = vtr(vb + (16 * s) * VP + db * 64), hi4 = vtr(vb + (16 * s + 8) * VP + db * 64);
            const bf16x8 a = (bf16x8){lo[0], lo[1], lo[2], lo[3], hi4[0], hi4[1], hi4[2], hi4[3]};
            O[db] = __builtin_amdgcn_mfma_f32_32x32x16_bf16(a, P[s], O[db], 0, 0, 0);
        }
}
struct VFrag { bf16x8 a[2][4]; };
__device__ __forceinline__ void vload32(VFrag& f, const LAS char* Vp, int lane) {
    const int i = lane & 15, q = i >> 2, p = i & 3, dsel = (lane >> 4) & 1, h = lane >> 5;
    const LAS char* vb = Vp + (4 * h + q) * VP + (16 * dsel + 4 * p) * 2;
#pragma unroll
    for (int s = 0; s < 2; ++s)
#pragma unroll
        for (int db = 0; db < 4; ++db) { const s16x4 lo = vtr(vb + (16 * s) * VP + db * 64), hi4 = vtr(vb + (16 * s + 8) * VP + db * 64);
            f.a[s][db] = (bf16x8){lo[0], lo[1], lo[2], lo[3], hi4[0], hi4[1], hi4[2], hi4[3]}; }
}
template <int SS>
__device__ __forceinline__ void vload16(VFrag& f, const LAS char* Vp, int lane) {
    const int i = lane & 15, q = i >> 2, p = i & 3, dsel = (lane >> 4) & 1, h = lane >> 5;
    const LAS char* vb = Vp + (4 * h + q) * VP + (16 * dsel + 4 * p) * 2;
#pragma unroll
    for (int db = 0; db < 4; ++db) { const s16x4 lo = vtr(vb + (16 * SS) * VP + db * 64), hi4 = vtr(vb + (16 * SS + 8) * VP + db * 64);
        f.a[SS][db] = (bf16x8){lo[0], lo[1], lo[2], lo[3], hi4[0], hi4[1], hi4[2], hi4[3]}; }
}
__device__ __forceinline__ void pvmm32(f32x16 (&O)[4], const bf16x8 (&P)[2], const VFrag& f) {
#pragma unroll
    for (int s = 0; s < 2; ++s)
#pragma unroll
        for (int db = 0; db < 4; ++db) O[db] = __builtin_amdgcn_mfma_f32_32x32x16_bf16(f.a[s][db], P[s], O[db], 0, 0, 0);
}
template <int NK>
__device__ __forceinline__ void kload32(bf16x8 (&kf)[NK], const LAS char* Kp, int r32, int hi) {
    const LAS char* kb = Kp + r32 * KP + hi * 16;
#pragma unroll
    for (int ks = 0; ks < NK; ++ks) kf[ks] = *(const LAS bf16x8*)(kb + ks * 32);
}
template <int NK>
__device__ __forceinline__ void qkmm32(f32x16& S, const bf16x8 (&kf)[NK], const bf16x8* Q) {
#pragma unroll
    for (int ks = 0; ks < NK; ++ks) S = __builtin_amdgcn_mfma_f32_32x32x16_bf16(kf[ks], Q[ks], S, 0, 0, 0);
}
#define SCHED_FENCE() __builtin_amdgcn_sched_barrier(0)
template <int MODE>
__device__ __forceinline__ void soft32(const f32x16& S, bf16x8 (&P)[2], float& l, float dbase, float nslope) {
    float p[16];
#pragma unroll
    for (int r = 0; r < 16; ++r) {
        float s = S[r];
        if (MODE >= 1) { const float a = fabsf(dbase - (float)((r & 3) + 8 * (r >> 2))); s = fmaf(nslope, a, s); float e = __builtin_amdgcn_exp2f(s); if (MODE == 2) e = (a <= 64.f) ? e : 0.f; p[r] = e; }
        else p[r] = __builtin_amdgcn_exp2f(s);
        l += p[r];
    }
#pragma unroll
    for (int s = 0; s < 2; ++s) { u32x4 w; w.x = cvtpk(p[8 * s + 0], p[8 * s + 1]); w.y = cvtpk(p[8 * s + 2], p[8 * s + 3]); w.z = cvtpk(p[8 * s + 4], p[8 * s + 5]); w.w = cvtpk(p[8 * s + 6], p[8 * s + 7]); P[s] = __builtin_bit_cast(bf16x8, w); }
}
__device__ __forceinline__ void zero16(f32x16& v) {
#pragma unroll
    for (int r = 0; r < 16; ++r) v[r] = 0.f;
}

__device__ __forceinline__ void stage_put(LAS char* wl, int r32, int hi2, int db, int g4, u32x2 w) { *(LAS u32x2*)(wl + r32 * 272 + (32 * db + 8 * g4 + 4 * hi2) * 2) = w; }
__device__ __forceinline__ void stage_flush(const LAS char* wl, bf16* qbase, size_t row_stride, int lane) {
    asm volatile("s_waitcnt lgkmcnt(0)" ::: "memory");
#pragma unroll
    for (int i = 0; i < 8; ++i) { const int row = 4 * i + (lane >> 4); const u32x4 v = *(const LAS u32x4*)(wl + row * 272 + (lane & 15) * 16);
        *(u32x4*)(qbase + (size_t)row * row_stride + (lane & 15) * 8) = v; }
}
template <int NC, bool DIAG>
__device__ __forceinline__ void attn_tile(f32x16 (&O)[4], float& l, const bf16x8* Q, const LAS char* Kb, const LAS char* Vb, int r32, int hi, int lane, float qd, int k0, int qw, float nslope, float negM0) {
    constexpr int NQ = (NC == 2) ? 4 : 8;
    f32x16 S0, S1; bf16x8 P0[2], P1[2];
    const int k1 = k0 + 32;
    if (NC == 2) {
        const float ns0 = (k0 < qw) ? nslope : ((k0 > qw) ? -nslope : 0.f), ns1 = (k1 < qw) ? nslope : ((k1 > qw) ? -nslope : 0.f);
        const float b0 = fmaf(ns0, qd - (float)k0, negM0), b1 = fmaf(ns1, qd - (float)k1, negM0);
#pragma unroll
        for (int r = 0; r < 16; ++r) { S0[r] = fmaf(-ns0, (float)((r & 3) + 8 * (r >> 2)), b0); S1[r] = fmaf(-ns1, (float)((r & 3) + 8 * (r >> 2)), b1); }
    } else {
#pragma unroll
        for (int r = 0; r < 16; ++r) { S0[r] = negM0; S1[r] = negM0; }
    }
    VFrag vf0, vf1;
    if (NC == 2) {
        bf16x8 kf0[NQ], kf1[NQ];
        kload32<NQ>(kf0, Kb, r32, hi);
        SCHED_FENCE();
        qkmm32<NQ>(S0, kf0, Q);
        kload32<NQ>(kf1, Kb + 32 * KP, r32, hi);
        vload16<0>(vf0, Vb, lane);
        SCHED_FENCE();
        qkmm32<NQ>(S1, kf1, Q);
        if (DIAG) { const float nd = (k0 == qw) ? nslope : 0.f;
#pragma unroll
            for (int r = 0; r < 16; ++r) S0[r] = fmaf(nd, fabsf(qd - (float)k0 - (float)((r & 3) + 8 * (r >> 2))), S0[r]); }
        soft32<0>(S0, P0, l, 0.f, 0.f);
        vload16<1>(vf0, Vb, lane);
        SCHED_FENCE();
    } else {
        bf16x8 kf[NQ];
        kload32<NQ>(kf, Kb, r32, hi);
        SCHED_FENCE();
        qkmm32<NQ>(S0, kf, Q);
        kload32<NQ>(kf, Kb + 32 * KP, r32, hi);
        vload32(vf0, Vb, lane);
        SCHED_FENCE();
        qkmm32<NQ>(S1, kf, Q);
        soft32<0>(S0, P0, l, 0.f, 0.f);
        SCHED_FENCE();
    }
    pvmm32(O, P0, vf0);
    if (NC == 2 && DIAG) { const float nd = (k1 == qw) ? nslope : 0.f;
#pragma unroll
        for (int r = 0; r < 16; ++r) S1[r] = fmaf(nd, fabsf(qd - (float)k1 - (float)((r & 3) + 8 * (r >> 2))), S1[r]); }
    soft32<0>(S1, P1, l, 0.f, 0.f);
    if (NC == 2) {
    vload16<0>(vf1, Vb + 32 * VP, lane);
    SCHED_FENCE();
    vload16<1>(vf1, Vb + 32 * VP, lane);
    } else {
    vload32(vf1, Vb + 32 * VP, lane);
    SCHED_FENCE();
    }
    pvmm32(O, P1, vf1);
}

template <int NC>
__device__ __forceinline__ void attn_shared_unit(LAS char* lds, bf16* qbase, const bf16* Kg, const bf16* Vg, int kvp, int nt, int qpos, int qw, float nslope, float negM0, float lam, const float* subln, int wave_id) {
    const int wv = wave_id, tid = pg8::tid_fresh(wave_id);
    const int lane = tid & 63, r32 = lane & 31, hi = lane >> 5;
    const int cm = (NC == 2) ? (wv & 1) : 0;
    constexpr int NQ = (NC == 2) ? 4 : 8;
    bf16x8 Q[NQ];
    { const bf16* qrow0 = qbase + (size_t)r32 * LDQ;
#pragma unroll
    for (int ks = 0; ks < NQ; ++ks) Q[ks] = *(const bf16x8*)(qrow0 + cm * 64 + 16 * ks + 8 * hi); }
    f32x16 O[4]; float l = 0.f;
#pragma unroll
    for (int db = 0; db < 4; ++db) zero16(O[db]);
    const int lrow = tid >> 3, lcb = (tid & 7) * 32;
    const char* kgp = (const char*)(Kg + (size_t)lrow * kvp) + lcb; const char* vgp = (const char*)(Vg + (size_t)lrow * kvp) + lcb;
    const size_t tstep = (size_t)64 * kvp * 2;
    u32x4 ka0, ka1, va0, va1, kb0, kb1, vb0, vb1;
#define LOADA(tt) do { const char* kp_ = kgp + (size_t)(tt) * tstep; const char* vp_ = vgp + (size_t)(tt) * tstep; ka0 = *(const u32x4*)kp_; ka1 = *(const u32x4*)(kp_ + 16); va0 = *(const u32x4*)vp_; va1 = *(const u32x4*)(vp_ + 16); } while (0)
#define LOADB(tt) do { const char* kp_ = kgp + (size_t)(tt) * tstep; const char* vp_ = vgp + (size_t)(tt) * tstep; kb0 = *(const u32x4*)kp_; kb1 = *(const u32x4*)(kp_ + 16); vb0 = *(const u32x4*)vp_; vb1 = *(const u32x4*)(vp_ + 16); } while (0)
#define WRITEA(buf) do { LAS char* kw_ = lds + (buf) * BUFB + lrow * KP + lcb; LAS char* vw_ = lds + (buf) * BUFB + 64 * KP + lrow * VP + lcb; *(LAS u32x4*)kw_ = ka0; *(LAS u32x4*)(kw_ + 16) = ka1; *(LAS u32x4*)vw_ = va0; *(LAS u32x4*)(vw_ + 16) = va1; } while (0)
#define WRITEB(buf) do { LAS char* kw_ = lds + (buf) * BUFB + lrow * KP + lcb; LAS char* vw_ = lds + (buf) * BUFB + 64 * KP + lrow * VP + lcb; *(LAS u32x4*)kw_ = kb0; *(LAS u32x4*)(kw_ + 16) = kb1; *(LAS u32x4*)vw_ = vb0; *(LAS u32x4*)(vw_ + 16) = vb1; } while (0)
    constexpr int BUFB = 64 * KP + 64 * VP;
    const float qd = (float)(qpos - 4 * hi);
    const int td = qw >> 6;
    if (NC == 2) {
    const int qb0 = qw & ~127;
    const float dkf = 152.f / fmaxf(-nslope, 1e-6f);
    const int Dk = (dkf < 4096.f) ? (int)dkf + 1 : 4096;
    int t_lo = ((qb0 - Dk > 0) ? (qb0 - Dk) : 0) >> 6, t_hi = ((qb0 + 127 + Dk) >> 6) + 1;
    t_lo &= ~1; t_hi = (t_hi + 1) & ~1; if (t_hi > nt) t_hi = nt;
    LOADA(t_lo); LOADB(t_lo + 1);
    __syncthreads();
    WRITEA(0);
    __syncthreads();
#pragma unroll 1
    for (int t = t_lo; t < t_hi; t += 2) {
        {
            if (t + 2 < t_hi) LOADA(t + 2);
            int k0v = t * 64; asm volatile("" : "+s"(k0v));
            const LAS char* Kb = lds + cm * 128; const LAS char* Vb = lds + 64 * KP;
            if (t == td) attn_tile<NC, true>(O, l, Q, Kb, Vb, r32, hi, lane, qd, k0v, qw, nslope, negM0);
            else attn_tile<NC, false>(O, l, Q, Kb, Vb, r32, hi, lane, qd, k0v, qw, nslope, negM0);
            WRITEB(1);
            __syncthreads();
        }
        {
            if (t + 3 < t_hi) LOADB(t + 3);
            int k0v = (t + 1) * 64; asm volatile("" : "+s"(k0v));
            const LAS char* Kb = lds + BUFB + cm * 128; const LAS char* Vb = lds + BUFB + 64 * KP;
            if (t + 1 == td) attn_tile<NC, true>(O, l, Q, Kb, Vb, r32, hi, lane, qd, k0v, qw, nslope, negM0);
            else attn_tile<NC, false>(O, l, Q, Kb, Vb, r32, hi, lane, qd, k0v, qw, nslope, negM0);
            if (t + 2 < t_hi) WRITEA(0);
            __syncthreads();
        }
    }
    } else {
    LOADA(0);
    __syncthreads();
    WRITEA(0);
    __syncthreads();
#pragma unroll 1
    for (int t = 0; t < nt; ++t) {
        const bool more = (t + 1 < nt);
        if (more) LOADA(t + 1);
        int k0v = t * 64; asm volatile("" : "+s"(k0v));
        const LAS char* Kb = lds + (t & 1) * BUFB; const LAS char* Vb = lds + (t & 1) * BUFB + 64 * KP;
        attn_tile<NC, false>(O, l, Q, Kb, Vb, r32, hi, lane, qd, k0v, qw, nslope, negM0);
        if (more) WRITEA((t + 1) & 1);
        __syncthreads();
    }
    }
#undef LOADA
#undef LOADB
#undef WRITEA
#undef WRITEB
    const int lane2 = pg8::lane_id_fresh(), hi2 = lane2 >> 5;
    bf16* qrow = qbase + (size_t)(lane2 & 31) * LDQ;
    l = pg8::sum_halves(l);
    if (NC == 2) {
        LAS float* XO = (LAS float*)lds + (wv >> 1) * 4096 + lane2;
        if (cm == 1) { const float i2 = *(const LAS float*)(lds + (LDS_BYTES - 64 + 32)) * __builtin_amdgcn_rcpf(l);
#pragma unroll
            for (int db = 0; db < 4; ++db)
#pragma unroll
                for (int r = 0; r < 16; ++r) XO[(db * 16 + r) * 64] = O[db][r] * i2; }
        __syncthreads();
        if (cm == 0) {
            const float i1 = 1.f / l; float ss = 0.f;
#pragma unroll
            for (int db = 0; db < 4; ++db)
#pragma unroll
                for (int r = 0; r < 16; ++r) { const float o = O[db][r] * i1 - XO[(db * 16 + r) * 64]; O[db][r] = o; ss += o * o; }
            ss = pg8::sum_halves(ss);
            const float rstd = (1.f / sqrtf(ss * (1.f / 128.f) + EPS)) * 0.8f;
#pragma unroll
            for (int db = 0; db < 4; ++db)
#pragma unroll
                for (int g4 = 0; g4 < 4; ++g4) { const int d = 32 * db + 8 * g4 + 4 * hi2; const f32x4 gn = *(const f32x4*)(subln + d);
                    u32x2 w; w.x = cvtpk(O[db][4 * g4 + 0] * rstd * gn[0], O[db][4 * g4 + 1] * rstd * gn[1]); w.y = cvtpk(O[db][4 * g4 + 2] * rstd * gn[2], O[db][4 * g4 + 3] * rstd * gn[3]);
                    stage_put(lds + (wv >> 1) * 16384, lane2 & 31, hi2, db, g4, w); (void)d; }
            stage_flush(lds + (wv >> 1) * 16384, qbase, LDQ, lane2);
        }
    } else {
        const float i1 = 1.f / l;
#pragma unroll
        for (int db = 0; db < 4; ++db)
#pragma unroll
            for (int g4 = 0; g4 < 4; ++g4) { const int d = 32 * db + 8 * g4 + 4 * hi2;
                u32x2 w; w.x = cvtpk(O[db][4 * g4 + 0] * i1, O[db][4 * g4 + 1] * i1); w.y = cvtpk(O[db][4 * g4 + 2] * i1, O[db][4 * g4 + 3] * i1);
                stage_put(lds + wv * 8704, lane2 & 31, hi2, db, g4, w); (void)d; }
        stage_flush(lds + wv * 8704, qbase, LDQ, lane2);
    }
}

template <bool SEG2>
__device__ __forceinline__ void attn_b_block_unit(LAS char* lds, bf16* R, float* LB, int b, int g, int j, int res0, int q0, int dil, float nslope, float negM0, int wave_id) {
    const int tid = pg8::tid_fresh(wave_id), lane = tid & 63, r32 = lane & 31, hi = lane >> 5;
    const int sub_len = SEQ / dil, hcol = (g * 4 + j) * 128;
    const int wres = SEG2 ? res0 + (wave_id >> 2) : res0;
    const int qs = SEG2 ? 32 * (wave_id & 3) : q0 + 32 * wave_id;
    const size_t rowb = (size_t)b * SEQ;
    bf16x8 Q[8];
    { const bf16* qr = R + (rowb + (size_t)(qs + r32) * dil + wres) * LDQ + C_BQ + hcol;
#pragma unroll
      for (int ks = 0; ks < 8; ++ks) Q[ks] = *(const bf16x8*)(qr + 16 * ks + 8 * hi); }
    f32x16 O[4]; float l = 0.f;
#pragma unroll
    for (int db = 0; db < 4; ++db) zero16(O[db]);
    constexpr int TK = SEG2 ? 32 : 64;
    const int k_lo = SEG2 ? 0 : ((q0 - 64 > 0) ? q0 - 64 : 0), k_hi = SEG2 ? 128 : ((q0 + 320 < sub_len) ? q0 + 320 : sub_len);
    const int nsteps = (k_hi - k_lo) / TK;
    const int lrow = tid >> 3, lcb = (tid & 7) * 32;
    const int lres = SEG2 ? res0 + (lrow >> 5) : res0, lkey = SEG2 ? (lrow & 31) : lrow;
    const char* kg = (const char*)(R + (rowb + (size_t)(k_lo + lkey) * dil + lres) * LDQ + C_BK + hcol) + lcb;
    const size_t sstep = (size_t)TK * dil * LDQ * 2;
    constexpr int VOFF = (C_BV - C_BK) * 2, BUFB = 64 * KP + 64 * VP;
    u32x4 kr0, kr1, vr0, vr1;
    kr0 = *(const u32x4*)kg; kr1 = *(const u32x4*)(kg + 16); vr0 = *(const u32x4*)(kg + VOFF); vr1 = *(const u32x4*)(kg + VOFF + 16);
    __syncthreads();
    { LAS char* kw = lds + lrow * KP + lcb; LAS char* vw = lds + 64 * KP + lrow * VP + lcb;
      *(LAS u32x4*)kw = kr0; *(LAS u32x4*)(kw + 16) = kr1; *(LAS u32x4*)vw = vr0; *(LAS u32x4*)(vw + 16) = vr1; }
    __syncthreads();
    const float qf = (float)(qs + r32 - 4 * hi);
#pragma unroll 1
    for (int s = 0; s < nsteps; ++s) {
        const bool more = (s + 1 < nsteps);
        if (more) { const char* kp = kg + (size_t)(s + 1) * sstep; kr0 = *(const u32x4*)kp; kr1 = *(const u32x4*)(kp + 16); vr0 = *(const u32x4*)(kp + VOFF); vr1 = *(const u32x4*)(kp + VOFF + 16); }
        const int kb = k_lo + s * TK;
        const LAS char* Kb = lds + (s & 1) * BUFB; const LAS char* Vb = Kb + 64 * KP;
#pragma unroll
        for (int hh = 0; hh < (SEG2 ? 1 : 2); ++hh) {
            const int row0 = SEG2 ? 32 * (wave_id >> 2) : 32 * hh, kbase = SEG2 ? kb : kb + 32 * hh;
            if (kbase + 31 >= qs - 64 && kbase <= qs + 95) {
                f32x16 S;
#pragma unroll
                for (int r = 0; r < 16; ++r) S[r] = negM0;
                qk32<8>(S, Kb + row0 * KP, Q, 0, r32, hi);
                bf16x8 P[2];
                soft32<2>(S, P, l, qf - (float)kbase, nslope);
                pv32(O, P, Vb + row0 * VP, lane);
            }
        }
        if (more) { LAS char* kw = lds + ((s + 1) & 1) * BUFB + lrow * KP + lcb; LAS char* vw = lds + ((s + 1) & 1) * BUFB + 64 * KP + lrow * VP + lcb;
            *(LAS u32x4*)kw = kr0; *(LAS u32x4*)(kw + 16) = kr1; *(LAS u32x4*)vw = vr0; *(LAS u32x4*)(vw + 16) = vr1; }
        __syncthreads();
    }
    const int lane2 = pg8::lane_id_fresh(), hi2 = lane2 >> 5;
    const size_t qrow_i = rowb + (size_t)(qs + (lane2 & 31)) * dil + wres;
    bf16* qrow = R + qrow_i * LDQ + C_BQ + hcol;
    l = pg8::sum_halves(l);
    const float i1 = 1.f / l;
#pragma unroll
    for (int db = 0; db < 4; ++db)
#pragma unroll
        for (int g4 = 0; g4 < 4; ++g4) { const int d = 32 * db + 8 * g4 + 4 * hi2;
            u32x2 w; w.x = cvtpk(O[db][4 * g4 + 0] * i1, O[db][4 * g4 + 1] * i1); w.y = cvtpk(O[db][4 * g4 + 2] * i1, O[db][4 * g4 + 3] * i1);
            stage_put(lds + wave_id * 8704, lane2 & 31, hi2, db, g4, w); (void)d; }
    stage_flush(lds + wave_id * 8704, R + (rowb + (size_t)qs * dil + wres) * LDQ + C_BQ + hcol, (size_t)dil * LDQ, lane2);
    if (hi2 == 0) LB[((size_t)g * M + qrow_i) * 4 + j] = l;
}

#define XB_TMO      128
#define XB_XCNT(j)  (256  + 64 * (j))
#define XB_XSUB(j)  (1280 + 64 * (j))
#define XB_XGEN(j)  (2304 + 64 * (j))
#define XB_TOP      3328
#define XB_TOPGEN   3392
#define XCD_BAR_WORDS 3456
#define XB_SPIN_CAP (1u << 18)

__device__ __forceinline__ unsigned xb_ld(unsigned* p)              { return __hip_atomic_load(p, __ATOMIC_RELAXED, __HIP_MEMORY_SCOPE_AGENT); }
__device__ __forceinline__ unsigned xb_add(unsigned* p, unsigned v) { return __hip_atomic_fetch_add(p, v, __ATOMIC_RELAXED, __HIP_MEMORY_SCOPE_AGENT); }
__device__ __forceinline__ unsigned xb_xcc_id() { return (unsigned)__builtin_amdgcn_s_getreg((3 << 11) | 20) & 0xFu; }
#define XB_SPIN(cond, bar) do { unsigned _sp = 0; while (cond) { __builtin_amdgcn_s_sleep(1); \
    if ((++_sp & 255u) == 0u) { if (xb_ld(&(bar)[XB_TMO])) break; if (_sp > XB_SPIN_CAP) { atomicAdd(&(bar)[XB_TMO], 1u); break; } } } } while (0)

struct XcdBarrier {
    unsigned* bar; unsigned x;
    volatile LAS unsigned* st;
};

__device__ __forceinline__ XcdBarrier xcd_barrier_post(unsigned* bar, volatile LAS unsigned* st) {
    XcdBarrier b; b.bar = bar; b.x = xb_xcc_id(); b.st = st;
    if (threadIdx.x == 0) (void)xb_add(&bar[XB_XCNT(b.x)], 1u);
    return b;
}
__device__ __forceinline__ void xcd_barrier_complete(unsigned* bar, unsigned x, unsigned& nloc, unsigned& nx) {
    const unsigned G = gridDim.x * gridDim.y * gridDim.z;
    unsigned sum, cnt, mine, sp = 0u;
    for (;;) {
        sum = 0u; cnt = 0u; mine = 0u;
#pragma unroll
        for (unsigned j = 0; j < 16; ++j) { const unsigned c = xb_ld(&bar[XB_XCNT(j)]); sum += c; cnt += (c > 0u) ? 1u : 0u; mine = (j == x) ? c : mine; }
        if (sum == G) break;
        __builtin_amdgcn_s_sleep(1);
        if ((++sp & 255u) == 0u) { if (xb_ld(&bar[XB_TMO])) break; if (sp > XB_SPIN_CAP) { atomicAdd(&bar[XB_TMO], 1u); break; } }
    }
    nloc = mine > 0u ? mine : 1u; nx = cnt > 0u ? cnt : 1u;
}

__device__ __forceinline__ void xcd_barrier(const XcdBarrier& b, int wave_id) {
    asm volatile("s_waitcnt vmcnt(0)" ::: "memory");
    __syncthreads();
    if (pg8::tid_fresh(wave_id) == 0) {
        unsigned* bar = b.bar;
        __builtin_amdgcn_s_waitcnt(0);
        unsigned nloc = b.st[0], nx = b.st[1];
        if (nloc == 0u) { xcd_barrier_complete(bar, b.x, nloc, nx); b.st[0] = nloc; b.st[1] = nx; }
        const unsigned old = xb_add(&bar[XB_XSUB(b.x)], 1u);
        const unsigned gen = old / nloc;
        if (old + 1u == (gen + 1u) * nloc) {
            __builtin_amdgcn_fence(__ATOMIC_RELEASE, "agent");
            asm volatile("s_waitcnt vmcnt(0)" ::: "memory");
            const unsigned og = xb_add(&bar[XB_TOP], 1u);
            const unsigned tg = og / nx;
            if (og + 1u == (tg + 1u) * nx) xb_add(&bar[XB_TOPGEN], 1u);
            else XB_SPIN(xb_ld(&bar[XB_TOPGEN]) == tg, bar);
            __builtin_amdgcn_fence(__ATOMIC_ACQUIRE, "agent");
            xb_add(&bar[XB_XGEN(b.x)], 1u);
            asm volatile("s_waitcnt vmcnt(0)" ::: "memory");
        } else {
            XB_SPIN(xb_ld(&bar[XB_XGEN(b.x)]) == gen, bar);
            __builtin_amdgcn_fence(__ATOMIC_ACQUIRE, "agent");
            asm volatile("s_waitcnt vmcnt(0)" ::: "memory");
        }
    }
    __syncthreads();
}

struct Args { const float* in[25]; float* out; unsigned char* ws; };

__global__ void __launch_bounds__(512, 2) fwd_megakernel(Args a) {
    extern __shared__ __attribute__((aligned(16))) unsigned char lds_raw[];
    LAS unsigned char* lds = (LAS unsigned char*)lds_raw;
    cg::grid_group grid = cg::this_grid();
    const int wave = __builtin_amdgcn_readfirstlane((int)threadIdx.x >> 6);
#define FRESH_LANE const int lane = pg8::lane_id_fresh();
    const int G = gridDim.x, bid = blockIdx.x;
    const int gw = bid * 8 + wave, NGW = G * 8;
    unsigned char* ws = a.ws;
    const float* x = a.in[0]; const float* mem = a.in[1];
    bf16* W_IN = (bf16*)(ws + WS_WIN); bf16* W_G = (bf16*)(ws + WS_WG); bf16* W_MEM = (bf16*)(ws + WS_WMEM); bf16* W_BR = (bf16*)(ws + WS_WBR);
    bf16* W_OUT = (bf16*)(ws + WS_WOUT3); bf16* W_GU = (bf16*)(ws + WS_WGU); bf16* W_DN = (bf16*)(ws + WS_WDN);
    float* LB = (float*)(ws + WS_LB); bf16* R = (bf16*)(ws + WS_R);
    unsigned char* dob = (unsigned char*)a.out;
    bf16* XN = (bf16*)(dob + DO_XN); bf16* MN = (bf16*)(dob + DO_MN); bf16* CKV = (bf16*)(dob + DO_CKV);

    volatile LAS unsigned* MISC = (volatile LAS unsigned*)(lds + MISC_OFF);
    unsigned* barw = (unsigned*)(ws + WS_BAR);
    if (threadIdx.x < 16) MISC[threadIdx.x] = 0u;
    if (a.ws == nullptr) grid.sync();
    XcdBarrier bar = xcd_barrier_post(barw, MISC);
    __syncthreads();
    {
        FRESH_LANE
        LAS float* scr = (LAS float*)(lds + wave * 8704);
        constexpr int I_IN = 16 * (DIN / 32), I_MEM = 16 * (D / 32);
        for (int it = gw; it < I_IN + I_MEM; it += NGW) {
            int r = it;
            if (r < I_IN) { const int nb = DIN / 32; tr_item(a.in[3], DIN, 64 * (r / nb), 32 * (r % nb), W_IN, D, 0, 0, 1, 0, scr, lane); continue; } r -= I_IN;
            { const int nb = D / 32; tr_item(a.in[16], D, 64 * (r / nb), 32 * (r % nb), W_MEM, D, 0, 0, 1, 0, scr, lane); }
        }
        { float* SSQ0 = (float*)(ws + WS_SSQ); for (int i = gw * 64 + lane; i < M; i += NGW * 64) SSQ0[i] = 0.f; }
        for (int m0 = gw; m0 < M + MMEM; m0 += 3 * NGW) {
            f32x4 v[3][4]; float ssq[3];
#pragma unroll
            for (int q = 0; q < 3; ++q) { const int m = m0 + q * NGW; ssq[q] = 0.f;
                if (m < M + MMEM) { const f32x4* xr = (const f32x4*)((m < M) ? x + (size_t)m * D : mem + (size_t)(m - M) * D) + lane;
#pragma unroll
                    for (int j = 0; j < 4; ++j) v[q][j] = __builtin_nontemporal_load(xr + 64 * j); } }
#pragma unroll
            for (int q = 0; q < 3; ++q) { const int m = m0 + q * NGW;
                if (m < M + MMEM) {
                    float s = 0.f;
#pragma unroll
                    for (int j = 0; j < 4; ++j) s += (v[q][j][0] * v[q][j][0] + v[q][j][1] * v[q][j][1]) + (v[q][j][2] * v[q][j][2] + v[q][j][3] * v[q][j][3]);
                    const float rstd = 1.f / sqrtf(wave_sum(s) * (1.f / 1024.f) + EPS);
                    const f32x4* gr = (const f32x4*)((m < M) ? a.in[2] : a.in[15]) + lane;
                    u32x2* o8 = (u32x2*)((m < M) ? XN + (size_t)m * D : MN + (size_t)(m - M) * D) + lane;
#pragma unroll
                    for (int j = 0; j < 4; ++j) { const f32x4 gn = gr[64 * j]; u32x2 w; w.x = cvtpk(v[q][j][0] * rstd * gn[0], v[q][j][1] * rstd * gn[1]); w.y = cvtpk(v[q][j][2] * rstd * gn[2], v[q][j][3] * rstd * gn[3]); o8[64 * j] = w; }
                } }
        }
    }
    xcd_barrier(bar, wave);

    {
        LAS float* GT = (LAS float*)(lds + GT_OFF);
        { const int t2 = pg8::tid_fresh(wave);
          if (t2 < 64) { GT[t2] = a.in[6][t2]; GT[64 + t2] = a.in[7][t2]; }
          if (t2 < 128) { GT[128 + t2] = a.in[13][t2]; GT[256 + t2] = a.in[14][t2]; GT[384 + t2] = a.in[17][t2]; GT[512 + t2] = a.in[18][t2]; } }
        __syncthreads();
        { const pg8::EpiQKV E{R, LDQ, CKV, D, GT, (LAS float*)(lds + XCH_OFF)};
          pg8::Gemm g{XN, W_IN, M, DIN, D, D, MN, W_MEM, nullptr, nullptr}; pg8::DualOrder S; S.init(M, DIN, MMEM, D, G, bid);
          pg8::gemm_phase<pg8::EpiQKV, pg8::DualOrder, true, true>(lds, g, S, E, wave); }
        {
            constexpr int I_G = 16 * (3 * D / 32), I_BR = 8 * (D / 32), I_OUT = 16 * (D / 32), I_FF = 16 * (DFF / 32);
            constexpr int NREST = I_G + 3 * I_BR + I_OUT + 2 * I_FF;
            const int first = (G == 256) ? 160 : 0, nsl = G - first;
            if (bid >= first) {
                const int lane = pg8::lane_id_fresh();
                LAS float* scr = (LAS float*)(lds + wave * 8704);
                for (int it = (bid - first) * 8 + wave; it < NREST; it += nsl * 8) {
                    int r = it;
                    if (r < I_G) { const int nb = 3 * D / 32; tr_item(a.in[4], 3 * D, 64 * (r / nb), 32 * (r % nb), W_G, D, 0, 0, 1, 0, scr, lane); continue; } r -= I_G;
                    if (r < 3 * I_BR) { const int gI = r / I_BR, rr = r % I_BR, nb = D / 32; tr_item(a.in[19] + (size_t)gI * 512 * D, D, 64 * (rr / nb), 32 * (rr % nb), W_BR + (size_t)gI * D * 512, 512, 0, 0, 1, 0, scr, lane); continue; } r -= 3 * I_BR;
                    if (r < I_OUT) { const int nb = D / 32; tr_item(a.in[20], D, 64 * (r / nb), 32 * (r % nb), W_OUT, D, 0, 0, 1, 0, scr, lane); continue; } r -= I_OUT;
                    { const int s = r / I_FF, rr = r % I_FF, nb = DFF / 32; const int n0 = 32 * (rr % nb);
                      tr_item(a.in[22 + s], DFF, 64 * (rr / nb), n0, W_GU, D, 256 * (n0 / 128) + 128 * s + (n0 % 128) - n0, 0, 1, 0, scr, lane); }
                }
            }
        }
    }
    xcd_barrier(bar, wave);

    {
        FRESH_LANE
#define UNIFORM_F(v) __builtin_bit_cast(float, __builtin_amdgcn_readfirstlane(__builtin_bit_cast(int, (float)(v))))
        const float negM_a = UNIFORM_F(-8.f * absmax_vec(a.in[6], 64, lane) * absmax_vec(a.in[7], 64, lane) * L2E);
        const float lam = UNIFORM_F(expf(wave_sum(a.in[8][lane] * a.in[9][lane])) - expf(wave_sum(a.in[10][lane] * a.in[11][lane])) + 0.2f);
        *(LAS float*)(lds + (LDS_BYTES - 64 + 32)) = lam;
        for (int rr = 0; rr < (512 + G - 1) / G; ++rr) {
            int b, h, qblk;
            if (G == 256) {
                const int j = bid >> 3, i = j >> 1; b = bid & 7;
                if ((j & 1) == 0) { h = (rr == 0) ? 1 : 0; qblk = i; }
                else { const int n = 16 + 2 * i + rr; h = 1 + (n >> 4); qblk = n & 15; }
            } else { const int u = rr * G + bid; if (u >= 512) break; b = u >> 6; h = (u >> 4) & 3; qblk = u & 15; }
            const int ta_ = pg8::lane_id_fresh();
            const int qpos = qblk * 128 + (wave >> 1) * 32 + (ta_ & 31);
            bf16* qrow = R + ((size_t)b * SEQ + qblk * 128 + (wave >> 1) * 32) * LDQ + C_AQ + h * 128;
            const bf16* Kg = R + (size_t)b * SEQ * LDQ + C_AK + h * 128; const bf16* Vg = R + (size_t)b * SEQ * LDQ + C_AV + h * 128;
            const float nslope = -__builtin_amdgcn_exp2f(-2.f * (float)(h + 1)) * L2E;
            attn_shared_unit<2>((LAS char*)lds, qrow, Kg, Vg, LDQ, SEQ / 64, qpos, qblk * 128 + (wave >> 1) * 32, nslope, negM_a, lam, a.in[12], wave);
        }
        const int lnc_ = pg8::lane_id_fresh();
        const float negM_c = UNIFORM_F(-11.313708499f * absmax_vec(a.in[17], 128, lnc_) * absmax_vec(a.in[18], 128, lnc_) * L2E);
        for (int u = bid; u < 256; u += G) {
            const int b = u >> 5, h = (u >> 3) & 3, qblk = u & 7;
            const int tc_ = pg8::lane_id_fresh();
            const int qpos = qblk * 256 + wave * 32 + (tc_ & 31);
            bf16* qrow = R + ((size_t)b * SEQ + qblk * 256 + wave * 32) * LDQ + C_CQ + h * 128;
            const bf16* Kg = CKV + (size_t)b * NMEM * D + h * 128; const bf16* Vg = Kg + 512;
            attn_shared_unit<1>((LAS char*)lds, qrow, Kg, Vg, D, NMEM / 64, qpos, 0, 0.f, negM_c, 0.f, a.in[12], wave);
        }
        __syncthreads();
        { const int lnb_ = pg8::lane_id_fresh();
          const float negM_b = UNIFORM_F(-11.313708499f * absmax_vec(a.in[13], 128, lnb_) * absmax_vec(a.in[14], 128, lnb_) * L2E);
          const int jb = bid >> 3, heavy = jb & 1, xq = bid & 7, ib = jb >> 1;
          const int nbu = (G == 256) ? (heavy ? 2 : 4) : (768 + G - 1) / G;
          for (int rr = 0; rr < nbu; ++rr) {
              int u;
              if (G == 256) {
                  int s, loc;
                  if (rr < 2) { const int kb = (heavy ? 32 : 0) + 2 * ib + rr, st = kb >> 3; s = 3 * (st >> 1) + ((st & 1) ? ((xq < 4) ? 2 : 1) : 0); loc = kb & 7; }
                  else { const int ks = 2 * ib + (rr - 2); s = 3 * (ks >> 3) + ((xq < 4) ? 1 : 2); loc = ks & 7; }
                  u = (xq + 8 * s) * 8 + loc;
              }
              else { u = rr * G + bid; if (u >= 768) break; }
              const int sid = u >> 3, loc = u & 7, b = sid / 12, g = (sid % 12) >> 2, j = sid & 3;
              const float slope = __builtin_amdgcn_exp2f(-8.f * (float)(g * 4 + j + 1) / 12.f);
              if (g == 0) attn_b_block_unit<false>((LAS char*)lds, R, LB, b, g, j, 0, loc * 256, 1, -slope * L2E, negM_b, wave);
              else if (g == 1) attn_b_block_unit<false>((LAS char*)lds, R, LB, b, g, j, loc >> 1, (loc & 1) * 256, 4, -slope * 4.f * L2E, negM_b, wave);
              else attn_b_block_unit<true>((LAS char*)lds, R, LB, b, g, j, 2 * loc, 0, 16, -slope * 16.f * L2E, negM_b, wave);
          } }
    }
    xcd_barrier(bar, wave);

    { FRESH_LANE
    const int j = lane >> 4, d8 = (lane & 15) * 8;
    for (int m0 = gw; m0 < M; m0 += 4 * NGW) {
        u32x4 o0[4], o1[4], o2[4]; float l0[4], l1[4], l2[4];
#pragma unroll
        for (int q = 0; q < 4; ++q) { const int m = m0 + q * NGW;
            if (m < M) { const bf16* p0 = R + (size_t)m * LDQ + C_BQ + j * 128 + d8;
                o0[q] = *(const u32x4*)p0; o1[q] = *(const u32x4*)(p0 + 512); o2[q] = *(const u32x4*)(p0 + 1024);
                l0[q] = LB[((size_t)0 * M + m) * 4 + j]; l1[q] = LB[((size_t)1 * M + m) * 4 + j]; l2[q] = LB[((size_t)2 * M + m) * 4 + j]; } }
#pragma unroll
        for (int q = 0; q < 4; ++q) { const int m = m0 + q * NGW;
            if (m < M) {
                const float inv = 1.f / (l0[q] + l1[q] + l2[q]); const float w0 = l0[q] * inv, w1 = l1[q] * inv, w2 = l2[q] * inv;
                u32x4 w;
#pragma unroll
                for (int e = 0; e < 4; ++e) {
                    const float lo = w0 * pg8::bf_lo(o0[q][e]) + w1 * pg8::bf_lo(o1[q][e]) + w2 * pg8::bf_lo(o2[q][e]);
                    const float hi = w0 * pg8::bf_hi(o0[q][e]) + w1 * pg8::bf_hi(o1[q][e]) + w2 * pg8::bf_hi(o2[q][e]);
                    w[e] = cvtpk(lo, hi);
                }
                *(u32x4*)(R + (size_t)m * LDQ + C_BQ + j * 128 + d8) = w; } }
    } }
    {
        pg8::Gemm g{XN, W_G, M, 3 * D, D, D, nullptr, nullptr, nullptr, nullptr}; pg8::StaticOrder S; S.init(M, 3 * D, G, bid);
        pg8::EpiGate E{R + C_GATE, LDQ, a.in[5]};
        pg8::gemm_phase<pg8::EpiGate, pg8::StaticOrder, true, true>(lds, g, S, E, wave);
    }
    xcd_barrier(bar, wave);

    {
        pg8::Gemm g{R + C_AQ, W_BR, M, D, 512, LDQ, R + C_BQ, W_BR + (size_t)D * 512, R + C_CQ, W_BR + (size_t)2 * D * 512};
        pg8::RepeatOrder S; S.init(M, D, 3, G, bid);
        pg8::EpiBranch E{R + C_GATE, R + C_GATE, LDQ, D};
        pg8::gemm_phase<pg8::EpiBranch, pg8::RepeatOrder, true, true>(lds, g, S, E, wave);
    }
    xcd_barrier(bar, wave);

    {
        pg8::Gemm g{R + C_GATE, W_OUT, M, D, D, LDQ, nullptr, nullptr, nullptr, nullptr}; pg8::StaticOrder S; S.init(M, D, G, bid);
        pg8::EpiResidNorm E{x, a.out, D, a.in[21], R + C_H2, LDQ, (float*)(ws + WS_SSQ)};
        pg8::gemm_phase<pg8::EpiResidNorm, pg8::StaticOrder, true, true>(lds, g, S, E, wave);
    }
    xcd_barrier(bar, wave);

    {
        pg8::Gemm g{R + C_H2, W_GU, M, 2 * DFF, D, LDQ, nullptr, nullptr, nullptr, nullptr}; pg8::StaticOrder S; S.init(M, 2 * DFF, G, bid);
        pg8::EpiSwiGLU E{R + C_ACT, LDQ, (const float*)(ws + WS_SSQ)};
        pg8::gemm_phase<pg8::EpiSwiGLU, pg8::StaticOrder, true, true>(lds, g, S, E, wave);
        { constexpr int I_DN = (DFF / 64) * (D / 32);
          const int first = (G == 256) ? 128 : 0, nsl = G - first;
          if (bid >= first) { const int lane = pg8::lane_id_fresh(); LAS float* scr = (LAS float*)(lds + wave * 8704);
              for (int r = (bid - first) * 8 + wave; r < I_DN; r += nsl * 8) { const int nb = D / 32; tr_item(a.in[24], D, 64 * (r / nb), 32 * (r % nb), W_DN, DFF, 0, 0, 1, 0, scr, lane); } } }
    }
    xcd_barrier(bar, wave);

    {
        pg8::Gemm g{R + C_ACT, W_DN, M, D, DFF, LDQ, nullptr, nullptr, nullptr, nullptr}; pg8::StaticOrder S; S.init(M, D, G, bid);
        pg8::EpiResid E{a.out, a.out, D};
        pg8::gemm_phase<pg8::EpiResid, pg8::StaticOrder, true, true>(lds, g, S, E, wave);
    }
}

extern "C" void kernel_launch(void* const* d_in, const int* in_sizes, int n_in, void* d_out, int out_size, void* d_ws, size_t ws_size, hipStream_t stream) {
    static int grid = 0;
    if (grid == 0) {
        if (n_in != 25 || out_size != M * D || ws_size < WS_END) { fprintf(stderr, "kernel_launch: unexpected problem shape (n_in %d out %d ws %zu)\n", n_in, out_size, ws_size); grid = -1; return; }
        int dev = 0, cus = 0, per_cu = 0;
        hipGetDevice(&dev);
        hipDeviceGetAttribute(&cus, hipDeviceAttributeMultiprocessorCount, dev);
        if (hipFuncSetAttribute((const void*)fwd_megakernel, hipFuncAttributeMaxDynamicSharedMemorySize, LDS_BYTES) != hipSuccess) { fprintf(stderr, "kernel_launch: hipFuncSetAttribute failed\n"); }
        hipOccupancyMaxActiveBlocksPerMultiprocessor(&per_cu, (const void*)fwd_megakernel, 512, LDS_BYTES);
        (void)hipGetLastError();
        if (per_cu < 1) per_cu = 1;
        grid = cus;
        fprintf(stderr, "kernel_launch: cus %d per_cu %d grid %d\n", cus, per_cu, grid);
    }
    if (grid < 0) return;
    if (hipMemsetAsync((char*)d_ws + WS_BAR, 0, 16384, stream) != hipSuccess) { fprintf(stderr, "kernel_launch: memset of the barrier words failed\n"); return; }
    Args a{};
    for (int i = 0; i < 25; ++i) a.in[i] = (const float*)d_in[i];
    a.out = (float*)d_out; a.ws = (unsigned char*)d_ws;
    void* args[] = {&a};
    hipError_t e = hipLaunchCooperativeKernel((const void*)fwd_megakernel, dim3(grid), dim3(512), args, LDS_BYTES, stream);
    if (e != hipSuccess) fprintf(stderr, "cooperative launch failed: %s (grid %d)\n", hipGetErrorString(e), grid);
}
```

```cpp
#include <hip/hip_runtime.h>
#include <hip/hip_cooperative_groups.h>
#include <cstdio>
#include <cstdint>
namespace cg = cooperative_groups;
namespace pg8 {
#define PG8_LAS __attribute__((address_space(3)))
typedef unsigned short bf16_t;
typedef short bf16x8 __attribute__((ext_vector_type(8)));
typedef float f32x4 __attribute__((ext_vector_type(4)));
typedef unsigned u32x4 __attribute__((ext_vector_type(4)));
constexpr int BM = 256, BK = 64, HALF = 128, HTB = HALF * BK * 2  , STAGE_BYTES = 8 * HTB, NXCD = 8, WGM = 8;

__host__ __device__ __forceinline__ int lds_byte(int r, int c) { const int st = (r >> 4) * 2 + (c >> 5), rr = r & 15, cc = c & 31, ob = rr * 64 + cc * 2; return st * 1024 + (ob ^ (((ob >> 9) & 1) << 5)); }
__host__ __device__ __forceinline__ void stage_rc(int b, int& R, int& C) { const int st = b / 1024, sb = b % 1024, swz = sb ^ (((sb >> 9) & 1) << 5); R = (st >> 1) * 16 + swz / 64; C = (st & 1) * 32 + (swz % 64) / 2; }
__host__ __device__ __forceinline__ int perm32(int rho) { const int n = rho >> 4, i = rho & 15; return 8 * (i >> 2) + 4 * n + (i & 3); }

struct Unit { int pm, pn, src; };
struct Gemm { const bf16_t* A; const bf16_t* Bt; int M, N, K, lda; const bf16_t* A2; const bf16_t* Bt2; const bf16_t* A3; const bf16_t* Bt3; };

struct StaticOrder {
    int nM, nN, nwg, G, c;
    __host__ __device__ void init(int M, int N, int G_, int c_) { nM = M / BM; nN = N / BM; nwg = nM * nN; G = G_; c = c_; }
    __host__ __device__ bool next(int i, Unit& u) const {
        const long L = (long)i * G + c; if (L >= nwg) return false;
        int wgid = (int)L; { const int q = nwg / NXCD, r = nwg % NXCD, xcd = wgid % NXCD, off = wgid / NXCD; wgid = (xcd < r ? xcd * (q + 1) : r * (q + 1) + (xcd - r) * q) + off; }
        const int nig = WGM * nN, gid = wgid / nig, fm = gid * WGM, gsz = (nM - fm) < WGM ? (nM - fm) : WGM;
        u.pm = fm + ((wgid % nig) % gsz); u.pn = (wgid % nig) / gsz; u.src = 0; return true;
    }
    __device__ __forceinline__ void a_ready(const Unit&) const {}
    __device__ __forceinline__ void done(const Unit&) const {}
};

struct DualOrder {
    StaticOrder S1; int nM2, nN2;
    __host__ __device__ void init(int M, int N, int M2, int N2, int G_, int c_) { S1.init(M, N, G_, c_); nM2 = M2 / BM; nN2 = N2 / BM; }
    __host__ __device__ bool next(int i, Unit& u) const {
        if (S1.next(i, u)) return true;
        const long L = (long)i * S1.G + S1.c - S1.nwg; if (L < 0 || L >= (long)nM2 * nN2) return false;
        u.pm = (int)L % nM2; u.pn = (int)L / nM2; u.src = 1; return true;
    }
    __device__ __forceinline__ void a_ready(const Unit&) const {}
    __device__ __forceinline__ void done(const Unit&) const {}
};

struct RepeatOrder {
    StaticOrder S1; int nrep;
    __host__ __device__ void init(int M, int N, int nrep_, int G_, int c_) { S1.init(M, N, G_, c_); nrep = nrep_; }
    __host__ __device__ bool next(int i, Unit& u) const { if (i >= nrep) return false; if (!S1.next(0, u)) return false; u.src = i; return true; }
    __device__ __forceinline__ void a_ready(const Unit&) const {}
    __device__ __forceinline__ void done(const Unit&) const {}
};

template <int K> __device__ __forceinline__ float shx(float v) {
    return __builtin_bit_cast(float, __builtin_amdgcn_ds_swizzle(__builtin_bit_cast(int, v), (K << 10) | 0x1f)); }
__device__ __forceinline__ float sum_halves(float v) {
    auto rr = __builtin_amdgcn_permlane32_swap(__builtin_bit_cast(unsigned, v), __builtin_bit_cast(unsigned, v), false, false);
    return __builtin_bit_cast(float, (unsigned)rr[0]) + __builtin_bit_cast(float, (unsigned)rr[1]); }
__device__ __forceinline__ float max_halves(float v) {
    auto rr = __builtin_amdgcn_permlane32_swap(__builtin_bit_cast(unsigned, v), __builtin_bit_cast(unsigned, v), false, false);
    return fmaxf(__builtin_bit_cast(float, (unsigned)rr[0]), __builtin_bit_cast(float, (unsigned)rr[1])); }
__device__ __forceinline__ int lane_id_fresh() { int z = 0; asm volatile("" : "+s"(z)); return __builtin_amdgcn_mbcnt_hi(~0u, __builtin_amdgcn_mbcnt_lo(~0u, z)); }
__device__ __forceinline__ int tid_fresh(int wave) { return wave * 64 + lane_id_fresh(); }
typedef float f32x2v_t __attribute__((ext_vector_type(2))); typedef __bf16 bf16x2v_t __attribute__((ext_vector_type(2)));
__device__ __forceinline__ unsigned cvt_pk_bf16(float lo, float hi) { f32x2v_t v = {lo, hi}; bf16x2v_t b = __builtin_convertvector(v, bf16x2v_t); return __builtin_bit_cast(unsigned, b); }
__device__ __forceinline__ float bf_lo(unsigned w) { return __builtin_bit_cast(float, w << 16); }
__device__ __forceinline__ float bf_hi(unsigned w) { return __builtin_bit_cast(float, w & 0xffff0000u); }
#define PG8_ACC const f32x4 (&acc)[2][2][4][2]

struct EpiQKV {
    static constexpr bool PERM = true, AFTER_DRAIN = false;
    bf16_t* O; int ldc; bf16_t* O2; int ldc2;
    PG8_LAS const float* GT;
    PG8_LAS float* X;
    __device__ __forceinline__ void operator()(PG8_ACC, const Unit& u, int wr, int wc, int fr, int fq) const {
        const int pn = u.pn;
        int kind, gp; float sc = 1.f;
        constexpr float L2E = 1.4426950408889634f;
        const int mode = u.src;
        if (mode == 0) {
            if (pn < 2) { kind = 1; gp = 0; sc = 0.125f * L2E; }
            else if (pn < 4) { kind = 1; gp = 64; }
            else if (pn < 6) { kind = 0; gp = 64; }
            else if (pn < 12) { kind = 2; gp = 128; sc = 0.08838834764831845f * L2E; }
            else if (pn < 18) { kind = 2; gp = 256; }
            else if (pn < 24) { kind = 0; gp = 256; }
            else { kind = 2; gp = 384; sc = 0.08838834764831845f * L2E; }
        } else {
            if (pn < 2) { kind = 2; gp = 512; } else { kind = 0; gp = 512; }
        }
        const int row0 = u.pm * BM + wr * 64 + fr, col0 = pn * BM + wc * 32 + 8 * fq;
        float rs[2][4][2];
        f32x4 gv[2];
        if (kind != 0) {
#pragma unroll
            for (int ai = 0; ai < 2; ++ai)
#pragma unroll
                for (int m = 0; m < 4; ++m)
#pragma unroll
                    for (int bj = 0; bj < 2; ++bj) {
                        const f32x4 a = acc[ai][bj][m][0], b = acc[ai][bj][m][1];
                        float s = (a[0] * a[0] + a[1] * a[1]) + (a[2] * a[2] + a[3] * a[3]) + (b[0] * b[0] + b[1] * b[1]) + (b[2] * b[2] + b[3] * b[3]);
                        s += shx<16>(s); s = sum_halves(s);
                        if (fq == 0) X[((ai * 128 + wr * 64 + m * 16 + fr) * 2 + bj) * 4 + wc] = s;
                    }
            asm volatile("s_waitcnt lgkmcnt(0)" ::: "memory"); __builtin_amdgcn_s_barrier(); asm volatile("" ::: "memory");
            const int hd = (kind == 1) ? 64 : 128;
            const float inv_hd = (kind == 1) ? (1.f / 64.f) : (1.f / 128.f);
#pragma unroll
            for (int ai = 0; ai < 2; ++ai)
#pragma unroll
                for (int m = 0; m < 4; ++m)
#pragma unroll
                    for (int bj = 0; bj < 2; ++bj) {
                        const f32x4 xs = *(const PG8_LAS f32x4*)(X + ((ai * 128 + wr * 64 + m * 16 + fr) * 2 + bj) * 4);
                        float tot;
                        if (kind == 1) tot = (wc < 2) ? (xs[0] + xs[1]) : (xs[2] + xs[3]);
                        else tot = (xs[0] + xs[1]) + (xs[2] + xs[3]);
                        rs[ai][m][bj] = __builtin_amdgcn_rsqf(tot * inv_hd + 1e-6f) * sc;
                    }
            const int gc = ((wc * 32 + 8 * fq) & (hd - 1));
            gv[0] = *(const PG8_LAS f32x4*)(GT + gp + gc); gv[1] = *(const PG8_LAS f32x4*)(GT + gp + gc + 4);
        } else {
#pragma unroll
            for (int ai = 0; ai < 2; ++ai)
#pragma unroll
                for (int m = 0; m < 4; ++m)
#pragma unroll
                    for (int bj = 0; bj < 2; ++bj) rs[ai][m][bj] = 1.f;
            gv[0] = (f32x4){1.f, 1.f, 1.f, 1.f}; gv[1] = gv[0];
        }
#pragma unroll
        for (int ai = 0; ai < 2; ++ai)
#pragma unroll
            for (int m = 0; m < 4; ++m) { bf16_t* rowp = (mode ? O2 : O) + (size_t)(row0 + ai * HALF + m * 16) * (mode ? ldc2 : ldc) + col0;
#pragma unroll
                for (int bj = 0; bj < 2; ++bj) { const float r = rs[ai][m][bj];
                    const f32x4 v0 = acc[ai][bj][m][0] * gv[0] * r, v1 = acc[ai][bj][m][1] * gv[1] * r;
                    u32x4 w; w.x = cvt_pk_bf16(v0[0], v0[1]); w.y = cvt_pk_bf16(v0[2], v0[3]); w.z = cvt_pk_bf16(v1[0], v1[1]); w.w = cvt_pk_bf16(v1[2], v1[3]);
                    *(u32x4*)(rowp + bj * HALF) = w; } }
    }
};

struct EpiGate {
    static constexpr bool PERM = true, AFTER_DRAIN = false;
    bf16_t* O; int ldc; const float* bias;
    __device__ __forceinline__ void operator()(PG8_ACC, const Unit& u, int wr, int wc, int fr, int fq) const {
        const int row0 = u.pm * BM + wr * 64 + fr, col0 = u.pn * BM + wc * 32 + 8 * fq;
        f32x4 bv[2][2];
#pragma unroll
        for (int bj = 0; bj < 2; ++bj)
#pragma unroll
            for (int n = 0; n < 2; ++n) bv[bj][n] = *(const f32x4*)(bias + col0 + bj * HALF + 4 * n);
#pragma unroll
        for (int ai = 0; ai < 2; ++ai)
#pragma unroll
            for (int m = 0; m < 4; ++m) { bf16_t* rowp = O + (size_t)(row0 + ai * HALF + m * 16) * ldc + col0;
#pragma unroll
                for (int bj = 0; bj < 2; ++bj) { f32x4 v0 = acc[ai][bj][m][0] + bv[bj][0], v1 = acc[ai][bj][m][1] + bv[bj][1];
#pragma unroll
                    for (int e = 0; e < 4; ++e) { v0[e] = __builtin_amdgcn_rcpf(1.f + __builtin_amdgcn_exp2f(-1.4426950408889634f * v0[e])); v1[e] = __builtin_amdgcn_rcpf(1.f + __builtin_amdgcn_exp2f(-1.4426950408889634f * v1[e])); }
                    u32x4 w; w.x = cvt_pk_bf16(v0[0], v0[1]); w.y = cvt_pk_bf16(v0[2], v0[3]); w.z = cvt_pk_bf16(v1[0], v1[1]); w.w = cvt_pk_bf16(v1[2], v1[3]);
                    *(u32x4*)(rowp + bj * HALF) = w; } }
    }
};

struct EpiBranch {
    static constexpr bool PERM = true, AFTER_DRAIN = false;
    bf16_t* MIX; const bf16_t* GATE0; int ldc; int gstride;
    __device__ __forceinline__ void operator()(PG8_ACC, const Unit& u, int wr, int wc, int fr, int fq) const {
        const int row0 = u.pm * BM + wr * 64 + fr, col0 = u.pn * BM + wc * 32 + 8 * fq;
        const bf16_t* GATE = GATE0 + (size_t)u.src * gstride; const int accum = u.src;
#pragma unroll
        for (int ai = 0; ai < 2; ++ai)
#pragma unroll
            for (int m = 0; m < 4; ++m) { const size_t off = (size_t)(row0 + ai * HALF + m * 16) * ldc + col0;
#pragma unroll
                for (int bj = 0; bj < 2; ++bj) { const u32x4 gt = *(const u32x4*)(GATE + off + bj * HALF);
                    f32x4 a = acc[ai][bj][m][0], b = acc[ai][bj][m][1];
                    a[0] *= bf_lo(gt.x); a[1] *= bf_hi(gt.x); a[2] *= bf_lo(gt.y); a[3] *= bf_hi(gt.y); b[0] *= bf_lo(gt.z); b[1] *= bf_hi(gt.z); b[2] *= bf_lo(gt.w); b[3] *= bf_hi(gt.w);
                    if (accum) { const u32x4 mx = *(const u32x4*)(MIX + off + bj * HALF);
                        a[0] += bf_lo(mx.x); a[1] += bf_hi(mx.x); a[2] += bf_lo(mx.y); a[3] += bf_hi(mx.y); b[0] += bf_lo(mx.z); b[1] += bf_hi(mx.z); b[2] += bf_lo(mx.w); b[3] += bf_hi(mx.w); }
                    u32x4 w; w.x = cvt_pk_bf16(a[0], a[1]); w.y = cvt_pk_bf16(a[2], a[3]); w.z = cvt_pk_bf16(b[0], b[1]); w.w = cvt_pk_bf16(b[2], b[3]);
                    *(u32x4*)(MIX + off + bj * HALF) = w; } }
    }
};

struct EpiResid {
    static constexpr bool PERM = true, AFTER_DRAIN = false;
    const float* res; float* out; int ld;
    __device__ __forceinline__ void operator()(PG8_ACC, const Unit& u, int wr, int wc, int fr, int fq) const {
        const int row0 = u.pm * BM + wr * 64 + fr, col0 = u.pn * BM + wc * 32 + 8 * fq;
#pragma unroll
        for (int ai = 0; ai < 2; ++ai)
#pragma unroll
            for (int m = 0; m < 4; ++m) { const size_t off = (size_t)(row0 + ai * HALF + m * 16) * ld + col0;
#pragma unroll
                for (int bj = 0; bj < 2; ++bj) {
                    const f32x4 r0 = *(const f32x4*)(res + off + bj * HALF), r1 = *(const f32x4*)(res + off + bj * HALF + 4);
                    const f32x4 v0 = acc[ai][bj][m][0] + r0, v1 = acc[ai][bj][m][1] + r1;
                    *(f32x4*)(out + off + bj * HALF) = v0; *(f32x4*)(out + off + bj * HALF + 4) = v1; } }
    }
};

struct EpiResidNorm {
    static constexpr bool PERM = true, AFTER_DRAIN = false;
    const float* res; float* out; int ld; const float* gain; bf16_t* H; int ldh; float* SSQ;
    __device__ __forceinline__ void operator()(PG8_ACC, const Unit& u, int wr, int wc, int fr, int fq) const {
        const int row0 = u.pm * BM + wr * 64 + fr, col0 = u.pn * BM + wc * 32 + 8 * fq;
        f32x4 gv[2][2];
#pragma unroll
        for (int bj = 0; bj < 2; ++bj)
#pragma unroll
            for (int n = 0; n < 2; ++n) gv[bj][n] = *(const f32x4*)(gain + col0 + bj * HALF + 4 * n);
#pragma unroll
        for (int ai = 0; ai < 2; ++ai)
#pragma unroll
            for (int m = 0; m < 4; ++m) { const int row = row0 + ai * HALF + m * 16; const size_t off = (size_t)row * ld + col0; float s = 0.f;
#pragma unroll
                for (int bj = 0; bj < 2; ++bj) {
                    const f32x4 r0 = *(const f32x4*)(res + off + bj * HALF), r1 = *(const f32x4*)(res + off + bj * HALF + 4);
                    const f32x4 v0 = acc[ai][bj][m][0] + r0, v1 = acc[ai][bj][m][1] + r1;
                    *(f32x4*)(out + off + bj * HALF) = v0; *(f32x4*)(out + off + bj * HALF + 4) = v1;
                    s += (v0[0] * v0[0] + v0[1] * v0[1]) + (v0[2] * v0[2] + v0[3] * v0[3]) + (v1[0] * v1[0] + v1[1] * v1[1]) + (v1[2] * v1[2] + v1[3] * v1[3]);
                    const f32x4 h0 = v0 * gv[bj][0], h1 = v1 * gv[bj][1];
                    u32x4 w; w.x = cvt_pk_bf16(h0[0], h0[1]); w.y = cvt_pk_bf16(h0[2], h0[3]); w.z = cvt_pk_bf16(h1[0], h1[1]); w.w = cvt_pk_bf16(h1[2], h1[3]);
                    *(u32x4*)(H + (size_t)row * ldh + col0 + bj * HALF) = w; }
                s += shx<16>(s); s = sum_halves(s);
                if (fq == 0) atomicAdd(SSQ + row, s); }
    }
};

struct EpiSwiGLU {
    static constexpr bool PERM = true, AFTER_DRAIN = false;
    bf16_t* O; int ldc; const float* SSQ;
    __device__ __forceinline__ void operator()(PG8_ACC, const Unit& u, int wr, int wc, int fr, int fq) const {
        const int row0 = u.pm * BM + wr * 64 + fr, col0 = u.pn * HALF + wc * 32 + 8 * fq;
#pragma unroll
        for (int ai = 0; ai < 2; ++ai)
#pragma unroll
            for (int m = 0; m < 4; ++m) { bf16_t* rowp = O + (size_t)(row0 + ai * HALF + m * 16) * ldc + col0;
                const float rstd = __builtin_amdgcn_rsqf(SSQ[row0 + ai * HALF + m * 16] * (1.f / 1024.f) + 1e-6f);
                f32x4 v[2];
#pragma unroll
                for (int n = 0; n < 2; ++n) { const f32x4 gt = acc[ai][0][m][n] * rstd, up = acc[ai][1][m][n] * rstd;
#pragma unroll
                    for (int e = 0; e < 4; ++e) v[n][e] = gt[e] * __builtin_amdgcn_rcpf(1.f + __builtin_amdgcn_exp2f(-1.4426950408889634f * gt[e])) * up[e]; }
                u32x4 w; w.x = cvt_pk_bf16(v[0][0], v[0][1]); w.y = cvt_pk_bf16(v[0][2], v[0][3]); w.z = cvt_pk_bf16(v[1][0], v[1][1]); w.w = cvt_pk_bf16(v[1][2], v[1][3]);
                *(u32x4*)rowp = w; }
    }
};

template <class Epi, class Sched, bool ALIGN_EPI = false, bool SP2 = false>
__device__ __forceinline__ void gemm_phase(PG8_LAS unsigned char* lds, const Gemm g, const Sched& S, const Epi& E, int wave_id) {
    const int tid = tid_fresh(wave_id);
    const int wid = __builtin_amdgcn_readfirstlane(tid >> 6), lane = tid & 63, wr = wid >> 2, wc = wid & 3, fr = lane & 15, fq = lane >> 4;
    const int K = g.K, nt = K / BK;
    unsigned voffA[2], voffB[2];
#pragma unroll
    for (int i = 0; i < 2; ++i) { int R, C; stage_rc(tid * 16 + i * 8192, R, C); const int Rb = Epi::PERM ? ((R & ~31) + perm32(R & 31)) : R;
        voffA[i] = (unsigned)(R * g.lda + C) * 2u; voffB[i] = (unsigned)(Rb * K + C) * 2u; }
    const size_t kstep = (size_t)(BK * 2);
    const size_t hstepA = (size_t)HALF * g.lda * 2, hstepB = (size_t)HALF * K * 2;
    const size_t tstepA = 2 * hstepA, tstepB = 2 * hstepB;
    const unsigned ldsw = (unsigned)wid * 1024u;
    const int aoff = lds_byte(wr * 64 + fr, fq * 8), boff = lds_byte(wc * 32 + fr, fq * 8);
#define PG8_SA(b, h) (((b) * 2 + (h)) * HTB)
#define PG8_SB(b, h) ((4 + (b) * 2 + (h)) * HTB)
#define PG8_STAGE(bufoff, gbase, voff) do { _Pragma("unroll") for (int _i = 0; _i < 2; ++_i) \
        __builtin_amdgcn_global_load_lds((const unsigned*)((const char*)(gbase) + (voff)[_i]), (PG8_LAS unsigned*)(lds + (bufoff) + ldsw + _i * 8192), 16, 0, 0); } while (0)
#define PG8_LDA(dst, b, h) do { _Pragma("unroll") for (int m = 0; m < 4; ++m) _Pragma("unroll") for (int k = 0; k < 2; ++k) dst[m][k] = *(const PG8_LAS bf16x8*)(lds + PG8_SA(b, h) + aoff + m * 2048 + k * 1024); } while (0)
#define PG8_LDB(dst, b, h) do { _Pragma("unroll") for (int n = 0; n < 2; ++n) _Pragma("unroll") for (int k = 0; k < 2; ++k) dst[n][k] = *(const PG8_LAS bf16x8*)(lds + PG8_SB(b, h) + boff + n * 2048 + k * 1024); } while (0)
#define PG8_MMA(ai, bj, At, Bt) do { __builtin_amdgcn_s_setprio(1); _Pragma("unroll") for (int m = 0; m < 4; ++m) _Pragma("unroll") for (int n = 0; n < 2; ++n) _Pragma("unroll") for (int k = 0; k < 2; ++k) \
        acc[ai][bj][m][n] = __builtin_amdgcn_mfma_f32_16x16x32_bf16(Bt[n][k], At[m][k], acc[ai][bj][m][n], 0, 0, 0); __builtin_amdgcn_s_setprio(0); } while (0)
#define PG8_WAIT_V(n) asm volatile("s_waitcnt vmcnt(" #n ")" ::: "memory")
#define PG8_WAIT_L(n) asm volatile("s_waitcnt lgkmcnt(" #n ")" ::: "memory")
#define PG8_BAR __builtin_amdgcn_s_barrier()
#define PG8_SCHED __builtin_amdgcn_sched_barrier(0)
    Unit cur, nxt; int ui = 0;
    if (!S.next(0, cur)) return;
    f32x4 acc[2][2][4][2];
#pragma unroll
    for (int a = 0; a < 2; ++a)
#pragma unroll
        for (int b = 0; b < 2; ++b)
#pragma unroll
            for (int m = 0; m < 4; ++m)
#pragma unroll
                for (int n = 0; n < 2; ++n) acc[a][b][m][n] = (f32x4){0.f, 0.f, 0.f, 0.f};
    bf16x8 At[4][2], B0[2][2], B1[2][2];
    const char* cA = (const char*)(cur.src == 0 ? g.A : (cur.src == 1 ? g.A2 : g.A3)) + (size_t)cur.pm * tstepA; const char* cB = (const char*)(cur.src == 0 ? g.Bt : (cur.src == 1 ? g.Bt2 : g.Bt3)) + (size_t)cur.pn * tstepB;
    S.a_ready(cur);
    if constexpr (SP2) {
        PG8_STAGE(PG8_SB(0, 0), cB, voffB); PG8_STAGE(PG8_SB(0, 1), cB + hstepB, voffB); PG8_STAGE(PG8_SA(0, 0), cA, voffA); PG8_STAGE(PG8_SA(0, 1), cA + hstepA, voffA);
        if (wr == 1) PG8_BAR;
        PG8_WAIT_V(2); PG8_BAR;
        PG8_STAGE(PG8_SB(1, 0), cB + kstep, voffB); PG8_STAGE(PG8_SA(1, 0), cA + kstep, voffA); PG8_STAGE(PG8_SB(1, 1), cB + hstepB + kstep, voffB);
        PG8_WAIT_V(6); PG8_BAR;
    } else {
        PG8_STAGE(PG8_SB(0, 0), cB, voffB); PG8_STAGE(PG8_SA(0, 0), cA, voffA); PG8_STAGE(PG8_SB(0, 1), cB + hstepB, voffB); PG8_STAGE(PG8_SA(0, 1), cA + hstepA, voffA);
        if (wr == 1) PG8_BAR;
        PG8_WAIT_V(4); PG8_BAR;
        PG8_STAGE(PG8_SB(1, 0), cB + kstep, voffB); PG8_STAGE(PG8_SA(1, 0), cA + kstep, voffA); PG8_STAGE(PG8_SB(1, 1), cB + hstepB + kstep, voffB);
        PG8_WAIT_V(6); PG8_BAR;
    }
    for (;;) {
        const bool has_next = S.next(ui + 1, nxt);
        const char* nA = has_next ? (const char*)(nxt.src == 0 ? g.A : (nxt.src == 1 ? g.A2 : g.A3)) + (size_t)nxt.pm * tstepA : cA; const char* nB = has_next ? (const char*)(nxt.src == 0 ? g.Bt : (nxt.src == 1 ? g.Bt2 : g.Bt3)) + (size_t)nxt.pn * tstepB : cB;
        for (int t = 0; t < nt; t += 2) {
            const bool last = (t == nt - 2);
            const char* a1 = cA + (size_t)(t + 1) * kstep;
            const char* a2 = last ? nA : cA + (size_t)(t + 2) * kstep; const char* b2 = last ? nB : cB + (size_t)(t + 2) * kstep;
            const char* a3 = a2 + kstep; const char* b3 = b2 + kstep;
            if (last && has_next) S.a_ready(nxt);
            if constexpr (SP2) {
            PG8_LDB(B0, 0, 0); PG8_LDB(B1, 0, 1); PG8_SCHED; PG8_LDA(At, 0, 0); PG8_STAGE(PG8_SA(1, 1), a1 + hstepA, voffA);
            PG8_WAIT_V(8); PG8_WAIT_L(0); PG8_BAR; PG8_MMA(0, 0, At, B0); PG8_MMA(0, 1, At, B1); PG8_BAR; PG8_SCHED;
            PG8_LDA(At, 0, 1); PG8_STAGE(PG8_SB(0, 0), b2, voffB); PG8_STAGE(PG8_SB(0, 1), b2 + hstepB, voffB); PG8_STAGE(PG8_SA(0, 0), a2, voffA);
            PG8_WAIT_V(8); PG8_WAIT_L(0); PG8_BAR; PG8_MMA(1, 0, At, B0); PG8_MMA(1, 1, At, B1); PG8_BAR; PG8_SCHED;
            PG8_LDB(B0, 1, 0); PG8_LDB(B1, 1, 1); PG8_SCHED; PG8_LDA(At, 1, 0); PG8_STAGE(PG8_SA(0, 1), a2 + hstepA, voffA);
            PG8_WAIT_V(8); PG8_WAIT_L(0); PG8_BAR; PG8_MMA(0, 0, At, B0); PG8_MMA(0, 1, At, B1); PG8_BAR; PG8_SCHED;
            PG8_LDA(At, 1, 1); PG8_STAGE(PG8_SB(1, 0), b3, voffB); PG8_STAGE(PG8_SB(1, 1), b3 + hstepB, voffB); PG8_STAGE(PG8_SA(1, 0), a3, voffA);
            PG8_WAIT_V(8); PG8_WAIT_L(0); PG8_BAR; PG8_MMA(1, 0, At, B0); PG8_MMA(1, 1, At, B1); PG8_BAR; PG8_SCHED;
            } else {
            PG8_LDB(B0, 0, 0); PG8_SCHED; PG8_LDA(At, 0, 0); PG8_STAGE(PG8_SA(1, 1), a1 + hstepA, voffA);
            PG8_WAIT_L(8); PG8_BAR; PG8_WAIT_L(0); PG8_MMA(0, 0, At, B0); PG8_BAR; PG8_SCHED;
            PG8_LDB(B1, 0, 1); PG8_STAGE(PG8_SB(0, 0), b2, voffB);
            PG8_BAR; PG8_WAIT_L(0); PG8_MMA(0, 1, At, B1); PG8_BAR;
            PG8_LDA(At, 0, 1); PG8_STAGE(PG8_SA(0, 0), a2, voffA);
            PG8_BAR; PG8_WAIT_L(0); PG8_MMA(1, 0, At, B0); PG8_BAR; PG8_SCHED;
            PG8_STAGE(PG8_SB(0, 1), b2 + hstepB, voffB);
            PG8_WAIT_V(6); PG8_BAR; PG8_MMA(1, 1, At, B1); PG8_BAR;
            PG8_LDB(B0, 1, 0); PG8_SCHED; PG8_LDA(At, 1, 0); PG8_STAGE(PG8_SA(0, 1), a2 + hstepA, voffA);
            PG8_WAIT_L(8); PG8_BAR; PG8_WAIT_L(0); PG8_MMA(0, 0, At, B0); PG8_BAR; PG8_SCHED;
            PG8_LDB(B1, 1, 1); PG8_STAGE(PG8_SB(1, 0), b3, voffB);
            PG8_BAR; PG8_WAIT_L(0); PG8_MMA(0, 1, At, B1); PG8_BAR;
            PG8_LDA(At, 1, 1); PG8_STAGE(PG8_SA(1, 0), a3, voffA);
            PG8_BAR; PG8_WAIT_L(0); PG8_MMA(1, 0, At, B0); PG8_BAR; PG8_SCHED;
            PG8_STAGE(PG8_SB(1, 1), b3 + hstepB, voffB);
            PG8_WAIT_V(6); PG8_BAR; PG8_MMA(1, 1, At, B1); PG8_BAR;
            }
        }
        if constexpr (ALIGN_EPI) { if (wr == 0) PG8_BAR; }
        if constexpr (!Epi::AFTER_DRAIN) { E(acc, cur, wr, wc, fr, fq); S.done(cur); }
        if (!has_next) break;
#pragma unroll
        for (int a = 0; a < 2; ++a)
#pragma unroll
            for (int b = 0; b < 2; ++b)
#pragma unroll
                for (int m = 0; m < 4; ++m)
#pragma unroll
                    for (int n = 0; n < 2; ++n) acc[a][b][m][n] = (f32x4){0.f, 0.f, 0.f, 0.f};
        cur = nxt; cA = nA; cB = nB; ++ui;
        if constexpr (ALIGN_EPI) { if (wr == 1) PG8_BAR; }
    }
    PG8_WAIT_V(0);
    if constexpr (!ALIGN_EPI) { if (wr == 0) PG8_BAR; }
    PG8_BAR;
    if constexpr (Epi::AFTER_DRAIN) { E.fused(acc, cur, wr, wc, fr, fq, lds, wid, lane); S.done(cur); }
#undef PG8_SA
#undef PG8_SB
#undef PG8_STAGE
#undef PG8_LDA
#undef PG8_LDB
#undef PG8_MMA
#undef PG8_WAIT_V
#undef PG8_WAIT_L
#undef PG8_BAR
#undef PG8_SCHED
}
}

#define LAS __attribute__((address_space(3)))
typedef unsigned short bf16;
typedef short bf16x8 __attribute__((ext_vector_type(8)));
typedef short s16x4 __attribute__((ext_vector_type(4)));
typedef short v4i16_t __attribute__((ext_vector_type(4)));
typedef float f32x16 __attribute__((ext_vector_type(16)));
typedef float f32x4 __attribute__((ext_vector_type(4)));
typedef float f32x2_t __attribute__((ext_vector_type(2)));
typedef __bf16 bf16x2_t __attribute__((ext_vector_type(2)));
typedef unsigned u32x4 __attribute__((ext_vector_type(4)));
typedef unsigned u32x2 __attribute__((ext_vector_type(2)));

constexpr int D = 1024, SEQ = 2048, NB = 8, M = NB * SEQ, NMEM = 256, MMEM = NB * NMEM, DIN = 6656, DFF = 2816;
constexpr int LDQ = 6656;
constexpr int C_AQ = 0, C_AK = 512, C_AV = 1024, C_BQ = 1536, C_BK = 3072, C_BV = 4608, C_CQ = 6144;
constexpr int C_GATE = 3072;
constexpr int C_H2 = 0, C_ACT = 1024;
constexpr float L2E = 1.4426950408889634f;
constexpr float EPS = 1e-6f;

constexpr size_t WS_WIN = 0;
constexpr size_t WS_WG = WS_WIN + (size_t)DIN * D * 2;
constexpr size_t WS_WMEM = WS_WG + (size_t)3 * D * D * 2;
constexpr size_t WS_WBR = WS_WMEM + (size_t)D * D * 2;
constexpr size_t WS_WOUT3 = WS_WBR + (size_t)3 * D * 512 * 2;
constexpr size_t WS_WGU = WS_WOUT3 + (size_t)D * 3 * D * 2;
constexpr size_t WS_WDN = WS_WGU + (size_t)2 * DFF * D * 2;
constexpr size_t WS_LB = WS_WDN + (size_t)D * DFF * 2;
constexpr size_t WS_R = WS_LB + (size_t)3 * M * 4 * 4;
constexpr size_t WS_BAR = WS_R + (size_t)M * LDQ * 2;
constexpr size_t WS_SSQ = WS_BAR + 16384;
constexpr size_t WS_END = WS_SSQ + (size_t)M * 4;
static_assert(WS_END <= (size_t)256 * 1024 * 1024, "d_ws map");
constexpr size_t DO_XN = 0;
constexpr size_t DO_MN = DO_XN + (size_t)M * D * 2;
constexpr size_t DO_CKV = DO_MN + (size_t)MMEM * D * 2;
static_assert(DO_CKV + (size_t)MMEM * D * 2 <= (size_t)M * D * 4, "d_out scratch map");

constexpr int LDS_BYTES = 155648;
constexpr int XCH_OFF = 131072, GT_OFF = 131072 + 8192;
constexpr int MISC_OFF = LDS_BYTES - 64;
constexpr int KP = 272, VP = 320;

__device__ __forceinline__ unsigned cvtpk(float lo, float hi) { f32x2_t v = {lo, hi}; bf16x2_t b = __builtin_convertvector(v, bf16x2_t); return __builtin_bit_cast(unsigned, b); }
__device__ __forceinline__ float wave_sum(float v) {
    v += pg8::shx<1>(v); v += pg8::shx<2>(v); v += pg8::shx<4>(v); v += pg8::shx<8>(v); v += pg8::shx<16>(v); v = pg8::sum_halves(v);
    return v;
}
__device__ __forceinline__ float wave_max(float v) {
    v = fmaxf(v, pg8::shx<1>(v)); v = fmaxf(v, pg8::shx<2>(v)); v = fmaxf(v, pg8::shx<4>(v)); v = fmaxf(v, pg8::shx<8>(v)); v = fmaxf(v, pg8::shx<16>(v)); v = pg8::max_halves(v);
    return v;
}
__device__ __forceinline__ float absmax_vec(const float* g, int n, int lane) {
    float v = fabsf(g[lane]); if (n > 64) v = fmaxf(v, fabsf(g[lane + 64]));
    return wave_max(v);
}

__device__ __forceinline__ void tr_item(const float* W, int N, int k0, int n0, bf16* WT, int dst_pitch, int dst_row0, int dst_k0, int ncopies, int copy_stride, LAS float* scr, int lane) {
#pragma unroll 8
    for (int i = 0; i < 32; ++i) { const int kk = 2 * i + (lane >> 5); scr[kk * 33 + (lane & 31)] = __builtin_nontemporal_load(W + (size_t)(k0 + kk) * N + n0 + (lane & 31)); }
    asm volatile("s_waitcnt lgkmcnt(0)" ::: "memory");
    const int c = lane & 7;
#pragma unroll
    for (int j = 0; j < 4; ++j) { const int n = (lane >> 3) + 8 * j; const LAS float* s = scr + (8 * c) * 33 + n;
        u32x4 o; o.x = cvtpk(s[0 * 33], s[1 * 33]); o.y = cvtpk(s[2 * 33], s[3 * 33]); o.z = cvtpk(s[4 * 33], s[5 * 33]); o.w = cvtpk(s[6 * 33], s[7 * 33]);
        bf16* dst = WT + (size_t)(dst_row0 + n0 + n) * dst_pitch + dst_k0 + k0 + 8 * c;
        for (int cp = 0; cp < ncopies; ++cp) *(u32x4*)(dst + (size_t)cp * copy_stride) = o; }
    asm volatile("s_waitcnt lgkmcnt(0)" ::: "memory");
}
__device__ __forceinline__ void rms_row_to_bf16(const float* xrow, const float* gain, bf16* orow, int lane) {
    const f32x4* xr = (const f32x4*)xrow + lane; const f32x4* gr = (const f32x4*)gain + lane;
    f32x4 v[4]; float s = 0.f;
#pragma unroll
    for (int j = 0; j < 4; ++j) { v[j] = xr[64 * j]; s += (v[j][0] * v[j][0] + v[j][1] * v[j][1]) + (v[j][2] * v[j][2] + v[j][3] * v[j][3]); }
    const float rstd = 1.f / sqrtf(wave_sum(s) * (1.f / 1024.f) + EPS);
    u32x2* o8 = (u32x2*)orow + lane;
#pragma unroll
    for (int j = 0; j < 4; ++j) { const f32x4 g = gr[64 * j]; u32x2 w; w.x = cvtpk(v[j][0] * rstd * g[0], v[j][1] * rstd * g[1]); w.y = cvtpk(v[j][2] * rstd * g[2], v[j][3] * rstd * g[3]); o8[64 * j] = w; }
}

__device__ __forceinline__ s16x4 vtr(const LAS char* p) { return __builtin_bit_cast(s16x4, __builtin_amdgcn_ds_read_tr16_b64_v4i16((LAS v4i16_t*)p)); }

template <int NK>
__device__ __forceinline__ void qk32(f32x16& S, const LAS char* Kp, const bf16x8* Q, int ks0, int r32, int hi) {
    const LAS char* kb = Kp + r32 * KP + hi * 16 + ks0 * 32;
#pragma unroll
    for (int ks = 0; ks < NK; ++ks) { const bf16x8 kf = *(const LAS bf16x8*)(kb + ks * 32); S = __builtin_amdgcn_mfma_f32_32x32x16_bf16(kf, Q[ks0 + ks], S, 0, 0, 0); }
}
__device__ __forceinline__ void pv32(f32x16 (&O)[4], const bf16x8 (&P)[2], const LAS char* Vp, int lane) {
    const int i = lane & 15, q = i >> 2, p = i & 3, dsel = (lane >> 4) & 1, h = lane >> 5;
    const LAS char* vb = Vp + (4 * h + q) * VP + (16 * dsel + 4 * p) * 2;
#pragma unroll
    for (int s = 0; s < 2; ++s)
#pragma unroll
        for (int db = 0; db < 4; ++db) {
            const s16x4 lo = vtr(vb + (16 * s) * VP + db * 64), hi4 = vtr(vb + (16 * s + 8) * VP + db * 64);
            const bf16x8 a = (bf16x8){lo[0], lo[1], lo[2], lo[3], hi4[0], hi4[1], hi4[2], hi4[3]};
            O[db] = __builtin_amdgcn_mfma_f32_32x32x16_bf16(a, P[s], O[db], 0, 0, 0);
        }
}
struct VFrag { bf16x8 a[2][4]; };
__device__ __forceinline__ void vload32(VFrag& f, const LAS char* Vp, int lane) {
    const int i = lane & 15, q = i >> 2, p = i & 3, dsel = (lane >> 4) & 1, h = lane >> 5;
    const LAS char* vb = Vp + (4 * h + q) * VP + (16 * dsel + 4 * p) * 2;
#pragma unroll
    for (int s = 0; s < 2; ++s)
#pragma unroll
        for (int db = 0; db < 4; ++db) { const s16x4 lo = vtr(vb + (16 * s) * VP + db * 64), hi4 = vtr(vb + (16 * s + 8) * VP + db * 64);
            f.a[s][db] = (bf16x8){lo[0], lo[1], lo[2], lo[3], hi4[0], hi4[1], hi4[2], hi4[3]}; }
}
template <int SS>
__device__ __forceinline__ void vload16(VFrag& f, const LAS char* Vp, int lane) {
    const int i = lane & 15, q = i >> 2, p = i & 3, dsel = (lane >> 4) & 1, h = lane >> 5;
    const LAS char* vb = Vp + (4 * h + q) * VP + (16 * dsel + 4 * p) * 2;
#pragma unroll
    for (int db = 0; db < 4; ++db) { const s16x4 lo = vtr(vb + (16 * SS) * VP + db * 64), hi4 = vtr(vb + (16 * SS + 8) * VP + db * 64);
        f.a[SS][db] = (bf16x8){lo[0], lo[1], lo[2], lo[3], hi4[0], hi4[1], hi4[2], hi4[3]}; }
}
__device__ __forceinline__ void pvmm32(f32x16 (&O)[4], const bf16x8 (&P)[2], const VFrag& f) {
#pragma unroll
    for (int s = 0; s < 2; ++s)
#pragma unroll
        for (int db = 0; db < 4; ++db) O[db] = __builtin_amdgcn_mfma_f32_32x32x16_bf16(f.a[s][db], P[s], O[db], 0, 0, 0);
}
template <int NK>
__device__ __forceinline__ void kload32(bf16x8 (&kf)[NK], const LAS char* Kp, int r32, int hi) {
    const LAS char* kb = Kp + r32 * KP + hi * 16;
#pragma unroll
    for (int ks = 0; ks < NK; ++ks) kf[ks] = *(const LAS bf16x8*)(kb + ks * 32);
}
template <int NK>
__device__ __forceinline__ void qkmm32(f32x16& S, const bf16x8 (&kf)[NK], const bf16x8* Q) {
#pragma unroll
    for (int ks = 0; ks < NK; ++ks) S = __builtin_amdgcn_mfma_f32_32x32x16_bf16(kf[ks], Q[ks], S, 0, 0, 0);
}
#define SCHED_FENCE() __builtin_amdgcn_sched_barrier(0)
template <int MODE>
__device__ __forceinline__ void soft32(const f32x16& S, bf16x8 (&P)[2], float& l, float dbase, float nslope) {
    float p[16];
#pragma unroll
    for (int r = 0; r < 16; ++r) {
        float s = S[r];
        if (MODE >= 1) { const float a = fabsf(dbase - (float)((r & 3) + 8 * (r >> 2))); s = fmaf(nslope, a, s); float e = __builtin_amdgcn_exp2f(s); if (MODE == 2) e = (a <= 64.f) ? e : 0.f; p[r] = e; }
        else p[r] = __builtin_amdgcn_exp2f(s);
        l += p[r];
    }
#pragma unroll
    for (int s = 0; s < 2; ++s) { u32x4 w; w.x = cvtpk(p[8 * s + 0], p[8 * s + 1]); w.y = cvtpk(p[8 * s + 2], p[8 * s + 3]); w.z = cvtpk(p[8 * s + 4], p[8 * s + 5]); w.w = cvtpk(p[8 * s + 6], p[8 * s + 7]); P[s] = __builtin_bit_cast(bf16x8, w); }
}
__device__ __forceinline__ void zero16(f32x16& v) {
#pragma unroll
    for (int r = 0; r < 16; ++r) v[r] = 0.f;
}

__device__ __forceinline__ void stage_put(LAS char* wl, int r32, int hi2, int db, int g4, u32x2 w) { *(LAS u32x2*)(wl + r32 * 272 + (32 * db + 8 * g4 + 4 * hi2) * 2) = w; }
__device__ __forceinline__ void stage_flush(const LAS char* wl, bf16* qbase, size_t row_stride, int lane) {
    asm volatile("s_waitcnt lgkmcnt(0)" ::: "memory");
#pragma unroll
    for (int i = 0; i < 8; ++i) { const int row = 4 * i + (lane >> 4); const u32x4 v = *(const LAS u32x4*)(wl + row * 272 + (lane & 15) * 16);
        *(u32x4*)(qbase + (size_t)row * row_stride + (lane & 15) * 8) = v; }
}
template <int NC, bool DIAG>
__device__ __forceinline__ void attn_tile(f32x16 (&O)[4], float& l, const bf16x8* Q, const LAS char* Kb, const LAS char* Vb, int r32, int hi, int lane, float qd, int k0, int qw, float nslope, float negM0) {
    constexpr int NQ = (NC == 2) ? 4 : 8;
    f32x16 S0, S1; bf16x8 P0[2], P1[2];
    const int k1 = k0 + 32;
    if (NC == 2) {
        const float ns0 = (k0 < qw) ? nslope : ((k0 > qw) ? -nslope : 0.f), ns1 = (k1 < qw) ? nslope : ((k1 > qw) ? -nslope : 0.f);
        const float b0 = fmaf(ns0, qd - (float)k0, negM0), b1 = fmaf(ns1, qd - (float)k1, negM0);
#pragma unroll
        for (int r = 0; r < 16; ++r) { S0[r] = fmaf(-ns0, (float)((r & 3) + 8 * (r >> 2)), b0); S1[r] = fmaf(-ns1, (float)((r & 3) + 8 * (r >> 2)), b1); }
    } else {
#pragma unroll
        for (int r = 0; r < 16; ++r) { S0[r] = negM0; S1[r] = negM0; }
    }
    VFrag vf0, vf1;
    if (NC == 2) {
        bf16x8 kf0[NQ], kf1[NQ];
        kload32<NQ>(kf0, Kb, r32, hi);
        SCHED_FENCE();
        qkmm32<NQ>(S0, kf0, Q);
        kload32<NQ>(kf1, Kb + 32 * KP, r32, hi);
        vload16<0>(vf0, Vb, lane);
        SCHED_FENCE();
        qkmm32<NQ>(S1, kf1, Q);
        if (DIAG) { const float nd = (k0 == qw) ? nslope : 0.f;
#pragma unroll
            for (int r = 0; r < 16; ++r) S0[r] = fmaf(nd, fabsf(qd - (float)k0 - (float)((r & 3) + 8 * (r >> 2))), S0[r]); }
        soft32<0>(S0, P0, l, 0.f, 0.f);
        vload16<1>(vf0, Vb, lane);
        SCHED_FENCE();
    } else {
        bf16x8 kf[NQ];
        kload32<NQ>(kf, Kb, r32, hi);
        SCHED_FENCE();
        qkmm32<NQ>(S0, kf, Q);
        kload32<NQ>(kf, Kb + 32 * KP, r32, hi);
        vload32(vf0, Vb, lane);
        SCHED_FENCE();
        qkmm32<NQ>(S1, kf, Q);
        soft32<0>(S0, P0, l, 0.f, 0.f);
        SCHED_FENCE();
    }
    pvmm32(O, P0, vf0);
    if (NC == 2 && DIAG) { const float nd = (k1 == qw) ? nslope : 0.f;
#pragma unroll
        for (int r = 0; r < 16; ++r) S1[r] = fmaf(nd, fabsf(qd - (float)k1 - (float)((r & 3) + 8 * (r >> 2))), S1[r]); }
    soft32<0>(S1, P1, l, 0.f, 0.f);
    if (NC == 2) {
    vload16<0>(vf1, Vb + 32 * VP, lane);
    SCHED_FENCE();
    vload16<1>(vf1, Vb + 32 * VP, lane);
    } else {
    vload32(vf1, Vb + 32 * VP, lane);
    SCHED_FENCE();
    }
    pvmm32(O, P1, vf1);
}

template <int NC>
__device__ __forceinline__ void attn_shared_unit(LAS char* lds, bf16* qbase, const bf16* Kg, const bf16* Vg, int kvp, int nt, int qpos, int qw, float nslope, float negM0, float lam, const float* subln, int wave_id) {
    const int wv = wave_id, tid = pg8::tid_fresh(wave_id);
    const int lane = tid & 63, r32 = lane & 31, hi = lane >> 5;
    const int cm = (NC == 2) ? (wv & 1) : 0;
    constexpr int NQ = (NC == 2) ? 4 : 8;
    bf16x8 Q[NQ];
    { const bf16* qrow0 = qbase + (size_t)r32 * LDQ;
#pragma unroll
    for (int ks = 0; ks < NQ; ++ks) Q[ks] = *(const bf16x8*)(qrow0 + cm * 64 + 16 * ks + 8 * hi); }
    f32x16 O[4]; float l = 0.f;
#pragma unroll
    for (int db = 0; db < 4; ++db) zero16(O[db]);
    const int lrow = tid >> 3, lcb = (tid & 7) * 32;
    const char* kgp = (const char*)(Kg + (size_t)lrow * kvp) + lcb; const char* vgp = (const char*)(Vg + (size_t)lrow * kvp) + lcb;
    const size_t tstep = (size_t)64 * kvp * 2;
    u32x4 ka0, ka1, va0, va1, kb0, kb1, vb0, vb1;
#define LOADA(tt) do { const char* kp_ = kgp + (size_t)(tt) * tstep; const char* vp_ = vgp + (size_t)(tt) * tstep; ka0 = *(const u32x4*)kp_; ka1 = *(const u32x4*)(kp_ + 16); va0 = *(const u32x4*)vp_; va1 = *(const u32x4*)(vp_ + 16); } while (0)
#define LOADB(tt) do { const char* kp_ = kgp + (size_t)(tt) * tstep; const char* vp_ = vgp + (size_t)(tt) * tstep; kb0 = *(const u32x4*)kp_; kb1 = *(const u32x4*)(kp_ + 16); vb0 = *(const u32x4*)vp_; vb1 = *(const u32x4*)(vp_ + 16); } while (0)
#define WRITEA(buf) do { LAS char* kw_ = lds + (buf) * BUFB + lrow * KP + lcb; LAS char* vw_ = lds + (buf) * BUFB + 64 * KP + lrow * VP + lcb; *(LAS u32x4*)kw_ = ka0; *(LAS u32x4*)(kw_ + 16) = ka1; *(LAS u32x4*)vw_ = va0; *(LAS u32x4*)(vw_ + 16) = va1; } while (0)
#define WRITEB(buf) do { LAS char* kw_ = lds + (buf) * BUFB + lrow * KP + lcb; LAS char* vw_ = lds + (buf) * BUFB + 64 * KP + lrow * VP + lcb; *(LAS u32x4*)kw_ = kb0; *(LAS u32x4*)(kw_ + 16) = kb1; *(LAS u32x4*)vw_ = vb0; *(LAS u32x4*)(vw_ + 16) = vb1; } while (0)
    constexpr int BUFB = 64 * KP + 64 * VP;
    const float qd = (float)(qpos - 4 * hi);
    const int td = qw >> 6;
    if (NC == 2) {
    const int qb0 = qw & ~127;
    const float dkf = 152.f / fmaxf(-nslope, 1e-6f);
    const int Dk = (dkf < 4096.f) ? (int)dkf + 1 : 4096;
    int t_lo = ((qb0 - Dk > 0) ? (qb0 - Dk) : 0) >> 6, t_hi = ((qb0 + 127 + Dk) >> 6) + 1;
    t_lo &= ~1; t_hi = (t_hi + 1) & ~1; if (t_hi > nt) t_hi = nt;
    LOADA(t_lo); LOADB(t_lo + 1);
    __syncthreads();
    WRITEA(0);
    __syncthreads();
#pragma unroll 1
    for (int t = t_lo; t < t_hi; t += 2) {
        {
            if (t + 2 < t_hi) LOADA(t + 2);
            int k0v = t * 64; asm volatile("" : "+s"(k0v));
            const LAS char* Kb = lds + cm * 128; const LAS char* Vb = lds + 64 * KP;
            if (t == td) attn_tile<NC, true>(O, l, Q, Kb, Vb, r32, hi, lane, qd, k0v, qw, nslope, negM0);
            else attn_tile<NC, false>(O, l, Q, Kb, Vb, r32, hi, lane, qd, k0v, qw, nslope, negM0);
            WRITEB(1);
            __syncthreads();
        }
        {
            if (t + 3 < t_hi) LOADB(t + 3);
            int k0v = (t + 1) * 64; asm volatile("" : "+s"(k0v));
            const LAS char* Kb = lds + BUFB + cm * 128; const LAS char* Vb = lds + BUFB + 64 * KP;
            if (t + 1 == td) attn_tile<NC, true>(O, l, Q, Kb, Vb, r32, hi, lane, qd, k0v, qw, nslope, negM0);
            else attn_tile<NC, false>(O, l, Q, Kb, Vb, r32, hi, lane, qd, k0v, qw, nslope, negM0);
            if (t + 2 < t_hi) WRITEA(0);
            __syncthreads();
        }
    }
    } else {
    LOADA(0);
    __syncthreads();
    WRITEA(0);
    __syncthreads();
#pragma unroll 1
    for (int t = 0; t < nt; ++t) {
        const bool more = (t + 1 < nt);
        if (more) LOADA(t + 1);
        int k0v = t * 64; asm volatile("" : "+s"(k0v));
        const LAS char* Kb = lds + (t & 1) * BUFB; const LAS char* Vb = lds + (t & 1) * BUFB + 64 * KP;
        attn_tile<NC, false>(O, l, Q, Kb, Vb, r32, hi, lane, qd, k0v, qw, nslope, negM0);
        if (more) WRITEA((t + 1) & 1);
        __syncthreads();
    }
    }
#undef LOADA
#undef LOADB
#undef WRITEA
#undef WRITEB
    const int lane2 = pg8::lane_id_fresh(), hi2 = lane2 >> 5;
    bf16* qrow = qbase + (size_t)(lane2 & 31) * LDQ;
    l = pg8::sum_halves(l);
    if (NC == 2) {
        LAS float* XO = (LAS float*)lds + (wv >> 1) * 4096 + lane2;
        if (cm == 1) { const float i2 = *(const LAS float*)(lds + (LDS_BYTES - 64 + 32)) * __builtin_amdgcn_rcpf(l);
#pragma unroll
            for (int db = 0; db < 4; ++db)
#pragma unroll
                for (int r = 0; r < 16; ++r) XO[(db * 16 + r) * 64] = O[db][r] * i2; }
        __syncthreads();
        if (cm == 0) {
            const float i1 = 1.f / l; float ss = 0.f;
#pragma unroll
            for (int db = 0; db < 4; ++db)
#pragma unroll
                for (int r = 0; r < 16; ++r) { const float o = O[db][r] * i1 - XO[(db * 16 + r) * 64]; O[db][r] = o; ss += o * o; }
            ss = pg8::sum_halves(ss);
            const float rstd = (1.f / sqrtf(ss * (1.f / 128.f) + EPS)) * 0.8f;
#pragma unroll
            for (int db = 0; db < 4; ++db)
#pragma unroll
                for (int g4 = 0; g4 < 4; ++g4) { const int d = 32 * db + 8 * g4 + 4 * hi2; const f32x4 gn = *(const f32x4*)(subln + d);
                    u32x2 w; w.x = cvtpk(O[db][4 * g4 + 0] * rstd * gn[0], O[db][4 * g4 + 1] * rstd * gn[1]); w.y = cvtpk(O[db][4 * g4 + 2] * rstd * gn[2], O[db][4 * g4 + 3] * rstd * gn[3]);
                    stage_put(lds + (wv >> 1) * 16384, lane2 & 31, hi2, db, g4, w); (void)d; }
            stage_flush(lds + (wv >> 1) * 16384, qbase, LDQ, lane2);
        }
    } else {
        const float i1 = 1.f / l;
#pragma unroll
        for (int db = 0; db < 4; ++db)
#pragma unroll
            for (int g4 = 0; g4 < 4; ++g4) { const int d = 32 * db + 8 * g4 + 4 * hi2;
                u32x2 w; w.x = cvtpk(O[db][4 * g4 + 0] * i1, O[db][4 * g4 + 1] * i1); w.y = cvtpk(O[db][4 * g4 + 2] * i1, O[db][4 * g4 + 3] * i1);
                stage_put(lds + wv * 8704, lane2 & 31, hi2, db, g4, w); (void)d; }
        stage_flush(lds + wv * 8704, qbase, LDQ, lane2);
    }
}

template <bool SEG2>
__device__ __forceinline__ void attn_b_block_unit(LAS char* lds, bf16* R, float* LB, int b, int g, int j, int res0, int q0, int dil, float nslope, float negM0, int wave_id) {
    const int tid = pg8::tid_fresh(wave_id), lane = tid & 63, r32 = lane & 31, hi = lane >> 5;
    const int sub_len = SEQ / dil, hcol = (g * 4 + j) * 128;
    const int wres = SEG2 ? res0 + (wave_id >> 2) : res0;
    const int qs = SEG2 ? 32 * (wave_id & 3) : q0 + 32 * wave_id;
    const size_t rowb = (size_t)b * SEQ;
    bf16x8 Q[8];
    { const bf16* qr = R + (rowb + (size_t)(qs + r32) * dil + wres) * LDQ + C_BQ + hcol;
#pragma unroll
      for (int ks = 0; ks < 8; ++ks) Q[ks] = *(const bf16x8*)(qr + 16 * ks + 8 * hi); }
    f32x16 O[4]; float l = 0.f;
#pragma unroll
    for (int db = 0; db < 4; ++db) zero16(O[db]);
    constexpr int TK = SEG2 ? 32 : 64;
    const int k_lo = SEG2 ? 0 : ((q0 - 64 > 0) ? q0 - 64 : 0), k_hi = SEG2 ? 128 : ((q0 + 320 < sub_len) ? q0 + 320 : sub_len);
    const int nsteps = (k_hi - k_lo) / TK;
    const int lrow = tid >> 3, lcb = (tid & 7) * 32;
    const int lres = SEG2 ? res0 + (lrow >> 5) : res0, lkey = SEG2 ? (lrow & 31) : lrow;
    const char* kg = (const char*)(R + (rowb + (size_t)(k_lo + lkey) * dil + lres) * LDQ + C_BK + hcol) + lcb;
    const size_t sstep = (size_t)TK * dil * LDQ * 2;
    constexpr int VOFF = (C_BV - C_BK) * 2, BUFB = 64 * KP + 64 * VP;
    u32x4 kr0, kr1, vr0, vr1;
    kr0 = *(const u32x4*)kg; kr1 = *(const u32x4*)(kg + 16); vr0 = *(const u32x4*)(kg + VOFF); vr1 = *(const u32x4*)(kg + VOFF + 16);
    __syncthreads();
    { LAS char* kw = lds + lrow * KP + lcb; LAS char* vw = lds + 64 * KP + lrow * VP + lcb;
      *(LAS u32x4*)kw = kr0; *(LAS u32x4*)(kw + 16) = kr1; *(LAS u32x4*)vw = vr0; *(LAS u32x4*)(vw + 16) = vr1; }
    __syncthreads();
    const float qf = (float)(qs + r32 - 4 * hi);
#pragma unroll 1
    for (int s = 0; s < nsteps; ++s) {
        const bool more = (s + 1 < nsteps);
        if (more) { const char* kp = kg + (size_t)(s + 1) * sstep; kr0 = *(const u32x4*)kp; kr1 = *(const u32x4*)(kp + 16); vr0 = *(const u32x4*)(kp + VOFF); vr1 = *(const u32x4*)(kp + VOFF + 16); }
        const int kb = k_lo + s * TK;
        const LAS char* Kb = lds + (s & 1) * BUFB; const LAS char* Vb = Kb + 64 * KP;
#pragma unroll
        for (int hh = 0; hh < (SEG2 ? 1 : 2); ++hh) {
            const int row0 = SEG2 ? 32 * (wave_id >> 2) : 32 * hh, kbase = SEG2 ? kb : kb + 32 * hh;
            if (kbase + 31 >= qs - 64 && kbase <= qs + 95) {
                f32x16 S;
#pragma unroll
                for (int r = 0; r < 16; ++r) S[r] = negM0;
                qk32<8>(S, Kb + row0 * KP, Q, 0, r32, hi);
                bf16x8 P[2];
                soft32<2>(S, P, l, qf - (float)kbase, nslope);
                pv32(O, P, Vb + row0 * VP, lane);
            }
        }
        if (more) { LAS char* kw = lds + ((s + 1) & 1) * BUFB + lrow * KP + lcb; LAS char* vw = lds + ((s + 1) & 1) * BUFB + 64 * KP + lrow * VP + lcb;
            *(LAS u32x4*)kw = kr0; *(LAS u32x4*)(kw + 16) = kr1; *(LAS u32x4*)vw = vr0; *(LAS u32x4*)(vw + 16) = vr1; }
        __syncthreads();
    }
    const int lane2 = pg8::lane_id_fresh(), hi2 = lane2 >> 5;
    const size_t qrow_i = rowb + (size_t)(qs + (lane2 & 31)) * dil + wres;
    bf16* qrow = R + qrow_i * LDQ + C_BQ + hcol;
    l = pg8::sum_halves(l);
    const float i1 = 1.f / l;
#pragma unroll
    for (int db = 0; db < 4; ++db)
#pragma unroll
        for (int g4 = 0; g4 < 4; ++g4) { const int d = 32 * db + 8 * g4 + 4 * hi2;
            u32x2 w; w.x = cvtpk(O[db][4 * g4 + 0] * i1, O[db][4 * g4 + 1] * i1); w.y = cvtpk(O[db][4 * g4 + 2] * i1, O[db][4 * g4 + 3] * i1);
            stage_put(lds + wave_id * 8704, lane2 & 31, hi2, db, g4, w); (void)d; }
    stage_flush(lds + wave_id * 8704, R + (rowb + (size_t)qs * dil + wres) * LDQ + C_BQ + hcol, (size_t)dil * LDQ, lane2);
    if (hi2 == 0) LB[((size_t)g * M + qrow_i) * 4 + j] = l;
}

#define XB_TMO      128
#define XB_XCNT(j)  (256  + 64 * (j))
#define XB_XSUB(j)  (1280 + 64 * (j))
#define XB_XGEN(j)  (2304 + 64 * (j))
#define XB_TOP      3328
#define XB_TOPGEN   3392
#define XCD_BAR_WORDS 3456
#define XB_SPIN_CAP (1u << 18)

__device__ __forceinline__ unsigned xb_ld(unsigned* p)              { return __hip_atomic_load(p, __ATOMIC_RELAXED, __HIP_MEMORY_SCOPE_AGENT); }
__device__ __forceinline__ unsigned xb_add(unsigned* p, unsigned v) { return __hip_atomic_fetch_add(p, v, __ATOMIC_RELAXED, __HIP_MEMORY_SCOPE_AGENT); }
__device__ __forceinline__ unsigned xb_xcc_id() { return (unsigned)__builtin_amdgcn_s_getreg((3 << 11) | 20) & 0xFu; }
#define XB_SPIN(cond, bar) do { unsigned _sp = 0; while (cond) { __builtin_amdgcn_s_sleep(1); \
    if ((++_sp & 255u) == 0u) { if (xb_ld(&(bar)[XB_TMO])) break; if (_sp > XB_SPIN_CAP) { atomicAdd(&(bar)[XB_TMO], 1u); break; } } } } while (0)

struct XcdBarrier {
    unsigned* bar; unsigned x;
    volatile LAS unsigned* st;
};

__device__ __forceinline__ XcdBarrier xcd_barrier_post(unsigned* bar, volatile LAS unsigned* st) {
    XcdBarrier b; b.bar = bar; b.x = xb_xcc_id(); b.st = st;
    if (threadIdx.x == 0) (void)xb_add(&bar[XB_XCNT(b.x)], 1u);
    return b;
}
__device__ __forceinline__ void xcd_barrier_complete(unsigned* bar, unsigned x, unsigned& nloc, unsigned& nx) {
    const unsigned G = gridDim.x * gridDim.y * gridDim.z;
    unsigned sum, cnt, mine, sp = 0u;
    for (;;) {
        sum = 0u; cnt = 0u; mine = 0u;
#pragma unroll
        for (unsigned j = 0; j < 16; ++j) { const unsigned c = xb_ld(&bar[XB_XCNT(j)]); sum += c; cnt += (c > 0u) ? 1u : 0u; mine = (j == x) ? c : mine; }
        if (sum == G) break;
        __builtin_amdgcn_s_sleep(1);
        if ((++sp & 255u) == 0u) { if (xb_ld(&bar[XB_TMO])) break; if (sp > XB_SPIN_CAP) { atomicAdd(&bar[XB_TMO], 1u); break; } }
    }
    nloc = mine > 0u ? mine : 1u; nx = cnt > 0u ? cnt : 1u;
}

__device__ __forceinline__ void xcd_barrier(const XcdBarrier& b, int wave_id) {
    asm volatile("s_waitcnt vmcnt(0)" ::: "memory");
    __syncthreads();
    if (pg8::tid_fresh(wave_id) == 0) {
        unsigned* bar = b.bar;
        __builtin_amdgcn_s_waitcnt(0);
        unsigned nloc = b.st[0], nx = b.st[1];
        if (nloc == 0u) { xcd_barrier_complete(bar, b.x, nloc, nx); b.st[0] = nloc; b.st[1] = nx; }
        const unsigned old = xb_add(&bar[XB_XSUB(b.x)], 1u);
        const unsigned gen = old / nloc;
        if (old + 1u == (gen + 1u) * nloc) {
            __builtin_amdgcn_fence(__ATOMIC_RELEASE, "agent");
            asm volatile("s_waitcnt vmcnt(0)" ::: "memory");
            const unsigned og = xb_add(&bar[XB_TOP], 1u);
            const unsigned tg = og / nx;
            if (og + 1u == (tg + 1u) * nx) xb_add(&bar[XB_TOPGEN], 1u);
            else XB_SPIN(xb_ld(&bar[XB_TOPGEN]) == tg, bar);
            __builtin_amdgcn_fence(__ATOMIC_ACQUIRE, "agent");
            xb_add(&bar[XB_XGEN(b.x)], 1u);
            asm volatile("s_waitcnt vmcnt(0)" ::: "memory");
        } else {
            XB_SPIN(xb_ld(&bar[XB_XGEN(b.x)]) == gen, bar);
            __builtin_amdgcn_fence(__ATOMIC_ACQUIRE, "agent");
            asm volatile("s_waitcnt vmcnt(0)" ::: "memory");
        }
    }
    __syncthreads();
}

struct Args { const float* in[25]; float* out; unsigned char* ws; };

__global__ void __launch_bounds__(512, 2) fwd_megakernel(Args a) {
    extern __shared__ __attribute__((aligned(16))) unsigned char lds_raw[];
    LAS unsigned char* lds = (LAS unsigned char*)lds_raw;
    cg::grid_group grid = cg::this_grid();
    const int wave = __builtin_amdgcn_readfirstlane((int)threadIdx.x >> 6);
#define FRESH_LANE const int lane = pg8::lane_id_fresh();
    const int G = gridDim.x, bid = blockIdx.x;
    const int gw = bid * 8 + wave, NGW = G * 8;
    unsigned char* ws = a.ws;
    const float* x = a.in[0]; const float* mem = a.in[1];
    bf16* W_IN = (bf16*)(ws + WS_WIN); bf16* W_G = (bf16*)(ws + WS_WG); bf16* W_MEM = (bf16*)(ws + WS_WMEM); bf16* W_BR = (bf16*)(ws + WS_WBR);
    bf16* W_OUT = (bf16*)(ws + WS_WOUT3); bf16* W_GU = (bf16*)(ws + WS_WGU); bf16* W_DN = (bf16*)(ws + WS_WDN);
    float* LB = (float*)(ws + WS_LB); bf16* R = (bf16*)(ws + WS_R);
    unsigned char* dob = (unsigned char*)a.out;
    bf16* XN = (bf16*)(dob + DO_XN); bf16* MN = (bf16*)(dob + DO_MN); bf16* CKV = (bf16*)(dob + DO_CKV);

    volatile LAS unsigned* MISC = (volatile LAS unsigned*)(lds + MISC_OFF);
    unsigned* barw = (unsigned*)(ws + WS_BAR);
    if (threadIdx.x < 16) MISC[threadIdx.x] = 0u;
    if (a.ws == nullptr) grid.sync();
    XcdBarrier bar = xcd_barrier_post(barw, MISC);
    __syncthreads();
    {
        FRESH_LANE
        LAS float* scr = (LAS float*)(lds + wave * 8704);
        constexpr int I_IN = 16 * (DIN / 32), I_MEM = 16 * (D / 32);
        for (int it = gw; it < I_IN + I_MEM; it += NGW) {
            int r = it;
            if (r < I_IN) { const int nb = DIN / 32; tr_item(a.in[3], DIN, 64 * (r / nb), 32 * (r % nb), W_IN, D, 0, 0, 1, 0, scr, lane); continue; } r -= I_IN;
            { const int nb = D / 32; tr_item(a.in[16], D, 64 * (r / nb), 32 * (r % nb), W_MEM, D, 0, 0, 1, 0, scr, lane); }
        }
        { float* SSQ0 = (float*)(ws + WS_SSQ); for (int i = gw * 64 + lane; i < M; i += NGW * 64) SSQ0[i] = 0.f; }
        for (int m0 = gw; m0 < M + MMEM; m0 += 3 * NGW) {
            f32x4 v[3][4]; float ssq[3];
#pragma unroll
            for (int q = 0; q < 3; ++q) { const int m = m0 + q * NGW; ssq[q] = 0.f;
                if (m < M + MMEM) { const f32x4* xr = (const f32x4*)((m < M) ? x + (size_t)m * D : mem + (size_t)(m - M) * D) + lane;
#pragma unroll
                    for (int j = 0; j < 4; ++j) v[q][j] = __builtin_nontemporal_load(xr + 64 * j); } }
#pragma unroll
            for (int q = 0; q < 3; ++q) { const int m = m0 + q * NGW;
                if (m < M + MMEM) {
                    float s = 0.f;
#pragma unroll
                    for (int j = 0; j < 4; ++j) s += (v[q][j][0] * v[q][j][0] + v[q][j][1] * v[q][j][1]) + (v[q][j][2] * v[q][j][2] + v[q][j][3] * v[q][j][3]);
                    const float rstd = 1.f / sqrtf(wave_sum(s) * (1.f / 1024.f) + EPS);
                    const f32x4* gr = (const f32x4*)((m < M) ? a.in[2] : a.in[15]) + lane;
                    u32x2* o8 = (u32x2*)((m < M) ? XN + (size_t)m * D : MN + (size_t)(m - M) * D) + lane;
#pragma unroll
                    for (int j = 0; j < 4; ++j) { const f32x4 gn = gr[64 * j]; u32x2 w; w.x = cvtpk(v[q][j][0] * rstd * gn[0], v[q][j][1] * rstd * gn[1]); w.y = cvtpk(v[q][j][2] * rstd * gn[2], v[q][j][3] * rstd * gn[3]); __builtin_nontemporal_store(w, o8 + 64 * j); }
                } }
        }
    }
    xcd_barrier(bar, wave);

    {
        LAS float* GT = (LAS float*)(lds + GT_OFF);
        { const int t2 = pg8::tid_fresh(wave);
          if (t2 < 64) { GT[t2] = a.in[6][t2]; GT[64 + t2] = a.in[7][t2]; }
          if (t2 < 128) { GT[128 + t2] = a.in[13][t2]; GT[256 + t2] = a.in[14][t2]; GT[384 + t2] = a.in[17][t2]; GT[512 + t2] = a.in[18][t2]; } }
        __syncthreads();
        { const pg8::EpiQKV E{R, LDQ, CKV, D, GT, (LAS float*)(lds + XCH_OFF)};
          pg8::Gemm g{XN, W_IN, M, DIN, D, D, MN, W_MEM, nullptr, nullptr}; pg8::DualOrder S; S.init(M, DIN, MMEM, D, G, bid);
          pg8::gemm_phase<pg8::EpiQKV, pg8::DualOrder, true, true>(lds, g, S, E, wave); }
        {
            constexpr int I_G = 16 * (3 * D / 32), I_BR = 8 * (D / 32), I_OUT = 16 * (D / 32), I_FF = 16 * (DFF / 32);
            constexpr int NREST = I_G + 3 * I_BR + I_OUT + 2 * I_FF;
            const int first = (G == 256) ? 160 : 0, nsl = G - first;
            if (bid >= first) {
                const int lane = pg8::lane_id_fresh();
                LAS float* scr = (LAS float*)(lds + wave * 8704);
                for (int it = (bid - first) * 8 + wave; it < NREST; it += nsl * 8) {
                    int r = it;
                    if (r < I_G) { const int nb = 3 * D / 32; tr_item(a.in[4], 3 * D, 64 * (r / nb), 32 * (r % nb), W_G, D, 0, 0, 1, 0, scr, lane); continue; } r -= I_G;
                    if (r < 3 * I_BR) { const int gI = r / I_BR, rr = r % I_BR, nb = D / 32; tr_item(a.in[19] + (size_t)gI * 512 * D, D, 64 * (rr / nb), 32 * (rr % nb), W_BR + (size_t)gI * D * 512, 512, 0, 0, 1, 0, scr, lane); continue; } r -= 3 * I_BR;
                    if (r < I_OUT) { const int nb = D / 32; tr_item(a.in[20], D, 64 * (r / nb), 32 * (r % nb), W_OUT, D, 0, 0, 1, 0, scr, lane); continue; } r -= I_OUT;
                    { const int s = r / I_FF, rr = r % I_FF, nb = DFF / 32; const int n0 = 32 * (rr % nb);
                      tr_item(a.in[22 + s], DFF, 64 * (rr / nb), n0, W_GU, D, 256 * (n0 / 128) + 128 * s + (n0 % 128) - n0, 0, 1, 0, scr, lane); }
                }
            }
        }
    }
    xcd_barrier(bar, wave);

    {
        FRESH_LANE
#define UNIFORM_F(v) __builtin_bit_cast(float, __builtin_amdgcn_readfirstlane(__builtin_bit_cast(int, (float)(v))))
        const float negM_a = UNIFORM_F(-8.f * absmax_vec(a.in[6], 64, lane) * absmax_vec(a.in[7], 64, lane) * L2E);
        const float lam = UNIFORM_F(expf(wave_sum(a.in[8][lane] * a.in[9][lane])) - expf(wave_sum(a.in[10][lane] * a.in[11][lane])) + 0.2f);
        *(LAS float*)(lds + (LDS_BYTES - 64 + 32)) = lam;
        for (int rr = 0; rr < (512 + G - 1) / G; ++rr) {
            int b, h, qblk;
            if (G == 256) {
                const int j = bid >> 3, i = j >> 1; b = bid & 7;
                if ((j & 1) == 0) { h = (rr == 0) ? 1 : 0; qblk = i; }
                else { const int n = 16 + 2 * i + rr; h = 1 + (n >> 4); qblk = n & 15; }
            } else { const int u = rr * G + bid; if (u >= 512) break; b = u >> 6; h = (u >> 4) & 3; qblk = u & 15; }
            const int ta_ = pg8::lane_id_fresh();
            const int qpos = qblk * 128 + (wave >> 1) * 32 + (ta_ & 31);
            bf16* qrow = R + ((size_t)b * SEQ + qblk * 128 + (wave >> 1) * 32) * LDQ + C_AQ + h * 128;
            const bf16* Kg = R + (size_t)b * SEQ * LDQ + C_AK + h * 128; const bf16* Vg = R + (size_t)b * SEQ * LDQ + C_AV + h * 128;
            const float nslope = -__builtin_amdgcn_exp2f(-2.f * (float)(h + 1)) * L2E;
            attn_shared_unit<2>((LAS char*)lds, qrow, Kg, Vg, LDQ, SEQ / 64, qpos, qblk * 128 + (wave >> 1) * 32, nslope, negM_a, lam, a.in[12], wave);
        }
        const int lnc_ = pg8::lane_id_fresh();
        const float negM_c = UNIFORM_F(-11.313708499f * absmax_vec(a.in[17], 128, lnc_) * absmax_vec(a.in[18], 128, lnc_) * L2E);
        for (int u = bid; u < 256; u += G) {
            const int b = u >> 5, h = (u >> 3) & 3, qblk = u & 7;
            const int tc_ = pg8::lane_id_fresh();
            const int qpos = qblk * 256 + wave * 32 + (tc_ & 31);
            bf16* qrow = R + ((size_t)b * SEQ + qblk * 256 + wave * 32) * LDQ + C_CQ + h * 128;
            const bf16* Kg = CKV + (size_t)b * NMEM * D + h * 128; const bf16* Vg = Kg + 512;
            attn_shared_unit<1>((LAS char*)lds, qrow, Kg, Vg, D, NMEM / 64, qpos, 0, 0.f, negM_c, 0.f, a.in[12], wave);
        }
        __syncthreads();
        { const int lnb_ = pg8::lane_id_fresh();
          const float negM_b = UNIFORM_F(-11.313708499f * absmax_vec(a.in[13], 128, lnb_) * absmax_vec(a.in[14], 128, lnb_) * L2E);
          const int jb = bid >> 3, heavy = jb & 1, xq = bid & 7, ib = jb >> 1;
          const int nbu = (G == 256) ? (heavy ? 2 : 4) : (768 + G - 1) / G;
          for (int rr = 0; rr < nbu; ++rr) {
              int u;
              if (G == 256) {
                  int s, loc;
                  if (rr < 2) { const int kb = (heavy ? 32 : 0) + 2 * ib + rr, st = kb >> 3; s = 3 * (st >> 1) + ((st & 1) ? ((xq < 4) ? 2 : 1) : 0); loc = kb & 7; }
                  else { const int ks = 2 * ib + (rr - 2); s = 3 * (ks >> 3) + ((xq < 4) ? 1 : 2); loc = ks & 7; }
                  u = (xq + 8 * s) * 8 + loc;
              }
              else { u = rr * G + bid; if (u >= 768) break; }
              const int sid = u >> 3, loc = u & 7, b = sid / 12, g = (sid % 12) >> 2, j = sid & 3;
              const float slope = __builtin_amdgcn_exp2f(-8.f * (float)(g * 4 + j + 1) / 12.f);
              if (g == 0) attn_b_block_unit<false>((LAS char*)lds, R, LB, b, g, j, 0, loc * 256, 1, -slope * L2E, negM_b, wave);
              else if (g == 1) attn_b_block_unit<false>((LAS char*)lds, R, LB, b, g, j, loc >> 1, (loc & 1) * 256, 4, -slope * 4.f * L2E, negM_b, wave);
              else attn_b_block_unit<true>((LAS char*)lds, R, LB, b, g, j, 2 * loc, 0, 16, -slope * 16.f * L2E, negM_b, wave);
          } }
    }
    xcd_barrier(bar, wave);

    { FRESH_LANE
    const int j = lane >> 4, d8 = (lane & 15) * 8;
    for (int m0 = gw; m0 < M; m0 += 4 * NGW) {
        u32x4 o0[4], o1[4], o2[4]; float l0[4], l1[4], l2[4];
#pragma unroll
        for (int q = 0; q < 4; ++q) { const int m = m0 + q * NGW;
            if (m < M) { const bf16* p0 = R + (size_t)m * LDQ + C_BQ + j * 128 + d8;
                o0[q] = *(const u32x4*)p0; o1[q] = *(const u32x4*)(p0 + 512); o2[q] = *(const u32x4*)(p0 + 1024);
                l0[q] = LB[((size_t)0 * M + m) * 4 + j]; l1[q] = LB[((size_t)1 * M + m) * 4 + j]; l2[q] = LB[((size_t)2 * M + m) * 4 + j]; } }
#pragma unroll
        for (int q = 0; q < 4; ++q) { const int m = m0 + q * NGW;
            if (m < M) {
                const float inv = 1.f / (l0[q] + l1[q] + l2[q]); const float w0 = l0[q] * inv, w1 = l1[q] * inv, w2 = l2[q] * inv;
                u32x4 w;
#pragma unroll
                for (int e = 0; e < 4; ++e) {
                    const float lo = w0 * pg8::bf_lo(o0[q][e]) + w1 * pg8::bf_lo(o1[q][e]) + w2 * pg8::bf_lo(o2[q][e]);
                    const float hi = w0 * pg8::bf_hi(o0[q][e]) + w1 * pg8::bf_hi(o1[q][e]) + w2 * pg8::bf_hi(o2[q][e]);
                    w[e] = cvtpk(lo, hi);
                }
                *(u32x4*)(R + (size_t)m * LDQ + C_BQ + j * 128 + d8) = w; } }
    } }
    {
        pg8::Gemm g{XN, W_G, M, 3 * D, D, D, nullptr, nullptr, nullptr, nullptr}; pg8::StaticOrder S; S.init(M, 3 * D, G, bid);
        pg8::EpiGate E{R + C_GATE, LDQ, a.in[5]};
        pg8::gemm_phase<pg8::EpiGate, pg8::StaticOrder, true, true>(lds, g, S, E, wave);
    }
    xcd_barrier(bar, wave);

    {
        pg8::Gemm g{R + C_AQ, W_BR, M, D, 512, LDQ, R + C_BQ, W_BR + (size_t)D * 512, R + C_CQ, W_BR + (size_t)2 * D * 512};
        pg8::RepeatOrder S; S.init(M, D, 3, G, bid);
        pg8::EpiBranch E{R + C_GATE, R + C_GATE, LDQ, D};
        pg8::gemm_phase<pg8::EpiBranch, pg8::RepeatOrder, true, true>(lds, g, S, E, wave);
    }
    xcd_barrier(bar, wave);

    {
        pg8::Gemm g{R + C_GATE, W_OUT, M, D, D, LDQ, nullptr, nullptr, nullptr, nullptr}; pg8::StaticOrder S; S.init(M, D, G, bid);
        pg8::EpiResidNorm E{x, a.out, D, a.in[21], R + C_H2, LDQ, (float*)(ws + WS_SSQ)};
        pg8::gemm_phase<pg8::EpiResidNorm, pg8::StaticOrder, true, true>(lds, g, S, E, wave);
    }
    xcd_barrier(bar, wave);

    {
        pg8::Gemm g{R + C_H2, W_GU, M, 2 * DFF, D, LDQ, nullptr, nullptr, nullptr, nullptr}; pg8::StaticOrder S; S.init(M, 2 * DFF, G, bid);
        pg8::EpiSwiGLU E{R + C_ACT, LDQ, (const float*)(ws + WS_SSQ)};
        pg8::gemm_phase<pg8::EpiSwiGLU, pg8::StaticOrder, true, true>(lds, g, S, E, wave);
        { constexpr int I_DN = (DFF / 64) * (D / 32);
          const int first = (G == 256) ? 128 : 0, nsl = G - first;
          if (bid >= first) { const int lane = pg8::lane_id_fresh(); LAS float* scr = (LAS float*)(lds + wave * 8704);
              for (int r = (bid - first) * 8 + wave; r < I_DN; r += nsl * 8) { const int nb = D / 32; tr_item(a.in[24], D, 64 * (r / nb), 32 * (r % nb), W_DN, DFF, 0, 0, 1, 0, scr, lane); } } }
    }
    xcd_barrier(bar, wave);

    {
        pg8::Gemm g{R + C_ACT, W_DN, M, D, DFF, LDQ, nullptr, nullptr, nullptr, nullptr}; pg8::StaticOrder S; S.init(M, D, G, bid);
        pg8::EpiResid E{a.out, a.out, D};
        pg8::gemm_phase<pg8::EpiResid, pg8::StaticOrder, true, true>(lds, g, S, E, wave);
    }
}

extern "C" void kernel_launch(void* const* d_in, const int* in_sizes, int n_in, void* d_out, int out_size, void* d_ws, size_t ws_size, hipStream_t stream) {
    static int grid = 0;
    if (grid == 0) {
        if (n_in != 25 || out_size != M * D || ws_size < WS_END) { fprintf(stderr, "kernel_launch: unexpected problem shape (n_in %d out %d ws %zu)\n", n_in, out_size, ws_size); grid = -1; return; }
        int dev = 0, cus = 0, per_cu = 0;
        hipGetDevice(&dev);
        hipDeviceGetAttribute(&cus, hipDeviceAttributeMultiprocessorCount, dev);
        if (hipFuncSetAttribute((const void*)fwd_megakernel, hipFuncAttributeMaxDynamicSharedMemorySize, LDS_BYTES) != hipSuccess) { fprintf(stderr, "kernel_launch: hipFuncSetAttribute failed\n"); }
        hipOccupancyMaxActiveBlocksPerMultiprocessor(&per_cu, (const void*)fwd_megakernel, 512, LDS_BYTES);
        (void)hipGetLastError();
        if (per_cu < 1) per_cu = 1;
        grid = cus;
        fprintf(stderr, "kernel_launch: cus %d per_cu %d grid %d\n", cus, per_cu, grid);
    }
    if (grid < 0) return;
    if (hipMemsetAsync((char*)d_ws + WS_BAR, 0, 16384, stream) != hipSuccess) { fprintf(stderr, "kernel_launch: memset of the barrier words failed\n"); return; }
    Args a{};
    for (int i = 0; i < 25; ++i) a.in[i] = (const float*)d_in[i];
    a.out = (float*)d_out; a.ws = (unsigned char*)d_ws;
    void* args[] = {&a};
    hipError_t e = hipLaunchCooperativeKernel((const void*)fwd_megakernel, dim3(grid), dim3(512), args, LDS_BYTES, stream);
    if (e != hipSuccess) fprintf(stderr, "cooperative launch failed: %s (grid %d)\n", hipGetErrorString(e), grid);
}
```
